# Optimizing an MI355X kernel written in HIP

```python
import math
import jax
import jax.numpy as jnp
from jax import lax
import numpy as np

D_MODEL = 1024
BATCH = 16
SEQ = 2048
DEPTH = 4

GRID_W = 64
CTX_LEN = 256

HEAD_DIM = 64
N_Q_HEADS = 8
N_KV_HEADS = 2
D_Q = N_Q_HEADS * HEAD_DIM
D_KV = N_KV_HEADS * HEAD_DIM
WINDOW = 128
ATTN_BLOCK = 128
ROPE_BASE = 10000.0

D_SSM = D_MODEL // 4
SSM_GROUP = 16
N_SSM_GROUPS = D_SSM // SSM_GROUP
SSM_STATE = 64

D_CONV = D_MODEL // 4
CONV_WIDTH = 3

N_BRANCH = 3
IN_SIZES = (D_SSM, D_CONV, D_CONV, D_CONV, D_Q, D_KV, D_KV, N_BRANCH * D_MODEL)
D_IN = sum(IN_SIZES)

N_EXPERTS = 32
TOP_K = 4
D_EXPERT = D_MODEL
SWIGLU_LIMIT = 7.0
SWIGLU_ALPHA = 1.702
MOE_BLOCK = 256

EPS = 1e-6

kernel_name = 'hybrid_s5_conv_swa_moe_dit'


def rms_norm(x, g):
    xf = x.astype(jnp.float32)
    y = xf * lax.rsqrt(jnp.mean(xf * xf, axis=-1, keepdims=True) + EPS)
    return (y * g.astype(jnp.float32)).astype(x.dtype)


def modulate(h, shift, scale):
    return h * (1.0 + scale) + shift


def softmax_with_sink(logits, sink):
    sink_col = jnp.broadcast_to(sink, logits.shape[:-1] + (1,))
    probs = jax.nn.softmax(jnp.concatenate([logits, sink_col], axis=-1), axis=-1)
    return probs[..., :-1]


def axial_rope(n_lat):
    rows = n_lat // GRID_W
    t = jnp.arange(rows * GRID_W)
    row = (t // GRID_W).astype(jnp.float32)
    col = (t % GRID_W).astype(jnp.float32)
    n_pairs = HEAD_DIM // 4
    inv_freq = ROPE_BASE ** (-jnp.arange(n_pairs, dtype=jnp.float32) / n_pairs)
    ang = jnp.concatenate([row[:, None] * inv_freq, col[:, None] * inv_freq], axis=-1)
    return jnp.cos(ang), jnp.sin(ang)


def apply_rope(x, cos, sin):
    xf = x.astype(jnp.float32)
    x1, x2 = jnp.split(xf, 2, axis=-1)
    c = cos[None, :, None, :]
    s = sin[None, :, None, :]
    return jnp.concatenate([x1 * c - x2 * s, x1 * s + x2 * c], axis=-1).astype(x.dtype)


def _linear_recurrence(left, right):
    a_l, b_l = left
    a_r, b_r = right
    return a_l * a_r, a_r * b_l + b_r


def s5_bidirectional(u_c, u_l, lam_re, lam_im, log_dt, b_re, b_im, c_re, c_im, d_skip):
    f32 = jnp.float32
    bsz, n_ctx, _ = u_c.shape
    n_lat = u_l.shape[1]
    n_tot = n_ctx + n_lat
    lam = lax.complex(lam_re.astype(f32), lam_im.astype(f32))
    dt = jnp.exp(log_dt.astype(f32))[..., None]
    lam_bar = jnp.exp(lam * dt)
    b_bar = ((lam_bar - 1.0) / lam)[..., None] * lax.complex(b_re.astype(f32), b_im.astype(f32))
    c_mat = lax.complex(c_re.astype(f32), c_im.astype(f32))
    seq_fwd = jnp.concatenate([u_c, u_l], axis=1)
    seq_bwd = jnp.concatenate([u_c[:, ::-1], u_l[:, ::-1]], axis=1)
    u = jnp.stack([seq_fwd, seq_bwd]).astype(f32).reshape(2, bsz, n_tot, N_SSM_GROUPS, SSM_GROUP)
    bu = jnp.einsum('zbtgh,zgph->zbtgp', u.astype(jnp.complex64), b_bar)
    a = jnp.broadcast_to(lam_bar[:, None, None], (2, 1, n_tot, N_SSM_GROUPS, SSM_STATE))
    _, states = lax.associative_scan(_linear_recurrence, (a, bu), axis=2)
    y = jnp.einsum('zbtgp,zghp->zbtgh', states, c_mat).real.reshape(2, bsz, n_tot, D_SSM)
    y_c = y[0, :, :n_ctx] + y[1, :, :n_ctx][:, ::-1]
    y_l = y[0, :, n_ctx:] + y[1, :, n_ctx:][:, ::-1]
    d = d_skip.astype(f32)
    out_c = (y_c + d * u_c.astype(f32)).astype(u_c.dtype)
    out_l = (y_l + d * u_l.astype(f32)).astype(u_l.dtype)
    return out_c, out_l


def short_conv_mixer(b_gate, c_gate, x_in, conv_w):
    z = c_gate * x_in
    taps = conv_w[:, None, :].astype(z.dtype)
    pad = CONV_WIDTH // 2
    zc = lax.conv_general_dilated(z, taps, window_strides=(1,), padding=[(pad, pad)],
                                  dimension_numbers=('NWC', 'WIO', 'NWC'),
                                  feature_group_count=D_CONV)
    return b_gate * zc


def context_attention(q_c, k_c, v_c, sinks):
    bsz, n_ctx = q_c.shape[:2]
    rep = N_Q_HEADS // N_KV_HEADS
    q = q_c.reshape(bsz, n_ctx, N_KV_HEADS, rep, HEAD_DIM)
    s = jnp.einsum('blgrd,bmgd->bgrlm', q, k_c).astype(jnp.float32) * HEAD_DIM ** -0.5
    p = softmax_with_sink(s, sinks.astype(jnp.float32).reshape(1, N_KV_HEADS, rep, 1, 1))
    o = jnp.einsum('bgrlm,bmgd->blgrd', p.astype(v_c.dtype), v_c)
    return o.reshape(bsz, n_ctx, D_Q)


def windowed_latent_attention(q_l, k_l, v_l, k_c, v_c, sinks):
    bsz, n_lat = q_l.shape[:2]
    rep = N_Q_HEADS // N_KV_HEADS
    blk = ATTN_BLOCK
    nb = n_lat // blk
    scale = HEAD_DIM ** -0.5
    sink = sinks.astype(jnp.float32).reshape(1, N_KV_HEADS, rep, 1, 1)

    def band(t):
        tp = jnp.pad(t, ((0, 0), (blk, blk), (0, 0), (0, 0))).reshape(bsz, nb + 2, blk, N_KV_HEADS, HEAD_DIM)
        tb = jnp.concatenate([tp[:, :-2], tp[:, 1:-1], tp[:, 2:]], axis=2)
        return jnp.moveaxis(tb, 1, 0)

    q_blocks = jnp.moveaxis(q_l.reshape(bsz, nb, blk, N_KV_HEADS, rep, HEAD_DIM), 1, 0)
    k_band = band(k_l)
    v_band = band(v_l)
    q_pos = jnp.arange(nb)[:, None] * blk + jnp.arange(blk)[None, :]
    k_pos = (jnp.arange(nb)[:, None] - 1) * blk + jnp.arange(3 * blk)[None, :]
    valid = ((jnp.abs(q_pos[:, :, None] - k_pos[:, None, :]) <= WINDOW)
             & (k_pos[:, None, :] >= 0) & (k_pos[:, None, :] < n_lat))

    def one_block(args):
        q, k, v, m = args
        s_loc = jnp.einsum('bqgrd,bkgd->bgrqk', q, k).astype(jnp.float32) * scale
        s_loc = jnp.where(m, s_loc, -jnp.inf)
        s_ctx = jnp.einsum('bqgrd,bmgd->bgrqm', q, k_c).astype(jnp.float32) * scale
        p = softmax_with_sink(jnp.concatenate([s_loc, s_ctx], axis=-1), sink).astype(v.dtype)
        return (jnp.einsum('bgrqk,bkgd->bqgrd', p[..., :3 * blk], v)
                + jnp.einsum('bgrqm,bmgd->bqgrd', p[..., 3 * blk:], v_c))

    o = lax.map(one_block, (q_blocks, k_band, v_band, valid))
    return jnp.moveaxis(o, 0, 1).reshape(bsz, n_lat, D_Q)


def branch_merge(y_ssm, y_conv, y_attn, gate_logits, p):
    z = jax.nn.gelu(y_ssm)
    br_ssm = (z * jax.nn.sigmoid(z @ p['w_glu'])) @ p['w_ssm_out']
    br_conv = y_conv @ p['w_conv_out']
    br_attn = y_attn @ p['w_attn_out']
    g_ssm, g_conv, g_attn = jnp.split(jax.nn.sigmoid(gate_logits), N_BRANCH, axis=-1)
    return (g_ssm * br_ssm + g_conv * br_conv + g_attn * br_attn) @ p['w_o']


def hybrid_mixer(h_c, h_l, p, with_ctx_out):
    splits = np.cumsum(IN_SIZES)[:-1].tolist()
    u_c, cb_c, cc_c, cx_c, q_c, k_c, v_c, gt_c = jnp.split(h_c @ p['w_in'], splits, axis=-1)
    u_l, cb_l, cc_l, cx_l, q_l, k_l, v_l, gt_l = jnp.split(h_l @ p['w_in'], splits, axis=-1)
    n_lat = h_l.shape[1]

    ys_c, ys_l = s5_bidirectional(u_c, u_l, p['ssm_lam_re'], p['ssm_lam_im'], p['ssm_log_dt'],
                                  p['ssm_b_re'], p['ssm_b_im'], p['ssm_c_re'], p['ssm_c_im'], p['ssm_d'])

    def heads(t, n):
        return t.reshape(t.shape[:2] + (n, HEAD_DIM))
    kh_c = rms_norm(heads(k_c, N_KV_HEADS), p['k_norm_g'])
    vh_c = heads(v_c, N_KV_HEADS)
    cos, sin = axial_rope(n_lat)
    qh_l = apply_rope(rms_norm(heads(q_l, N_Q_HEADS), p['q_norm_g']), cos, sin)
    kh_l = apply_rope(rms_norm(heads(k_l, N_KV_HEADS), p['k_norm_g']), cos, sin)
    vh_l = heads(v_l, N_KV_HEADS)
    ya_l = windowed_latent_attention(qh_l, kh_l, vh_l, kh_c, vh_c, p['attn_sinks'])

    yb_l = short_conv_mixer(cb_l, cc_l, cx_l, p['conv_w'])
    out_l = branch_merge(ys_l, yb_l, ya_l, gt_l, p)

    out_c = None
    if with_ctx_out:
        qh_c = rms_norm(heads(q_c, N_Q_HEADS), p['q_norm_g'])
        ya_c = context_attention(qh_c, kh_c, vh_c, p['attn_sinks'])
        yb_c = short_conv_mixer(cb_c, cc_c, cx_c, p['conv_w'])
        out_c = branch_merge(ys_c, yb_c, ya_c, gt_c, p)
    return out_c, out_l


def moe_ffn(h, w_router, b_router, w_gu, b_gu, w_down, b_down):
    n_tok, d = h.shape
    logits = (h @ w_router).astype(jnp.float32) + b_router.astype(jnp.float32)
    top_val, top_idx = lax.top_k(logits, TOP_K)
    gates = jax.nn.softmax(top_val, axis=-1)
    n_assign = n_tok * TOP_K
    flat_e = top_idx.reshape(-1)
    order = jnp.argsort(flat_e)
    sorted_e = flat_e[order]
    sorted_tok = (order // TOP_K).astype(jnp.int32)
    counts = jnp.zeros((N_EXPERTS,), jnp.int32).at[flat_e].add(1)
    padded = (counts + MOE_BLOCK - 1) // MOE_BLOCK * MOE_BLOCK
    pad_end = jnp.cumsum(padded)
    pad_start = pad_end - padded
    start = jnp.cumsum(counts) - counts
    slot = pad_start[sorted_e] + jnp.arange(n_assign, dtype=jnp.int32) - start[sorted_e]
    n_blocks = (n_assign + N_EXPERTS * (MOE_BLOCK - 1)) // MOE_BLOCK
    n_slots = n_blocks * MOE_BLOCK
    slot_tok = jnp.full((n_slots,), n_tok, jnp.int32).at[slot].set(sorted_tok)
    slot_gate = jnp.zeros((n_slots,), jnp.float32).at[slot].set(gates.reshape(-1)[order])
    block_expert = jnp.minimum(
        jnp.searchsorted(pad_end, jnp.arange(n_blocks, dtype=jnp.int32) * MOE_BLOCK, side='right'),
        N_EXPERTS - 1)
    h_pad = jnp.concatenate([h, jnp.zeros((1, d), h.dtype)], axis=0)

    def expert_block(args):
        tok, g, e = args
        gu = h_pad[tok] @ w_gu[e] + b_gu[e]
        glu = jnp.minimum(gu[:, 0::2], SWIGLU_LIMIT)
        up = jnp.clip(gu[:, 1::2], -SWIGLU_LIMIT, SWIGLU_LIMIT)
        act = glu * jax.nn.sigmoid(SWIGLU_ALPHA * glu) * (up + 1.0)
        y = act @ w_down[e] + b_down[e]
        return y * g[:, None].astype(y.dtype)

    ys = lax.map(expert_block, (slot_tok.reshape(n_blocks, MOE_BLOCK),
                                slot_gate.reshape(n_blocks, MOE_BLOCK), block_expert))
    out = jnp.zeros((n_tok + 1, d), ys.dtype).at[slot_tok].add(ys.reshape(n_slots, d))
    return out[:n_tok]


def hybrid_layer(x_c, x_l, c, c_ctx, p, with_ctx_out):
    mod_l = (jax.nn.silu(c) @ p['w_mod'] + p['b_mod'])[:, None, :]
    mod_c = (jax.nn.silu(c_ctx) @ p['w_mod'] + p['b_mod'])[None, None, :]
    sh1_l, sc1_l, g1_l, sh2_l, sc2_l, g2_l = jnp.split(mod_l, 6, axis=-1)
    sh1_c, sc1_c, g1_c, sh2_c, sc2_c, g2_c = jnp.split(mod_c, 6, axis=-1)
    h_l = modulate(rms_norm(x_l, p['norm1_g']), sh1_l, sc1_l)
    h_c = modulate(rms_norm(x_c, p['norm1_g']), sh1_c, sc1_c)
    mix_c, mix_l = hybrid_mixer(h_c, h_l, p, with_ctx_out)
    x_l = x_l + g1_l * mix_l
    h2_l = modulate(rms_norm(x_l, p['norm2_g']), sh2_l, sc2_l)
    if not with_ctx_out:
        y_l = moe_ffn(h2_l.reshape(-1, D_MODEL), p['w_router'], p['b_router'], p['w_gate_up'],
                      p['b_gate_up'], p['w_down'], p['b_down'])
        return x_c, x_l + g2_l * y_l.reshape(x_l.shape)
    x_c = x_c + g1_c * mix_c
    h2_c = modulate(rms_norm(x_c, p['norm2_g']), sh2_c, sc2_c)
    n_c = h2_c.shape[0] * h2_c.shape[1]
    tokens = jnp.concatenate([h2_c.reshape(-1, D_MODEL), h2_l.reshape(-1, D_MODEL)], axis=0)
    y = moe_ffn(tokens, p['w_router'], p['b_router'], p['w_gate_up'], p['b_gate_up'],
                p['w_down'], p['b_down'])
    x_c = x_c + g2_c * y[:n_c].reshape(x_c.shape)
    x_l = x_l + g2_l * y[n_c:].reshape(x_l.shape)
    return x_c, x_l


def setup_inputs(seed: int = 0) -> dict:
    key = jax.random.key(seed)
    ks = jax.random.split(key, 32)
    f32 = jnp.float32
    nl, d, g, st, gh = DEPTH, D_MODEL, N_SSM_GROUPS, SSM_STATE, SSM_GROUP

    def nrm(k, shape, scale):
        return jax.random.normal(k, shape, f32) * scale

    lam_im_init = jnp.pi * jnp.arange(st, dtype=f32)
    return {
        'x': nrm(ks[0], (BATCH, SEQ, d), 1.0),
        'c': nrm(ks[1], (BATCH, d), 1.0),
        'ctx': nrm(ks[2], (BATCH, CTX_LEN, d), 1.0),
        'c_ctx': nrm(ks[3], (d,), 1.0),
        'w_mod': nrm(ks[4], (nl, d, 6 * d), 0.5 * d ** -0.5),
        'b_mod': nrm(ks[5], (nl, 6 * d), 0.02),
        'norm1_g': 1.0 + nrm(ks[6], (nl, d), 0.05),
        'norm2_g': 1.0 + nrm(ks[7], (nl, d), 0.05),
        'w_in': nrm(ks[8], (nl, d, D_IN), d ** -0.5),
        'ssm_lam_re': -0.5 + nrm(ks[9], (nl, 2, g, st), 0.01),
        'ssm_lam_im': lam_im_init + nrm(ks[10], (nl, 2, g, st), 0.01),
        'ssm_log_dt': jax.random.uniform(ks[11], (nl, 2, g), f32, math.log(1e-3), math.log(1e-1)),
        'ssm_b_re': nrm(ks[12], (nl, 2, g, st, gh), (2 * gh) ** -0.5),
        'ssm_b_im': nrm(ks[13], (nl, 2, g, st, gh), (2 * gh) ** -0.5),
        'ssm_c_re': nrm(ks[14], (nl, 2, g, gh, st), st ** -0.5),
        'ssm_c_im': nrm(ks[15], (nl, 2, g, gh, st), st ** -0.5),
        'ssm_d': nrm(ks[16], (nl, D_SSM), 1.0),
        'w_glu': nrm(ks[17], (nl, D_SSM, D_SSM), D_SSM ** -0.5),
        'w_ssm_out': nrm(ks[18], (nl, D_SSM, d), D_SSM ** -0.5),
        'conv_w': nrm(ks[19], (nl, CONV_WIDTH, D_CONV), CONV_WIDTH ** -0.5),
        'w_conv_out': nrm(ks[20], (nl, D_CONV, d), D_CONV ** -0.5),
        'q_norm_g': 1.0 + nrm(ks[21], (nl, HEAD_DIM), 0.05),
        'k_norm_g': 1.0 + nrm(ks[22], (nl, HEAD_DIM), 0.05),
        'attn_sinks': nrm(ks[23], (nl, N_Q_HEADS), 1.0),
        'w_attn_out': nrm(ks[24], (nl, D_Q, d), D_Q ** -0.5),
        'w_o': nrm(ks[25], (nl, d, d), d ** -0.5),
        'w_router': nrm(ks[26], (nl, d, N_EXPERTS), d ** -0.5),
        'b_router': nrm(ks[27], (nl, N_EXPERTS), 0.01),
        'w_gate_up': nrm(ks[28], (nl, N_EXPERTS, d, 2 * D_EXPERT), d ** -0.5),
        'b_gate_up': nrm(ks[29], (nl, N_EXPERTS, 2 * D_EXPERT), 0.01),
        'w_down': nrm(ks[30], (nl, N_EXPERTS, D_EXPERT, d), D_EXPERT ** -0.5),
        'b_down': nrm(ks[31], (nl, N_EXPERTS, d), 0.01),
    }


def reference(x, c, ctx, c_ctx, w_mod, b_mod, norm1_g, norm2_g, w_in, ssm_lam_re, ssm_lam_im,
              ssm_log_dt, ssm_b_re, ssm_b_im, ssm_c_re, ssm_c_im, ssm_d, w_glu, w_ssm_out, conv_w,
              w_conv_out, q_norm_g, k_norm_g, attn_sinks, w_attn_out, w_o, w_router, b_router,
              w_gate_up, b_gate_up, w_down, b_down):
    x_c, x_l = ctx, x
    for l in range(DEPTH):
        p = {
            'w_mod': w_mod[l], 'b_mod': b_mod[l], 'norm1_g': norm1_g[l], 'norm2_g': norm2_g[l],
            'w_in': w_in[l],
            'ssm_lam_re': ssm_lam_re[l], 'ssm_lam_im': ssm_lam_im[l], 'ssm_log_dt': ssm_log_dt[l],
            'ssm_b_re': ssm_b_re[l], 'ssm_b_im': ssm_b_im[l], 'ssm_c_re': ssm_c_re[l],
            'ssm_c_im': ssm_c_im[l], 'ssm_d': ssm_d[l], 'w_glu': w_glu[l], 'w_ssm_out': w_ssm_out[l],
            'conv_w': conv_w[l], 'w_conv_out': w_conv_out[l],
            'q_norm_g': q_norm_g[l], 'k_norm_g': k_norm_g[l], 'attn_sinks': attn_sinks[l],
            'w_attn_out': w_attn_out[l], 'w_o': w_o[l],
            'w_router': w_router[l], 'b_router': b_router[l], 'w_gate_up': w_gate_up[l],
            'b_gate_up': b_gate_up[l], 'w_down': w_down[l], 'b_down': b_down[l],
        }
        x_c, x_l = hybrid_layer(x_c, x_l, c, c_ctx, p, l < DEPTH - 1)
    return x_l
```

```cpp
#include <hip/hip_runtime.h>
#include <cstdio>
#include <cstdint>
namespace pg8 {
#define PG8_LAS __attribute__((address_space(3)))
typedef unsigned short bf16_t;
typedef short bf16x8 __attribute__((ext_vector_type(8)));
typedef float f32x4 __attribute__((ext_vector_type(4)));
typedef unsigned u32x4 __attribute__((ext_vector_type(4)));
constexpr int BM = 256, BK = 64, HALF = 128, HTB = HALF * BK * 2  , STAGE_BYTES = 8 * HTB, NXCD = 8, WGM = 8;

__host__ __device__ __forceinline__ int lds_byte(int r, int c) { const int st = (r >> 4) * 2 + (c >> 5), rr = r & 15, cc = c & 31, ob = rr * 64 + cc * 2; return st * 1024 + (ob ^ (((ob >> 9) & 1) << 5)); }
__host__ __device__ __forceinline__ void stage_rc(int b, int& R, int& C) { const int st = b / 1024, sb = b % 1024, swz = sb ^ (((sb >> 9) & 1) << 5); R = (st >> 1) * 16 + swz / 64; C = (st & 1) * 32 + (swz % 64) / 2; }
__host__ __device__ __forceinline__ int perm32(int rho) { const int n = rho >> 4, i = rho & 15; return 8 * (i >> 2) + 4 * n + (i & 3); }

struct Unit { int pm, pn; };
struct Gemm { const bf16_t* A; const bf16_t* Bt; int M, N, K; };

struct StaticOrder {
    int nM, nN, nwg, G, c;
    __host__ __device__ void init(int M, int N, int G_, int c_) { nM = M / BM; nN = N / BM; nwg = nM * nN; G = G_; c = c_; }
    __host__ __device__ bool next(int i, Unit& u) const {
        const long L = (long)i * G + c; if (L >= nwg) return false;
        int wgid = (int)L; { const int q = nwg / NXCD, r = nwg % NXCD, xcd = wgid % NXCD, off = wgid / NXCD; wgid = (xcd < r ? xcd * (q + 1) : r * (q + 1) + (xcd - r) * q) + off; }
        const int nig = WGM * nN, gid = wgid / nig, fm = gid * WGM, gsz = (nM - fm) < WGM ? (nM - fm) : WGM;
        u.pm = fm + ((wgid % nig) % gsz); u.pn = (wgid % nig) / gsz; return true;
    }
    __device__ __forceinline__ void a_ready(const Unit&) const {}
    __device__ __forceinline__ void done(const Unit&) const {}
    __device__ __forceinline__ const char* aptr(const Gemm& g, const Unit& u, size_t tstep) const { return (const char*)g.A + (size_t)u.pm * tstep; }
    __device__ __forceinline__ const char* bptr(const Gemm& g, const Unit& u, size_t tstep) const { return (const char*)g.Bt + (size_t)u.pn * tstep; }
};

__device__ __forceinline__ unsigned cvt_pk_bf16(float lo, float hi) { unsigned r; asm volatile("v_cvt_pk_bf16_f32 %0, %1, %2" : "=v"(r) : "v"(lo), "v"(hi)); return r; }
__device__ __forceinline__ float bf_lo(unsigned w) { return __uint_as_float(w << 16); }
__device__ __forceinline__ float bf_hi(unsigned w) { return __uint_as_float(w & 0xffff0000u); }
__device__ __forceinline__ float sigm(float x) { return __builtin_amdgcn_rcpf(1.0f + __expf(-x)); }
#define PG8_FRESH_LANE() { unsigned z_ = 0u; asm volatile("" : "+s"(z_)); const int l_ = (int)__builtin_amdgcn_mbcnt_hi(~0u, __builtin_amdgcn_mbcnt_lo(~0u, z_)); fr = l_ & 15; fq = l_ >> 4; }

struct EpiPlain {
    static constexpr bool PERM = true, AFTER_DRAIN = false;
    bf16_t* O; int ldc;
    __device__ __forceinline__ void operator()(const f32x4 (&acc)[2][2][4][2], const Unit& u, int wr, int wc, int fr, int fq) const {
        PG8_FRESH_LANE();
        const int row0 = u.pm * BM + wr * 64 + fr, col0 = u.pn * BM + wc * 32 + 8 * fq;
#pragma unroll
        for (int ai = 0; ai < 2; ++ai)
#pragma unroll
            for (int m = 0; m < 4; ++m) { bf16_t* rowp = O + (size_t)(row0 + ai * HALF + m * 16) * ldc + col0;
#pragma unroll
                for (int bj = 0; bj < 2; ++bj) { const f32x4 v0 = acc[ai][bj][m][0], v1 = acc[ai][bj][m][1];
                    u32x4 w; w.x = cvt_pk_bf16(v0[0], v0[1]); w.y = cvt_pk_bf16(v0[2], v0[3]); w.z = cvt_pk_bf16(v1[0], v1[1]); w.w = cvt_pk_bf16(v1[2], v1[3]);
                    *(u32x4*)(rowp + bj * HALF) = w; } }
    }
};
struct EpiGlu {
    static constexpr bool PERM = true, AFTER_DRAIN = false;
    const bf16_t* Z; bf16_t* O; int ldc;
    __device__ __forceinline__ void operator()(const f32x4 (&acc)[2][2][4][2], const Unit& u, int wr, int wc, int fr, int fq) const {
        PG8_FRESH_LANE();
        const int row0 = u.pm * BM + wr * 64 + fr, col0 = u.pn * BM + wc * 32 + 8 * fq;
#pragma unroll
        for (int ai = 0; ai < 2; ++ai)
#pragma unroll
            for (int m = 0; m < 4; ++m) { const size_t off = (size_t)(row0 + ai * HALF + m * 16) * ldc + col0;
#pragma unroll
                for (int bj = 0; bj < 2; ++bj) { const f32x4 v0 = acc[ai][bj][m][0], v1 = acc[ai][bj][m][1];
                    const u32x4 z = *(const u32x4*)(Z + off + bj * HALF);
                    u32x4 w; w.x = cvt_pk_bf16(bf_lo(z.x) * sigm(v0[0]), bf_hi(z.x) * sigm(v0[1])); w.y = cvt_pk_bf16(bf_lo(z.y) * sigm(v0[2]), bf_hi(z.y) * sigm(v0[3]));
                    w.z = cvt_pk_bf16(bf_lo(z.z) * sigm(v1[0]), bf_hi(z.z) * sigm(v1[1])); w.w = cvt_pk_bf16(bf_lo(z.w) * sigm(v1[2]), bf_hi(z.w) * sigm(v1[3]));
                    *(u32x4*)(O + off + bj * HALF) = w; }
                asm volatile("" ::: "memory"); }
    }
};
template <bool FIRST> struct EpiBranch {
    static constexpr bool PERM = true, AFTER_DRAIN = false;
    const bf16_t* GT; int ldg; bf16_t* MM; int ldc;
    __device__ __forceinline__ void operator()(const f32x4 (&acc)[2][2][4][2], const Unit& u, int wr, int wc, int fr, int fq) const {
        PG8_FRESH_LANE();
        const unsigned row0 = u.pm * BM + wr * 64 + fr, col0 = u.pn * BM + wc * 32 + 8 * fq;
        unsigned goff = row0 * (unsigned)ldg + col0, moff = row0 * (unsigned)ldc + col0;
#pragma unroll
        for (int ai = 0; ai < 2; ++ai) {
#pragma unroll
            for (int m = 0; m < 4; ++m) {
#pragma unroll
                for (int bj = 0; bj < 2; ++bj) { const f32x4 v0 = acc[ai][bj][m][0], v1 = acc[ai][bj][m][1];
                    const u32x4 g = *(const u32x4*)(GT + goff + bj * HALF);
                    bf16_t* mp = MM + moff + bj * HALF;
                    float o[8];
                    o[0] = sigm(bf_lo(g.x)) * v0[0]; o[1] = sigm(bf_hi(g.x)) * v0[1]; o[2] = sigm(bf_lo(g.y)) * v0[2]; o[3] = sigm(bf_hi(g.y)) * v0[3];
                    o[4] = sigm(bf_lo(g.z)) * v1[0]; o[5] = sigm(bf_hi(g.z)) * v1[1]; o[6] = sigm(bf_lo(g.w)) * v1[2]; o[7] = sigm(bf_hi(g.w)) * v1[3];
                    if (!FIRST) { const u32x4 p = *(const u32x4*)mp;
                        o[0] += bf_lo(p.x); o[1] += bf_hi(p.x); o[2] += bf_lo(p.y); o[3] += bf_hi(p.y); o[4] += bf_lo(p.z); o[5] += bf_hi(p.z); o[6] += bf_lo(p.w); o[7] += bf_hi(p.w); }
                    u32x4 w; w.x = cvt_pk_bf16(o[0], o[1]); w.y = cvt_pk_bf16(o[2], o[3]); w.z = cvt_pk_bf16(o[4], o[5]); w.w = cvt_pk_bf16(o[6], o[7]);
                    *(u32x4*)mp = w;
                    asm volatile("" ::: "memory"); }
                goff += 16u * (unsigned)ldg; moff += 16u * (unsigned)ldc; }
            goff += 64u * (unsigned)ldg; moff += 64u * (unsigned)ldc; }
    }
};
struct EpiWo {
    static constexpr bool PERM = false, AFTER_DRAIN = false;
    float* X; const float* g1base;
    __device__ __forceinline__ void operator()(const f32x4 (&acc)[2][2][4][2], const Unit& u, int wr, int wc, int fr, int fq) const {
        PG8_FRESH_LANE();
        const int row0 = u.pm * BM + wr * 64 + fr, col0 = u.pn * BM + wc * 32 + 4 * fq;
        const int r = (u.pm % 9 == 0) ? 16 : u.pm / 9; const float* g1 = g1base + (size_t)r * 6144 + col0;
        f32x4 gv[2][2];
#pragma unroll
        for (int bj = 0; bj < 2; ++bj)
#pragma unroll
            for (int n = 0; n < 2; ++n) gv[bj][n] = *(const f32x4*)(g1 + bj * HALF + n * 16);
#pragma unroll
        for (int ai = 0; ai < 2; ++ai)
#pragma unroll
            for (int m = 0; m < 4; ++m) { float* rowp = X + (size_t)(row0 + ai * HALF + m * 16) * 1024 + col0;
#pragma unroll
                for (int bj = 0; bj < 2; ++bj)
#pragma unroll
                    for (int n = 0; n < 2; ++n) { f32x4* p = (f32x4*)(rowp + bj * HALF + n * 16); *p = *p + gv[bj][n] * acc[ai][bj][m][n]; }
                asm volatile("" ::: "memory"); }
    }
};
struct EpiSwiglu {
    static constexpr bool PERM = true, AFTER_DRAIN = false;
    bf16_t* O; const float* bias; const PG8_LAS unsigned char* tile_e;
    __device__ __forceinline__ void operator()(const f32x4 (&acc)[2][2][4][2], const Unit& u, int wr, int wc, int fr, int fq) const {
        PG8_FRESH_LANE();
        const int row0 = u.pm * BM + wr * 64 + fr, acol0 = u.pn * HALF + wc * 32 + 8 * fq;
        const int e = tile_e[u.pm]; const float* bb = bias + (size_t)e * 2048 + 2 * acol0;
        const f32x4 b0 = *(const f32x4*)(bb), b1 = *(const f32x4*)(bb + 4), b2 = *(const f32x4*)(bb + 8), b3 = *(const f32x4*)(bb + 12);
        const float bg[8] = {b0[0], b0[2], b1[0], b1[2], b2[0], b2[2], b3[0], b3[2]}, bu[8] = {b0[1], b0[3], b1[1], b1[3], b2[1], b2[3], b3[1], b3[3]};
#pragma unroll
        for (int ai = 0; ai < 2; ++ai)
#pragma unroll
            for (int m = 0; m < 4; ++m) { bf16_t* rowp = O + (size_t)(row0 + ai * HALF + m * 16) * 1024 + acol0;
                float o[8];
#pragma unroll
                for (int j = 0; j < 8; ++j) { const float gt = acc[ai][0][m][j >> 2][j & 3] + bg[j], up = acc[ai][1][m][j >> 2][j & 3] + bu[j];
                    const float glu = fminf(gt, 7.0f), upc = fminf(fmaxf(up, -7.0f), 7.0f);
                    o[j] = glu * sigm(1.702f * glu) * (upc + 1.0f); }
                u32x4 w; w.x = cvt_pk_bf16(o[0], o[1]); w.y = cvt_pk_bf16(o[2], o[3]); w.z = cvt_pk_bf16(o[4], o[5]); w.w = cvt_pk_bf16(o[6], o[7]);
                *(u32x4*)rowp = w; }
    }
};
struct EpiDown {
    static constexpr bool PERM = true, AFTER_DRAIN = false;
    bf16_t* O; const float* bias; const PG8_LAS unsigned char* tile_e;
    __device__ __forceinline__ void operator()(const f32x4 (&acc)[2][2][4][2], const Unit& u, int wr, int wc, int fr, int fq) const {
        PG8_FRESH_LANE();
        const int row0 = u.pm * BM + wr * 64 + fr, col0 = u.pn * BM + wc * 32 + 8 * fq;
        const int e = tile_e[u.pm]; const float* bb = bias + (size_t)e * 1024 + col0;
        f32x4 bv[2][2];
#pragma unroll
        for (int bj = 0; bj < 2; ++bj)
#pragma unroll
            for (int n = 0; n < 2; ++n) bv[bj][n] = *(const f32x4*)(bb + bj * HALF + 4 * n);
#pragma unroll
        for (int ai = 0; ai < 2; ++ai)
#pragma unroll
            for (int m = 0; m < 4; ++m) { bf16_t* rowp = O + (size_t)(row0 + ai * HALF + m * 16) * 1024 + col0;
#pragma unroll
                for (int bj = 0; bj < 2; ++bj) { const f32x4 v0 = acc[ai][bj][m][0] + bv[bj][0], v1 = acc[ai][bj][m][1] + bv[bj][1];
                    u32x4 w; w.x = cvt_pk_bf16(v0[0], v0[1]); w.y = cvt_pk_bf16(v0[2], v0[3]); w.z = cvt_pk_bf16(v1[0], v1[1]); w.w = cvt_pk_bf16(v1[2], v1[3]);
                    *(u32x4*)(rowp + bj * HALF) = w; } }
    }
};
struct MoeOrder {
    int nN, total, G, c; const PG8_LAS unsigned char* tile_e; size_t estride;
    __device__ __forceinline__ bool next(int i, Unit& u) const { const int L = i * G + c; if (L >= total) return false; u.pm = L / nN; u.pn = L - u.pm * nN; return true; }
    __device__ __forceinline__ void a_ready(const Unit&) const {}
    __device__ __forceinline__ void done(const Unit&) const {}
    __device__ __forceinline__ const char* aptr(const Gemm& g, const Unit& u, size_t tstep) const { return (const char*)g.A + (size_t)u.pm * tstep; }
    __device__ __forceinline__ const char* bptr(const Gemm& g, const Unit& u, size_t tstep) const { return (const char*)g.Bt + (size_t)tile_e[u.pm] * estride + (size_t)u.pn * tstep; }
};


template <class Epi, class Sched, bool ALIGN_EPI = false, bool SP2 = false>
__device__ __forceinline__ void gemm_phase(PG8_LAS unsigned char* lds, const Gemm g, const Sched& S, const Epi& E, int tid_in) {
    int tid_ = tid_in; asm volatile("" : "+v"(tid_));
    const int tid = tid_, wid = __builtin_amdgcn_readfirstlane(tid >> 6), lane = tid & 63, wr = wid >> 2, wc = wid & 3, fr = lane & 15, fq = lane >> 4;
    const int K = g.K, nt = K / BK;
    unsigned voffA[2], voffB[2];
#pragma unroll
    for (int i = 0; i < 2; ++i) { int R, C; stage_rc(tid * 16 + i * 8192, R, C); const int Rb = Epi::PERM ? ((R & ~31) + perm32(R & 31)) : R;
        voffA[i] = (unsigned)(R * K + C) * 2u; voffB[i] = (unsigned)(Rb * K + C) * 2u; }
    const size_t kstep = (size_t)(BK * 2);
    const size_t hstep = (size_t)HALF * K * 2;
    const size_t tstep = 2 * hstep;
    const unsigned ldsw = (unsigned)wid * 1024u;
    const int aoff = lds_byte(wr * 64 + fr, fq * 8), boff = lds_byte(wc * 32 + fr, fq * 8);
#define PG8_SA(b, h) (((b) * 2 + (h)) * HTB)
#define PG8_SB(b, h) ((4 + (b) * 2 + (h)) * HTB)
#define PG8_STAGE(bufoff, gbase, voff) do { _Pragma("unroll") for (int _i = 0; _i < 2; ++_i) \
        __builtin_amdgcn_global_load_lds((const unsigned*)((const char*)(gbase) + (voff)[_i]), (PG8_LAS unsigned*)(lds + (bufoff) + ldsw + _i * 8192), 16, 0, 0); } while (0)
#define PG8_LDA(dst, b, h) do { _Pragma("unroll") for (int m = 0; m < 4; ++m) _Pragma("unroll") for (int k = 0; k < 2; ++k) dst[m][k] = *(const PG8_LAS bf16x8*)(lds + PG8_SA(b, h) + aoff + m * 2048 + k * 1024); } while (0)
#define PG8_LDB(dst, b, h) do { _Pragma("unroll") for (int n = 0; n < 2; ++n) _Pragma("unroll") for (int k = 0; k < 2; ++k) dst[n][k] = *(const PG8_LAS bf16x8*)(lds + PG8_SB(b, h) + boff + n * 2048 + k * 1024); } while (0)
#define PG8_MMA(ai, bj, At, Bt) do { __builtin_amdgcn_s_setprio(1); _Pragma("unroll") for (int m = 0; m < 4; ++m) _Pragma("unroll") for (int n = 0; n < 2; ++n) _Pragma("unroll") for (int k = 0; k < 2; ++k) \
        acc[ai][bj][m][n] = __builtin_amdgcn_mfma_f32_16x16x32_bf16(Bt[n][k], At[m][k], acc[ai][bj][m][n], 0, 0, 0); __builtin_amdgcn_s_setprio(0); } while (0)
#define PG8_WAIT_V(n) asm volatile("s_waitcnt vmcnt(" #n ")" ::: "memory")
#define PG8_WAIT_L(n) asm volatile("s_waitcnt lgkmcnt(" #n ")" ::: "memory")
#define PG8_BAR __builtin_amdgcn_s_barrier()
#define PG8_SCHED __builtin_amdgcn_sched_barrier(0)
    Unit cur, nxt; int ui = 0;
    if (!S.next(0, cur)) return;
    f32x4 acc[2][2][4][2];
#pragma unroll
    for (int a = 0; a < 2; ++a)
#pragma unroll
        for (int b = 0; b < 2; ++b)
#pragma unroll
            for (int m = 0; m < 4; ++m)
#pragma unroll
                for (int n = 0; n < 2; ++n) acc[a][b][m][n] = (f32x4){0.f, 0.f, 0.f, 0.f};
    bf16x8 At[4][2], B0[2][2], B1[2][2];
    const char* cA = S.aptr(g, cur, tstep); const char* cB = S.bptr(g, cur, tstep);
    S.a_ready(cur);
    if constexpr (SP2) {
        PG8_STAGE(PG8_SB(0, 0), cB, voffB); PG8_STAGE(PG8_SB(0, 1), cB + hstep, voffB); PG8_STAGE(PG8_SA(0, 0), cA, voffA); PG8_STAGE(PG8_SA(0, 1), cA + hstep, voffA);
        if (wr == 1) PG8_BAR;
        PG8_WAIT_V(2); PG8_BAR;
        PG8_STAGE(PG8_SB(1, 0), cB + kstep, voffB); PG8_STAGE(PG8_SA(1, 0), cA + kstep, voffA); PG8_STAGE(PG8_SB(1, 1), cB + hstep + kstep, voffB);
        PG8_WAIT_V(6); PG8_BAR;
    } else {
        PG8_STAGE(PG8_SB(0, 0), cB, voffB); PG8_STAGE(PG8_SA(0, 0), cA, voffA); PG8_STAGE(PG8_SB(0, 1), cB + hstep, voffB); PG8_STAGE(PG8_SA(0, 1), cA + hstep, voffA);
        if (wr == 1) PG8_BAR;
        PG8_WAIT_V(4); PG8_BAR;
        PG8_STAGE(PG8_SB(1, 0), cB + kstep, voffB); PG8_STAGE(PG8_SA(1, 0), cA + kstep, voffA); PG8_STAGE(PG8_SB(1, 1), cB + hstep + kstep, voffB);
        PG8_WAIT_V(6); PG8_BAR;
    }
    for (;;) {
        const bool has_next = S.next(ui + 1, nxt);
        const char* nA = has_next ? S.aptr(g, nxt, tstep) : cA; const char* nB = has_next ? S.bptr(g, nxt, tstep) : cB;
        for (int t = 0; t < nt; t += 2) {
            const bool last = (t == nt - 2);
            const char* a1 = cA + (size_t)(t + 1) * kstep;
            const char* a2 = last ? nA : cA + (size_t)(t + 2) * kstep; const char* b2 = last ? nB : cB + (size_t)(t + 2) * kstep;
            const char* a3 = a2 + kstep; const char* b3 = b2 + kstep;
            if (last && has_next) S.a_ready(nxt);
            if constexpr (SP2) {
            PG8_LDB(B0, 0, 0); PG8_LDB(B1, 0, 1); PG8_SCHED; PG8_LDA(At, 0, 0); PG8_STAGE(PG8_SA(1, 1), a1 + hstep, voffA);
            PG8_WAIT_V(8); PG8_WAIT_L(0); PG8_BAR; PG8_MMA(0, 0, At, B0); PG8_MMA(0, 1, At, B1); PG8_BAR; PG8_SCHED;
            PG8_LDA(At, 0, 1); PG8_STAGE(PG8_SB(0, 0), b2, voffB); PG8_STAGE(PG8_SB(0, 1), b2 + hstep, voffB); PG8_STAGE(PG8_SA(0, 0), a2, voffA);
            PG8_WAIT_V(8); PG8_WAIT_L(0); PG8_BAR; PG8_MMA(1, 0, At, B0); PG8_MMA(1, 1, At, B1); PG8_BAR; PG8_SCHED;
            PG8_LDB(B0, 1, 0); PG8_LDB(B1, 1, 1); PG8_SCHED; PG8_LDA(At, 1, 0); PG8_STAGE(PG8_SA(0, 1), a2 + hstep, voffA);
            PG8_WAIT_V(8); PG8_WAIT_L(0); PG8_BAR; PG8_MMA(0, 0, At, B0); PG8_MMA(0, 1, At, B1); PG8_BAR; PG8_SCHED;
            PG8_LDA(At, 1, 1); PG8_STAGE(PG8_SB(1, 0), b3, voffB); PG8_STAGE(PG8_SB(1, 1), b3 + hstep, voffB); PG8_STAGE(PG8_SA(1, 0), a3, voffA);
            PG8_WAIT_V(8); PG8_WAIT_L(0); PG8_BAR; PG8_MMA(1, 0, At, B0); PG8_MMA(1, 1, At, B1); PG8_BAR; PG8_SCHED;
            } else {
            PG8_LDB(B0, 0, 0); PG8_SCHED; PG8_LDA(At, 0, 0); PG8_STAGE(PG8_SA(1, 1), a1 + hstep, voffA);
            PG8_WAIT_L(8); PG8_BAR; PG8_WAIT_L(0); PG8_MMA(0, 0, At, B0); PG8_BAR; PG8_SCHED;
            PG8_LDB(B1, 0, 1); PG8_STAGE(PG8_SB(0, 0), b2, voffB);
            PG8_BAR; PG8_WAIT_L(0); PG8_MMA(0, 1, At, B1); PG8_BAR;
            PG8_LDA(At, 0, 1); PG8_STAGE(PG8_SA(0, 0), a2, voffA);
            PG8_BAR; PG8_WAIT_L(0); PG8_MMA(1, 0, At, B0); PG8_BAR; PG8_SCHED;
            PG8_STAGE(PG8_SB(0, 1), b2 + hstep, voffB);
            PG8_WAIT_V(6); PG8_BAR; PG8_MMA(1, 1, At, B1); PG8_BAR;
            PG8_LDB(B0, 1, 0); PG8_SCHED; PG8_LDA(At, 1, 0); PG8_STAGE(PG8_SA(0, 1), a2 + hstep, voffA);
            PG8_WAIT_L(8); PG8_BAR; PG8_WAIT_L(0); PG8_MMA(0, 0, At, B0); PG8_BAR; PG8_SCHED;
            PG8_LDB(B1, 1, 1); PG8_STAGE(PG8_SB(1, 0), b3, voffB);
            PG8_BAR; PG8_WAIT_L(0); PG8_MMA(0, 1, At, B1); PG8_BAR;
            PG8_LDA(At, 1, 1); PG8_STAGE(PG8_SA(1, 0), a3, voffA);
            PG8_BAR; PG8_WAIT_L(0); PG8_MMA(1, 0, At, B0); PG8_BAR; PG8_SCHED;
            PG8_STAGE(PG8_SB(1, 1), b3 + hstep, voffB);
            PG8_WAIT_V(6); PG8_BAR; PG8_MMA(1, 1, At, B1); PG8_BAR;
            }
        }
        if constexpr (ALIGN_EPI) { if (wr == 0) PG8_BAR; }
        if constexpr (!Epi::AFTER_DRAIN) { E(acc, cur, wr, wc, fr, fq); S.done(cur); }
        if (!has_next) break;
#pragma unroll
        for (int a = 0; a < 2; ++a)
#pragma unroll
            for (int b = 0; b < 2; ++b)
#pragma unroll
                for (int m = 0; m < 4; ++m)
#pragma unroll
                    for (int n = 0; n < 2; ++n) acc[a][b][m][n] = (f32x4){0.f, 0.f, 0.f, 0.f};
        cur = nxt; cA = nA; cB = nB; ++ui;
        if constexpr (ALIGN_EPI) { if (wr == 1) PG8_BAR; }
    }
    PG8_WAIT_V(0);
    if constexpr (!ALIGN_EPI) { if (wr == 0) PG8_BAR; }
    PG8_BAR;
    if constexpr (Epi::AFTER_DRAIN) { E.fused(acc, cur, wr, wc, fr, fq, lds, wid, lane); S.done(cur); }
#undef PG8_SA
#undef PG8_SB
#undef PG8_STAGE
#undef PG8_LDA
#undef PG8_LDB
#undef PG8_MMA
#undef PG8_WAIT_V
#undef PG8_WAIT_L
#undef PG8_BAR
#undef PG8_SCHED
}
}

#ifndef MK_ONE_LAUNCH
#define MK_ONE_LAUNCH 1
#endif
constexpr int NWAVES = 8, NTHREADS = 512;
constexpr int NB = 16, SEQ = 2048, CTX = 256, TB = SEQ + CTX, T = NB * TB, D = 1024, DIN = 4864, DEPTH = 4;
constexpr int OFF_U = 0, OFF_CB = 256, OFF_CC = 512, OFF_CX = 768, OFF_Q = 1024, OFF_K = 1536, OFF_V = 1664, OFF_GT = 1792;
constexpr int NE = 32, MAX_TILES = (T * 4 + NE * 255) / 256, MAX_SLOTS = MAX_TILES * 256;
constexpr float EPS = 1e-6f;
enum { I_X = 0, I_C, I_CTX, I_CCTX, I_WMOD, I_BMOD, I_N1G, I_N2G, I_WIN, I_LRE, I_LIM, I_LDT, I_BRE, I_BIM, I_CRE, I_CIM, I_SD, I_WGLU, I_WSO, I_CONVW, I_WCO, I_QG, I_KG, I_SINK, I_WAO, I_WO,
       I_WR, I_BR, I_WGU, I_BGU, I_WD, I_BD, N_IN };
constexpr size_t MiB = 1u << 20;
constexpr size_t WS_CTL = 0, CTL_ZERO_BYTES = 1 * MiB;
constexpr size_t WS_MOD = 1 * MiB;
constexpr size_t WS_WRT = 3 * MiB;
constexpr size_t WS_ROPE = 4 * MiB;
constexpr size_t WS_WGLU = 5 * MiB;
constexpr size_t WS_WSO = 6 * MiB;
constexpr size_t WS_WCO = 8 * MiB;
constexpr size_t WS_WAO = 10 * MiB;
constexpr size_t WS_WO = 14 * MiB;
constexpr size_t WS_WIN = 22 * MiB;
constexpr size_t WS_WGU = 60 * MiB;
constexpr size_t WS_WD = 572 * MiB;
constexpr size_t WS_X = 828 * MiB;
constexpr size_t WS_H = 972 * MiB;
constexpr size_t WS_PROJ = 1044 * MiB;
constexpr size_t WS_QN = 1386 * MiB;
constexpr size_t WS_KN = 1422 * MiB;
constexpr size_t WS_Z = 1431 * MiB;
constexpr size_t WS_Z2 = 1449 * MiB;
constexpr size_t WS_YB = 1467 * MiB;
constexpr size_t WS_YA = 1485 * MiB;
constexpr size_t WS_MM = 1521 * MiB;
constexpr size_t WS_XG = 1593 * MiB;
constexpr size_t WS_ACT = 1897 * MiB;
constexpr size_t WS_TOPG = 2201 * MiB;
constexpr size_t WS_SLOT = 2202 * MiB;
constexpr size_t WS_YD = 2203 * MiB;
constexpr size_t WS_END = 2275 * MiB;
static_assert(WS_WIN + (size_t)4 * DIN * D * 2 <= WS_WGU && WS_PROJ + (size_t)T * DIN * 2 <= WS_QN && WS_XG + (size_t)MAX_SLOTS * D * 2 <= WS_ACT && WS_ACT + (size_t)MAX_SLOTS * D * 2 <= WS_TOPG, "d_ws map");
static_assert(WS_X + (size_t)T * D * 4 <= WS_H && WS_H + (size_t)T * D * 2 <= WS_PROJ && WS_YD + (size_t)2 * T * 256 * 4 <= WS_END, "d_ws map 2");
constexpr int CW_CNT = 64;
constexpr int CW_BAR = 4096;
constexpr int RING_BYTES = 131072, MISC_OFF = RING_BYTES, TILE_E_OFF = MISC_OFF + 256, PADS_OFF = MISC_OFF + 1024, LDS_BYTES = 147456;

#define GAS __attribute__((address_space(1)))
#define LAS __attribute__((address_space(3)))
typedef unsigned short bf16;
typedef unsigned v4u __attribute__((ext_vector_type(4)));
typedef unsigned v2u __attribute__((ext_vector_type(2)));
typedef float f32x4 __attribute__((ext_vector_type(4)));
typedef float f32x2 __attribute__((ext_vector_type(2)));
typedef GAS unsigned gu32;
#define RLX_AGENT __ATOMIC_RELAXED, __HIP_MEMORY_SCOPE_AGENT
#define LDS_WAIT() asm volatile("s_waitcnt lgkmcnt(0)" ::: "memory")
#define VM_WAIT() asm volatile("s_waitcnt vmcnt(0)" ::: "memory")
__device__ __forceinline__ unsigned f2bf(float f) { unsigned u = __builtin_bit_cast(unsigned, f); return (u + 0x7fffu + ((u >> 16) & 1u)) >> 16; }
__device__ __forceinline__ unsigned pk2(float lo, float hi) { return f2bf(lo) | (f2bf(hi) << 16); }
__device__ __forceinline__ float bflo(unsigned w) { return __uint_as_float(w << 16); }
__device__ __forceinline__ float bfhi(unsigned w) { return __uint_as_float(w & 0xffff0000u); }

#define XB_TMO      128
#define XB_XCNT(j)  (256  + 64 * (j))
#define XB_XSUB(j)  (1280 + 64 * (j))
#define XB_XGEN(j)  (2304 + 64 * (j))
#define XB_TOP      3328
#define XB_TOPGEN   3392
#define XCD_BAR_WORDS 3456
#define XB_SPIN_CAP (1u << 18)

__device__ __forceinline__ unsigned xb_ld(unsigned* p)              { return __hip_atomic_load(p, __ATOMIC_RELAXED, __HIP_MEMORY_SCOPE_AGENT); }
__device__ __forceinline__ unsigned xb_add(unsigned* p, unsigned v) { return __hip_atomic_fetch_add(p, v, __ATOMIC_RELAXED, __HIP_MEMORY_SCOPE_AGENT); }
__device__ __forceinline__ unsigned xb_xcc_id() { return (unsigned)__builtin_amdgcn_s_getreg((3 << 11) | 20) & 0xFu; }
#define XB_SPIN(cond, bar) do { unsigned _sp = 0; while (cond) { __builtin_amdgcn_s_sleep(1); \
    if ((++_sp & 255u) == 0u) { if (xb_ld(&(bar)[XB_TMO])) break; if (_sp > XB_SPIN_CAP) { atomicAdd(&(bar)[XB_TMO], 1u); break; } } } } while (0)

struct XcdBarrier {
    unsigned* bar; unsigned x;
    volatile LAS unsigned* st;
};

__device__ __forceinline__ XcdBarrier xcd_barrier_post(unsigned* bar, volatile LAS unsigned* st) {
    XcdBarrier b; b.bar = bar; b.x = xb_xcc_id(); b.st = st;
    if (threadIdx.x == 0) (void)xb_add(&bar[XB_XCNT(b.x)], 1u);
    return b;
}
__device__ __forceinline__ void xcd_barrier_complete(unsigned* bar, unsigned x, unsigned& nloc, unsigned& nx) {
    const unsigned G = gridDim.x * gridDim.y * gridDim.z;
    unsigned sum, cnt, mine, sp = 0u;
    for (;;) {
        sum = 0u; cnt = 0u; mine = 0u;
#pragma unroll
        for (unsigned j = 0; j < 16; ++j) { const unsigned c = xb_ld(&bar[XB_XCNT(j)]); sum += c; cnt += (c > 0u) ? 1u : 0u; mine = (j == x) ? c : mine; }
        if (sum == G) break;
        __builtin_amdgcn_s_sleep(1);
        if ((++sp & 255u) == 0u) { if (xb_ld(&bar[XB_TMO])) break; if (sp > XB_SPIN_CAP) { atomicAdd(&bar[XB_TMO], 1u); break; } }
    }
    nloc = mine > 0u ? mine : 1u; nx = cnt > 0u ? cnt : 1u;
}

__device__ __forceinline__ void xcd_barrier(const XcdBarrier& b, const bool leader) {
    asm volatile("s_waitcnt vmcnt(0)" ::: "memory");
    __syncthreads();
    if (leader) {
        unsigned* bar = b.bar;
        __builtin_amdgcn_s_waitcnt(0);
        unsigned nloc = b.st[0], nx = b.st[1];
        if (nloc == 0u) { xcd_barrier_complete(bar, b.x, nloc, nx); b.st[0] = nloc; b.st[1] = nx; }
        const unsigned old = xb_add(&bar[XB_XSUB(b.x)], 1u);
        const unsigned gen = old / nloc;
        if (old + 1u == (gen + 1u) * nloc) {
            __builtin_amdgcn_fence(__ATOMIC_RELEASE, "agent");
            asm volatile("s_waitcnt vmcnt(0)" ::: "memory");
            const unsigned og = xb_add(&bar[XB_TOP], 1u);
            const unsigned tg = og / nx;
            if (og + 1u == (tg + 1u) * nx) xb_add(&bar[XB_TOPGEN], 1u);
            else XB_SPIN(xb_ld(&bar[XB_TOPGEN]) == tg, bar);
            __builtin_amdgcn_fence(__ATOMIC_ACQUIRE, "agent");
            xb_add(&bar[XB_XGEN(b.x)], 1u);
            asm volatile("s_waitcnt vmcnt(0)" ::: "memory");
        } else {
            XB_SPIN(xb_ld(&bar[XB_XGEN(b.x)]) == gen, bar);
            __builtin_amdgcn_fence(__ATOMIC_ACQUIRE, "agent");
            asm volatile("s_waitcnt vmcnt(0)" ::: "memory");
        }
    }
    __syncthreads();
}

struct Args { const float* in[N_IN]; float* out; unsigned char* ws; int ph_lo, ph_hi; };
typedef const __attribute__((address_space(4))) Args CA;
typedef CA* CArgs;
__device__ __forceinline__ CArgs get_args() { CArgs p = (CArgs)__builtin_amdgcn_kernarg_segment_ptr(); asm volatile("" : "+s"(p)); return p; }

__device__ __forceinline__ float shx(float v, int m, int lane) { return __builtin_bit_cast(float, __builtin_amdgcn_ds_bpermute((lane ^ m) << 2, __builtin_bit_cast(int, v))); }
__device__ __forceinline__ float wave_sum(float v, int lane) {
#pragma unroll
    for (int o = 1; o < 64; o <<= 1) v += shx(v, o, lane);
    return v;
}
__device__ __forceinline__ float wave_max(float v, int lane) {
#pragma unroll
    for (int o = 1; o < 64; o <<= 1) v = fmaxf(v, shx(v, o, lane));
    return v;
}
__device__ __forceinline__ float gelu_tanh(float x) {
    const float y = 0.7978845608028654f * (x + 0.044715f * x * x * x);
    const float t = 1.0f - 2.0f * __builtin_amdgcn_rcpf(1.0f + __expf(2.0f * y));
    return 0.5f * x * (1.0f + t);
}

template <int MODE>
__device__ __forceinline__ void transpose_item(const float* W, int K, int N, bf16* WT, LAS float* scr, int item, int lane) {
    const int nblk = N / 32, kb = item / nblk, nb = item - kb * nblk, k0 = 64 * kb, n0 = 32 * nb;
#pragma unroll 8
    for (int i = 0; i < 32; ++i) { const int kk = 2 * i + (lane >> 5); scr[kk * 33 + (lane & 31)] = W[(size_t)(k0 + kk) * N + n0 + (lane & 31)]; }
    LDS_WAIT(); asm volatile("" ::: "memory");
    const int c = lane & 7;
#pragma unroll
    for (int j = 0; j < 4; ++j) { const int n = (lane >> 3) + 8 * j; const LAS float* s = scr + (8 * c) * 33 + n;
        v4u o; o.x = pk2(s[0 * 33], s[1 * 33]); o.y = pk2(s[2 * 33], s[3 * 33]); o.z = pk2(s[4 * 33], s[5 * 33]); o.w = pk2(s[6 * 33], s[7 * 33]);
        const int nn = n0 + n; const int jj = nn >> 1;
        const int drow = (MODE == 0) ? nn : ((jj >> 7) * 256 + (nn & 1) * 128 + (jj & 127));
        *(GAS v4u*)(WT + (size_t)drow * K + k0 + 8 * c) = o; }
    LDS_WAIT(); asm volatile("" ::: "memory");
}

__device__ __forceinline__ void phase_prologue(CArgs ap, LAS unsigned char* lds, int tid, int lane, int wave, int bid, int G) {
    CA& a = *ap;
    unsigned char* ws = a.ws;
    if (bid < 192) {
        LAS float* S = (LAS float*)lds;
        LAS float* R = (LAS float*)(lds + 17 * 1024 * 4);
        for (int idx = tid; idx < 17 * 1024; idx += NTHREADS) { const int r = idx >> 10, k = idx & 1023; const float v = r < 16 ? a.in[I_C][r * 1024 + k] : a.in[I_CCTX][k]; S[idx] = v / (1.0f + __expf(-v)); }
        __syncthreads();
        const int l = bid / 48, c0 = (bid % 48) * 128, col = tid & 127, kq = tid >> 7;
        float acc[17];
#pragma unroll
        for (int r = 0; r < 17; ++r) acc[r] = 0.f;
        const float* wp = a.in[I_WMOD] + ((size_t)l * 1024 + kq * 256) * 6144 + c0 + col;
#pragma unroll 4
        for (int k = 0; k < 256; ++k) { const float w = wp[(size_t)k * 6144];
#pragma unroll
            for (int r = 0; r < 17; ++r) acc[r] += S[r * 1024 + kq * 256 + k] * w; }
#pragma unroll
        for (int r = 0; r < 17; ++r) R[(kq * 17 + r) * 128 + col] = acc[r];
        __syncthreads();
        float* MOD = (float*)(ws + WS_MOD);
        for (int idx = tid; idx < 17 * 128; idx += NTHREADS) { const int r = idx >> 7, cc = idx & 127;
            const float v = R[(0 * 17 + r) * 128 + cc] + R[(1 * 17 + r) * 128 + cc] + R[(2 * 17 + r) * 128 + cc] + R[(3 * 17 + r) * 128 + cc] + a.in[I_BMOD][l * 6144 + c0 + cc];
            MOD[((size_t)l * 17 + r) * 6144 + c0 + cc] = v; }
    }
    __syncthreads();
    {
        LAS float* scr = (LAS float*)(lds + wave * 16384);
        const int gw = bid * NWAVES + wave, NGW = G * NWAVES;
        constexpr int N_WGU = 128 * 1024, N_WD = 128 * 512, N_WIN = 4 * 2432, N_WO = 4 * 512, N_WAO = 4 * 256, N_WSO = 4 * 128, N_WCO = 4 * 128, N_WGLU = 4 * 32;
        constexpr int NITEMS = N_WGU + N_WD + N_WIN + N_WO + N_WAO + N_WSO + N_WCO + N_WGLU;
        for (int it = gw; it < NITEMS; it += NGW) {
            int r = it;
            if (r < N_WGU) { const int m = r >> 10; transpose_item<1>(a.in[I_WGU] + (size_t)m * 1024 * 2048, 1024, 2048, (bf16*)(ws + WS_WGU) + (size_t)m * 2048 * 1024, scr, r & 1023, lane); continue; } r -= N_WGU;
            if (r < N_WD) { const int m = r >> 9; transpose_item<0>(a.in[I_WD] + (size_t)m * 1024 * 1024, 1024, 1024, (bf16*)(ws + WS_WD) + (size_t)m * 1024 * 1024, scr, r & 511, lane); continue; } r -= N_WD;
            if (r < N_WIN) { const int m = r / 2432; transpose_item<0>(a.in[I_WIN] + (size_t)m * 1024 * DIN, 1024, DIN, (bf16*)(ws + WS_WIN) + (size_t)m * DIN * 1024, scr, r - m * 2432, lane); continue; } r -= N_WIN;
            if (r < N_WO) { const int m = r >> 9; transpose_item<0>(a.in[I_WO] + (size_t)m * 1024 * 1024, 1024, 1024, (bf16*)(ws + WS_WO) + (size_t)m * 1024 * 1024, scr, r & 511, lane); continue; } r -= N_WO;
            if (r < N_WAO) { const int m = r >> 8; transpose_item<0>(a.in[I_WAO] + (size_t)m * 512 * 1024, 512, 1024, (bf16*)(ws + WS_WAO) + (size_t)m * 1024 * 512, scr, r & 255, lane); continue; } r -= N_WAO;
            if (r < N_WSO) { const int m = r >> 7; transpose_item<0>(a.in[I_WSO] + (size_t)m * 256 * 1024, 256, 1024, (bf16*)(ws + WS_WSO) + (size_t)m * 1024 * 256, scr, r & 127, lane); continue; } r -= N_WSO;
            if (r < N_WCO) { const int m = r >> 7; transpose_item<0>(a.in[I_WCO] + (size_t)m * 256 * 1024, 256, 1024, (bf16*)(ws + WS_WCO) + (size_t)m * 1024 * 256, scr, r & 127, lane); continue; } r -= N_WCO;
            { const int m = r >> 5; transpose_item<0>(a.in[I_WGLU] + (size_t)m * 256 * 256, 256, 256, (bf16*)(ws + WS_WGLU) + (size_t)m * 256 * 256, scr, r & 31, lane); }
        }
    }
    {
        const int gt = bid * NTHREADS + tid, NGT = G * NTHREADS;
        float* WRT = (float*)(ws + WS_WRT);
        for (int i = gt; i < 4 * 32 * 1024; i += NGT) { const int l = i >> 15, e = (i >> 10) & 31, k = i & 1023; WRT[i] = a.in[I_WR][((size_t)l * 1024 + k) * 32 + e]; }
        float* ROPE = (float*)(ws + WS_ROPE);
        for (int i = gt; i < 2048 * 32; i += NGT) { const int t = i >> 5, p = i & 31; const float pos = (float)(p < 16 ? (t >> 6) : (t & 63));
            const float inv = powf(10000.0f, -(float)(p & 15) / 16.0f); float sn, cs; sincosf(pos * inv, &sn, &cs); ROPE[2 * i] = cs; ROPE[2 * i + 1] = sn; }
    }
}

template <int MODE>
__device__ __forceinline__ void phase_n1(CArgs ap, int l, int lane, int gw, int NGW) {
    CA& a = *ap;
    unsigned char* ws = a.ws;
    float* X = (float*)(ws + WS_X); bf16* H = (bf16*)(ws + WS_H);
    const float* MOD = (const float*)(ws + WS_MOD);
    const bf16* YS = (const bf16*)(ws + WS_XG); const float* TOPG = (const float*)(ws + WS_TOPG); const int* SLOT = (const int*)(ws + WS_SLOT);
    for (int row = gw; row < T; row += NGW) {
        const int b = row / TB, s = row - b * TB; const bool isctx = s < CTX; const int r = isctx ? 16 : b;
        if (MODE == 2 && isctx) continue;
        const float* src = (MODE == 0) ? (isctx ? a.in[I_CTX] + ((size_t)b * CTX + s) * D : a.in[I_X] + ((size_t)b * SEQ + (s - CTX)) * D) : X + (size_t)row * D;
        f32x4 v[4];
#pragma unroll
        for (int j = 0; j < 4; ++j) v[j] = *(const f32x4*)(src + 4 * lane + 256 * j);
        if (MODE != 0) {
            const float* g2 = MOD + ((size_t)(l - 1) * 17 + r) * 6144 + 5120;
            const f32x4 tg = *(const f32x4*)(TOPG + (size_t)row * 4); const int4 sl = *(const int4*)(SLOT + (size_t)row * 4);
            const int sls[4] = {sl.x, sl.y, sl.z, sl.w};
            f32x4 acc[4];
#pragma unroll
            for (int j = 0; j < 4; ++j) acc[j] = (f32x4){0.f, 0.f, 0.f, 0.f};
#pragma unroll
            for (int k = 0; k < 4; ++k) { const bf16* yr = YS + (size_t)sls[k] * D; const float gk = tg[k];
#pragma unroll
                for (int j = 0; j < 4; ++j) { const v2u w = *(const v2u*)(yr + 4 * lane + 256 * j);
                    acc[j] += gk * (f32x4){bflo(w.x), bfhi(w.x), bflo(w.y), bfhi(w.y)}; } }
#pragma unroll
            for (int j = 0; j < 4; ++j) v[j] += *(const f32x4*)(g2 + 4 * lane + 256 * j) * acc[j];
        }
        if (MODE == 2) {
            float* o = a.out + ((size_t)b * SEQ + (s - CTX)) * D;
#pragma unroll
            for (int j = 0; j < 4; ++j) *(f32x4*)(o + 4 * lane + 256 * j) = v[j];
            continue;
        }
        float ss = 0.f;
#pragma unroll
        for (int j = 0; j < 4; ++j) { *(f32x4*)(X + (size_t)row * D + 4 * lane + 256 * j) = v[j]; ss += (v[j].x * v[j].x + v[j].y * v[j].y) + (v[j].z * v[j].z + v[j].w * v[j].w); }
        const float rstd = rsqrtf(wave_sum(ss, lane) * (1.0f / D) + EPS);
        const float* md = MOD + ((size_t)l * 17 + r) * 6144; const float* gn = a.in[I_N1G] + l * D;
#pragma unroll
        for (int j = 0; j < 4; ++j) { const int c = 4 * lane + 256 * j;
            const f32x4 g = *(const f32x4*)(gn + c), sh = *(const f32x4*)(md + c), sc = *(const f32x4*)(md + 1024 + c);
            const f32x4 h = (v[j] * rstd * g) * (sc + 1.0f) + sh;
            v2u o; o.x = pk2(h.x, h.y); o.y = pk2(h.z, h.w); *(v2u*)(H + (size_t)row * D + c) = o; }
    }
}

__device__ __forceinline__ void phase_prep(CArgs ap, int l, int lane, int gw, int NGW) {
    CA& a = *ap;
    unsigned char* ws = a.ws;
    const bf16* P = (const bf16*)(ws + WS_PROJ); bf16* YB = (bf16*)(ws + WS_YB); bf16* QN = (bf16*)(ws + WS_QN); bf16* KN = (bf16*)(ws + WS_KN);
    const float* ROPE = (const float*)(ws + WS_ROPE);
    const float* cw = a.in[I_CONVW] + l * 3 * 256;
    for (int row = gw; row < T; row += NGW) {
        const int b = row / TB, s = row - b * TB; const bool isctx = s < CTX;
        const int lo = isctx ? 0 : CTX, hi = isctx ? CTX : TB;
        { const int c4 = 4 * lane; f32x4 zz[3];
#pragma unroll
            for (int d = 0; d < 3; ++d) { const int s2 = s + d - 1;
                if (s2 >= lo && s2 < hi) { const bf16* pr = P + (size_t)(row + d - 1) * DIN; const v2u cc = *(const v2u*)(pr + OFF_CC + c4), cx = *(const v2u*)(pr + OFF_CX + c4);
                    zz[d] = (f32x4){bflo(cc.x) * bflo(cx.x), bfhi(cc.x) * bfhi(cx.x), bflo(cc.y) * bflo(cx.y), bfhi(cc.y) * bfhi(cx.y)}; }
                else zz[d] = (f32x4){0.f, 0.f, 0.f, 0.f}; }
            const v2u cb = *(const v2u*)(P + (size_t)row * DIN + OFF_CB + c4);
            const f32x4 w0 = *(const f32x4*)(cw + c4), w1 = *(const f32x4*)(cw + 256 + c4), w2 = *(const f32x4*)(cw + 512 + c4);
            const f32x4 y = (f32x4){bflo(cb.x), bfhi(cb.x), bflo(cb.y), bfhi(cb.y)} * (w0 * zz[0] + w1 * zz[1] + w2 * zz[2]);
            v2u o; o.x = pk2(y.x, y.y); o.y = pk2(y.z, y.w); *(v2u*)(YB + (size_t)row * 256 + c4) = o; }
#pragma unroll
        for (int pass = 0; pass < 2; ++pass) {
            const int ln = pass ? (lane & 15) : lane;
            const v4u w = *(const v4u*)(P + (size_t)row * DIN + (pass ? OFF_K : OFF_Q) + ln * 8);
            float x[8] = {bflo(w.x), bfhi(w.x), bflo(w.y), bfhi(w.y), bflo(w.z), bfhi(w.z), bflo(w.w), bfhi(w.w)};
            float ss = 0.f;
#pragma unroll
            for (int i = 0; i < 8; ++i) ss += x[i] * x[i];
            ss += shx(ss, 1, lane); ss += shx(ss, 2, lane); ss += shx(ss, 4, lane);
            const float rstd = rsqrtf(ss * (1.0f / 64.0f) + EPS);
            const int d0 = (ln & 7) * 8; const float* gg = (pass ? a.in[I_KG] : a.in[I_QG]) + l * 64 + d0;
#pragma unroll
            for (int i = 0; i < 8; ++i) x[i] = x[i] * rstd * gg[i];
            if (!isctx) {
                const float* rp = ROPE + ((size_t)(s - CTX) * 32 + (d0 & 31)) * 2;
                const bool first = (ln & 4) == 0;
#pragma unroll
                for (int i = 0; i < 8; ++i) { const float pr = shx(x[i], 4, lane); const float cs = rp[2 * i], sn = rp[2 * i + 1];
                    x[i] = first ? (x[i] * cs - pr * sn) : (pr * sn + x[i] * cs); }
            }
            v4u o; o.x = pk2(x[0], x[1]); o.y = pk2(x[2], x[3]); o.z = pk2(x[4], x[5]); o.w = pk2(x[6], x[7]);
            if (pass == 0) *(v4u*)(QN + (size_t)row * 512 + lane * 8) = o;
            else if (lane < 16) *(v4u*)(KN + (size_t)row * 128 + lane * 8) = o;
        }
    }
}

__device__ __forceinline__ void s5_scan_unit(CArgs ap, int l, int u, int lane) {
    CA& a = *ap;
    unsigned char* ws = a.ws;
    const bf16* P = (const bf16*)(ws + WS_PROJ); float* YD = (float*)(ws + WS_YD);
    const int b = u & 15, dir = (u >> 4) & 1, g = u >> 5, p = lane;
    const int pi = (l * 2 + dir) * 16 + g;
    const float lam_re = a.in[I_LRE][pi * 64 + p], lam_im = a.in[I_LIM][pi * 64 + p], dt = expf(a.in[I_LDT][pi]);
    float sn, cs; sincosf(lam_im * dt, &sn, &cs); const float er = expf(lam_re * dt);
    const float lbr = er * cs, lbi = er * sn;
    const float d2 = lam_re * lam_re + lam_im * lam_im; const float nr = lbr - 1.0f, ni = lbi;
    const float qr = (nr * lam_re + ni * lam_im) / d2, qi = (ni * lam_re - nr * lam_im) / d2;
    float Bbr[16], Bbi[16], Cr[16], Ci[16];
#pragma unroll
    for (int h = 0; h < 16; ++h) { const float br = a.in[I_BRE][((size_t)pi * 64 + p) * 16 + h], bi = a.in[I_BIM][((size_t)pi * 64 + p) * 16 + h];
        Bbr[h] = qr * br - qi * bi; Bbi[h] = qr * bi + qi * br;
        Cr[h] = a.in[I_CRE][((size_t)pi * 16 + h) * 64 + p]; Ci[h] = a.in[I_CIM][((size_t)pi * 16 + h) * 64 + p]; }
    float sr = 0.f, si = 0.f;
    for (int kb = 0; kb < TB / 64; ++kb) {
        const int n = kb * 64 + lane; const int s_l = dir == 0 ? n : (n < CTX ? CTX - 1 - n : TB + CTX - 1 - n);
        const bf16* up = P + (size_t)(b * TB + s_l) * DIN + OFF_U + g * 16;
        const v4u u0 = *(const v4u*)up, u1 = *(const v4u*)(up + 8);
        for (int j = 0; j < 64; ++j) {
            const unsigned w[8] = {(unsigned)__builtin_amdgcn_readlane((int)u0.x, j), (unsigned)__builtin_amdgcn_readlane((int)u0.y, j), (unsigned)__builtin_amdgcn_readlane((int)u0.z, j), (unsigned)__builtin_amdgcn_readlane((int)u0.w, j),
                                   (unsigned)__builtin_amdgcn_readlane((int)u1.x, j), (unsigned)__builtin_amdgcn_readlane((int)u1.y, j), (unsigned)__builtin_amdgcn_readlane((int)u1.z, j), (unsigned)__builtin_amdgcn_readlane((int)u1.w, j)};
            float bur = 0.f, bui = 0.f;
#pragma unroll
            for (int h = 0; h < 8; ++h) { const float ua = bflo(w[h]), ub = bfhi(w[h]); bur += Bbr[2 * h] * ua + Bbr[2 * h + 1] * ub; bui += Bbi[2 * h] * ua + Bbi[2 * h + 1] * ub; }
            const float nsr = lbr * sr - lbi * si + bur, nsi = lbr * si + lbi * sr + bui; sr = nsr; si = nsi;
            float v[16];
#pragma unroll
            for (int h = 0; h < 16; ++h) v[h] = Cr[h] * sr - Ci[h] * si;
            float w8[8], w4[4], w2[2], w1;
            { const bool hb = (lane & 32) != 0;
#pragma unroll
              for (int i = 0; i < 8; ++i) { const float keep = hb ? v[i + 8] : v[i], send = hb ? v[i] : v[i + 8]; w8[i] = keep + shx(send, 32, lane); } }
            { const bool hb = (lane & 16) != 0;
#pragma unroll
              for (int i = 0; i < 4; ++i) { const float keep = hb ? w8[i + 4] : w8[i], send = hb ? w8[i] : w8[i + 4]; w4[i] = keep + shx(send, 16, lane); } }
            { const bool hb = (lane & 8) != 0;
#pragma unroll
              for (int i = 0; i < 2; ++i) { const float keep = hb ? w4[i + 2] : w4[i], send = hb ? w4[i] : w4[i + 2]; w2[i] = keep + shx(send, 8, lane); } }
            { const bool hb = (lane & 4) != 0; const float keep = hb ? w2[1] : w2[0], send = hb ? w2[0] : w2[1]; w1 = keep + shx(send, 4, lane); }
            w1 += shx(w1, 1, lane); w1 += shx(w1, 2, lane);
            const int nj = kb * 64 + j; const int sj = dir == 0 ? nj : (nj < CTX ? CTX - 1 - nj : TB + CTX - 1 - nj);
            if ((lane & 3) == 0) YD[((size_t)dir * T + (size_t)(b * TB + sj)) * 256 + g * 16 + (lane >> 2)] = w1;
        }
    }
}

__device__ __forceinline__ void phase_zcombine(CArgs ap, int l, int lane, int gw, int NGW) {
    CA& a = *ap;
    unsigned char* ws = a.ws;
    const bf16* P = (const bf16*)(ws + WS_PROJ); const float* YD = (const float*)(ws + WS_YD); bf16* Z = (bf16*)(ws + WS_Z);
    const f32x4 dsk = *(const f32x4*)(a.in[I_SD] + l * 256 + 4 * lane);
    for (int row = gw; row < T; row += NGW) {
        const f32x4 y0 = *(const f32x4*)(YD + (size_t)row * 256 + 4 * lane), y1 = *(const f32x4*)(YD + ((size_t)T + row) * 256 + 4 * lane);
        const v2u uw = *(const v2u*)(P + (size_t)row * DIN + OFF_U + 4 * lane);
        const f32x4 ys = y0 + y1 + dsk * (f32x4){bflo(uw.x), bfhi(uw.x), bflo(uw.y), bfhi(uw.y)};
        v2u o; o.x = pk2(gelu_tanh(ys.x), gelu_tanh(ys.y)); o.y = pk2(gelu_tanh(ys.z), gelu_tanh(ys.w)); *(v2u*)(Z + (size_t)row * 256 + 4 * lane) = o;
    }
}

__device__ __forceinline__ void attn_simple_item(CArgs ap, int l, int item, int lane) {
    CA& a = *ap;
    unsigned char* ws = a.ws;
    const bf16* P = (const bf16*)(ws + WS_PROJ); const bf16* QN = (const bf16*)(ws + WS_QN); const bf16* KN = (const bf16*)(ws + WS_KN); bf16* YA = (bf16*)(ws + WS_YA);
    int b, hq, ch; bool lat;
    if (item < 4096) { b = item >> 8; hq = (item >> 5) & 7; ch = item & 31; lat = true; } else { const int it = item - 4096; b = it >> 5; hq = (it >> 2) & 7; ch = it & 3; lat = false; }
    const int g = hq >> 2;
    const int qpos = ch * 64 + lane;
    const int row = b * TB + (lat ? CTX : 0) + qpos;
    float q[64], o[64];
    { const bf16* qp = QN + (size_t)row * 512 + hq * 64;
#pragma unroll
      for (int i = 0; i < 8; ++i) { const v4u w = *(const v4u*)(qp + 8 * i);
          q[8 * i + 0] = bflo(w.x) * 0.125f; q[8 * i + 1] = bfhi(w.x) * 0.125f; q[8 * i + 2] = bflo(w.y) * 0.125f; q[8 * i + 3] = bfhi(w.y) * 0.125f;
          q[8 * i + 4] = bflo(w.z) * 0.125f; q[8 * i + 5] = bfhi(w.z) * 0.125f; q[8 * i + 6] = bflo(w.w) * 0.125f; q[8 * i + 7] = bfhi(w.w) * 0.125f; } }
#pragma unroll
    for (int i = 0; i < 64; ++i) o[i] = 0.f;
    float m = a.in[I_SINK][l * 8 + hq], lsum = 1.0f;
    const int j0 = lat ? (ch * 64 - 128 < 0 ? 0 : ch * 64 - 128) : 0, j1 = lat ? (ch * 64 + 192 > SEQ ? SEQ : ch * 64 + 192) : 0;
    const int nlat = j1 - j0, ntot = nlat + CTX;
    for (int jj = 0; jj < ntot; ++jj) {
        const bool islat = jj < nlat; const int j = islat ? j0 + jj : jj - nlat;
        const int krow = __builtin_amdgcn_readfirstlane(b * TB + (islat ? CTX + j : j));
        const bf16* kp = KN + (size_t)krow * 128 + g * 64; const bf16* vp = P + (size_t)krow * DIN + OFF_V + g * 64;
        float s = 0.f;
#pragma unroll
        for (int i = 0; i < 8; ++i) { const v4u w = *(const v4u*)(kp + 8 * i);
            s += q[8 * i] * bflo(w.x) + q[8 * i + 1] * bfhi(w.x) + q[8 * i + 2] * bflo(w.y) + q[8 * i + 3] * bfhi(w.y) + q[8 * i + 4] * bflo(w.z) + q[8 * i + 5] * bfhi(w.z) + q[8 * i + 6] * bflo(w.w) + q[8 * i + 7] * bfhi(w.w); }
        const int dq = qpos - j; const bool valid = !islat || (dq <= 128 && dq >= -128);
        if (!valid) s = -INFINITY;
        const float mn = fmaxf(m, s), al = __expf(m - mn), pe = __expf(s - mn);
        lsum = lsum * al + pe; m = mn;
#pragma unroll
        for (int i = 0; i < 8; ++i) { const v4u w = *(const v4u*)(vp + 8 * i);
            o[8 * i + 0] = o[8 * i + 0] * al + pe * bflo(w.x); o[8 * i + 1] = o[8 * i + 1] * al + pe * bfhi(w.x); o[8 * i + 2] = o[8 * i + 2] * al + pe * bflo(w.y); o[8 * i + 3] = o[8 * i + 3] * al + pe * bfhi(w.y);
            o[8 * i + 4] = o[8 * i + 4] * al + pe * bflo(w.z); o[8 * i + 5] = o[8 * i + 5] * al + pe * bfhi(w.z); o[8 * i + 6] = o[8 * i + 6] * al + pe * bflo(w.w); o[8 * i + 7] = o[8 * i + 7] * al + pe * bfhi(w.w); }
    }
    const float inv = 1.0f / lsum;
    bf16* op = YA + (size_t)row * 512 + hq * 64;
#pragma unroll
    for (int i = 0; i < 8; ++i) { v4u w; w.x = pk2(o[8 * i] * inv, o[8 * i + 1] * inv); w.y = pk2(o[8 * i + 2] * inv, o[8 * i + 3] * inv); w.z = pk2(o[8 * i + 4] * inv, o[8 * i + 5] * inv); w.w = pk2(o[8 * i + 6] * inv, o[8 * i + 7] * inv);
        *(v4u*)(op + 8 * i) = w; }
}

__device__ __forceinline__ void phase_n2(CArgs ap, int l, LAS unsigned char* lds, int tid, int lane, int gw, int NGW) {
    CA& a = *ap;
    unsigned char* ws = a.ws;
    const float* X = (const float*)(ws + WS_X); bf16* H = (bf16*)(ws + WS_H); const float* MOD = (const float*)(ws + WS_MOD);
    float* TOPG = (float*)(ws + WS_TOPG); int* SLOT = (int*)(ws + WS_SLOT); unsigned* CNT = (unsigned*)(ws + WS_CTL) + CW_CNT + l * 32;
    LAS f32x4* TB4 = (LAS f32x4*)lds;
    { const f32x4* src = (const f32x4*)((const float*)(ws + WS_WRT) + (size_t)l * 32 * 1024);
      for (int i = tid; i < 32 * 256; i += NTHREADS) TB4[i] = src[i]; }
    __syncthreads();
    const float brt = a.in[I_BR][l * 32 + (lane >> 1)];
    for (int row = gw; row < T; row += NGW) {
        const int b = row / TB, s = row - b * TB; const int r = s < CTX ? 16 : b;
        f32x4 v[4]; float ss = 0.f;
#pragma unroll
        for (int j = 0; j < 4; ++j) { v[j] = *(const f32x4*)(X + (size_t)row * D + 4 * lane + 256 * j); ss += (v[j].x * v[j].x + v[j].y * v[j].y) + (v[j].z * v[j].z + v[j].w * v[j].w); }
        const float rstd = rsqrtf(wave_sum(ss, lane) * (1.0f / D) + EPS);
        const float* md = MOD + ((size_t)l * 17 + r) * 6144; const float* gn = a.in[I_N2G] + l * D;
#pragma unroll
        for (int j = 0; j < 4; ++j) { const int c = 4 * lane + 256 * j;
            const f32x4 g = *(const f32x4*)(gn + c), sh = *(const f32x4*)(md + 3072 + c), sc = *(const f32x4*)(md + 4096 + c);
            v[j] = (v[j] * rstd * g) * (sc + 1.0f) + sh;
            v2u o; o.x = pk2(v[j].x, v[j].y); o.y = pk2(v[j].z, v[j].w); *(v2u*)(H + (size_t)row * D + c) = o; }
        float pe[32];
#pragma unroll
        for (int e = 0; e < 32; ++e) { float sacc = 0.f;
#pragma unroll
            for (int j = 0; j < 4; ++j) { const f32x4 w = TB4[e * 256 + lane + 64 * j]; sacc += (v[j].x * w.x + v[j].y * w.y) + (v[j].z * w.z + v[j].w * w.w); }
            pe[e] = sacc; if (e & 1) asm volatile("" ::: "memory"); }
        float p16[16], p8[8], p4[4], p2[2], lg;
        { const bool hb = (lane & 32) != 0;
#pragma unroll
          for (int i = 0; i < 16; ++i) { const float keep = hb ? pe[i + 16] : pe[i], send = hb ? pe[i] : pe[i + 16]; p16[i] = keep + shx(send, 32, lane); } }
        { const bool hb = (lane & 16) != 0;
#pragma unroll
          for (int i = 0; i < 8; ++i) { const float keep = hb ? p16[i + 8] : p16[i], send = hb ? p16[i] : p16[i + 8]; p8[i] = keep + shx(send, 16, lane); } }
        { const bool hb = (lane & 8) != 0;
#pragma unroll
          for (int i = 0; i < 4; ++i) { const float keep = hb ? p8[i + 4] : p8[i], send = hb ? p8[i] : p8[i + 4]; p4[i] = keep + shx(send, 8, lane); } }
        { const bool hb = (lane & 4) != 0;
#pragma unroll
          for (int i = 0; i < 2; ++i) { const float keep = hb ? p4[i + 2] : p4[i], send = hb ? p4[i] : p4[i + 2]; p2[i] = keep + shx(send, 4, lane); } }
        { const bool hb = (lane & 2) != 0; const float keep = hb ? p2[1] : p2[0], send = hb ? p2[0] : p2[1]; lg = keep + shx(send, 2, lane); }
        lg += shx(lg, 1, lane);
        lg += brt;
        float tv[4]; int te[4];
#pragma unroll
        for (int k = 0; k < 4; ++k) { const float mx = wave_max(lg, lane); const unsigned long long bal = __ballot(lg == mx); const int first = __ffsll((long long)bal) - 1;
            tv[k] = mx; te[k] = first >> 1; if ((lane >> 1) == te[k]) lg = -INFINITY; }
        const float e1 = __expf(tv[1] - tv[0]), e2 = __expf(tv[2] - tv[0]), e3 = __expf(tv[3] - tv[0]); const float inv = 1.0f / (1.0f + e1 + e2 + e3);
        if (lane < 4) { const int ek = lane == 0 ? te[0] : lane == 1 ? te[1] : lane == 2 ? te[2] : te[3]; const float gk = (lane == 0 ? 1.0f : lane == 1 ? e1 : lane == 2 ? e2 : e3) * inv;
            const unsigned rank = __hip_atomic_fetch_add(CNT + ek, 1u, RLX_AGENT);
            TOPG[(size_t)row * 4 + lane] = gk; SLOT[(size_t)row * 4 + lane] = (int)(((unsigned)ek << 24) | rank); }
    }
    __syncthreads();
}

__device__ __forceinline__ void build_expert_tables(CArgs ap, int l, LAS unsigned char* lds, int tid) {
    CA& a = *ap;
    if (tid == 0) { const unsigned* CNT = (const unsigned*)(a.ws + WS_CTL) + CW_CNT + l * 32; LAS int* pads = (LAS int*)(lds + PADS_OFF); LAS unsigned char* te = lds + TILE_E_OFF;
        int t = 0;
#pragma nounroll
        for (int e = 0; e < 32; ++e) { const int c = (int)__hip_atomic_load(CNT + e, RLX_AGENT); const int nt = (c + 255) >> 8; pads[e] = t * 256;
#pragma nounroll
            for (int i = 0; i < nt; ++i) te[t + i] = (unsigned char)e;
            t += nt; }
        pads[32] = t; }
    __syncthreads();
}

__device__ __forceinline__ void phase_moe_prep(CArgs ap, int l, LAS unsigned char* lds, int tid, int lane, int gw, int NGW) {
    CA& a = *ap;
    unsigned char* ws = a.ws;
    build_expert_tables(ap, l, lds, tid);
    const LAS int* pads = (const LAS int*)(lds + PADS_OFF);
    const bf16* H = (const bf16*)(ws + WS_H); bf16* XG = (bf16*)(ws + WS_XG); int* SLOT = (int*)(ws + WS_SLOT);
    for (int row = gw; row < T; row += NGW) {
        const int4 sl = *(const int4*)(SLOT + (size_t)row * 4); const unsigned pk[4] = {(unsigned)sl.x, (unsigned)sl.y, (unsigned)sl.z, (unsigned)sl.w};
        int st[4];
#pragma unroll
        for (int k = 0; k < 4; ++k) st[k] = pads[pk[k] >> 24] + (int)(pk[k] & 0xffffffu);
        if (lane == 0) *(int4*)(SLOT + (size_t)row * 4) = make_int4(st[0], st[1], st[2], st[3]);
        const v4u h0 = *(const v4u*)(H + (size_t)row * D + 8 * lane), h1 = *(const v4u*)(H + (size_t)row * D + 512 + 8 * lane);
#pragma unroll
        for (int k = 0; k < 4; ++k) { bf16* dst = XG + (size_t)st[k] * D; *(v4u*)(dst + 8 * lane) = h0; *(v4u*)(dst + 512 + 8 * lane) = h1; }
    }
}

constexpr int PH_PER_LAYER = 11, NPHASES = 1 + DEPTH * PH_PER_LAYER + 1;
__global__ void __launch_bounds__(NTHREADS, 2) fwd(Args args) {
    extern __shared__ __attribute__((aligned(16))) unsigned char lds_raw[];
    volatile LAS unsigned* MISC = (volatile LAS unsigned*)((LAS unsigned char*)lds_raw + MISC_OFF);
    if (threadIdx.x < 64) MISC[threadIdx.x] = 0u;
    __syncthreads();
    const int lo = args.ph_lo, hi = args.ph_hi;
    const int wave_s = __builtin_amdgcn_readfirstlane(threadIdx.x >> 6);
#if MK_ONE_LAUNCH
    (void)xcd_barrier_post((unsigned*)(args.ws + WS_CTL) + CW_BAR, MISC + 8);
#define SEAM(k) do { if ((k) + 1 < hi) { CArgs ap_ = get_args(); XcdBarrier b_; b_.bar = (unsigned*)(ap_->ws + WS_CTL) + CW_BAR; b_.x = xb_xcc_id(); \
        LAS unsigned char* l_ = (LAS unsigned char*)lds_raw; asm volatile("" : "+s"(l_)); b_.st = (volatile LAS unsigned*)(l_ + MISC_OFF) + 8; \
        unsigned z2_ = 0u; asm volatile("" : "+s"(z2_)); const int ln_ = (int)__builtin_amdgcn_mbcnt_hi(~0u, __builtin_amdgcn_mbcnt_lo(~0u, z2_)); \
        xcd_barrier(b_, wave_s == 0 && ln_ == 0); } } while (0)
#else
#define SEAM(k) do { } while (0)
#endif
#ifndef DBG_MASK
#define DBG_MASK 0xFFFFu
#endif
#ifndef DBGD
#define DBGD DEPTH
#endif
#define EN(j) (((DBG_MASK) >> (j)) & 1u)
#define IN(k) (lo <= (k) && (k) < hi)
#define PHASE_CTX() CArgs ap = get_args(); unsigned char* ws = ap->ws; (void)ws; \
    LAS unsigned char* lds = (LAS unsigned char*)lds_raw; asm volatile("" : "+s"(lds)); (void)lds; \
    int wave = wave_s; asm volatile("" : "+s"(wave)); unsigned zero_ = 0u; asm volatile("" : "+s"(zero_)); const int lane = (int)__builtin_amdgcn_mbcnt_hi(~0u, __builtin_amdgcn_mbcnt_lo(~0u, zero_)); const int tid = wave * 64 + lane; (void)tid; \
    int bid = blockIdx.x; asm volatile("" : "+s"(bid)); int G = gridDim.x; asm volatile("" : "+s"(G)); \
    const int gw = bid * NWAVES + wave, NGW = G * NWAVES, gws = wave * G + bid; (void)gw; (void)NGW; (void)gws


    if (EN(11) && IN(0)) { PHASE_CTX(); phase_prologue(ap, lds, tid, lane, wave, bid, G); SEAM(0); }

    for (int l = 0; l < DBGD; ++l) {
        const int pb = 1 + PH_PER_LAYER * l;
        if (EN(0) && IN(pb + 0)) { PHASE_CTX(); if (l == 0) phase_n1<0>(ap, l, lane, gw, NGW); else phase_n1<1>(ap, l, lane, gw, NGW); SEAM(pb + 0); }
        if (EN(1) && IN(pb + 1)) { PHASE_CTX();
            pg8::Gemm g{(const bf16*)(ws + WS_H), (const bf16*)(ws + WS_WIN) + (size_t)l * DIN * D, T, DIN, D}; pg8::StaticOrder S; S.init(T, DIN, G, bid);
            pg8::EpiPlain E{(bf16*)(ws + WS_PROJ), DIN};
            pg8::gemm_phase<pg8::EpiPlain, pg8::StaticOrder, true, true>(lds, g, S, E, tid);
            SEAM(pb + 1);
        }
        if (EN(2) && IN(pb + 2)) { PHASE_CTX();
            phase_prep(ap, l, lane, gw, NGW);
            for (int u = gws; u < 512; u += NGW) s5_scan_unit(ap, l, u, lane);
            SEAM(pb + 2);
        }
        if (EN(3) && IN(pb + 3)) { PHASE_CTX();
            for (int item = gws; item < 4608; item += NGW) attn_simple_item(ap, l, item, lane);
            phase_zcombine(ap, l, lane, gw, NGW);
            SEAM(pb + 3);
        }
        if (EN(4) && IN(pb + 4)) { PHASE_CTX();
            pg8::Gemm g{(const bf16*)(ws + WS_Z), (const bf16*)(ws + WS_WGLU) + (size_t)l * 256 * 256, T, 256, 256}; pg8::StaticOrder S; S.init(T, 256, G, bid);
            pg8::EpiGlu E{(const bf16*)(ws + WS_Z), (bf16*)(ws + WS_Z2), 256};
            pg8::gemm_phase<pg8::EpiGlu, pg8::StaticOrder, true, true>(lds, g, S, E, tid);
            SEAM(pb + 4);
        }
        if (EN(5) && IN(pb + 5)) {
            { PHASE_CTX(); pg8::StaticOrder S; S.init(T, D, G, bid);
              pg8::Gemm g{(const bf16*)(ws + WS_Z2), (const bf16*)(ws + WS_WSO) + (size_t)l * D * 256, T, D, 256};
              pg8::EpiBranch<true> E{(const bf16*)(ws + WS_PROJ) + OFF_GT, DIN, (bf16*)(ws + WS_MM), D}; pg8::gemm_phase<pg8::EpiBranch<true>, pg8::StaticOrder, true, true>(lds, g, S, E, tid); }
            { PHASE_CTX(); pg8::StaticOrder S; S.init(T, D, G, bid);
              pg8::Gemm g{(const bf16*)(ws + WS_YB), (const bf16*)(ws + WS_WCO) + (size_t)l * D * 256, T, D, 256};
              pg8::EpiBranch<false> E{(const bf16*)(ws + WS_PROJ) + OFF_GT + D, DIN, (bf16*)(ws + WS_MM), D}; pg8::gemm_phase<pg8::EpiBranch<false>, pg8::StaticOrder, true, true>(lds, g, S, E, tid); }
            { PHASE_CTX(); pg8::StaticOrder S; S.init(T, D, G, bid);
              pg8::Gemm g{(const bf16*)(ws + WS_YA), (const bf16*)(ws + WS_WAO) + (size_t)l * D * 512, T, D, 512};
              pg8::EpiBranch<false> E{(const bf16*)(ws + WS_PROJ) + OFF_GT + 2 * D, DIN, (bf16*)(ws + WS_MM), D}; pg8::gemm_phase<pg8::EpiBranch<false>, pg8::StaticOrder, true, true>(lds, g, S, E, tid); }
            SEAM(pb + 5);
        }
        if (EN(6) && IN(pb + 6)) { PHASE_CTX();
            pg8::Gemm g{(const bf16*)(ws + WS_MM), (const bf16*)(ws + WS_WO) + (size_t)l * D * D, T, D, D}; pg8::StaticOrder S; S.init(T, D, G, bid);
            pg8::EpiWo E{(float*)(ws + WS_X), (const float*)(ws + WS_MOD) + (size_t)l * 17 * 6144 + 2048};
            pg8::gemm_phase<pg8::EpiWo, pg8::StaticOrder, true, true>(lds, g, S, E, tid);
            SEAM(pb + 6);
        }
        if (EN(7) && IN(pb + 7)) { PHASE_CTX(); phase_n2(ap, l, lds, tid, lane, gw, NGW); SEAM(pb + 7); }
        if (EN(8) && IN(pb + 8)) { PHASE_CTX(); phase_moe_prep(ap, l, lds, tid, lane, gw, NGW); SEAM(pb + 8); }
        if (EN(9) && IN(pb + 9)) { PHASE_CTX();
            build_expert_tables(ap, l, lds, tid);
            const int nt = ((const LAS int*)(lds + PADS_OFF))[32];
            pg8::Gemm g{(const bf16*)(ws + WS_XG), (const bf16*)(ws + WS_WGU) + (size_t)l * 32 * 2048 * 1024, nt * 256, 2048, 1024};
            pg8::MoeOrder S{8, nt * 8, G, bid, lds + TILE_E_OFF, (size_t)2048 * 1024 * 2};
            pg8::EpiSwiglu E{(bf16*)(ws + WS_ACT), ap->in[I_BGU] + (size_t)l * 32 * 2048, lds + TILE_E_OFF};
            pg8::gemm_phase<pg8::EpiSwiglu, pg8::MoeOrder, true, true>(lds, g, S, E, tid);
            SEAM(pb + 9);
        }
        if (EN(10) && IN(pb + 10)) { PHASE_CTX();
            build_expert_tables(ap, l, lds, tid);
            const int nt = ((const LAS int*)(lds + PADS_OFF))[32];
            pg8::Gemm g{(const bf16*)(ws + WS_ACT), (const bf16*)(ws + WS_WD) + (size_t)l * 32 * 1024 * 1024, nt * 256, 1024, 1024};
            pg8::MoeOrder S{4, nt * 4, G, bid, lds + TILE_E_OFF, (size_t)1024 * 1024 * 2};
            pg8::EpiDown E{(bf16*)(ws + WS_XG), ap->in[I_BD] + (size_t)l * 32 * 1024, lds + TILE_E_OFF};
            pg8::gemm_phase<pg8::EpiDown, pg8::MoeOrder, true, true>(lds, g, S, E, tid);
            SEAM(pb + 10);
        }
    }
    if (EN(12) && IN(NPHASES - 1)) { PHASE_CTX(); phase_n1<2>(ap, DEPTH, lane, gw, NGW); }
#undef IN
#undef SEAM
}

extern "C" void kernel_launch(void* const* d_in, const int* in_sizes, int n_in, void* d_out, int out_size, void* d_ws, size_t ws_size, hipStream_t stream) {
    static int grid = 0;
    if (grid == 0) {
        if (n_in != N_IN || out_size != NB * SEQ * D || ws_size < WS_END) { fprintf(stderr, "kernel_launch: unexpected sizes (n_in %d out %d ws %zu, need %zu)\n", n_in, out_size, ws_size, (size_t)WS_END); grid = -1; return; }
        int dev = 0, cus = 0, per_cu = 0;
        if (hipGetDevice(&dev) != hipSuccess || hipDeviceGetAttribute(&cus, hipDeviceAttributeMultiprocessorCount, dev) != hipSuccess) { grid = -1; return; }
        if (hipFuncSetAttribute((const void*)fwd, hipFuncAttributeMaxDynamicSharedMemorySize, LDS_BYTES) != hipSuccess) { fprintf(stderr, "kernel_launch: hipFuncSetAttribute failed\n"); grid = -1; return; }
        if (hipOccupancyMaxActiveBlocksPerMultiprocessor(&per_cu, (const void*)fwd, NTHREADS, LDS_BYTES) != hipSuccess || per_cu < 1) { fprintf(stderr, "kernel_launch: occupancy query says %d\n", per_cu); }
        (void)hipGetLastError();
        grid = cus;
    }
    if (grid < 0) return;
    if (hipMemsetAsync((char*)d_ws + WS_CTL, 0, CTL_ZERO_BYTES, stream) != hipSuccess) return;
    Args a{};
    for (int i = 0; i < N_IN; ++i) a.in[i] = (const float*)d_in[i];
    a.out = (float*)d_out; a.ws = (unsigned char*)d_ws;
#if MK_ONE_LAUNCH
    a.ph_lo = 0; a.ph_hi = NPHASES;
    hipLaunchKernelGGL(fwd, dim3(grid), dim3(NTHREADS), LDS_BYTES, stream, a);
#else
    for (int p = 0; p < NPHASES; ++p) { a.ph_lo = p; a.ph_hi = p + 1; hipLaunchKernelGGL(fwd, dim3(grid), dim3(NTHREADS), LDS_BYTES, stream, a); }
#endif
}
```

```cpp
#include <hip/hip_runtime.h>
#include <cstdio>
#include <cstdint>
namespace pg8 {
#define PG8_LAS __attribute__((address_space(3)))
typedef unsigned short bf16_t;
typedef short bf16x8 __attribute__((ext_vector_type(8)));
typedef float f32x4 __attribute__((ext_vector_type(4)));
typedef unsigned u32x4 __attribute__((ext_vector_type(4)));
constexpr int BM = 256, BK = 64, HALF = 128, HTB = HALF * BK * 2  , STAGE_BYTES = 8 * HTB, NXCD = 8, WGM = 8;

__host__ __device__ __forceinline__ int lds_byte(int r, int c) { const int st = (r >> 4) * 2 + (c >> 5), rr = r & 15, cc = c & 31, ob = rr * 64 + cc * 2; return st * 1024 + (ob ^ (((ob >> 9) & 1) << 5)); }
__host__ __device__ __forceinline__ void stage_rc(int b, int& R, int& C) { const int st = b / 1024, sb = b % 1024, swz = sb ^ (((sb >> 9) & 1) << 5); R = (st >> 1) * 16 + swz / 64; C = (st & 1) * 32 + (swz % 64) / 2; }
__host__ __device__ __forceinline__ int perm32(int rho) { const int n = rho >> 4, i = rho & 15; return 8 * (i >> 2) + 4 * n + (i & 3); }

struct Unit { int pm, pn; };
struct Gemm { const bf16_t* A; const bf16_t* Bt; int M, N, K; };

struct StaticOrder {
    int nM, nN, nwg, G, c;
    __host__ __device__ void init(int M, int N, int G_, int c_) { nM = M / BM; nN = N / BM; nwg = nM * nN; G = G_; c = c_; }
    __host__ __device__ bool next(int i, Unit& u) const {
        const long L = (long)i * G + c; if (L >= nwg) return false;
        int wgid = (int)L; { const int q = nwg / NXCD, r = nwg % NXCD, xcd = wgid % NXCD, off = wgid / NXCD; wgid = (xcd < r ? xcd * (q + 1) : r * (q + 1) + (xcd - r) * q) + off; }
        const int nig = WGM * nN, gid = wgid / nig, fm = gid * WGM, gsz = (nM - fm) < WGM ? (nM - fm) : WGM;
        u.pm = fm + ((wgid % nig) % gsz); u.pn = (wgid % nig) / gsz; return true;
    }
    __device__ __forceinline__ void a_ready(const Unit&) const {}
    __device__ __forceinline__ void done(const Unit&) const {}
    __device__ __forceinline__ const char* aptr(const Gemm& g, const Unit& u, size_t tstep) const { return (const char*)g.A + (size_t)u.pm * tstep; }
    __device__ __forceinline__ const char* bptr(const Gemm& g, const Unit& u, size_t tstep) const { return (const char*)g.Bt + (size_t)u.pn * tstep; }
};

__device__ __forceinline__ unsigned cvt_pk_bf16(float lo, float hi) { unsigned r; asm volatile("v_cvt_pk_bf16_f32 %0, %1, %2" : "=v"(r) : "v"(lo), "v"(hi)); return r; }
__device__ __forceinline__ float bf_lo(unsigned w) { return __uint_as_float(w << 16); }
__device__ __forceinline__ float bf_hi(unsigned w) { return __uint_as_float(w & 0xffff0000u); }
__device__ __forceinline__ float sigm(float x) { return __builtin_amdgcn_rcpf(1.0f + __expf(-x)); }
#define PG8_FRESH_LANE() { unsigned z_ = 0u; asm volatile("" : "+s"(z_)); const int l_ = (int)__builtin_amdgcn_mbcnt_hi(~0u, __builtin_amdgcn_mbcnt_lo(~0u, z_)); fr = l_ & 15; fq = l_ >> 4; }

struct EpiPlain {
    static constexpr bool PERM = true, AFTER_DRAIN = false;
    bf16_t* O; int ldc;
    __device__ __forceinline__ void operator()(const f32x4 (&acc)[2][2][4][2], const Unit& u, int wr, int wc, int fr, int fq) const {
        PG8_FRESH_LANE();
        const int row0 = u.pm * BM + wr * 64 + fr, col0 = u.pn * BM + wc * 32 + 8 * fq;
#pragma unroll
        for (int ai = 0; ai < 2; ++ai)
#pragma unroll
            for (int m = 0; m < 4; ++m) { bf16_t* rowp = O + (size_t)(row0 + ai * HALF + m * 16) * ldc + col0;
#pragma unroll
                for (int bj = 0; bj < 2; ++bj) { const f32x4 v0 = acc[ai][bj][m][0], v1 = acc[ai][bj][m][1];
                    u32x4 w; w.x = cvt_pk_bf16(v0[0], v0[1]); w.y = cvt_pk_bf16(v0[2], v0[3]); w.z = cvt_pk_bf16(v1[0], v1[1]); w.w = cvt_pk_bf16(v1[2], v1[3]);
                    *(u32x4*)(rowp + bj * HALF) = w; } }
    }
};
struct EpiGlu {
    static constexpr bool PERM = true, AFTER_DRAIN = false;
    const bf16_t* Z; bf16_t* O; int ldc;
    __device__ __forceinline__ void operator()(const f32x4 (&acc)[2][2][4][2], const Unit& u, int wr, int wc, int fr, int fq) const {
        PG8_FRESH_LANE();
        const int row0 = u.pm * BM + wr * 64 + fr, col0 = u.pn * BM + wc * 32 + 8 * fq;
#pragma unroll
        for (int ai = 0; ai < 2; ++ai)
#pragma unroll
            for (int m = 0; m < 4; ++m) { const size_t off = (size_t)(row0 + ai * HALF + m * 16) * ldc + col0;
#pragma unroll
                for (int bj = 0; bj < 2; ++bj) { const f32x4 v0 = acc[ai][bj][m][0], v1 = acc[ai][bj][m][1];
                    const u32x4 z = *(const u32x4*)(Z + off + bj * HALF);
                    u32x4 w; w.x = cvt_pk_bf16(bf_lo(z.x) * sigm(v0[0]), bf_hi(z.x) * sigm(v0[1])); w.y = cvt_pk_bf16(bf_lo(z.y) * sigm(v0[2]), bf_hi(z.y) * sigm(v0[3]));
                    w.z = cvt_pk_bf16(bf_lo(z.z) * sigm(v1[0]), bf_hi(z.z) * sigm(v1[1])); w.w = cvt_pk_bf16(bf_lo(z.w) * sigm(v1[2]), bf_hi(z.w) * sigm(v1[3]));
                    *(u32x4*)(O + off + bj * HALF) = w; }
                asm volatile("" ::: "memory"); }
    }
};
template <bool FIRST> struct EpiBranch {
    static constexpr bool PERM = true, AFTER_DRAIN = false;
    const bf16_t* GT; int ldg; bf16_t* MM; int ldc;
    __device__ __forceinline__ void operator()(const f32x4 (&acc)[2][2][4][2], const Unit& u, int wr, int wc, int fr, int fq) const {
        PG8_FRESH_LANE();
        const unsigned row0 = u.pm * BM + wr * 64 + fr, col0 = u.pn * BM + wc * 32 + 8 * fq;
        unsigned goff = row0 * (unsigned)ldg + col0, moff = row0 * (unsigned)ldc + col0;
#pragma unroll
        for (int ai = 0; ai < 2; ++ai) {
#pragma unroll
            for (int m = 0; m < 4; ++m) {
#pragma unroll
                for (int bj = 0; bj < 2; ++bj) { const f32x4 v0 = acc[ai][bj][m][0], v1 = acc[ai][bj][m][1];
                    const u32x4 g = *(const u32x4*)(GT + goff + bj * HALF);
                    bf16_t* mp = MM + moff + bj * HALF;
                    float o[8];
                    o[0] = sigm(bf_lo(g.x)) * v0[0]; o[1] = sigm(bf_hi(g.x)) * v0[1]; o[2] = sigm(bf_lo(g.y)) * v0[2]; o[3] = sigm(bf_hi(g.y)) * v0[3];
                    o[4] = sigm(bf_lo(g.z)) * v1[0]; o[5] = sigm(bf_hi(g.z)) * v1[1]; o[6] = sigm(bf_lo(g.w)) * v1[2]; o[7] = sigm(bf_hi(g.w)) * v1[3];
                    if (!FIRST) { const u32x4 p = *(const u32x4*)mp;
                        o[0] += bf_lo(p.x); o[1] += bf_hi(p.x); o[2] += bf_lo(p.y); o[3] += bf_hi(p.y); o[4] += bf_lo(p.z); o[5] += bf_hi(p.z); o[6] += bf_lo(p.w); o[7] += bf_hi(p.w); }
                    u32x4 w; w.x = cvt_pk_bf16(o[0], o[1]); w.y = cvt_pk_bf16(o[2], o[3]); w.z = cvt_pk_bf16(o[4], o[5]); w.w = cvt_pk_bf16(o[6], o[7]);
                    *(u32x4*)mp = w;
                    asm volatile("" ::: "memory"); }
                goff += 16u * (unsigned)ldg; moff += 16u * (unsigned)ldc; }
            goff += 64u * (unsigned)ldg; moff += 64u * (unsigned)ldc; }
    }
};
struct EpiWo {
    static constexpr bool PERM = false, AFTER_DRAIN = false;
    float* X; const float* g1base;
    __device__ __forceinline__ void operator()(const f32x4 (&acc)[2][2][4][2], const Unit& u, int wr, int wc, int fr, int fq) const {
        PG8_FRESH_LANE();
        const int row0 = u.pm * BM + wr * 64 + fr, col0 = u.pn * BM + wc * 32 + 4 * fq;
        const int r = (u.pm % 9 == 0) ? 16 : u.pm / 9; const float* g1 = g1base + (size_t)r * 6144 + col0;
        f32x4 gv[2][2];
#pragma unroll
        for (int bj = 0; bj < 2; ++bj)
#pragma unroll
            for (int n = 0; n < 2; ++n) gv[bj][n] = *(const f32x4*)(g1 + bj * HALF + n * 16);
#pragma unroll
        for (int ai = 0; ai < 2; ++ai)
#pragma unroll
            for (int m = 0; m < 4; ++m) { float* rowp = X + (size_t)(row0 + ai * HALF + m * 16) * 1024 + col0;
#pragma unroll
                for (int bj = 0; bj < 2; ++bj)
#pragma unroll
                    for (int n = 0; n < 2; ++n) { f32x4* p = (f32x4*)(rowp + bj * HALF + n * 16); *p = *p + gv[bj][n] * acc[ai][bj][m][n]; }
                asm volatile("" ::: "memory"); }
    }
};
struct EpiSwiglu {
    static constexpr bool PERM = true, AFTER_DRAIN = false;
    bf16_t* O; const float* bias; const PG8_LAS unsigned char* tile_e;
    __device__ __forceinline__ void operator()(const f32x4 (&acc)[2][2][4][2], const Unit& u, int wr, int wc, int fr, int fq) const {
        PG8_FRESH_LANE();
        const int row0 = u.pm * BM + wr * 64 + fr, acol0 = u.pn * HALF + wc * 32 + 8 * fq;
        const int e = tile_e[u.pm]; const float* bb = bias + (size_t)e * 2048 + 2 * acol0;
        const f32x4 b0 = *(const f32x4*)(bb), b1 = *(const f32x4*)(bb + 4), b2 = *(const f32x4*)(bb + 8), b3 = *(const f32x4*)(bb + 12);
        const float bg[8] = {b0[0], b0[2], b1[0], b1[2], b2[0], b2[2], b3[0], b3[2]}, bu[8] = {b0[1], b0[3], b1[1], b1[3], b2[1], b2[3], b3[1], b3[3]};
#pragma unroll
        for (int ai = 0; ai < 2; ++ai)
#pragma unroll
            for (int m = 0; m < 4; ++m) { bf16_t* rowp = O + (size_t)(row0 + ai * HALF + m * 16) * 1024 + acol0;
                float o[8];
#pragma unroll
                for (int j = 0; j < 8; ++j) { const float gt = acc[ai][0][m][j >> 2][j & 3] + bg[j], up = acc[ai][1][m][j >> 2][j & 3] + bu[j];
                    const float glu = fminf(gt, 7.0f), upc = fminf(fmaxf(up, -7.0f), 7.0f);
                    o[j] = glu * sigm(1.702f * glu) * (upc + 1.0f); }
                u32x4 w; w.x = cvt_pk_bf16(o[0], o[1]); w.y = cvt_pk_bf16(o[2], o[3]); w.z = cvt_pk_bf16(o[4], o[5]); w.w = cvt_pk_bf16(o[6], o[7]);
                *(u32x4*)rowp = w; }
    }
};
struct EpiDown {
    static constexpr bool PERM = true, AFTER_DRAIN = false;
    bf16_t* O; const float* bias; const PG8_LAS unsigned char* tile_e;
    __device__ __forceinline__ void operator()(const f32x4 (&acc)[2][2][4][2], const Unit& u, int wr, int wc, int fr, int fq) const {
        PG8_FRESH_LANE();
        const int row0 = u.pm * BM + wr * 64 + fr, col0 = u.pn * BM + wc * 32 + 8 * fq;
        const int e = tile_e[u.pm]; const float* bb = bias + (size_t)e * 1024 + col0;
        f32x4 bv[2][2];
#pragma unroll
        for (int bj = 0; bj < 2; ++bj)
#pragma unroll
            for (int n = 0; n < 2; ++n) bv[bj][n] = *(const f32x4*)(bb + bj * HALF + 4 * n);
#pragma unroll
        for (int ai = 0; ai < 2; ++ai)
#pragma unroll
            for (int m = 0; m < 4; ++m) { bf16_t* rowp = O + (size_t)(row0 + ai * HALF + m * 16) * 1024 + col0;
#pragma unroll
                for (int bj = 0; bj < 2; ++bj) { const f32x4 v0 = acc[ai][bj][m][0] + bv[bj][0], v1 = acc[ai][bj][m][1] + bv[bj][1];
                    u32x4 w; w.x = cvt_pk_bf16(v0[0], v0[1]); w.y = cvt_pk_bf16(v0[2], v0[3]); w.z = cvt_pk_bf16(v1[0], v1[1]); w.w = cvt_pk_bf16(v1[2], v1[3]);
                    *(u32x4*)(rowp + bj * HALF) = w; } }
    }
};
struct MoeOrder {
    int nN, total, G, c; const PG8_LAS unsigned char* tile_e; size_t estride;
    __device__ __forceinline__ bool next(int i, Unit& u) const { const int L = i * G + c; if (L >= total) return false; u.pm = L / nN; u.pn = L - u.pm * nN; return true; }
    __device__ __forceinline__ void a_ready(const Unit&) const {}
    __device__ __forceinline__ void done(const Unit&) const {}
    __device__ __forceinline__ const char* aptr(const Gemm& g, const Unit& u, size_t tstep) const { return (const char*)g.A + (size_t)u.pm * tstep; }
    __device__ __forceinline__ const char* bptr(const Gemm& g, const Unit& u, size_t tstep) const { return (const char*)g.Bt + (size_t)tile_e[u.pm] * estride + (size_t)u.pn * tstep; }
};


template <class Epi, class Sched, bool ALIGN_EPI = false, bool SP2 = false>
__device__ __forceinline__ void gemm_phase(PG8_LAS unsigned char* lds, const Gemm g, const Sched& S, const Epi& E, int tid_in) {
    int tid_ = tid_in; asm volatile("" : "+v"(tid_));
    const int tid = tid_, wid = __builtin_amdgcn_readfirstlane(tid >> 6), lane = tid & 63, wr = wid >> 2, wc = wid & 3, fr = lane & 15, fq = lane >> 4;
    const int K = g.K, nt = K / BK;
    unsigned voffA[2], voffB[2];
#pragma unroll
    for (int i = 0; i < 2; ++i) { int R, C; stage_rc(tid * 16 + i * 8192, R, C); const int Rb = Epi::PERM ? ((R & ~31) + perm32(R & 31)) : R;
        voffA[i] = (unsigned)(R * K + C) * 2u; voffB[i] = (unsigned)(Rb * K + C) * 2u; }
    const size_t kstep = (size_t)(BK * 2);
    const size_t hstep = (size_t)HALF * K * 2;
    const size_t tstep = 2 * hstep;
    const unsigned ldsw = (unsigned)wid * 1024u;
    const int aoff = lds_byte(wr * 64 + fr, fq * 8), boff = lds_byte(wc * 32 + fr, fq * 8);
#define PG8_SA(b, h) (((b) * 2 + (h)) * HTB)
#define PG8_SB(b, h) ((4 + (b) * 2 + (h)) * HTB)
#define PG8_STAGE(bufoff, gbase, voff) do { _Pragma("unroll") for (int _i = 0; _i < 2; ++_i) \
        __builtin_amdgcn_global_load_lds((const unsigned*)((const char*)(gbase) + (voff)[_i]), (PG8_LAS unsigned*)(lds + (bufoff) + ldsw + _i * 8192), 16, 0, 0); } while (0)
#define PG8_LDA(dst, b, h) do { _Pragma("unroll") for (int m = 0; m < 4; ++m) _Pragma("unroll") for (int k = 0; k < 2; ++k) dst[m][k] = *(const PG8_LAS bf16x8*)(lds + PG8_SA(b, h) + aoff + m * 2048 + k * 1024); } while (0)
#define PG8_LDB(dst, b, h) do { _Pragma("unroll") for (int n = 0; n < 2; ++n) _Pragma("unroll") for (int k = 0; k < 2; ++k) dst[n][k] = *(const PG8_LAS bf16x8*)(lds + PG8_SB(b, h) + boff + n * 2048 + k * 1024); } while (0)
#define PG8_MMA(ai, bj, At, Bt) do { __builtin_amdgcn_s_setprio(1); _Pragma("unroll") for (int m = 0; m < 4; ++m) _Pragma("unroll") for (int n = 0; n < 2; ++n) _Pragma("unroll") for (int k = 0; k < 2; ++k) \
        acc[ai][bj][m][n] = __builtin_amdgcn_mfma_f32_16x16x32_bf16(Bt[n][k], At[m][k], acc[ai][bj][m][n], 0, 0, 0); __builtin_amdgcn_s_setprio(0); } while (0)
#define PG8_WAIT_V(n) asm volatile("s_waitcnt vmcnt(" #n ")" ::: "memory")
#define PG8_WAIT_L(n) asm volatile("s_waitcnt lgkmcnt(" #n ")" ::: "memory")
#define PG8_BAR __builtin_amdgcn_s_barrier()
#define PG8_SCHED __builtin_amdgcn_sched_barrier(0)
    Unit cur, nxt; int ui = 0;
    if (!S.next(0, cur)) return;
    f32x4 acc[2][2][4][2];
#pragma unroll
    for (int a = 0; a < 2; ++a)
#pragma unroll
        for (int b = 0; b < 2; ++b)
#pragma unroll
            for (int m = 0; m < 4; ++m)
#pragma unroll
                for (int n = 0; n < 2; ++n) acc[a][b][m][n] = (f32x4){0.f, 0.f, 0.f, 0.f};
    bf16x8 At[4][2], B0[2][2], B1[2][2];
    const char* cA = S.aptr(g, cur, tstep); const char* cB = S.bptr(g, cur, tstep);
    S.a_ready(cur);
    if constexpr (SP2) {
        PG8_STAGE(PG8_SB(0, 0), cB, voffB); PG8_STAGE(PG8_SB(0, 1), cB + hstep, voffB); PG8_STAGE(PG8_SA(0, 0), cA, voffA); PG8_STAGE(PG8_SA(0, 1), cA + hstep, voffA);
        if (wr == 1) PG8_BAR;
        PG8_WAIT_V(2); PG8_BAR;
        PG8_STAGE(PG8_SB(1, 0), cB + kstep, voffB); PG8_STAGE(PG8_SA(1, 0), cA + kstep, voffA); PG8_STAGE(PG8_SB(1, 1), cB + hstep + kstep, voffB);
        PG8_WAIT_V(6); PG8_BAR;
    } else {
        PG8_STAGE(PG8_SB(0, 0), cB, voffB); PG8_STAGE(PG8_SA(0, 0), cA, voffA); PG8_STAGE(PG8_SB(0, 1), cB + hstep, voffB); PG8_STAGE(PG8_SA(0, 1), cA + hstep, voffA);
        if (wr == 1) PG8_BAR;
        PG8_WAIT_V(4); PG8_BAR;
        PG8_STAGE(PG8_SB(1, 0), cB + kstep, voffB); PG8_STAGE(PG8_SA(1, 0), cA + kstep, voffA); PG8_STAGE(PG8_SB(1, 1), cB + hstep + kstep, voffB);
        PG8_WAIT_V(6); PG8_BAR;
    }
    for (;;) {
        const bool has_next = S.next(ui + 1, nxt);
        const char* nA = has_next ? S.aptr(g, nxt, tstep) : cA; const char* nB = has_next ? S.bptr(g, nxt, tstep) : cB;
        for (int t = 0; t < nt; t += 2) {
            const bool last = (t == nt - 2);
            const char* a1 = cA + (size_t)(t + 1) * kstep;
            const char* a2 = last ? nA : cA + (size_t)(t + 2) * kstep; const char* b2 = last ? nB : cB + (size_t)(t + 2) * kstep;
            const char* a3 = a2 + kstep; const char* b3 = b2 + kstep;
            if (last && has_next) S.a_ready(nxt);
            if constexpr (SP2) {
            PG8_LDB(B0, 0, 0); PG8_LDB(B1, 0, 1); PG8_SCHED; PG8_LDA(At, 0, 0); PG8_STAGE(PG8_SA(1, 1), a1 + hstep, voffA);
            PG8_WAIT_V(8); PG8_WAIT_L(0); PG8_BAR; PG8_MMA(0, 0, At, B0); PG8_MMA(0, 1, At, B1); PG8_BAR; PG8_SCHED;
            PG8_LDA(At, 0, 1); PG8_STAGE(PG8_SB(0, 0), b2, voffB); PG8_STAGE(PG8_SB(0, 1), b2 + hstep, voffB); PG8_STAGE(PG8_SA(0, 0), a2, voffA);
            PG8_WAIT_V(8); PG8_WAIT_L(0); PG8_BAR; PG8_MMA(1, 0, At, B0); PG8_MMA(1, 1, At, B1); PG8_BAR; PG8_SCHED;
            PG8_LDB(B0, 1, 0); PG8_LDB(B1, 1, 1); PG8_SCHED; PG8_LDA(At, 1, 0); PG8_STAGE(PG8_SA(0, 1), a2 + hstep, voffA);
            PG8_WAIT_V(8); PG8_WAIT_L(0); PG8_BAR; PG8_MMA(0, 0, At, B0); PG8_MMA(0, 1, At, B1); PG8_BAR; PG8_SCHED;
            PG8_LDA(At, 1, 1); PG8_STAGE(PG8_SB(1, 0), b3, voffB); PG8_STAGE(PG8_SB(1, 1), b3 + hstep, voffB); PG8_STAGE(PG8_SA(1, 0), a3, voffA);
            PG8_WAIT_V(8); PG8_WAIT_L(0); PG8_BAR; PG8_MMA(1, 0, At, B0); PG8_MMA(1, 1, At, B1); PG8_BAR; PG8_SCHED;
            } else {
            PG8_LDB(B0, 0, 0); PG8_SCHED; PG8_LDA(At, 0, 0); PG8_STAGE(PG8_SA(1, 1), a1 + hstep, voffA);
            PG8_WAIT_L(8); PG8_BAR; PG8_WAIT_L(0); PG8_MMA(0, 0, At, B0); PG8_BAR; PG8_SCHED;
            PG8_LDB(B1, 0, 1); PG8_STAGE(PG8_SB(0, 0), b2, voffB);
            PG8_BAR; PG8_WAIT_L(0); PG8_MMA(0, 1, At, B1); PG8_BAR;
            PG8_LDA(At, 0, 1); PG8_STAGE(PG8_SA(0, 0), a2, voffA);
            PG8_BAR; PG8_WAIT_L(0); PG8_MMA(1, 0, At, B0); PG8_BAR; PG8_SCHED;
            PG8_STAGE(PG8_SB(0, 1), b2 + hstep, voffB);
            PG8_WAIT_V(6); PG8_BAR; PG8_MMA(1, 1, At, B1); PG8_BAR;
            PG8_LDB(B0, 1, 0); PG8_SCHED; PG8_LDA(At, 1, 0); PG8_STAGE(PG8_SA(0, 1), a2 + hstep, voffA);
            PG8_WAIT_L(8); PG8_BAR; PG8_WAIT_L(0); PG8_MMA(0, 0, At, B0); PG8_BAR; PG8_SCHED;
            PG8_LDB(B1, 1, 1); PG8_STAGE(PG8_SB(1, 0), b3, voffB);
            PG8_BAR; PG8_WAIT_L(0); PG8_MMA(0, 1, At, B1); PG8_BAR;
            PG8_LDA(At, 1, 1); PG8_STAGE(PG8_SA(1, 0), a3, voffA);
            PG8_BAR; PG8_WAIT_L(0); PG8_MMA(1, 0, At, B0); PG8_BAR; PG8_SCHED;
            PG8_STAGE(PG8_SB(1, 1), b3 + hstep, voffB);
            PG8_WAIT_V(6); PG8_BAR; PG8_MMA(1, 1, At, B1); PG8_BAR;
            }
        }
        if constexpr (ALIGN_EPI) { if (wr == 0) PG8_BAR; }
        if constexpr (!Epi::AFTER_DRAIN) { E(acc, cur, wr, wc, fr, fq); S.done(cur); }
        if (!has_next) break;
#pragma unroll
        for (int a = 0; a < 2; ++a)
#pragma unroll
            for (int b = 0; b < 2; ++b)
#pragma unroll
                for (int m = 0; m < 4; ++m)
#pragma unroll
                    for (int n = 0; n < 2; ++n) acc[a][b][m][n] = (f32x4){0.f, 0.f, 0.f, 0.f};
        cur = nxt; cA = nA; cB = nB; ++ui;
        if constexpr (ALIGN_EPI) { if (wr == 1) PG8_BAR; }
    }
    PG8_WAIT_V(0);
    if constexpr (!ALIGN_EPI) { if (wr == 0) PG8_BAR; }
    PG8_BAR;
    if constexpr (Epi::AFTER_DRAIN) { E.fused(acc, cur, wr, wc, fr, fq, lds, wid, lane); S.done(cur); }
#undef PG8_SA
#undef PG8_SB
#undef PG8_STAGE
#undef PG8_LDA
#undef PG8_LDB
#undef PG8_MMA
#undef PG8_WAIT_V
#undef PG8_WAIT_L
#undef PG8_BAR
#undef PG8_SCHED
}
}

#ifndef MK_ONE_LAUNCH
#define MK_ONE_LAUNCH 1
#endif
constexpr int NWAVES = 8, NTHREADS = 512;
constexpr int NB = 16, SEQ = 2048, CTX = 256, TB = SEQ + CTX, T = NB * TB, D = 1024, DIN = 4864, DEPTH = 4;
constexpr int OFF_U = 0, OFF_CB = 256, OFF_CC = 512, OFF_CX = 768, OFF_Q = 1024, OFF_K = 1536, OFF_V = 1664, OFF_GT = 1792;
constexpr int NE = 32, MAX_TILES = (T * 4 + NE * 255) / 256, MAX_SLOTS = MAX_TILES * 256;
constexpr float EPS = 1e-6f;
enum { I_X = 0, I_C, I_CTX, I_CCTX, I_WMOD, I_BMOD, I_N1G, I_N2G, I_WIN, I_LRE, I_LIM, I_LDT, I_BRE, I_BIM, I_CRE, I_CIM, I_SD, I_WGLU, I_WSO, I_CONVW, I_WCO, I_QG, I_KG, I_SINK, I_WAO, I_WO,
       I_WR, I_BR, I_WGU, I_BGU, I_WD, I_BD, N_IN };
constexpr size_t MiB = 1u << 20;
constexpr size_t WS_CTL = 0, CTL_ZERO_BYTES = 1 * MiB;
constexpr size_t WS_MOD = 1 * MiB;
constexpr size_t WS_WRT = 3 * MiB;
constexpr size_t WS_ROPE = 4 * MiB;
constexpr size_t WS_WGLU = 5 * MiB;
constexpr size_t WS_WSO = 6 * MiB;
constexpr size_t WS_WCO = 8 * MiB;
constexpr size_t WS_WAO = 10 * MiB;
constexpr size_t WS_WO = 14 * MiB;
constexpr size_t WS_WIN = 22 * MiB;
constexpr size_t WS_WGU = 60 * MiB;
constexpr size_t WS_WD = 572 * MiB;
constexpr size_t WS_X = 828 * MiB;
constexpr size_t WS_H = 972 * MiB;
constexpr size_t WS_PROJ = 1044 * MiB;
constexpr size_t WS_QN = 1386 * MiB;
constexpr size_t WS_KN = 1422 * MiB;
constexpr size_t WS_Z = 1431 * MiB;
constexpr size_t WS_Z2 = 1449 * MiB;
constexpr size_t WS_YB = 1467 * MiB;
constexpr size_t WS_YA = 1485 * MiB;
constexpr size_t WS_MM = 1521 * MiB;
constexpr size_t WS_XG = 1593 * MiB;
constexpr size_t WS_ACT = 1897 * MiB;
constexpr size_t WS_TOPG = 2201 * MiB;
constexpr size_t WS_SLOT = 2202 * MiB;
constexpr size_t WS_S5S = 2203 * MiB;
constexpr size_t WS_XIN = 2275 * MiB;
constexpr size_t WS_VT = 2311 * MiB;
constexpr size_t WS_MS = 2320 * MiB;
constexpr size_t WS_W5 = 2324 * MiB;
constexpr size_t WS_END = 2330 * MiB;
static_assert(WS_WIN + (size_t)4 * DIN * D * 2 <= WS_WGU && WS_PROJ + (size_t)T * DIN * 2 <= WS_QN && WS_XG + (size_t)MAX_SLOTS * D * 2 <= WS_ACT && WS_ACT + (size_t)MAX_SLOTS * D * 2 <= WS_TOPG, "d_ws map");
static_assert(WS_X + (size_t)T * D * 4 <= WS_H && WS_H + (size_t)T * D * 2 <= WS_PROJ && WS_S5S + (size_t)16 * 4608 * 256 * 4 <= WS_XIN && WS_XIN + (size_t)32 * 4608 * 128 * 2 <= WS_VT && WS_VT + (size_t)32 * 64 * TB * 2 <= WS_MS && WS_W5 + (size_t)64 * 128 * 384 * 2 <= WS_END, "d_ws map 2");
constexpr int CW_CNT = 64;
constexpr int CW_BAR = 4096;
constexpr int RING_BYTES = 131072, MISC_OFF = RING_BYTES, TILE_E_OFF = MISC_OFF + 256, PADS_OFF = MISC_OFF + 1024, LDS_BYTES = 147456;

#define GAS __attribute__((address_space(1)))
#define LAS __attribute__((address_space(3)))
typedef unsigned short bf16;
typedef unsigned v4u __attribute__((ext_vector_type(4)));
typedef unsigned v2u __attribute__((ext_vector_type(2)));
typedef float f32x4 __attribute__((ext_vector_type(4)));
typedef float f32x2 __attribute__((ext_vector_type(2)));
typedef GAS unsigned gu32;
#define RLX_AGENT __ATOMIC_RELAXED, __HIP_MEMORY_SCOPE_AGENT
#define LDS_WAIT() asm volatile("s_waitcnt lgkmcnt(0)" ::: "memory")
#define VM_WAIT() asm volatile("s_waitcnt vmcnt(0)" ::: "memory")
__device__ __forceinline__ unsigned f2bf(float f) { unsigned u = __builtin_bit_cast(unsigned, f); return (u + 0x7fffu + ((u >> 16) & 1u)) >> 16; }
__device__ __forceinline__ unsigned pk2(float lo, float hi) { return f2bf(lo) | (f2bf(hi) << 16); }
__device__ __forceinline__ float bflo(unsigned w) { return __uint_as_float(w << 16); }
__device__ __forceinline__ float bfhi(unsigned w) { return __uint_as_float(w & 0xffff0000u); }

#define XB_TMO      128
#define XB_XCNT(j)  (256  + 64 * (j))
#define XB_XSUB(j)  (1280 + 64 * (j))
#define XB_XGEN(j)  (2304 + 64 * (j))
#define XB_TOP      3328
#define XB_TOPGEN   3392
#define XCD_BAR_WORDS 3456
#define XB_SPIN_CAP (1u << 18)

__device__ __forceinline__ unsigned xb_ld(unsigned* p)              { return __hip_atomic_load(p, __ATOMIC_RELAXED, __HIP_MEMORY_SCOPE_AGENT); }
__device__ __forceinline__ unsigned xb_add(unsigned* p, unsigned v) { return __hip_atomic_fetch_add(p, v, __ATOMIC_RELAXED, __HIP_MEMORY_SCOPE_AGENT); }
__device__ __forceinline__ unsigned xb_xcc_id() { return (unsigned)__builtin_amdgcn_s_getreg((3 << 11) | 20) & 0xFu; }
#define XB_SPIN(cond, bar) do { unsigned _sp = 0; while (cond) { __builtin_amdgcn_s_sleep(1); \
    if ((++_sp & 255u) == 0u) { if (xb_ld(&(bar)[XB_TMO])) break; if (_sp > XB_SPIN_CAP) { atomicAdd(&(bar)[XB_TMO], 1u); break; } } } } while (0)

struct XcdBarrier {
    unsigned* bar; unsigned x;
    volatile LAS unsigned* st;
};

__device__ __forceinline__ XcdBarrier xcd_barrier_post(unsigned* bar, volatile LAS unsigned* st) {
    XcdBarrier b; b.bar = bar; b.x = xb_xcc_id(); b.st = st;
    if (threadIdx.x == 0) (void)xb_add(&bar[XB_XCNT(b.x)], 1u);
    return b;
}
__device__ __forceinline__ void xcd_barrier_complete(unsigned* bar, unsigned x, unsigned& nloc, unsigned& nx) {
    const unsigned G = gridDim.x * gridDim.y * gridDim.z;
    unsigned sum, cnt, mine, sp = 0u;
    for (;;) {
        sum = 0u; cnt = 0u; mine = 0u;
#pragma unroll
        for (unsigned j = 0; j < 16; ++j) { const unsigned c = xb_ld(&bar[XB_XCNT(j)]); sum += c; cnt += (c > 0u) ? 1u : 0u; mine = (j == x) ? c : mine; }
        if (sum == G) break;
        __builtin_amdgcn_s_sleep(1);
        if ((++sp & 255u) == 0u) { if (xb_ld(&bar[XB_TMO])) break; if (sp > XB_SPIN_CAP) { atomicAdd(&bar[XB_TMO], 1u); break; } }
    }
    nloc = mine > 0u ? mine : 1u; nx = cnt > 0u ? cnt : 1u;
}

__device__ __forceinline__ void xcd_barrier(const XcdBarrier& b, const bool leader) {
    asm volatile("s_waitcnt vmcnt(0)" ::: "memory");
    __syncthreads();
    if (leader) {
        unsigned* bar = b.bar;
        __builtin_amdgcn_s_waitcnt(0);
        unsigned nloc = b.st[0], nx = b.st[1];
        if (nloc == 0u) { xcd_barrier_complete(bar, b.x, nloc, nx); b.st[0] = nloc; b.st[1] = nx; }
        const unsigned old = xb_add(&bar[XB_XSUB(b.x)], 1u);
        const unsigned gen = old / nloc;
        if (old + 1u == (gen + 1u) * nloc) {
            __builtin_amdgcn_fence(__ATOMIC_RELEASE, "agent");
            asm volatile("s_waitcnt vmcnt(0)" ::: "memory");
            const unsigned og = xb_add(&bar[XB_TOP], 1u);
            const unsigned tg = og / nx;
            if (og + 1u == (tg + 1u) * nx) xb_add(&bar[XB_TOPGEN], 1u);
            else XB_SPIN(xb_ld(&bar[XB_TOPGEN]) == tg, bar);
            __builtin_amdgcn_fence(__ATOMIC_ACQUIRE, "agent");
            xb_add(&bar[XB_XGEN(b.x)], 1u);
            asm volatile("s_waitcnt vmcnt(0)" ::: "memory");
        } else {
            XB_SPIN(xb_ld(&bar[XB_XGEN(b.x)]) == gen, bar);
            __builtin_amdgcn_fence(__ATOMIC_ACQUIRE, "agent");
            asm volatile("s_waitcnt vmcnt(0)" ::: "memory");
        }
    }
    __syncthreads();
}

struct Args { const float* in[N_IN]; float* out; unsigned char* ws; int ph_lo, ph_hi; };
typedef const __attribute__((address_space(4))) Args CA;
typedef CA* CArgs;
__device__ __forceinline__ CArgs get_args() { CArgs p = (CArgs)__builtin_amdgcn_kernarg_segment_ptr(); asm volatile("" : "+s"(p)); return p; }

__device__ __forceinline__ float shx(float v, int m, int lane) { return __builtin_bit_cast(float, __builtin_amdgcn_ds_bpermute((lane ^ m) << 2, __builtin_bit_cast(int, v))); }
__device__ __forceinline__ float wave_sum(float v, int lane) {
#pragma unroll
    for (int o = 1; o < 64; o <<= 1) v += shx(v, o, lane);
    return v;
}
__device__ __forceinline__ float wave_max(float v, int lane) {
#pragma unroll
    for (int o = 1; o < 64; o <<= 1) v = fmaxf(v, shx(v, o, lane));
    return v;
}
__device__ __forceinline__ float gelu_tanh(float x) {
    const float y = 0.7978845608028654f * (x + 0.044715f * x * x * x);
    const float t = 1.0f - 2.0f * __builtin_amdgcn_rcpf(1.0f + __expf(2.0f * y));
    return 0.5f * x * (1.0f + t);
}

__device__ __forceinline__ void s5_build_mats(CArgs ap, LAS unsigned char* lds, int tid, int l, int g);
template <int MODE>
__device__ __forceinline__ void transpose_item(const float* W, int K, int N, bf16* WT, LAS float* scr, int item, int lane) {
    const int nblk = N / 32, kb = item / nblk, nb = item - kb * nblk, k0 = 64 * kb, n0 = 32 * nb;
#pragma unroll 8
    for (int i = 0; i < 32; ++i) { const int kk = 2 * i + (lane >> 5); scr[kk * 33 + (lane & 31)] = W[(size_t)(k0 + kk) * N + n0 + (lane & 31)]; }
    LDS_WAIT(); asm volatile("" ::: "memory");
    const int c = lane & 7;
#pragma unroll
    for (int j = 0; j < 4; ++j) { const int n = (lane >> 3) + 8 * j; const LAS float* s = scr + (8 * c) * 33 + n;
        v4u o; o.x = pk2(s[0 * 33], s[1 * 33]); o.y = pk2(s[2 * 33], s[3 * 33]); o.z = pk2(s[4 * 33], s[5 * 33]); o.w = pk2(s[6 * 33], s[7 * 33]);
        const int nn = n0 + n; const int jj = nn >> 1;
        const int drow = (MODE == 0) ? nn : ((jj >> 7) * 256 + (nn & 1) * 128 + (jj & 127));
        *(GAS v4u*)(WT + (size_t)drow * K + k0 + 8 * c) = o; }
    LDS_WAIT(); asm volatile("" ::: "memory");
}

__device__ __forceinline__ void phase_prologue(CArgs ap, LAS unsigned char* lds, int tid, int lane, int wave, int bid, int G) {
    CA& a = *ap;
    unsigned char* ws = a.ws;
    if (bid < 192) {
        LAS float* S = (LAS float*)lds;
        LAS float* R = (LAS float*)(lds + 17 * 1024 * 4);
        for (int idx = tid; idx < 17 * 1024; idx += NTHREADS) { const int r = idx >> 10, k = idx & 1023; const float v = r < 16 ? a.in[I_C][r * 1024 + k] : a.in[I_CCTX][k]; S[idx] = v / (1.0f + __expf(-v)); }
        __syncthreads();
        const int l = bid / 48, c0 = (bid % 48) * 128, col = tid & 127, kq = tid >> 7;
        float acc[17];
#pragma unroll
        for (int r = 0; r < 17; ++r) acc[r] = 0.f;
        const float* wp = a.in[I_WMOD] + ((size_t)l * 1024 + kq * 256) * 6144 + c0 + col;
#pragma unroll 4
        for (int k = 0; k < 256; ++k) { const float w = wp[(size_t)k * 6144];
#pragma unroll
            for (int r = 0; r < 17; ++r) acc[r] += S[r * 1024 + kq * 256 + k] * w; }
#pragma unroll
        for (int r = 0; r < 17; ++r) R[(kq * 17 + r) * 128 + col] = acc[r];
        __syncthreads();
        float* MOD = (float*)(ws + WS_MOD);
        for (int idx = tid; idx < 17 * 128; idx += NTHREADS) { const int r = idx >> 7, cc = idx & 127;
            const float v = R[(0 * 17 + r) * 128 + cc] + R[(1 * 17 + r) * 128 + cc] + R[(2 * 17 + r) * 128 + cc] + R[(3 * 17 + r) * 128 + cc] + a.in[I_BMOD][l * 6144 + c0 + cc];
            MOD[((size_t)l * 17 + r) * 6144 + c0 + cc] = v; }
    }
    else s5_build_mats(ap, lds, tid, (bid - 192) >> 4, (bid - 192) & 15);
    __syncthreads();
    {
        LAS float* scr = (LAS float*)(lds + wave * 16384);
        const int gw = bid * NWAVES + wave, NGW = G * NWAVES;
        constexpr int N_WGU = 128 * 1024, N_WD = 128 * 512, N_WIN = 4 * 2432, N_WO = 4 * 512, N_WAO = 4 * 256, N_WSO = 4 * 128, N_WCO = 4 * 128, N_WGLU = 4 * 32;
        constexpr int NITEMS = N_WGU + N_WD + N_WIN + N_WO + N_WAO + N_WSO + N_WCO + N_WGLU;
        for (int it = gw; it < NITEMS; it += NGW) {
            int r = it;
            if (r < N_WGU) { const int m = r >> 10; transpose_item<1>(a.in[I_WGU] + (size_t)m * 1024 * 2048, 1024, 2048, (bf16*)(ws + WS_WGU) + (size_t)m * 2048 * 1024, scr, r & 1023, lane); continue; } r -= N_WGU;
            if (r < N_WD) { const int m = r >> 9; transpose_item<0>(a.in[I_WD] + (size_t)m * 1024 * 1024, 1024, 1024, (bf16*)(ws + WS_WD) + (size_t)m * 1024 * 1024, scr, r & 511, lane); continue; } r -= N_WD;
            if (r < N_WIN) { const int m = r / 2432; transpose_item<0>(a.in[I_WIN] + (size_t)m * 1024 * DIN, 1024, DIN, (bf16*)(ws + WS_WIN) + (size_t)m * DIN * 1024, scr, r - m * 2432, lane); continue; } r -= N_WIN;
            if (r < N_WO) { const int m = r >> 9; transpose_item<0>(a.in[I_WO] + (size_t)m * 1024 * 1024, 1024, 1024, (bf16*)(ws + WS_WO) + (size_t)m * 1024 * 1024, scr, r & 511, lane); continue; } r -= N_WO;
            if (r < N_WAO) { const int m = r >> 8; transpose_item<0>(a.in[I_WAO] + (size_t)m * 512 * 1024, 512, 1024, (bf16*)(ws + WS_WAO) + (size_t)m * 1024 * 512, scr, r & 255, lane); continue; } r -= N_WAO;
            if (r < N_WSO) { const int m = r >> 7; transpose_item<0>(a.in[I_WSO] + (size_t)m * 256 * 1024, 256, 1024, (bf16*)(ws + WS_WSO) + (size_t)m * 1024 * 256, scr, r & 127, lane); continue; } r -= N_WSO;
            if (r < N_WCO) { const int m = r >> 7; transpose_item<0>(a.in[I_WCO] + (size_t)m * 256 * 1024, 256, 1024, (bf16*)(ws + WS_WCO) + (size_t)m * 1024 * 256, scr, r & 127, lane); continue; } r -= N_WCO;
            { const int m = r >> 5; transpose_item<0>(a.in[I_WGLU] + (size_t)m * 256 * 256, 256, 256, (bf16*)(ws + WS_WGLU) + (size_t)m * 256 * 256, scr, r & 31, lane); }
        }
    }
    {
        const int gt = bid * NTHREADS + tid, NGT = G * NTHREADS;
        float* WRT = (float*)(ws + WS_WRT);
        for (int i = gt; i < 4 * 32 * 1024; i += NGT) { const int l = i >> 15, e = (i >> 10) & 31, k = i & 1023; WRT[i] = a.in[I_WR][((size_t)l * 1024 + k) * 32 + e]; }
        float* ROPE = (float*)(ws + WS_ROPE);
        for (int i = gt; i < 2048 * 32; i += NGT) { const int t = i >> 5, p = i & 31; const float pos = (float)(p < 16 ? (t >> 6) : (t & 63));
            const float inv = powf(10000.0f, -(float)(p & 15) / 16.0f); float sn, cs; sincosf(pos * inv, &sn, &cs); ROPE[2 * i] = cs; ROPE[2 * i + 1] = sn; }
    }
}

template <int MODE>
__device__ __forceinline__ void phase_n1(CArgs ap, int l, int lane, int gw, int NGW) {
    CA& a = *ap;
    unsigned char* ws = a.ws;
    float* X = (float*)(ws + WS_X); bf16* H = (bf16*)(ws + WS_H);
    const float* MOD = (const float*)(ws + WS_MOD);
    const bf16* YS = (const bf16*)(ws + WS_XG); const float* TOPG = (const float*)(ws + WS_TOPG); const int* SLOT = (const int*)(ws + WS_SLOT);
    for (int row = gw; row < T; row += NGW) {
        const int b = row / TB, s = row - b * TB; const bool isctx = s < CTX; const int r = isctx ? 16 : b;
        if (MODE == 2 && isctx) continue;
        const float* src = (MODE == 0) ? (isctx ? a.in[I_CTX] + ((size_t)b * CTX + s) * D : a.in[I_X] + ((size_t)b * SEQ + (s - CTX)) * D) : X + (size_t)row * D;
        f32x4 v[4];
#pragma unroll
        for (int j = 0; j < 4; ++j) v[j] = *(const f32x4*)(src + 4 * lane + 256 * j);
        if (MODE != 0) {
            const float* g2 = MOD + ((size_t)(l - 1) * 17 + r) * 6144 + 5120;
            const f32x4 tg = *(const f32x4*)(TOPG + (size_t)row * 4); const int4 sl = *(const int4*)(SLOT + (size_t)row * 4);
            const int sls[4] = {sl.x, sl.y, sl.z, sl.w};
            f32x4 acc[4];
#pragma unroll
            for (int j = 0; j < 4; ++j) acc[j] = (f32x4){0.f, 0.f, 0.f, 0.f};
#pragma unroll
            for (int k = 0; k < 4; ++k) { const bf16* yr = YS + (size_t)sls[k] * D; const float gk = tg[k];
#pragma unroll
                for (int j = 0; j < 4; ++j) { const v2u w = *(const v2u*)(yr + 4 * lane + 256 * j);
                    acc[j] += gk * (f32x4){bflo(w.x), bfhi(w.x), bflo(w.y), bfhi(w.y)}; } }
#pragma unroll
            for (int j = 0; j < 4; ++j) v[j] += *(const f32x4*)(g2 + 4 * lane + 256 * j) * acc[j];
        }
        if (MODE == 2) {
            float* o = a.out + ((size_t)b * SEQ + (s - CTX)) * D;
#pragma unroll
            for (int j = 0; j < 4; ++j) *(f32x4*)(o + 4 * lane + 256 * j) = v[j];
            continue;
        }
        float ss = 0.f;
#pragma unroll
        for (int j = 0; j < 4; ++j) { *(f32x4*)(X + (size_t)row * D + 4 * lane + 256 * j) = v[j]; ss += (v[j].x * v[j].x + v[j].y * v[j].y) + (v[j].z * v[j].z + v[j].w * v[j].w); }
        const float rstd = rsqrtf(wave_sum(ss, lane) * (1.0f / D) + EPS);
        const float* md = MOD + ((size_t)l * 17 + r) * 6144; const float* gn = a.in[I_N1G] + l * D;
#pragma unroll
        for (int j = 0; j < 4; ++j) { const int c = 4 * lane + 256 * j;
            const f32x4 g = *(const f32x4*)(gn + c), sh = *(const f32x4*)(md + c), sc = *(const f32x4*)(md + 1024 + c);
            const f32x4 h = (v[j] * rstd * g) * (sc + 1.0f) + sh;
            v2u o; o.x = pk2(h.x, h.y); o.y = pk2(h.z, h.w); *(v2u*)(H + (size_t)row * D + c) = o; }
    }
}

__device__ __forceinline__ void phase_prep(CArgs ap, int l, int lane, int gw, int NGW) {
    CA& a = *ap;
    unsigned char* ws = a.ws;
    const bf16* P = (const bf16*)(ws + WS_PROJ); bf16* YB = (bf16*)(ws + WS_YB); bf16* QN = (bf16*)(ws + WS_QN); bf16* KN = (bf16*)(ws + WS_KN);
    const float* ROPE = (const float*)(ws + WS_ROPE);
    const float* cw = a.in[I_CONVW] + l * 3 * 256;
    for (int row = gw; row < T; row += NGW) {
        const int b = row / TB, s = row - b * TB; const bool isctx = s < CTX;
        const int lo = isctx ? 0 : CTX, hi = isctx ? CTX : TB;
        { const int c4 = 4 * lane; f32x4 zz[3];
#pragma unroll
            for (int d = 0; d < 3; ++d) { const int s2 = s + d - 1;
                if (s2 >= lo && s2 < hi) { const bf16* pr = P + (size_t)(row + d - 1) * DIN; const v2u cc = *(const v2u*)(pr + OFF_CC + c4), cx = *(const v2u*)(pr + OFF_CX + c4);
                    zz[d] = (f32x4){bflo(cc.x) * bflo(cx.x), bfhi(cc.x) * bfhi(cx.x), bflo(cc.y) * bflo(cx.y), bfhi(cc.y) * bfhi(cx.y)}; }
                else zz[d] = (f32x4){0.f, 0.f, 0.f, 0.f}; }
            const v2u cb = *(const v2u*)(P + (size_t)row * DIN + OFF_CB + c4);
            const f32x4 w0 = *(const f32x4*)(cw + c4), w1 = *(const f32x4*)(cw + 256 + c4), w2 = *(const f32x4*)(cw + 512 + c4);
            const f32x4 y = (f32x4){bflo(cb.x), bfhi(cb.x), bflo(cb.y), bfhi(cb.y)} * (w0 * zz[0] + w1 * zz[1] + w2 * zz[2]);
            v2u o; o.x = pk2(y.x, y.y); o.y = pk2(y.z, y.w); *(v2u*)(YB + (size_t)row * 256 + c4) = o; }
#pragma unroll
        for (int pass = 0; pass < 2; ++pass) {
            const int ln = pass ? (lane & 15) : lane;
            const v4u w = *(const v4u*)(P + (size_t)row * DIN + (pass ? OFF_K : OFF_Q) + ln * 8);
            float x[8] = {bflo(w.x), bfhi(w.x), bflo(w.y), bfhi(w.y), bflo(w.z), bfhi(w.z), bflo(w.w), bfhi(w.w)};
            float ss = 0.f;
#pragma unroll
            for (int i = 0; i < 8; ++i) ss += x[i] * x[i];
            ss += shx(ss, 1, lane); ss += shx(ss, 2, lane); ss += shx(ss, 4, lane);
            const float rstd = rsqrtf(ss * (1.0f / 64.0f) + EPS);
            const int d0 = (ln & 7) * 8; const float* gg = (pass ? a.in[I_KG] : a.in[I_QG]) + l * 64 + d0;
            const float qs = pass ? 1.0f : 0.125f;
#pragma unroll
            for (int i = 0; i < 8; ++i) x[i] = x[i] * rstd * gg[i] * qs;
            if (!isctx) {
                const float* rp = ROPE + ((size_t)(s - CTX) * 32 + (d0 & 31)) * 2;
                const bool first = (ln & 4) == 0;
#pragma unroll
                for (int i = 0; i < 8; ++i) { const float pr = shx(x[i], 4, lane); const float cs = rp[2 * i], sn = rp[2 * i + 1];
                    x[i] = first ? (x[i] * cs - pr * sn) : (pr * sn + x[i] * cs); }
            }
            v4u o; o.x = pk2(x[0], x[1]); o.y = pk2(x[2], x[3]); o.z = pk2(x[4], x[5]); o.w = pk2(x[6], x[7]);
            if (pass == 0) *(v4u*)(QN + (size_t)row * 512 + lane * 8) = o;
            else if (lane < 16) *(v4u*)(KN + (size_t)row * 128 + lane * 8) = o;
        }
    }
}


typedef short bf16x8v __attribute__((ext_vector_type(8)));
__device__ __forceinline__ f32x4 mfma16(const v4u& a, const v4u& b, const f32x4& c) { return __builtin_amdgcn_mfma_f32_16x16x32_bf16(__builtin_bit_cast(bf16x8v, a), __builtin_bit_cast(bf16x8v, b), c, 0, 0, 0); }
typedef float f32x2_t __attribute__((ext_vector_type(2))); typedef __bf16 bf16x2_t __attribute__((ext_vector_type(2)));
__device__ __forceinline__ unsigned cvtpk(float lo, float hi) { f32x2_t v = {lo, hi}; bf16x2_t b = __builtin_convertvector(v, bf16x2_t); return __builtin_bit_cast(unsigned, b); }

__device__ __forceinline__ void s5_build_mats(CArgs ap, LAS unsigned char* lds, int tid, int l, int g) {
    CA& a = *ap;
    LAS float* LP = (LAS float*)lds;
    LAS float* BB = LP + 2 * 9 * 64 * 2;
    LAS float* CC = BB + 2 * 64 * 16 * 2;
    for (int i = tid; i < 2 * 9 * 64; i += NTHREADS) { const int z = i / 576, d = (i / 64) % 9, p = i & 63; const int pi = (l * 2 + z) * 16 + g;
        const float lre = a.in[I_LRE][pi * 64 + p], lim = a.in[I_LIM][pi * 64 + p], dt = expf(a.in[I_LDT][pi]);
        float sn, cs; sincosf((float)d * lim * dt, &sn, &cs); const float er = expf((float)d * lre * dt);
        LP[2 * i] = er * cs; LP[2 * i + 1] = er * sn; }
    for (int i = tid; i < 2 * 64 * 16; i += NTHREADS) { const int z = i >> 10, p = (i >> 4) & 63, h = i & 15; const int pi = (l * 2 + z) * 16 + g;
        const float lre = a.in[I_LRE][pi * 64 + p], lim = a.in[I_LIM][pi * 64 + p], dt = expf(a.in[I_LDT][pi]);
        float sn, cs; sincosf(lim * dt, &sn, &cs); const float er = expf(lre * dt); const float nr = er * cs - 1.0f, ni = er * sn, d2 = lre * lre + lim * lim;
        const float qr = (nr * lre + ni * lim) / d2, qi = (ni * lre - nr * lim) / d2;
        const float br = a.in[I_BRE][((size_t)pi * 64 + p) * 16 + h], bi = a.in[I_BIM][((size_t)pi * 64 + p) * 16 + h];
        BB[2 * i] = qr * br - qi * bi; BB[2 * i + 1] = qr * bi + qi * br;
        const int hc = (i >> 6) & 15, pc = i & 63;
        CC[2 * i] = a.in[I_CRE][((size_t)pi * 16 + hc) * 64 + pc]; CC[2 * i + 1] = a.in[I_CIM][((size_t)pi * 16 + hc) * 64 + pc]; }
    __syncthreads();
    bf16* MS = (bf16*)(a.ws + WS_MS) + (size_t)(l * 16 + g) * 256 * 128; bf16* W = (bf16*)(a.ws + WS_W5) + (size_t)(l * 16 + g) * 128 * 384;
    for (int i = tid; i < 256 * 128; i += NTHREADS) { const int j = i & 7, ln = (i >> 3) & 63, nt = (i >> 9) & 15, ks = i >> 13; const int n = nt * 16 + (ln & 15), k = ks * 32 + (ln >> 4) * 8 + j;
        const int z = n >> 7, part = (n >> 6) & 1, p = n & 63, a2 = k >> 4, h2 = k & 15; const int e = z == 0 ? 7 - a2 : a2;
        const float lr = LP[2 * ((z * 9 + e) * 64 + p)], li = LP[2 * ((z * 9 + e) * 64 + p) + 1], br = BB[2 * ((z * 64 + p) * 16 + h2)], bi = BB[2 * ((z * 64 + p) * 16 + h2) + 1];
        MS[i] = (bf16)f2bf(part == 0 ? lr * br - li * bi : lr * bi + li * br); }
    for (int i = tid; i < 128 * 384; i += NTHREADS) { const int j = i & 7, ln = (i >> 3) & 63, nt = (i >> 9) & 7, ks = i >> 12; const int n = nt * 16 + (ln & 15), k = ks * 32 + (ln >> 4) * 8 + j;
        const int aa = n >> 4, h = n & 15; float v = 0.f;
        if (k < 128) { const int a2 = k >> 4, h2 = k & 15;
#pragma unroll
            for (int z = 0; z < 2; ++z) { const int d = z == 0 ? aa - a2 : a2 - aa; if (d < 0) continue;
                for (int p = 0; p < 64; ++p) { const float cr = CC[2 * ((z * 16 + h) * 64 + p)], ci = CC[2 * ((z * 16 + h) * 64 + p) + 1], lr = LP[2 * ((z * 9 + d) * 64 + p)], li = LP[2 * ((z * 9 + d) * 64 + p) + 1];
                    const float tr = cr * lr - ci * li, ti = cr * li + ci * lr; v += tr * BB[2 * ((z * 64 + p) * 16 + h2)] - ti * BB[2 * ((z * 64 + p) * 16 + h2) + 1]; } }
            if (a2 == aa && h2 == h) v += a.in[I_SD][l * 256 + g * 16 + h];
        } else { const int z = (k - 128) >> 7, kk = (k - 128) & 127, part = kk >> 6, p = kk & 63; const int d = z == 0 ? aa + 1 : 8 - aa;
            const float cr = CC[2 * ((z * 16 + h) * 64 + p)], ci = CC[2 * ((z * 16 + h) * 64 + p) + 1], lr = LP[2 * ((z * 9 + d) * 64 + p)], li = LP[2 * ((z * 9 + d) * 64 + p) + 1];
            v = part == 0 ? (cr * lr - ci * li) : -(cr * li + ci * lr); }
        W[i] = (bf16)f2bf(v); }
    __syncthreads();
}

constexpr int S5_ROWS = T / 8, S5_RT = S5_ROWS / 32;
__device__ __forceinline__ void s5a_item(CArgs ap, int l, int item, int lane) {
    CA& a = *ap; unsigned char* ws = a.ws;
    const int g = item / S5_RT, rt = item - g * S5_RT, c = lane & 15, q = lane >> 4;
    const char* Pu = (const char*)((const bf16*)(ws + WS_PROJ) + (size_t)rt * 256 * DIN + OFF_U + g * 16);
    const unsigned aoff = (unsigned)((c * 8 + (q >> 1)) * DIN + (q & 1) * 8) * 2u;
    const char* Mu = (const char*)((const bf16*)(ws + WS_MS) + (size_t)(l * 16 + g) * 256 * 128); const unsigned boff = (unsigned)lane * 16u;
    f32x4 acc[2][16];
#pragma unroll
    for (int m = 0; m < 2; ++m)
#pragma unroll
        for (int n = 0; n < 16; ++n) acc[m][n] = (f32x4){0.f, 0.f, 0.f, 0.f};
#pragma unroll
    for (int ks = 0; ks < 4; ++ks) {
        v4u af[2];
#pragma unroll
        for (int m = 0; m < 2; ++m) af[m] = *(const v4u*)(Pu + (size_t)(2 * ks * DIN * 2 + m * 128 * DIN * 2) + aoff);
#pragma unroll
        for (int n = 0; n < 16; ++n) { const v4u bfr = *(const v4u*)(Mu + (size_t)((ks * 16 + n) * 1024) + boff);
#pragma unroll
            for (int m = 0; m < 2; ++m) acc[m][n] = mfma16(bfr, af[m], acc[m][n]); }
        asm volatile("" ::: "memory");
    }
    char* Su = (char*)((float*)(ws + WS_S5S) + ((size_t)g * S5_ROWS + rt * 32) * 256); const unsigned soff = (unsigned)(c * 256 + 4 * q) * 4u;
#pragma unroll
    for (int m = 0; m < 2; ++m)
#pragma unroll
        for (int n = 0; n < 16; ++n) *(f32x4*)(Su + (size_t)(m * 16 * 256 * 4 + n * 64) + soff) = acc[m][n];
}
__device__ __forceinline__ void s5b_unit(CArgs ap, int l, int u, int lane) {
    CA& a = *ap; unsigned char* ws = a.ws;
    const int b = u & 15, z = (u >> 4) & 1, g = u >> 5, p = lane; const int pi = (l * 2 + z) * 16 + g;
    const float lre = a.in[I_LRE][pi * 64 + p], lim = a.in[I_LIM][pi * 64 + p], dt = expf(a.in[I_LDT][pi]);
    float sn, cs; sincosf(8.0f * lim * dt, &sn, &cs); const float er = expf(8.0f * lre * dt); const float l8r = er * cs, l8i = er * sn;
    const float* S = (const float*)(ws + WS_S5S) + ((size_t)g * S5_ROWS + b * 288) * 256 + z * 128 + p;
    bf16* XI = (bf16*)(ws + WS_XIN) + ((size_t)(z * 16 + g) * S5_ROWS + b * 288) * 128 + p;
    float xr = 0.f, xi = 0.f;
    for (int i0 = 0; i0 < 288; i0 += 8) {
        float sr[8], si[8]; int cc[8];
#pragma unroll
        for (int j = 0; j < 8; ++j) { const int i = i0 + j; cc[j] = z == 0 ? i : (i < 32 ? 31 - i : 319 - i); sr[j] = S[(size_t)cc[j] * 256]; si[j] = S[(size_t)cc[j] * 256 + 64]; }
#pragma unroll
        for (int j = 0; j < 8; ++j) { XI[(size_t)cc[j] * 128] = (bf16)f2bf(xr); XI[(size_t)cc[j] * 128 + 64] = (bf16)f2bf(xi);
            const float nr = l8r * xr - l8i * xi + sr[j], ni = l8r * xi + l8i * xr + si[j]; xr = nr; xi = ni; }
    }
}
__device__ __forceinline__ void s5c_item(CArgs ap, int l, int item, int lane) {
    CA& a = *ap; unsigned char* ws = a.ws;
    const int g = item / S5_RT, rt = item - g * S5_RT, c = lane & 15, q = lane >> 4;
    const char* Pu = (const char*)((const bf16*)(ws + WS_PROJ) + (size_t)rt * 256 * DIN + OFF_U + g * 16);
    const unsigned aoff = (unsigned)((c * 8 + (q >> 1)) * DIN + (q & 1) * 8) * 2u;
    const char* X0u = (const char*)((const bf16*)(ws + WS_XIN) + ((size_t)g * S5_ROWS + rt * 32) * 128); const char* X1u = X0u + (size_t)16 * S5_ROWS * 128 * 2; const unsigned xoff = (unsigned)(c * 128 + q * 8) * 2u;
    const char* Wu = (const char*)((const bf16*)(ws + WS_W5) + (size_t)(l * 16 + g) * 128 * 384); const unsigned boff = (unsigned)lane * 16u;
    f32x4 acc[2][8];
#pragma unroll
    for (int m = 0; m < 2; ++m)
#pragma unroll
        for (int n = 0; n < 8; ++n) acc[m][n] = (f32x4){0.f, 0.f, 0.f, 0.f};
#pragma unroll
    for (int ks = 0; ks < 12; ++ks) {
        v4u af[2];
#pragma unroll
        for (int m = 0; m < 2; ++m) {
            if (ks < 4) af[m] = *(const v4u*)(Pu + (size_t)(2 * ks * DIN * 2 + m * 128 * DIN * 2) + aoff);
            else if (ks < 8) af[m] = *(const v4u*)(X0u + (size_t)(m * 16 * 256 + (ks - 4) * 64) + xoff);
            else af[m] = *(const v4u*)(X1u + (size_t)(m * 16 * 256 + (ks - 8) * 64) + xoff); }
#pragma unroll
        for (int n = 0; n < 8; ++n) { const v4u bfr = *(const v4u*)(Wu + (size_t)((ks * 8 + n) * 1024) + boff);
#pragma unroll
            for (int m = 0; m < 2; ++m) acc[m][n] = mfma16(bfr, af[m], acc[m][n]); }
        if (ks & 1) asm volatile("" ::: "memory");
    }
    char* Zu = (char*)((bf16*)(ws + WS_Z) + (size_t)rt * 256 * 256 + g * 16); const unsigned zoff = (unsigned)(c * 8 * 256 + 4 * q) * 2u;
#pragma unroll
    for (int m = 0; m < 2; ++m)
#pragma unroll
        for (int n = 0; n < 8; ++n) { const f32x4 y = acc[m][n]; v2u o; o.x = cvtpk(gelu_tanh(y[0]), gelu_tanh(y[1])); o.y = cvtpk(gelu_tanh(y[2]), gelu_tanh(y[3]));
            *(v2u*)(Zu + (size_t)((m * 128 + n) * 256 * 2) + zoff) = o; }
}

typedef float f32x16 __attribute__((ext_vector_type(16)));
__device__ __forceinline__ f32x16 mfma32(const v4u& a, const v4u& b, const f32x16& c) { return __builtin_amdgcn_mfma_f32_32x32x16_bf16(__builtin_bit_cast(bf16x8v, a), __builtin_bit_cast(bf16x8v, b), c, 0, 0, 0); }
__device__ __forceinline__ void attn_item(CArgs ap, int l, int item, int lane) {
    CA& a = *ap; unsigned char* ws = a.ws;
    int b, hq, qg; bool lat;
    if (item < 8192) { b = item >> 9; qg = (item >> 3) & 63; hq = item & 7; lat = true; } else { const int it = item - 8192; b = it >> 6; qg = (it >> 3) & 7; hq = it & 7; lat = false; }
    const int g2 = hq >> 2, r = lane & 31, h = lane >> 5, q0 = qg * 32;
    const int qrow = b * TB + (lat ? CTX : 0) + q0 + r;
    const bf16* KN = (const bf16*)(ws + WS_KN) + (size_t)b * TB * 128 + g2 * 64 + 8 * h;
    const bf16* VT = (const bf16*)(ws + WS_VT) + ((size_t)(b * 2 + g2) * 64 + r) * TB + 4 * h;
    v4u bq[4];
#pragma unroll
    for (int ks = 0; ks < 4; ++ks) bq[ks] = *(const v4u*)((const bf16*)(ws + WS_QN) + (size_t)qrow * 512 + hq * 64 + 16 * ks + 8 * h);
    f32x16 o0, o1;
#pragma unroll
    for (int i = 0; i < 16; ++i) { o0[i] = 0.f; o1[i] = 0.f; }
    float m = a.in[I_SINK][l * 8 + hq], lsum = h == 0 ? 1.0f : 0.0f;
    const int ntile = lat ? 17 : 8;
    for (int tt = 0; tt < ntile; ++tt) {
        int s0, mode = 0;
        if (lat && tt < 9) { const int j0 = q0 - 128 + 32 * tt; if (j0 < 0 || j0 >= SEQ) continue; s0 = CTX + j0; mode = tt == 0 ? 1 : (tt == 8 ? 2 : 0); }
        else s0 = 32 * (lat ? tt - 9 : tt);
        v4u ka[4];
#pragma unroll
        for (int ks = 0; ks < 4; ++ks) ka[ks] = *(const v4u*)(KN + (size_t)(s0 + r) * 128 + 16 * ks);
        v2u va[2][2][2];
#pragma unroll
        for (int mt = 0; mt < 2; ++mt)
#pragma unroll
            for (int s = 0; s < 2; ++s) { va[mt][s][0] = *(const v2u*)(VT + (size_t)mt * 32 * TB + s0 + 16 * s); va[mt][s][1] = *(const v2u*)(VT + (size_t)mt * 32 * TB + s0 + 16 * s + 8); }
        f32x16 st;
#pragma unroll
        for (int i = 0; i < 16; ++i) st[i] = 0.f;
#pragma unroll
        for (int ks = 0; ks < 4; ++ks) st = mfma32(ka[ks], bq[ks], st);
        if (mode != 0) {
#pragma unroll
            for (int i = 0; i < 16; ++i) { const int jj = (i & 3) + 8 * (i >> 2) + 4 * h; const bool keep = mode == 1 ? (jj >= r) : (jj <= r); if (!keep) st[i] = -INFINITY; }
        }
        float mx = st[0];
#pragma unroll
        for (int i = 1; i < 16; ++i) mx = fmaxf(mx, st[i]);
        mx = fmaxf(mx, shx(mx, 32, lane));
        const float mn = fmaxf(m, mx), al = __expf(m - mn); m = mn;
        float ps = 0.f;
#pragma unroll
        for (int i = 0; i < 16; ++i) { st[i] = __expf(st[i] - mn); ps += st[i]; }
        lsum = lsum * al + ps;
#pragma unroll
        for (int i = 0; i < 16; ++i) { o0[i] *= al; o1[i] *= al; }
#pragma unroll
        for (int s = 0; s < 2; ++s) { v4u pb; pb.x = cvtpk(st[8 * s + 0], st[8 * s + 1]); pb.y = cvtpk(st[8 * s + 2], st[8 * s + 3]); pb.z = cvtpk(st[8 * s + 4], st[8 * s + 5]); pb.w = cvtpk(st[8 * s + 6], st[8 * s + 7]);
            v4u a0; a0.x = va[0][s][0].x; a0.y = va[0][s][0].y; a0.z = va[0][s][1].x; a0.w = va[0][s][1].y;
            v4u a1; a1.x = va[1][s][0].x; a1.y = va[1][s][0].y; a1.z = va[1][s][1].x; a1.w = va[1][s][1].y;
            o0 = mfma32(a0, pb, o0); o1 = mfma32(a1, pb, o1); }
    }
    lsum += shx(lsum, 32, lane);
    const float inv = 1.0f / lsum;
    bf16* op = (bf16*)(ws + WS_YA) + (size_t)qrow * 512 + hq * 64 + 4 * h;
#pragma unroll
    for (int gq = 0; gq < 4; ++gq) { v2u w0; w0.x = cvtpk(o0[4 * gq] * inv, o0[4 * gq + 1] * inv); w0.y = cvtpk(o0[4 * gq + 2] * inv, o0[4 * gq + 3] * inv); *(v2u*)(op + 8 * gq) = w0;
        v2u w1; w1.x = cvtpk(o1[4 * gq] * inv, o1[4 * gq + 1] * inv); w1.y = cvtpk(o1[4 * gq + 2] * inv, o1[4 * gq + 3] * inv); *(v2u*)(op + 32 + 8 * gq) = w1; }
}
__device__ __forceinline__ void vt_item(CArgs ap, int item, int lane) {
    CA& a = *ap; unsigned char* ws = a.ws;
    const int tile = item >> 1, g2 = item & 1; const int row = tile * 64 + lane; const int b = row / TB, s = row - b * TB;
    const bf16* vp = (const bf16*)(ws + WS_PROJ) + (size_t)row * DIN + OFF_V + g2 * 64;
    bf16* vt = (bf16*)(ws + WS_VT) + (size_t)(b * 2 + g2) * 64 * TB + s;
#pragma unroll
    for (int i = 0; i < 8; ++i) { const v4u w = *(const v4u*)(vp + 8 * i);
        vt[(size_t)(8 * i + 0) * TB] = (bf16)(w.x & 0xffffu); vt[(size_t)(8 * i + 1) * TB] = (bf16)(w.x >> 16); vt[(size_t)(8 * i + 2) * TB] = (bf16)(w.y & 0xffffu); vt[(size_t)(8 * i + 3) * TB] = (bf16)(w.y >> 16);
        vt[(size_t)(8 * i + 4) * TB] = (bf16)(w.z & 0xffffu); vt[(size_t)(8 * i + 5) * TB] = (bf16)(w.z >> 16); vt[(size_t)(8 * i + 6) * TB] = (bf16)(w.w & 0xffffu); vt[(size_t)(8 * i + 7) * TB] = (bf16)(w.w >> 16); }
}

__device__ __forceinline__ void phase_n2(CArgs ap, int l, LAS unsigned char* lds, int tid, int lane, int gw, int NGW) {
    CA& a = *ap;
    unsigned char* ws = a.ws;
    const float* X = (const float*)(ws + WS_X); bf16* H = (bf16*)(ws + WS_H); const float* MOD = (const float*)(ws + WS_MOD);
    float* TOPG = (float*)(ws + WS_TOPG); int* SLOT = (int*)(ws + WS_SLOT); unsigned* CNT = (unsigned*)(ws + WS_CTL) + CW_CNT + l * 32;
    LAS f32x4* TB4 = (LAS f32x4*)lds;
    { const f32x4* src = (const f32x4*)((const float*)(ws + WS_WRT) + (size_t)l * 32 * 1024);
      for (int i = tid; i < 32 * 256; i += NTHREADS) TB4[i] = src[i]; }
    __syncthreads();
    const float brt = a.in[I_BR][l * 32 + (lane >> 1)];
    for (int row = gw; row < T; row += NGW) {
        const int b = row / TB, s = row - b * TB; const int r = s < CTX ? 16 : b;
        f32x4 v[4]; float ss = 0.f;
#pragma unroll
        for (int j = 0; j < 4; ++j) { v[j] = *(const f32x4*)(X + (size_t)row * D + 4 * lane + 256 * j); ss += (v[j].x * v[j].x + v[j].y * v[j].y) + (v[j].z * v[j].z + v[j].w * v[j].w); }
        const float rstd = rsqrtf(wave_sum(ss, lane) * (1.0f / D) + EPS);
        const float* md = MOD + ((size_t)l * 17 + r) * 6144; const float* gn = a.in[I_N2G] + l * D;
#pragma unroll
        for (int j = 0; j < 4; ++j) { const int c = 4 * lane + 256 * j;
            const f32x4 g = *(const f32x4*)(gn + c), sh = *(const f32x4*)(md + 3072 + c), sc = *(const f32x4*)(md + 4096 + c);
            v[j] = (v[j] * rstd * g) * (sc + 1.0f) + sh;
            v2u o; o.x = pk2(v[j].x, v[j].y); o.y = pk2(v[j].z, v[j].w); *(v2u*)(H + (size_t)row * D + c) = o; }
        float pe[32];
#pragma unroll
        for (int e = 0; e < 32; ++e) { float sacc = 0.f;
#pragma unroll
            for (int j = 0; j < 4; ++j) { const f32x4 w = TB4[e * 256 + lane + 64 * j]; sacc += (v[j].x * w.x + v[j].y * w.y) + (v[j].z * w.z + v[j].w * w.w); }
            pe[e] = sacc; if (e & 1) asm volatile("" ::: "memory"); }
        float p16[16], p8[8], p4[4], p2[2], lg;
        { const bool hb = (lane & 32) != 0;
#pragma unroll
          for (int i = 0; i < 16; ++i) { const float keep = hb ? pe[i + 16] : pe[i], send = hb ? pe[i] : pe[i + 16]; p16[i] = keep + shx(send, 32, lane); } }
        { const bool hb = (lane & 16) != 0;
#pragma unroll
          for (int i = 0; i < 8; ++i) { const float keep = hb ? p16[i + 8] : p16[i], send = hb ? p16[i] : p16[i + 8]; p8[i] = keep + shx(send, 16, lane); } }
        { const bool hb = (lane & 8) != 0;
#pragma unroll
          for (int i = 0; i < 4; ++i) { const float keep = hb ? p8[i + 4] : p8[i], send = hb ? p8[i] : p8[i + 4]; p4[i] = keep + shx(send, 8, lane); } }
        { const bool hb = (lane & 4) != 0;
#pragma unroll
          for (int i = 0; i < 2; ++i) { const float keep = hb ? p4[i + 2] : p4[i], send = hb ? p4[i] : p4[i + 2]; p2[i] = keep + shx(send, 4, lane); } }
        { const bool hb = (lane & 2) != 0; const float keep = hb ? p2[1] : p2[0], send = hb ? p2[0] : p2[1]; lg = keep + shx(send, 2, lane); }
        lg += shx(lg, 1, lane);
        lg += brt;
        float tv[4]; int te[4];
#pragma unroll
        for (int k = 0; k < 4; ++k) { const float mx = wave_max(lg, lane); const unsigned long long bal = __ballot(lg == mx); const int first = __ffsll((long long)bal) - 1;
            tv[k] = mx; te[k] = first >> 1; if ((lane >> 1) == te[k]) lg = -INFINITY; }
        const float e1 = __expf(tv[1] - tv[0]), e2 = __expf(tv[2] - tv[0]), e3 = __expf(tv[3] - tv[0]); const float inv = 1.0f / (1.0f + e1 + e2 + e3);
        if (lane < 4) { const int ek = lane == 0 ? te[0] : lane == 1 ? te[1] : lane == 2 ? te[2] : te[3]; const float gk = (lane == 0 ? 1.0f : lane == 1 ? e1 : lane == 2 ? e2 : e3) * inv;
            const unsigned rank = __hip_atomic_fetch_add(CNT + ek, 1u, RLX_AGENT);
            TOPG[(size_t)row * 4 + lane] = gk; SLOT[(size_t)row * 4 + lane] = (int)(((unsigned)ek << 24) | rank); }
    }
    __syncthreads();
}

__device__ __forceinline__ void build_expert_tables(CArgs ap, int l, LAS unsigned char* lds, int tid) {
    CA& a = *ap;
    if (tid == 0) { const unsigned* CNT = (const unsigned*)(a.ws + WS_CTL) + CW_CNT + l * 32; LAS int* pads = (LAS int*)(lds + PADS_OFF); LAS unsigned char* te = lds + TILE_E_OFF;
        int t = 0;
#pragma nounroll
        for (int e = 0; e < 32; ++e) { const int c = (int)__hip_atomic_load(CNT + e, RLX_AGENT); const int nt = (c + 255) >> 8; pads[e] = t * 256;
#pragma nounroll
            for (int i = 0; i < nt; ++i) te[t + i] = (unsigned char)e;
            t += nt; }
        pads[32] = t; }
    __syncthreads();
}

__device__ __forceinline__ void phase_moe_prep(CArgs ap, int l, LAS unsigned char* lds, int tid, int lane, int gw, int NGW) {
    CA& a = *ap;
    unsigned char* ws = a.ws;
    build_expert_tables(ap, l, lds, tid);
    const LAS int* pads = (const LAS int*)(lds + PADS_OFF);
    const bf16* H = (const bf16*)(ws + WS_H); bf16* XG = (bf16*)(ws + WS_XG); int* SLOT = (int*)(ws + WS_SLOT);
    for (int row = gw; row < T; row += NGW) {
        const int4 sl = *(const int4*)(SLOT + (size_t)row * 4); const unsigned pk[4] = {(unsigned)sl.x, (unsigned)sl.y, (unsigned)sl.z, (unsigned)sl.w};
        int st[4];
#pragma unroll
        for (int k = 0; k < 4; ++k) st[k] = pads[pk[k] >> 24] + (int)(pk[k] & 0xffffffu);
        if (lane == 0) *(int4*)(SLOT + (size_t)row * 4) = make_int4(st[0], st[1], st[2], st[3]);
        const v4u h0 = *(const v4u*)(H + (size_t)row * D + 8 * lane), h1 = *(const v4u*)(H + (size_t)row * D + 512 + 8 * lane);
#pragma unroll
        for (int k = 0; k < 4; ++k) { bf16* dst = XG + (size_t)st[k] * D; *(v4u*)(dst + 8 * lane) = h0; *(v4u*)(dst + 512 + 8 * lane) = h1; }
    }
}

constexpr int PH_PER_LAYER = 12, NPHASES = 1 + DEPTH * PH_PER_LAYER + 1;
__global__ void __launch_bounds__(NTHREADS, 2) fwd(Args args) {
    extern __shared__ __attribute__((aligned(16))) unsigned char lds_raw[];
    volatile LAS unsigned* MISC = (volatile LAS unsigned*)((LAS unsigned char*)lds_raw + MISC_OFF);
    if (threadIdx.x < 64) MISC[threadIdx.x] = 0u;
    __syncthreads();
    const int lo = args.ph_lo, hi = args.ph_hi;
    const int wave_s = __builtin_amdgcn_readfirstlane(threadIdx.x >> 6);
#if MK_ONE_LAUNCH
    (void)xcd_barrier_post((unsigned*)(args.ws + WS_CTL) + CW_BAR, MISC + 8);
#define SEAM(k) do { if ((k) + 1 < hi) { CArgs ap_ = get_args(); XcdBarrier b_; b_.bar = (unsigned*)(ap_->ws + WS_CTL) + CW_BAR; b_.x = xb_xcc_id(); \
        LAS unsigned char* l_ = (LAS unsigned char*)lds_raw; asm volatile("" : "+s"(l_)); b_.st = (volatile LAS unsigned*)(l_ + MISC_OFF) + 8; \
        unsigned z2_ = 0u; asm volatile("" : "+s"(z2_)); const int ln_ = (int)__builtin_amdgcn_mbcnt_hi(~0u, __builtin_amdgcn_mbcnt_lo(~0u, z2_)); \
        xcd_barrier(b_, wave_s == 0 && ln_ == 0); } } while (0)
#else
#define SEAM(k) do { } while (0)
#endif
#ifndef DBG_MASK
#define DBG_MASK 0xFFFFu
#endif
#ifndef DBGD
#define DBGD DEPTH
#endif
#define EN(j) (((DBG_MASK) >> (j)) & 1u)
#define IN(k) (lo <= (k) && (k) < hi)
#define PHASE_CTX() CArgs ap = get_args(); unsigned char* ws = ap->ws; (void)ws; \
    LAS unsigned char* lds = (LAS unsigned char*)lds_raw; asm volatile("" : "+s"(lds)); (void)lds; \
    int wave = wave_s; asm volatile("" : "+s"(wave)); unsigned zero_ = 0u; asm volatile("" : "+s"(zero_)); const int lane = (int)__builtin_amdgcn_mbcnt_hi(~0u, __builtin_amdgcn_mbcnt_lo(~0u, zero_)); const int tid = wave * 64 + lane; (void)tid; \
    int bid = blockIdx.x; asm volatile("" : "+s"(bid)); int G = gridDim.x; asm volatile("" : "+s"(G)); \
    const int gw = bid * NWAVES + wave, NGW = G * NWAVES, gws = wave * G + bid; (void)gw; (void)NGW; (void)gws


    if (EN(11) && IN(0)) { PHASE_CTX(); phase_prologue(ap, lds, tid, lane, wave, bid, G); SEAM(0); }

    for (int l = 0; l < DBGD; ++l) {
        const int pb = 1 + PH_PER_LAYER * l;
        if (EN(0) && IN(pb + 0)) { PHASE_CTX(); if (l == 0) phase_n1<0>(ap, l, lane, gw, NGW); else phase_n1<1>(ap, l, lane, gw, NGW); SEAM(pb + 0); }
        if (EN(1) && IN(pb + 1)) { PHASE_CTX();
            pg8::Gemm g{(const bf16*)(ws + WS_H), (const bf16*)(ws + WS_WIN) + (size_t)l * DIN * D, T, DIN, D}; pg8::StaticOrder S; S.init(T, DIN, G, bid);
            pg8::EpiPlain E{(bf16*)(ws + WS_PROJ), DIN};
            pg8::gemm_phase<pg8::EpiPlain, pg8::StaticOrder, true, true>(lds, g, S, E, tid);
            SEAM(pb + 1);
        }
        if (EN(2) && IN(pb + 2)) { PHASE_CTX();
            phase_prep(ap, l, lane, gw, NGW);
            for (int it = gw; it < 1152; it += NGW) vt_item(ap, it, lane);
            for (int it = gw; it < 16 * S5_RT; it += NGW) s5a_item(ap, l, it, lane);
            SEAM(pb + 2);
        }
        if (EN(3) && IN(pb + 3)) { PHASE_CTX();
            for (int u = gws; u < 512; u += NGW) s5b_unit(ap, l, u, lane);
            for (int item = gw; item < 9216; item += NGW) attn_item(ap, l, item, lane);
            SEAM(pb + 3);
        }
        if (EN(13) && IN(pb + 4)) { PHASE_CTX();
            for (int it = gw; it < 16 * S5_RT; it += NGW) s5c_item(ap, l, it, lane);
            SEAM(pb + 4);
        }
        if (EN(4) && IN(pb + 5)) { PHASE_CTX();
            pg8::Gemm g{(const bf16*)(ws + WS_Z), (const bf16*)(ws + WS_WGLU) + (size_t)l * 256 * 256, T, 256, 256}; pg8::StaticOrder S; S.init(T, 256, G, bid);
            pg8::EpiGlu E{(const bf16*)(ws + WS_Z), (bf16*)(ws + WS_Z2), 256};
            pg8::gemm_phase<pg8::EpiGlu, pg8::StaticOrder, true, true>(lds, g, S, E, tid);
            SEAM(pb + 5);
        }
        if (EN(5) && IN(pb + 6)) {
            { PHASE_CTX(); pg8::StaticOrder S; S.init(T, D, G, bid);
              pg8::Gemm g{(const bf16*)(ws + WS_Z2), (const bf16*)(ws + WS_WSO) + (size_t)l * D * 256, T, D, 256};
              pg8::EpiBranch<true> E{(const bf16*)(ws + WS_PROJ) + OFF_GT, DIN, (bf16*)(ws + WS_MM), D}; pg8::gemm_phase<pg8::EpiBranch<true>, pg8::StaticOrder, true, true>(lds, g, S, E, tid); }
            { PHASE_CTX(); pg8::StaticOrder S; S.init(T, D, G, bid);
              pg8::Gemm g{(const bf16*)(ws + WS_YB), (const bf16*)(ws + WS_WCO) + (size_t)l * D * 256, T, D, 256};
              pg8::EpiBranch<false> E{(const bf16*)(ws + WS_PROJ) + OFF_GT + D, DIN, (bf16*)(ws + WS_MM), D}; pg8::gemm_phase<pg8::EpiBranch<false>, pg8::StaticOrder, true, true>(lds, g, S, E, tid); }
            { PHASE_CTX(); pg8::StaticOrder S; S.init(T, D, G, bid);
              pg8::Gemm g{(const bf16*)(ws + WS_YA), (const bf16*)(ws + WS_WAO) + (size_t)l * D * 512, T, D, 512};
              pg8::EpiBranch<false> E{(const bf16*)(ws + WS_PROJ) + OFF_GT + 2 * D, DIN, (bf16*)(ws + WS_MM), D}; pg8::gemm_phase<pg8::EpiBranch<false>, pg8::StaticOrder, true, true>(lds, g, S, E, tid); }
            SEAM(pb + 6);
        }
        if (EN(6) && IN(pb + 7)) { PHASE_CTX();
            pg8::Gemm g{(const bf16*)(ws + WS_MM), (const bf16*)(ws + WS_WO) + (size_t)l * D * D, T, D, D}; pg8::StaticOrder S; S.init(T, D, G, bid);
            pg8::EpiWo E{(float*)(ws + WS_X), (const float*)(ws + WS_MOD) + (size_t)l * 17 * 6144 + 2048};
            pg8::gemm_phase<pg8::EpiWo, pg8::StaticOrder, true, true>(lds, g, S, E, tid);
            SEAM(pb + 7);
        }
        if (EN(7) && IN(pb + 8)) { PHASE_CTX(); phase_n2(ap, l, lds, tid, lane, gw, NGW); SEAM(pb + 8); }
        if (EN(8) && IN(pb + 9)) { PHASE_CTX(); phase_moe_prep(ap, l, lds, tid, lane, gw, NGW); SEAM(pb + 9); }
        if (EN(9) && IN(pb + 10)) { PHASE_CTX();
            build_expert_tables(ap, l, lds, tid);
            const int nt = ((const LAS int*)(lds + PADS_OFF))[32];
            pg8::Gemm g{(const bf16*)(ws + WS_XG), (const bf16*)(ws + WS_WGU) + (size_t)l * 32 * 2048 * 1024, nt * 256, 2048, 1024};
            pg8::MoeOrder S{8, nt * 8, G, bid, lds + TILE_E_OFF, (size_t)2048 * 1024 * 2};
            pg8::EpiSwiglu E{(bf16*)(ws + WS_ACT), ap->in[I_BGU] + (size_t)l * 32 * 2048, lds + TILE_E_OFF};
            pg8::gemm_phase<pg8::EpiSwiglu, pg8::MoeOrder, true, true>(lds, g, S, E, tid);
            SEAM(pb + 10);
        }
        if (EN(10) && IN(pb + 11)) { PHASE_CTX();
            build_expert_tables(ap, l, lds, tid);
            const int nt = ((const LAS int*)(lds + PADS_OFF))[32];
            pg8::Gemm g{(const bf16*)(ws + WS_ACT), (const bf16*)(ws + WS_WD) + (size_t)l * 32 * 1024 * 1024, nt * 256, 1024, 1024};
            pg8::MoeOrder S{4, nt * 4, G, bid, lds + TILE_E_OFF, (size_t)1024 * 1024 * 2};
            pg8::EpiDown E{(bf16*)(ws + WS_XG), ap->in[I_BD] + (size_t)l * 32 * 1024, lds + TILE_E_OFF};
            pg8::gemm_phase<pg8::EpiDown, pg8::MoeOrder, true, true>(lds, g, S, E, tid);
            SEAM(pb + 11);
        }
    }
    if (EN(12) && IN(NPHASES - 1)) { PHASE_CTX(); phase_n1<2>(ap, DEPTH, lane, gw, NGW); }
#undef IN
#undef SEAM
}

extern "C" void kernel_launch(void* const* d_in, const int* in_sizes, int n_in, void* d_out, int out_size, void* d_ws, size_t ws_size, hipStream_t stream) {
    static int grid = 0;
    if (grid == 0) {
        if (n_in != N_IN || out_size != NB * SEQ * D || ws_size < WS_END) { fprintf(stderr, "kernel_launch: unexpected sizes (n_in %d out %d ws %zu, need %zu)\n", n_in, out_size, ws_size, (size_t)WS_END); grid = -1; return; }
        int dev = 0, cus = 0, per_cu = 0;
        if (hipGetDevice(&dev) != hipSuccess || hipDeviceGetAttribute(&cus, hipDeviceAttributeMultiprocessorCount, dev) != hipSuccess) { grid = -1; return; }
        if (hipFuncSetAttribute((const void*)fwd, hipFuncAttributeMaxDynamicSharedMemorySize, LDS_BYTES) != hipSuccess) { fprintf(stderr, "kernel_launch: hipFuncSetAttribute failed\n"); grid = -1; return; }
        if (hipOccupancyMaxActiveBlocksPerMultiprocessor(&per_cu, (const void*)fwd, NTHREADS, LDS_BYTES) != hipSuccess || per_cu < 1) { fprintf(stderr, "kernel_launch: occupancy query says %d\n", per_cu); }
        (void)hipGetLastError();
        grid = cus;
    }
    if (grid < 0) return;
    if (hipMemsetAsync((char*)d_ws + WS_CTL, 0, CTL_ZERO_BYTES, stream) != hipSuccess) return;
    Args a{};
    for (int i = 0; i < N_IN; ++i) a.in[i] = (const float*)d_in[i];
    a.out = (float*)d_out; a.ws = (unsigned char*)d_ws;
#if MK_ONE_LAUNCH
    a.ph_lo = 0; a.ph_hi = NPHASES;
    hipLaunchKernelGGL(fwd, dim3(grid), dim3(NTHREADS), LDS_BYTES, stream, a);
#else
    for (int p = 0; p < NPHASES; ++p) { a.ph_lo = p; a.ph_hi = p + 1; hipLaunchKernelGGL(fwd, dim3(grid), dim3(NTHREADS), LDS_BYTES, stream, a); }
#endif
}
```

```cpp
#include <hip/hip_runtime.h>
#include <cstdio>
#include <cstdint>
namespace pg8 {
#define PG8_LAS __attribute__((address_space(3)))
#define PG8_GAS __attribute__((address_space(1)))
typedef unsigned short bf16_t;
typedef short bf16x8 __attribute__((ext_vector_type(8)));
typedef float f32x4 __attribute__((ext_vector_type(4)));
typedef unsigned u32x4 __attribute__((ext_vector_type(4)));
typedef int pg8_i4 __attribute__((ext_vector_type(4)));
typedef int pg8_i8 __attribute__((ext_vector_type(8)));
constexpr int BM = 256, BK = 64, HALF = 128, HTB = HALF * BK * 2  , STAGE_BYTES = 8 * HTB, NXCD = 8, WGM = 8;

__host__ __device__ __forceinline__ int lds_byte(int r, int c) { const int st = (r >> 4) * 2 + (c >> 5), rr = r & 15, cc = c & 31, ob = rr * 64 + cc * 2; return st * 1024 + (ob ^ (((ob >> 9) & 1) << 5)); }
__host__ __device__ __forceinline__ void stage_rc(int b, int& R, int& C) { const int st = b / 1024, sb = b % 1024, swz = sb ^ (((sb >> 9) & 1) << 5); R = (st >> 1) * 16 + swz / 64; C = (st & 1) * 32 + (swz % 64) / 2; }
__host__ __device__ __forceinline__ int perm32(int rho) { const int n = rho >> 4, i = rho & 15; return 8 * (i >> 2) + 4 * n + (i & 3); }

struct Unit { int pm, pn; };
struct Gemm { const bf16_t* A; const bf16_t* Bt; int M, N, K; };

struct StaticOrder {
    static constexpr bool GATHER = false;
    int nM, nN, nwg, G, c;
    __host__ __device__ void init(int M, int N, int G_, int c_) { nM = M / BM; nN = N / BM; nwg = nM * nN; G = G_; c = c_; }
    __host__ __device__ bool next(int i, Unit& u) const {
        const long L = (long)i * G + c; if (L >= nwg) return false;
        int wgid = (int)L; { const int q = nwg / NXCD, r = nwg % NXCD, xcd = wgid % NXCD, off = wgid / NXCD; wgid = (xcd < r ? xcd * (q + 1) : r * (q + 1) + (xcd - r) * q) + off; }
        const int nig = WGM * nN, gid = wgid / nig, fm = gid * WGM, gsz = (nM - fm) < WGM ? (nM - fm) : WGM;
        u.pm = fm + ((wgid % nig) % gsz); u.pn = (wgid % nig) / gsz; return true;
    }
    __device__ __forceinline__ void a_ready(const Unit&) const {}
    __device__ __forceinline__ void done(const Unit&) const {}
    __device__ __forceinline__ const char* aptr(const Gemm& g, const Unit& u, size_t tstep) const { return (const char*)g.A + (size_t)u.pm * tstep; }
    __device__ __forceinline__ const char* bptr(const Gemm& g, const Unit& u, size_t tstep) const { return (const char*)g.Bt + (size_t)u.pn * tstep; }
};

__device__ __forceinline__ unsigned cvt_pk_bf16(float lo, float hi) { unsigned r; asm volatile("v_cvt_pk_bf16_f32 %0, %1, %2" : "=v"(r) : "v"(lo), "v"(hi)); return r; }
__device__ __forceinline__ float bf_lo(unsigned w) { return __uint_as_float(w << 16); }
__device__ __forceinline__ float bf_hi(unsigned w) { return __uint_as_float(w & 0xffff0000u); }
__device__ __forceinline__ float sigm(float x) { return __builtin_amdgcn_rcpf(1.0f + __expf(-x)); }
#define PG8_FRESH_LANE() { unsigned z_ = 0u; asm volatile("" : "+s"(z_)); const int l_ = (int)__builtin_amdgcn_mbcnt_hi(~0u, __builtin_amdgcn_mbcnt_lo(~0u, z_)); fr = l_ & 15; fq = l_ >> 4; }

struct EpiPlain {
    static constexpr bool PERM = true, AFTER_DRAIN = false, FP8 = false; static constexpr int WSCALE = 0x7f;
    bf16_t* O; int ldc;
    __device__ __forceinline__ void operator()(const f32x4 (&acc)[2][2][4][2], const Unit& u, int wr, int wc, int fr, int fq) const {
        PG8_FRESH_LANE();
        const int row0 = u.pm * BM + wr * 64 + fr, col0 = u.pn * BM + wc * 32 + 8 * fq;
#pragma unroll
        for (int ai = 0; ai < 2; ++ai)
#pragma unroll
            for (int m = 0; m < 4; ++m) { bf16_t* rowp = O + (size_t)(row0 + ai * HALF + m * 16) * ldc + col0;
#pragma unroll
                for (int bj = 0; bj < 2; ++bj) { const f32x4 v0 = acc[ai][bj][m][0], v1 = acc[ai][bj][m][1];
                    u32x4 w; w.x = cvt_pk_bf16(v0[0], v0[1]); w.y = cvt_pk_bf16(v0[2], v0[3]); w.z = cvt_pk_bf16(v1[0], v1[1]); w.w = cvt_pk_bf16(v1[2], v1[3]);
                    *(u32x4*)(rowp + bj * HALF) = w; } }
    }
};
struct EpiPlain8 {
    static constexpr bool PERM = true, AFTER_DRAIN = false, FP8 = true; static constexpr int WSCALE = 0;
    bf16_t* O; int ldc;
    __device__ __forceinline__ void operator()(const f32x4 (&acc)[2][2][4][2], const Unit& u, int wr, int wc, int fr, int fq) const {
        PG8_FRESH_LANE();
        const int row0 = u.pm * BM + wr * 64 + fr, col0 = u.pn * BM + wc * 32 + 8 * fq;
#pragma unroll
        for (int ai = 0; ai < 2; ++ai)
#pragma unroll
            for (int m = 0; m < 4; ++m) { bf16_t* rowp = O + (size_t)(row0 + ai * HALF + m * 16) * ldc + col0;
#pragma unroll
                for (int bj = 0; bj < 2; ++bj) { const f32x4 v0 = acc[ai][bj][m][0] * 0.03125f, v1 = acc[ai][bj][m][1] * 0.03125f;
                    u32x4 w; w.x = cvt_pk_bf16(v0[0], v0[1]); w.y = cvt_pk_bf16(v0[2], v0[3]); w.z = cvt_pk_bf16(v1[0], v1[1]); w.w = cvt_pk_bf16(v1[2], v1[3]);
                    *(u32x4*)(rowp + bj * HALF) = w; } }
    }
};
struct EpiGlu {
    static constexpr bool PERM = true, AFTER_DRAIN = false, FP8 = false; static constexpr int WSCALE = 0x7f;
    const bf16_t* Z; bf16_t* O; int ldc;
    __device__ __forceinline__ void operator()(const f32x4 (&acc)[2][2][4][2], const Unit& u, int wr, int wc, int fr, int fq) const {
        PG8_FRESH_LANE();
        const int row0 = u.pm * BM + wr * 64 + fr, col0 = u.pn * BM + wc * 32 + 8 * fq;
#pragma unroll
        for (int ai = 0; ai < 2; ++ai) {
            u32x4 z[4][2];
#pragma unroll
            for (int m = 0; m < 4; ++m)
#pragma unroll
                for (int bj = 0; bj < 2; ++bj) z[m][bj] = *(const u32x4*)(Z + (size_t)(row0 + ai * HALF + m * 16) * ldc + col0 + bj * HALF);
#pragma unroll
            for (int m = 0; m < 4; ++m)
#pragma unroll
                for (int bj = 0; bj < 2; ++bj) { const f32x4 v0 = acc[ai][bj][m][0], v1 = acc[ai][bj][m][1]; const u32x4 zz = z[m][bj];
                    u32x4 w; w.x = cvt_pk_bf16(bf_lo(zz.x) * sigm(v0[0]), bf_hi(zz.x) * sigm(v0[1])); w.y = cvt_pk_bf16(bf_lo(zz.y) * sigm(v0[2]), bf_hi(zz.y) * sigm(v0[3]));
                    w.z = cvt_pk_bf16(bf_lo(zz.z) * sigm(v1[0]), bf_hi(zz.z) * sigm(v1[1])); w.w = cvt_pk_bf16(bf_lo(zz.w) * sigm(v1[2]), bf_hi(zz.w) * sigm(v1[3]));
                    *(u32x4*)(O + (size_t)(row0 + ai * HALF + m * 16) * ldc + col0 + bj * HALF) = w; }
            asm volatile("" ::: "memory"); }
    }
};
template <bool FIRST> struct EpiBranch {
    static constexpr bool PERM = true, AFTER_DRAIN = false, FP8 = false; static constexpr int WSCALE = 0x7f;
    const bf16_t* GT; int ldg; bf16_t* MM; int ldc;
    __device__ __forceinline__ void operator()(const f32x4 (&acc)[2][2][4][2], const Unit& u, int wr, int wc, int fr, int fq) const {
        PG8_FRESH_LANE();
        const unsigned row0 = u.pm * BM + wr * 64 + fr, col0 = u.pn * BM + wc * 32 + 8 * fq;
#pragma unroll
        for (int ai = 0; ai < 2; ++ai) {
            u32x4 g[4][2], pv[4][2];
#pragma unroll
            for (int m = 0; m < 4; ++m)
#pragma unroll
                for (int bj = 0; bj < 2; ++bj) { const unsigned row = row0 + ai * HALF + m * 16;
                    g[m][bj] = *(const u32x4*)(GT + row * (unsigned)ldg + col0 + bj * HALF);
                    if (!FIRST) pv[m][bj] = *(const u32x4*)(MM + row * (unsigned)ldc + col0 + bj * HALF); }
#pragma unroll
            for (int m = 0; m < 4; ++m)
#pragma unroll
                for (int bj = 0; bj < 2; ++bj) { const unsigned row = row0 + ai * HALF + m * 16; const f32x4 v0 = acc[ai][bj][m][0], v1 = acc[ai][bj][m][1]; const u32x4 gg = g[m][bj];
                    float o[8];
                    o[0] = sigm(bf_lo(gg.x)) * v0[0]; o[1] = sigm(bf_hi(gg.x)) * v0[1]; o[2] = sigm(bf_lo(gg.y)) * v0[2]; o[3] = sigm(bf_hi(gg.y)) * v0[3];
                    o[4] = sigm(bf_lo(gg.z)) * v1[0]; o[5] = sigm(bf_hi(gg.z)) * v1[1]; o[6] = sigm(bf_lo(gg.w)) * v1[2]; o[7] = sigm(bf_hi(gg.w)) * v1[3];
                    if (!FIRST) { const u32x4 p = pv[m][bj];
                        o[0] += bf_lo(p.x); o[1] += bf_hi(p.x); o[2] += bf_lo(p.y); o[3] += bf_hi(p.y); o[4] += bf_lo(p.z); o[5] += bf_hi(p.z); o[6] += bf_lo(p.w); o[7] += bf_hi(p.w); }
                    u32x4 w; w.x = cvt_pk_bf16(o[0], o[1]); w.y = cvt_pk_bf16(o[2], o[3]); w.z = cvt_pk_bf16(o[4], o[5]); w.w = cvt_pk_bf16(o[6], o[7]);
                    *(u32x4*)(MM + row * (unsigned)ldc + col0 + bj * HALF) = w; }
            asm volatile("" ::: "memory"); }
    }
};
struct EpiWo {
    static constexpr bool PERM = false, AFTER_DRAIN = false, FP8 = false; static constexpr int WSCALE = 0x7f;
    float* X; const float* g1base;
    __device__ __forceinline__ void operator()(const f32x4 (&acc)[2][2][4][2], const Unit& u, int wr, int wc, int fr, int fq) const {
        PG8_FRESH_LANE();
        const int row0 = u.pm * BM + wr * 64 + fr, col0 = u.pn * BM + wc * 32 + 4 * fq;
        const int r = (u.pm % 9 == 0) ? 16 : u.pm / 9; const float* g1 = g1base + (size_t)r * 6144 + col0;
        f32x4 gv[2][2];
#pragma unroll
        for (int bj = 0; bj < 2; ++bj)
#pragma unroll
            for (int n = 0; n < 2; ++n) gv[bj][n] = *(const f32x4*)(g1 + bj * HALF + n * 16);
#pragma unroll
        for (int ai = 0; ai < 2; ++ai)
#pragma unroll
            for (int mh = 0; mh < 2; ++mh) {
                f32x4 xv[2][2][2];
#pragma unroll
                for (int mm = 0; mm < 2; ++mm)
#pragma unroll
                    for (int bj = 0; bj < 2; ++bj)
#pragma unroll
                        for (int n = 0; n < 2; ++n) xv[mm][bj][n] = *(const f32x4*)(X + (size_t)(row0 + ai * HALF + (2 * mh + mm) * 16) * 1024 + col0 + bj * HALF + n * 16);
#pragma unroll
                for (int mm = 0; mm < 2; ++mm)
#pragma unroll
                    for (int bj = 0; bj < 2; ++bj)
#pragma unroll
                        for (int n = 0; n < 2; ++n) *(f32x4*)(X + (size_t)(row0 + ai * HALF + (2 * mh + mm) * 16) * 1024 + col0 + bj * HALF + n * 16) = xv[mm][bj][n] + gv[bj][n] * acc[ai][bj][2 * mh + mm][n];
                asm volatile("" ::: "memory"); }
    }
};
struct EpiSwiglu {
    static constexpr bool PERM = true, AFTER_DRAIN = false, FP8 = true; static constexpr int WSCALE = 0;
    unsigned char* O; const float* bias; const PG8_LAS unsigned char* tile_e;
    __device__ __forceinline__ void operator()(const f32x4 (&acc)[2][2][4][2], const Unit& u, int wr, int wc, int fr, int fq) const {
        PG8_FRESH_LANE();
        const int row0 = u.pm * BM + wr * 64 + fr, acol0 = u.pn * HALF + wc * 32 + 8 * fq;
        const int e = tile_e[u.pm]; const float* bb = bias + (size_t)e * 2048 + 2 * acol0;
        const f32x4 b0 = *(const f32x4*)(bb), b1 = *(const f32x4*)(bb + 4), b2 = *(const f32x4*)(bb + 8), b3 = *(const f32x4*)(bb + 12);
        const float bg[8] = {b0[0], b0[2], b1[0], b1[2], b2[0], b2[2], b3[0], b3[2]}, bu[8] = {b0[1], b0[3], b1[1], b1[3], b2[1], b2[3], b3[1], b3[3]};
#pragma unroll
        for (int ai = 0; ai < 2; ++ai)
#pragma unroll
            for (int m = 0; m < 4; ++m) { unsigned char* rowp = O + (size_t)(row0 + ai * HALF + m * 16) * 1024 + acol0;
                float o[8];
#pragma unroll
                for (int j = 0; j < 8; ++j) { const float gt = acc[ai][0][m][j >> 2][j & 3] * 0.03125f + bg[j], up = acc[ai][1][m][j >> 2][j & 3] * 0.03125f + bu[j];
                    const float glu = fminf(gt, 7.0f), upc = fminf(fmaxf(up, -7.0f), 7.0f);
                    o[j] = glu * sigm(1.702f * glu) * (upc + 1.0f); }
                unsigned w0 = 0u, w1 = 0u;
                w0 = __builtin_amdgcn_cvt_pk_fp8_f32(o[0], o[1], w0, false); w0 = __builtin_amdgcn_cvt_pk_fp8_f32(o[2], o[3], w0, true);
                w1 = __builtin_amdgcn_cvt_pk_fp8_f32(o[4], o[5], w1, false); w1 = __builtin_amdgcn_cvt_pk_fp8_f32(o[6], o[7], w1, true);
                typedef unsigned u32x2 __attribute__((ext_vector_type(2)));
                *(u32x2*)rowp = (u32x2){w0, w1}; }
    }
};
struct EpiDown {
    static constexpr bool PERM = true, AFTER_DRAIN = false, FP8 = true; static constexpr int WSCALE = 0;
    unsigned char* O; const float* bias; const PG8_LAS unsigned char* tile_e;
    __device__ __forceinline__ void operator()(const f32x4 (&acc)[2][2][4][2], const Unit& u, int wr, int wc, int fr, int fq) const {
        PG8_FRESH_LANE();
        const int row0 = u.pm * BM + wr * 64 + fr, col0 = u.pn * BM + wc * 32 + 8 * fq;
        const int e = tile_e[u.pm]; const float* bb = bias + (size_t)e * 1024 + col0;
        f32x4 bv[2][2];
#pragma unroll
        for (int bj = 0; bj < 2; ++bj)
#pragma unroll
            for (int n = 0; n < 2; ++n) bv[bj][n] = *(const f32x4*)(bb + bj * HALF + 4 * n);
        typedef unsigned u32x2 __attribute__((ext_vector_type(2)));
#pragma unroll
        for (int ai = 0; ai < 2; ++ai)
#pragma unroll
            for (int m = 0; m < 4; ++m) { unsigned char* rowp = O + (size_t)(row0 + ai * HALF + m * 16) * 1024 + col0;
#pragma unroll
                for (int bj = 0; bj < 2; ++bj) { const f32x4 v0 = acc[ai][bj][m][0] * 0.03125f + bv[bj][0], v1 = acc[ai][bj][m][1] * 0.03125f + bv[bj][1];
                    unsigned w0 = 0u, w1 = 0u;
                    w0 = __builtin_amdgcn_cvt_pk_fp8_f32(v0[0], v0[1], w0, false); w0 = __builtin_amdgcn_cvt_pk_fp8_f32(v0[2], v0[3], w0, true);
                    w1 = __builtin_amdgcn_cvt_pk_fp8_f32(v1[0], v1[1], w1, false); w1 = __builtin_amdgcn_cvt_pk_fp8_f32(v1[2], v1[3], w1, true);
                    *(u32x2*)(rowp + bj * HALF) = (u32x2){w0, w1}; } }
    }
};
struct RowOrder : StaticOrder {
    int lat;
    __device__ __forceinline__ bool next(int i, Unit& u) const { if (!StaticOrder::next(i, u)) return false; if (lat) u.pm = (u.pm >> 3) * 9 + 1 + (u.pm & 7); return true; }
};
struct PanelOrder {
    static constexpr bool GATHER = false;
    int pm, nN;
    __device__ __forceinline__ bool next(int i, Unit& u) const { if (i >= nN) return false; u.pm = pm; u.pn = i; return true; }
    __device__ __forceinline__ void a_ready(const Unit&) const {}
    __device__ __forceinline__ void done(const Unit&) const {}
    __device__ __forceinline__ const char* aptr(const Gemm& g, const Unit& u, size_t tstep) const { const char* p = (const char*)g.A + (size_t)u.pm * tstep; asm volatile("" : "+s"(p)); return p; }
    __device__ __forceinline__ const char* bptr(const Gemm& g, const Unit& u, size_t tstep) const { return (const char*)g.Bt + (size_t)u.pn * tstep; }
};
struct MoeOrder {
    static constexpr bool GATHER = false;
    int nN, total, G, c; const PG8_LAS unsigned char* tile_e; size_t estride;
    __device__ __forceinline__ bool next(int i, Unit& u) const {
        if ((G & 7) == 0 && ((G >> 3) % nN) == 0) { const int x = c & 7, j = c >> 3, rpx = (G >> 3) / nN; u.pm = i * (G / nN) + x * rpx + j / nN; u.pn = j % nN; return u.pm * nN < total; }
        const int L = i * G + c; if (L >= total) return false; u.pm = L / nN; u.pn = L - u.pm * nN; return true; }
    __device__ __forceinline__ void a_ready(const Unit&) const {}
    __device__ __forceinline__ void done(const Unit&) const {}
    __device__ __forceinline__ const char* aptr(const Gemm& g, const Unit& u, size_t tstep) const { return (const char*)g.A + (size_t)u.pm * tstep; }
    __device__ __forceinline__ const char* bptr(const Gemm& g, const Unit& u, size_t tstep) const { return (const char*)g.Bt + (size_t)tile_e[u.pm] * estride + (size_t)u.pn * tstep; }
};

struct MoeGatherOrder : MoeOrder {
    static constexpr bool GATHER = true;
    const int* rows;
    __device__ __forceinline__ const char* aptr(const Gemm& g, const Unit&, size_t) const { return (const char*)g.A; }
    __device__ __forceinline__ void load_raw(const Unit& u, int (&raw)[2][2], int tid) const {
#pragma unroll
        for (int i = 0; i < 2; ++i) { int R, C; stage_rc(tid * 16 + i * 8192, R, C);
#pragma unroll
            for (int h = 0; h < 2; ++h) raw[h][i] = rows[u.pm * BM + h * HALF + R]; }
    }
    __device__ __forceinline__ void raw_to_off(const int (&raw)[2][2], unsigned (&voff)[2][2], int tid, int K) const {
#pragma unroll
        for (int i = 0; i < 2; ++i) { int R, C; stage_rc(tid * 16 + i * 8192, R, C);
#pragma unroll
            for (int h = 0; h < 2; ++h) voff[h][i] = ((unsigned)raw[h][i] * (unsigned)K + (unsigned)C) * 2u; }
    }
};

template <class Epi, class Sched, bool ALIGN_EPI = false, bool SP2 = false>
__device__ __forceinline__ void gemm_phase(PG8_LAS unsigned char* lds, const Gemm g, const Sched& S, const Epi& E, int tid_in) {
    int tid_ = tid_in; asm volatile("" : "+v"(tid_));
    const int tid = tid_, wid = __builtin_amdgcn_readfirstlane(tid >> 6), lane = tid & 63, wr = wid >> 2, wc = wid & 3, fr = lane & 15, fq = lane >> 4;
    const int K = g.K, nt = K / BK;
    unsigned voffA[2], voffB[2];
#pragma unroll
    for (int i = 0; i < 2; ++i) { int R, C; stage_rc(tid * 16 + i * 8192, R, C); const int Rb = Epi::PERM ? ((R & ~31) + perm32(R & 31)) : R;
        voffA[i] = (unsigned)(R * K + C) * 2u; voffB[i] = (unsigned)(Rb * K + C) * 2u; }
    const size_t kstep = (size_t)(BK * 2);
    const size_t hstep = (size_t)HALF * K * 2;
    const size_t tstep = 2 * hstep;
    const unsigned ldsw = (unsigned)wid * 1024u;
    const int aoff = lds_byte(wr * 64 + fr, fq * 8), boff = lds_byte(wc * 32 + fr, fq * 8);
#define PG8_SA(b, h) (((b) * 2 + (h)) * HTB)
#define PG8_SB(b, h) ((4 + (b) * 2 + (h)) * HTB)
#define PG8_STAGE(bufoff, gbase, voff) do { _Pragma("unroll") for (int _i = 0; _i < 2; ++_i) \
        __builtin_amdgcn_global_load_lds((const PG8_GAS unsigned*)((const PG8_GAS char*)(gbase) + (voff)[_i]), (PG8_LAS unsigned*)(lds + (bufoff) + ldsw + _i * 8192), 16, 0, 0); } while (0)
#define PG8_STAGE_A(bufoff, p, h, nx) do { if constexpr (Sched::GATHER) { _Pragma("unroll") for (int _i = 0; _i < 2; ++_i) \
            __builtin_amdgcn_global_load_lds((const PG8_GAS unsigned*)((const PG8_GAS char*)(p) + ((nx) ? voffGN[h][_i] : voffGC[h][_i])), (PG8_LAS unsigned*)(lds + (bufoff) + ldsw + _i * 8192), 16, 0, 0); } \
        else PG8_STAGE(bufoff, (p) + (h) * hstep, voffA); } while (0)
#define PG8_LD8(p) __builtin_shufflevector(*(const PG8_LAS pg8_i4*)(p), *(const PG8_LAS pg8_i4*)((p) + 1024), 0, 1, 2, 3, 4, 5, 6, 7)
#define PG8_LDA(dst, b, h) do { if constexpr (Epi::FP8) { _Pragma("unroll") for (int m = 0; m < 4; ++m) { dst##8[m].lo = *(const PG8_LAS pg8_i4*)(lds + PG8_SA(b, h) + aoff + m * 2048); dst##8[m].hi = *(const PG8_LAS pg8_i4*)(lds + PG8_SA(b, h) + aoff + m * 2048 + 1024); } } \
    else { _Pragma("unroll") for (int m = 0; m < 4; ++m) _Pragma("unroll") for (int k = 0; k < 2; ++k) dst[m][k] = *(const PG8_LAS bf16x8*)(lds + PG8_SA(b, h) + aoff + m * 2048 + k * 1024); } } while (0)
#define PG8_LDB(dst, b, h) do { if constexpr (Epi::FP8) { _Pragma("unroll") for (int n = 0; n < 2; ++n) { dst##8[n].lo = *(const PG8_LAS pg8_i4*)(lds + PG8_SB(b, h) + boff + n * 2048); dst##8[n].hi = *(const PG8_LAS pg8_i4*)(lds + PG8_SB(b, h) + boff + n * 2048 + 1024); } } \
    else { _Pragma("unroll") for (int n = 0; n < 2; ++n) _Pragma("unroll") for (int k = 0; k < 2; ++k) dst[n][k] = *(const PG8_LAS bf16x8*)(lds + PG8_SB(b, h) + boff + n * 2048 + k * 1024); } } while (0)
#define PG8_CAT8(lo, hi) __builtin_shufflevector(__builtin_bit_cast(pg8_i4, lo), __builtin_bit_cast(pg8_i4, hi), 0, 1, 2, 3, 4, 5, 6, 7)
#define PG8_MMA(ai, bj, At, Bt) do { __builtin_amdgcn_s_setprio(1); if constexpr (Epi::FP8) { __builtin_amdgcn_sched_barrier(0); _Pragma("unroll") for (int m = 0; m < 4; ++m) _Pragma("unroll") for (int n = 0; n < 2; ++n) \
        acc[ai][bj][m][n] = __builtin_amdgcn_mfma_scale_f32_16x16x128_f8f6f4(Bt##8[n], At##8[m], acc[ai][bj][m][n], 0, 0, 0, 0, 0, 0); \
          \
        asm volatile("" : "+v"(acc[ai][bj][0][0]), "+v"(acc[ai][bj][0][1]), "+v"(acc[ai][bj][1][0]), "+v"(acc[ai][bj][1][1]), "+v"(acc[ai][bj][2][0]), "+v"(acc[ai][bj][2][1]), "+v"(acc[ai][bj][3][0]), "+v"(acc[ai][bj][3][1])); \
        __builtin_amdgcn_sched_barrier(0); } \
    else { _Pragma("unroll") for (int m = 0; m < 4; ++m) _Pragma("unroll") for (int n = 0; n < 2; ++n) _Pragma("unroll") for (int k = 0; k < 2; ++k) \
        acc[ai][bj][m][n] = __builtin_amdgcn_mfma_f32_16x16x32_bf16(Bt[n][k], At[m][k], acc[ai][bj][m][n], 0, 0, 0); } __builtin_amdgcn_s_setprio(0); } while (0)
#define PG8_WAIT_V(n) asm volatile("s_waitcnt vmcnt(" #n ")" ::: "memory")
#define PG8_WAIT_L(n) asm volatile("s_waitcnt lgkmcnt(" #n ")" ::: "memory")
#define PG8_BAR __builtin_amdgcn_s_barrier()
#define PG8_SCHED __builtin_amdgcn_sched_barrier(0)
    Unit cur, nxt; int ui = 0;
    if (!S.next(0, cur)) return;
    f32x4 acc[2][2][4][2];
#pragma unroll
    for (int a = 0; a < 2; ++a)
#pragma unroll
        for (int b = 0; b < 2; ++b)
#pragma unroll
            for (int m = 0; m < 4; ++m)
#pragma unroll
                for (int n = 0; n < 2; ++n) acc[a][b][m][n] = (f32x4){0.f, 0.f, 0.f, 0.f};
    bf16x8 At[4][2], B0[2][2], B1[2][2];
    pg8_i8 At8[4], B08[2], B18[2];
    (void)At; (void)B0; (void)B1; (void)At8; (void)B08; (void)B18;
    const char* cA = S.aptr(g, cur, tstep); const char* cB = S.bptr(g, cur, tstep);
    unsigned voffGC[2][2] = {{0u, 0u}, {0u, 0u}}, voffGN[2][2] = {{0u, 0u}, {0u, 0u}}; int rawN[2][2] = {{0, 0}, {0, 0}};
    if constexpr (Sched::GATHER) { S.load_raw(cur, rawN, tid); S.raw_to_off(rawN, voffGC, tid, K); }
    S.a_ready(cur);
    if constexpr (SP2) {
        PG8_STAGE(PG8_SB(0, 0), cB, voffB); PG8_STAGE(PG8_SB(0, 1), cB + hstep, voffB); PG8_STAGE_A(PG8_SA(0, 0), cA, 0, false); PG8_STAGE_A(PG8_SA(0, 1), cA, 1, false);
        if (wr == 1) PG8_BAR;
        PG8_WAIT_V(2); PG8_BAR;
        PG8_STAGE(PG8_SB(1, 0), cB + kstep, voffB); PG8_STAGE_A(PG8_SA(1, 0), cA + kstep, 0, false); PG8_STAGE(PG8_SB(1, 1), cB + hstep + kstep, voffB);
        PG8_WAIT_V(6); PG8_BAR;
    } else {
        PG8_STAGE(PG8_SB(0, 0), cB, voffB); PG8_STAGE_A(PG8_SA(0, 0), cA, 0, false); PG8_STAGE(PG8_SB(0, 1), cB + hstep, voffB); PG8_STAGE_A(PG8_SA(0, 1), cA, 1, false);
        if (wr == 1) PG8_BAR;
        PG8_WAIT_V(4); PG8_BAR;
        PG8_STAGE(PG8_SB(1, 0), cB + kstep, voffB); PG8_STAGE_A(PG8_SA(1, 0), cA + kstep, 0, false); PG8_STAGE(PG8_SB(1, 1), cB + hstep + kstep, voffB);
        PG8_WAIT_V(6); PG8_BAR;
    }
    for (;;) {
        const bool has_next = S.next(ui + 1, nxt);
        const char* nA = has_next ? S.aptr(g, nxt, tstep) : cA; const char* nB = has_next ? S.bptr(g, nxt, tstep) : cB;
        for (int t = 0; t < nt; t += 2) {
            const bool last = (t == nt - 2);
            const char* a1 = cA + (size_t)(t + 1) * kstep;
            const char* a2 = last ? nA : cA + (size_t)(t + 2) * kstep; const char* b2 = last ? nB : cB + (size_t)(t + 2) * kstep;
            const char* a3 = a2 + kstep; const char* b3 = b2 + kstep;
            if (last && has_next) S.a_ready(nxt);
            if constexpr (Sched::GATHER) {
                if (t == nt - 4 && has_next) S.load_raw(nxt, rawN, tid);
                if (last) { if (has_next) S.raw_to_off(rawN, voffGN, tid, K); else { voffGN[0][0] = voffGC[0][0]; voffGN[0][1] = voffGC[0][1]; voffGN[1][0] = voffGC[1][0]; voffGN[1][1] = voffGC[1][1]; } } }
            if constexpr (SP2) {
            PG8_LDB(B0, 0, 0); PG8_LDB(B1, 0, 1); PG8_SCHED; PG8_LDA(At, 0, 0); PG8_STAGE_A(PG8_SA(1, 1), a1, 1, false);
            PG8_WAIT_V(8); PG8_WAIT_L(0); PG8_BAR; PG8_MMA(0, 0, At, B0); PG8_MMA(0, 1, At, B1); PG8_BAR; PG8_SCHED;
            PG8_LDA(At, 0, 1); PG8_STAGE(PG8_SB(0, 0), b2, voffB); PG8_STAGE(PG8_SB(0, 1), b2 + hstep, voffB); PG8_STAGE_A(PG8_SA(0, 0), a2, 0, last);
            PG8_WAIT_V(8); PG8_WAIT_L(0); PG8_BAR; PG8_MMA(1, 0, At, B0); PG8_MMA(1, 1, At, B1); PG8_BAR; PG8_SCHED;
            PG8_LDB(B0, 1, 0); PG8_LDB(B1, 1, 1); PG8_SCHED; PG8_LDA(At, 1, 0); PG8_STAGE_A(PG8_SA(0, 1), a2, 1, last);
            PG8_WAIT_V(8); PG8_WAIT_L(0); PG8_BAR; PG8_MMA(0, 0, At, B0); PG8_MMA(0, 1, At, B1); PG8_BAR; PG8_SCHED;
            PG8_LDA(At, 1, 1); PG8_STAGE(PG8_SB(1, 0), b3, voffB); PG8_STAGE(PG8_SB(1, 1), b3 + hstep, voffB); PG8_STAGE_A(PG8_SA(1, 0), a3, 0, last);
            PG8_WAIT_V(8); PG8_WAIT_L(0); PG8_BAR; PG8_MMA(1, 0, At, B0); PG8_MMA(1, 1, At, B1); PG8_BAR; PG8_SCHED;
            } else {
            PG8_LDB(B0, 0, 0); PG8_SCHED; PG8_LDA(At, 0, 0); PG8_STAGE_A(PG8_SA(1, 1), a1, 1, false);
            PG8_WAIT_L(8); PG8_BAR; PG8_WAIT_L(0); PG8_MMA(0, 0, At, B0); PG8_BAR; PG8_SCHED;
            PG8_LDB(B1, 0, 1); PG8_STAGE(PG8_SB(0, 0), b2, voffB);
            PG8_BAR; PG8_WAIT_L(0); PG8_MMA(0, 1, At, B1); PG8_BAR;
            PG8_LDA(At, 0, 1); PG8_STAGE_A(PG8_SA(0, 0), a2, 0, last);
            PG8_BAR; PG8_WAIT_L(0); PG8_MMA(1, 0, At, B0); PG8_BAR; PG8_SCHED;
            PG8_STAGE(PG8_SB(0, 1), b2 + hstep, voffB);
            PG8_WAIT_V(6); PG8_BAR; PG8_MMA(1, 1, At, B1); PG8_BAR;
            PG8_LDB(B0, 1, 0); PG8_SCHED; PG8_LDA(At, 1, 0); PG8_STAGE_A(PG8_SA(0, 1), a2, 1, last);
            PG8_WAIT_L(8); PG8_BAR; PG8_WAIT_L(0); PG8_MMA(0, 0, At, B0); PG8_BAR; PG8_SCHED;
            PG8_LDB(B1, 1, 1); PG8_STAGE(PG8_SB(1, 0), b3, voffB);
            PG8_BAR; PG8_WAIT_L(0); PG8_MMA(0, 1, At, B1); PG8_BAR;
            PG8_LDA(At, 1, 1); PG8_STAGE_A(PG8_SA(1, 0), a3, 0, last);
            PG8_BAR; PG8_WAIT_L(0); PG8_MMA(1, 0, At, B0); PG8_BAR; PG8_SCHED;
            PG8_STAGE(PG8_SB(1, 1), b3 + hstep, voffB);
            PG8_WAIT_V(6); PG8_BAR; PG8_MMA(1, 1, At, B1); PG8_BAR;
            }
        }
        if constexpr (ALIGN_EPI) { if (wr == 0) PG8_BAR; }
        if constexpr (!Epi::AFTER_DRAIN) { E(acc, cur, wr, wc, fr, fq); S.done(cur); }
        if (!has_next) break;
#pragma unroll
        for (int a = 0; a < 2; ++a)
#pragma unroll
            for (int b = 0; b < 2; ++b)
#pragma unroll
                for (int m = 0; m < 4; ++m)
#pragma unroll
                    for (int n = 0; n < 2; ++n) acc[a][b][m][n] = (f32x4){0.f, 0.f, 0.f, 0.f};
        cur = nxt; cA = nA; cB = nB; ++ui;
        if constexpr (Sched::GATHER) { voffGC[0][0] = voffGN[0][0]; voffGC[0][1] = voffGN[0][1]; voffGC[1][0] = voffGN[1][0]; voffGC[1][1] = voffGN[1][1]; }
        if constexpr (ALIGN_EPI) { if (wr == 1) PG8_BAR; }
    }
    PG8_WAIT_V(0);
    if constexpr (!ALIGN_EPI) { if (wr == 0) PG8_BAR; }
    PG8_BAR;
    if constexpr (Epi::AFTER_DRAIN) { E.fused(acc, cur, wr, wc, fr, fq, lds, wid, lane); S.done(cur); }
#undef PG8_SA
#undef PG8_SB
#undef PG8_STAGE
#undef PG8_CAT8
#undef PG8_LD8
#undef PG8_STAGE_A
#undef PG8_LDA
#undef PG8_LDB
#undef PG8_MMA
#undef PG8_WAIT_V
#undef PG8_WAIT_L
#undef PG8_BAR
#undef PG8_SCHED
}
}

#ifndef MK_ONE_LAUNCH
#define MK_ONE_LAUNCH 1
#endif
constexpr int NWAVES = 8, NTHREADS = 512;
constexpr int NB = 16, SEQ = 2048, CTX = 256, TB = SEQ + CTX, T = NB * TB, D = 1024, DIN = 4864, DEPTH = 4;
constexpr int OFF_U = 0, OFF_CB = 256, OFF_CC = 512, OFF_CX = 768, OFF_Q = 1024, OFF_K = 1536, OFF_V = 1664, OFF_GT = 1792;
constexpr int NE = 32, MAX_TILES = (T * 4 + NE * 255) / 256, MAX_SLOTS = MAX_TILES * 256;
constexpr float EPS = 1e-6f;
enum { I_X = 0, I_C, I_CTX, I_CCTX, I_WMOD, I_BMOD, I_N1G, I_N2G, I_WIN, I_LRE, I_LIM, I_LDT, I_BRE, I_BIM, I_CRE, I_CIM, I_SD, I_WGLU, I_WSO, I_CONVW, I_WCO, I_QG, I_KG, I_SINK, I_WAO, I_WO,
       I_WR, I_BR, I_WGU, I_BGU, I_WD, I_BD, N_IN };
constexpr size_t MiB = 1u << 20;
constexpr size_t WS_CTL = 0, CTL_ZERO_BYTES = 1 * MiB;
constexpr size_t WS_MOD = 1 * MiB;
constexpr size_t WS_WRT = 3 * MiB;
constexpr size_t WS_ROPE = 4 * MiB;
constexpr size_t WS_WGLU = 5 * MiB;
constexpr size_t WS_WSO = 6 * MiB;
constexpr size_t WS_WCO = 8 * MiB;
constexpr size_t WS_WAO = 10 * MiB;
constexpr size_t WS_WO = 14 * MiB;
constexpr size_t WS_WIN = 22 * MiB;
constexpr size_t WS_WGU = 60 * MiB;
constexpr size_t WS_WD = 572 * MiB;
constexpr size_t WS_X = 828 * MiB;
constexpr size_t WS_H = 972 * MiB;
constexpr size_t WS_PROJ = 1044 * MiB;
constexpr size_t WS_QN = 1386 * MiB;
constexpr size_t WS_KN = 1422 * MiB;
constexpr size_t WS_Z = 1431 * MiB;
constexpr size_t WS_Z2 = 1449 * MiB;
constexpr size_t WS_YB = 1467 * MiB;
constexpr size_t WS_YA = 1485 * MiB;
constexpr size_t WS_MM = 1521 * MiB;
constexpr size_t WS_XG = 1593 * MiB;
constexpr size_t WS_ACT = 1897 * MiB;
constexpr size_t WS_TOPG = 2201 * MiB;
constexpr size_t WS_SLOT = 2202 * MiB;
constexpr size_t WS_S5S = 2203 * MiB;
constexpr size_t WS_XIN = 2275 * MiB;
constexpr size_t WS_VT = 2311 * MiB;
constexpr size_t WS_MS = 2320 * MiB;
constexpr size_t WS_W5 = 2324 * MiB;
constexpr size_t WS_BASE = 2330 * MiB;
constexpr size_t WS_STOK = 2331 * MiB;
constexpr size_t WS_GC = 2334 * MiB;
constexpr size_t WS_H8 = 2335 * MiB;
constexpr size_t WS_WIN8 = 2371 * MiB;
constexpr size_t WS_YS8 = 2383 * MiB;
constexpr size_t WS_END = 2535 * MiB;
static_assert(WS_WIN + (size_t)4 * DIN * D * 2 <= WS_WGU && WS_PROJ + (size_t)T * DIN * 2 <= WS_QN && WS_XG + (size_t)MAX_SLOTS * D * 2 <= WS_ACT && WS_ACT + (size_t)MAX_SLOTS * D * 2 <= WS_TOPG, "d_ws map");
static_assert(WS_X + (size_t)T * D * 4 <= WS_H && WS_H + (size_t)T * D * 2 <= WS_PROJ && WS_S5S + (size_t)16 * 4608 * 256 * 4 <= WS_XIN && WS_XIN + (size_t)32 * 4608 * 128 * 2 <= WS_VT && WS_VT + (size_t)32 * 64 * TB * 2 <= WS_MS && WS_W5 + (size_t)64 * 128 * 384 * 2 <= WS_END, "d_ws map 2");
constexpr int CW_CNT = 64;
constexpr int CW_BAR = 4096;
constexpr int CW_TS = 16384;
constexpr int RING_BYTES = 131072, MISC_OFF = RING_BYTES, LCNT_OFF = MISC_OFF + 128, TILE_E_OFF = MISC_OFF + 256, PADS_OFF = MISC_OFF + 1024, SCR_OFF = MISC_OFF + 2048, LDS_BYTES = 155648;

#define GAS __attribute__((address_space(1)))
#define LAS __attribute__((address_space(3)))
typedef unsigned short bf16;
typedef unsigned v4u __attribute__((ext_vector_type(4)));
typedef unsigned v2u __attribute__((ext_vector_type(2)));
typedef float f32x4 __attribute__((ext_vector_type(4)));
typedef float f32x2 __attribute__((ext_vector_type(2)));
typedef GAS unsigned gu32;
#define RLX_AGENT __ATOMIC_RELAXED, __HIP_MEMORY_SCOPE_AGENT
#define LDS_WAIT() asm volatile("s_waitcnt lgkmcnt(0)" ::: "memory")
#define VM_WAIT() asm volatile("s_waitcnt vmcnt(0)" ::: "memory")
__device__ __forceinline__ unsigned f2bf(float f) { unsigned u = __builtin_bit_cast(unsigned, f); return (u + 0x7fffu + ((u >> 16) & 1u)) >> 16; }
__device__ __forceinline__ unsigned pk2(float lo, float hi) { return f2bf(lo) | (f2bf(hi) << 16); }
__device__ __forceinline__ float bflo(unsigned w) { return __uint_as_float(w << 16); }
__device__ __forceinline__ float bfhi(unsigned w) { return __uint_as_float(w & 0xffff0000u); }

#define XB_TMO      128
#define XB_XCNT(j)  (256  + 64 * (j))
#define XB_XSUB(j)  (1280 + 64 * (j))
#define XB_XGEN(j)  (2304 + 64 * (j))
#define XB_TOP      3328
#define XB_TOPGEN   3392
#define XCD_BAR_WORDS 3456
#define XB_SPIN_CAP (1u << 18)

__device__ __forceinline__ unsigned xb_ld(unsigned* p)              { return __hip_atomic_load(p, __ATOMIC_RELAXED, __HIP_MEMORY_SCOPE_AGENT); }
__device__ __forceinline__ unsigned xb_add(unsigned* p, unsigned v) { return __hip_atomic_fetch_add(p, v, __ATOMIC_RELAXED, __HIP_MEMORY_SCOPE_AGENT); }
__device__ __forceinline__ unsigned xb_xcc_id() { return (unsigned)__builtin_amdgcn_s_getreg((3 << 11) | 20) & 0xFu; }
#define XB_SPIN(cond, bar) do { unsigned _sp = 0; while (cond) { __builtin_amdgcn_s_sleep(1); \
    if ((++_sp & 255u) == 0u) { if (xb_ld(&(bar)[XB_TMO])) break; if (_sp > XB_SPIN_CAP) { atomicAdd(&(bar)[XB_TMO], 1u); break; } } } } while (0)

struct XcdBarrier {
    unsigned* bar; unsigned x;
    volatile LAS unsigned* st;
};

__device__ __forceinline__ XcdBarrier xcd_barrier_post(unsigned* bar, volatile LAS unsigned* st) {
    XcdBarrier b; b.bar = bar; b.x = xb_xcc_id(); b.st = st;
    if (threadIdx.x == 0) (void)xb_add(&bar[XB_XCNT(b.x)], 1u);
    return b;
}
__device__ __forceinline__ void xcd_barrier_complete(unsigned* bar, unsigned x, unsigned& nloc, unsigned& nx) {
    const unsigned G = gridDim.x * gridDim.y * gridDim.z;
    unsigned sum, cnt, mine, sp = 0u;
    for (;;) {
        sum = 0u; cnt = 0u; mine = 0u;
#pragma unroll
        for (unsigned j = 0; j < 16; ++j) { const unsigned c = xb_ld(&bar[XB_XCNT(j)]); sum += c; cnt += (c > 0u) ? 1u : 0u; mine = (j == x) ? c : mine; }
        if (sum == G) break;
        __builtin_amdgcn_s_sleep(1);
        if ((++sp & 255u) == 0u) { if (xb_ld(&bar[XB_TMO])) break; if (sp > XB_SPIN_CAP) { atomicAdd(&bar[XB_TMO], 1u); break; } }
    }
    nloc = mine > 0u ? mine : 1u; nx = cnt > 0u ? cnt : 1u;
}

__device__ __forceinline__ void xcd_barrier(const XcdBarrier& b, const bool leader) {
    asm volatile("s_waitcnt vmcnt(0)" ::: "memory");
    __syncthreads();
    if (leader) {
        unsigned* bar = b.bar;
        __builtin_amdgcn_s_waitcnt(0);
        unsigned nloc = b.st[0], nx = b.st[1];
        if (nloc == 0u) { xcd_barrier_complete(bar, b.x, nloc, nx); b.st[0] = nloc; b.st[1] = nx; }
        const unsigned old = xb_add(&bar[XB_XSUB(b.x)], 1u);
        const unsigned gen = old / nloc;
        if (old + 1u == (gen + 1u) * nloc) {
            __builtin_amdgcn_fence(__ATOMIC_RELEASE, "agent");
            asm volatile("s_waitcnt vmcnt(0)" ::: "memory");
            const unsigned og = xb_add(&bar[XB_TOP], 1u);
            const unsigned tg = og / nx;
            if (og + 1u == (tg + 1u) * nx) xb_add(&bar[XB_TOPGEN], 1u);
            else XB_SPIN(xb_ld(&bar[XB_TOPGEN]) == tg, bar);
            __builtin_amdgcn_fence(__ATOMIC_ACQUIRE, "agent");
            xb_add(&bar[XB_XGEN(b.x)], 1u);
            asm volatile("s_waitcnt vmcnt(0)" ::: "memory");
        } else {
            XB_SPIN(xb_ld(&bar[XB_XGEN(b.x)]) == gen, bar);
            __builtin_amdgcn_fence(__ATOMIC_ACQUIRE, "agent");
            asm volatile("s_waitcnt vmcnt(0)" ::: "memory");
        }
    }
    __syncthreads();
}

struct Args { const float* in[N_IN]; float* out; unsigned char* ws; int ph_lo, ph_hi; };
typedef const __attribute__((address_space(4))) Args CA;
typedef CA* CArgs;
__device__ __forceinline__ CArgs get_args() { CArgs p = (CArgs)__builtin_amdgcn_kernarg_segment_ptr(); asm volatile("" : "+s"(p)); return p; }

__device__ __forceinline__ float shx(float v, int m, int lane) { return __builtin_bit_cast(float, __builtin_amdgcn_ds_bpermute((lane ^ m) << 2, __builtin_bit_cast(int, v))); }
__device__ __forceinline__ float wave_sum(float v, int lane) {
#pragma unroll
    for (int o = 1; o < 64; o <<= 1) v += shx(v, o, lane);
    return v;
}
__device__ __forceinline__ float wave_max(float v, int lane) {
#pragma unroll
    for (int o = 1; o < 64; o <<= 1) v = fmaxf(v, shx(v, o, lane));
    return v;
}
typedef float f32x2_t __attribute__((ext_vector_type(2))); typedef __bf16 bf16x2_t __attribute__((ext_vector_type(2)));
__device__ __forceinline__ unsigned cvtpk(float lo, float hi) { f32x2_t v = {lo, hi}; bf16x2_t b = __builtin_convertvector(v, bf16x2_t); return __builtin_bit_cast(unsigned, b); }
#ifndef PROBE_MASK
#define PROBE_MASK 0
#endif
#ifndef PROBE_SUB_A
#define PROBE_SUB_A -1
#endif
#ifndef PROBE_SUB_B
#define PROBE_SUB_B -1
#endif
#ifndef PROBE_SUBF
#define PROBE_SUBF 16
#endif
#ifndef PROBE_BLK
#define PROBE_BLK 0
#endif
#define PROBE_SUB(ws_, tid_, i_) do { if (PROBE_MASK || PROBE_SUB_A >= 0) { if (blockIdx.x == PROBE_BLK && (tid_) == 0) { asm volatile("s_waitcnt vmcnt(0) lgkmcnt(0)" ::: "memory"); \
        __hip_atomic_store((unsigned long long*)((ws_) + WS_CTL) + CW_TS / 2 + 128 + (i_), (unsigned long long)__builtin_amdgcn_s_memrealtime(), RLX_AGENT); } } } while (0)
__device__ __forceinline__ float gelu_tanh(float x) {
    const float y = 0.7978845608028654f * (x + 0.044715f * x * x * x);
    const float t = 1.0f - 2.0f * __builtin_amdgcn_rcpf(1.0f + __expf(2.0f * y));
    return 0.5f * x * (1.0f + t);
}

__device__ __forceinline__ void s5_build_mats(CArgs ap, LAS unsigned char* lds, int tid, int l, int g);
template <int MODE>
__device__ __forceinline__ void transpose_item(const float* W, int K, int N, bf16* WT, LAS float* scr, int item, int lane) {
    const int nblk = N / 32, kb = item / nblk, nb = item - kb * nblk, k0 = 64 * kb, n0 = 32 * nb;
#pragma unroll 8
    for (int i = 0; i < 32; ++i) { const int kk = 2 * i + (lane >> 5); scr[kk * 33 + (lane & 31)] = W[(size_t)(k0 + kk) * N + n0 + (lane & 31)]; }
    LDS_WAIT(); asm volatile("" ::: "memory");
    const int c = lane & 7;
#pragma unroll
    for (int j = 0; j < 4; ++j) { const int n = (lane >> 3) + 8 * j; const LAS float* s = scr + (8 * c) * 33 + n;
        const int nn = n0 + n; const int jj = nn >> 1;
        const int drow = (MODE == 0 || MODE == 2) ? nn : ((jj >> 7) * 256 + (nn & 1) * 128 + (jj & 127));
        if (MODE >= 1) {
            unsigned w0 = 0u, w1 = 0u;
            w0 = __builtin_amdgcn_cvt_pk_fp8_f32(32.0f * s[0 * 33], 32.0f * s[1 * 33], w0, false); w0 = __builtin_amdgcn_cvt_pk_fp8_f32(32.0f * s[2 * 33], 32.0f * s[3 * 33], w0, true);
            w1 = __builtin_amdgcn_cvt_pk_fp8_f32(32.0f * s[4 * 33], 32.0f * s[5 * 33], w1, false); w1 = __builtin_amdgcn_cvt_pk_fp8_f32(32.0f * s[6 * 33], 32.0f * s[7 * 33], w1, true);
            *(GAS v2u*)((unsigned char*)WT + (size_t)drow * K + k0 + 8 * c) = (v2u){w0, w1};
        } else {
            v4u o; o.x = pk2(s[0 * 33], s[1 * 33]); o.y = pk2(s[2 * 33], s[3 * 33]); o.z = pk2(s[4 * 33], s[5 * 33]); o.w = pk2(s[6 * 33], s[7 * 33]);
            *(GAS v4u*)(WT + (size_t)drow * K + k0 + 8 * c) = o; } }
    LDS_WAIT(); asm volatile("" ::: "memory");
}

__device__ __forceinline__ void phase_prologue(CArgs ap, LAS unsigned char* lds, int tid, int lane, int wave, int bid, int G) {
    CA& a = *ap;
    unsigned char* ws = a.ws;
    PROBE_SUB(ws, tid, 11);
    if (bid < 192) {
        LAS float* S = (LAS float*)lds;
        LAS float* R = (LAS float*)(lds + 17 * 1024 * 4);
        for (int idx = tid; idx < 17 * 1024; idx += NTHREADS) { const int r = idx >> 10, k = idx & 1023; const float v = r < 16 ? a.in[I_C][r * 1024 + k] : a.in[I_CCTX][k]; S[idx] = v / (1.0f + __expf(-v)); }
        __syncthreads();
        const int l = bid / 48, c0 = (bid % 48) * 128, col = tid & 127, kq = tid >> 7;
        float acc[17];
#pragma unroll
        for (int r = 0; r < 17; ++r) acc[r] = 0.f;
        const float* wp = a.in[I_WMOD] + ((size_t)l * 1024 + kq * 256) * 6144 + c0 + col;
#pragma unroll 4
        for (int k = 0; k < 256; ++k) { const float w = wp[(size_t)k * 6144];
#pragma unroll
            for (int r = 0; r < 17; ++r) acc[r] += S[r * 1024 + kq * 256 + k] * w; }
#pragma unroll
        for (int r = 0; r < 17; ++r) R[(kq * 17 + r) * 128 + col] = acc[r];
        __syncthreads();
        float* MOD = (float*)(ws + WS_MOD);
        for (int idx = tid; idx < 17 * 128; idx += NTHREADS) { const int r = idx >> 7, cc = idx & 127;
            const float v = R[(0 * 17 + r) * 128 + cc] + R[(1 * 17 + r) * 128 + cc] + R[(2 * 17 + r) * 128 + cc] + R[(3 * 17 + r) * 128 + cc] + a.in[I_BMOD][l * 6144 + c0 + cc];
            MOD[((size_t)l * 17 + r) * 6144 + c0 + cc] = v; }
    }
    else s5_build_mats(ap, lds, tid, (bid - 192) >> 4, (bid - 192) & 15);
    PROBE_SUB(ws, tid, 12);
    __syncthreads();
    {
        LAS float* scr = (LAS float*)(lds + wave * 16384);
        const int gw = bid * NWAVES + wave, NGW = G * NWAVES;
        constexpr int N_WGU = 128 * 1024, N_WD = 128 * 512, N_WIN = 4 * 2432, N_WO = 4 * 512, N_WAO = 4 * 256, N_WSO = 4 * 128, N_WCO = 4 * 128, N_WGLU = 4 * 32;
        constexpr int NITEMS = N_WGU + N_WD + N_WIN + N_WO + N_WAO + N_WSO + N_WCO + N_WGLU;
        for (int it = gw; it < NITEMS; it += NGW) {
            int r = it;
            if (r < N_WGU) { const int m = r >> 10; transpose_item<1>(a.in[I_WGU] + (size_t)m * 1024 * 2048, 1024, 2048, (bf16*)(ws + WS_WGU + (size_t)m * 2048 * 1024), scr, r & 1023, lane); continue; } r -= N_WGU;
            if (r < N_WD) { const int m = r >> 9; transpose_item<2>(a.in[I_WD] + (size_t)m * 1024 * 1024, 1024, 1024, (bf16*)(ws + WS_WD + (size_t)m * 1024 * 1024), scr, r & 511, lane); continue; } r -= N_WD;
            if (r < N_WIN) { const int m = r / 2432, it2 = r - m * 2432;
                if ((it2 % 152) < 56) transpose_item<0>(a.in[I_WIN] + (size_t)m * 1024 * DIN, 1024, DIN, (bf16*)(ws + WS_WIN) + (size_t)m * 1792 * 1024, scr, it2, lane);
                else transpose_item<2>(a.in[I_WIN] + (size_t)m * 1024 * DIN, 1024, DIN, (bf16*)(ws + WS_WIN8 + (size_t)m * 3072 * 1024 - (size_t)1792 * 1024), scr, it2, lane);
                continue; } r -= N_WIN;
            if (r < N_WO) { const int m = r >> 9; transpose_item<0>(a.in[I_WO] + (size_t)m * 1024 * 1024, 1024, 1024, (bf16*)(ws + WS_WO) + (size_t)m * 1024 * 1024, scr, r & 511, lane); continue; } r -= N_WO;
            if (r < N_WAO) { const int m = r >> 8; transpose_item<0>(a.in[I_WAO] + (size_t)m * 512 * 1024, 512, 1024, (bf16*)(ws + WS_WAO) + (size_t)m * 1024 * 512, scr, r & 255, lane); continue; } r -= N_WAO;
            if (r < N_WSO) { const int m = r >> 7; transpose_item<0>(a.in[I_WSO] + (size_t)m * 256 * 1024, 256, 1024, (bf16*)(ws + WS_WSO) + (size_t)m * 1024 * 256, scr, r & 127, lane); continue; } r -= N_WSO;
            if (r < N_WCO) { const int m = r >> 7; transpose_item<0>(a.in[I_WCO] + (size_t)m * 256 * 1024, 256, 1024, (bf16*)(ws + WS_WCO) + (size_t)m * 1024 * 256, scr, r & 127, lane); continue; } r -= N_WCO;
            { const int m = r >> 5; transpose_item<0>(a.in[I_WGLU] + (size_t)m * 256 * 256, 256, 256, (bf16*)(ws + WS_WGLU) + (size_t)m * 256 * 256, scr, r & 31, lane); }
        }
    }
    PROBE_SUB(ws, tid, 13);
    {
        const int gt = bid * NTHREADS + tid, NGT = G * NTHREADS;
        unsigned* WRF = (unsigned*)(ws + WS_WRT);
        for (int i = gt; i < 4 * 32 * 2 * 64 * 4; i += NGT) { const int jp = i & 3, ln = (i >> 2) & 63, nt = (i >> 8) & 1, ks = (i >> 9) & 31, l = i >> 14;
            const int e = nt * 16 + (ln & 15), k = 32 * ks + 8 * (ln >> 4) + 2 * jp;
            const float w0 = a.in[I_WR][((size_t)l * 1024 + k) * 32 + e], w1 = a.in[I_WR][((size_t)l * 1024 + k + 1) * 32 + e];
            const unsigned hi = cvtpk(w0, w1); const unsigned lo = cvtpk(w0 - bflo(hi), w1 - bfhi(hi));
            const size_t base = ((((size_t)l * 32 + ks) * 2 + nt) * 2) * 256 + ln * 4 + jp;
            WRF[base] = hi; WRF[base + 256] = lo; }
        float* ROPE = (float*)(ws + WS_ROPE);
        for (int i = gt; i < 2048 * 32; i += NGT) { const int t = i >> 5, p = i & 31; const float pos = (float)(p < 16 ? (t >> 6) : (t & 63));
            const float inv = powf(10000.0f, -(float)(p & 15) / 16.0f); float sn, cs; sincosf(pos * inv, &sn, &cs); ROPE[2 * i] = cs; ROPE[2 * i + 1] = sn; }
    }
}

template <int MODE>
__device__ __forceinline__ void phase_n1(CArgs ap, int l, int lane, int gw, int NGW) {
    CA& a = *ap;
    unsigned char* ws = a.ws;
    float* X = (float*)(ws + WS_X); bf16* H = (bf16*)(ws + WS_H);
    const float* MOD = (const float*)(ws + WS_MOD);
    const unsigned char* YS = (const unsigned char*)(ws + WS_YS8); const float* TOPG = (const float*)(ws + WS_TOPG); const int* SLOT = (const int*)(ws + WS_SLOT);
    const float* gn = a.in[I_N1G] + (l < DEPTH ? l : 0) * D;
    constexpr int RPT = 3;
    for (int row0 = gw; row0 < T; row0 += RPT * NGW) {
        int rowv[RPT], bb[RPT], sv[RPT], rv[RPT]; bool on[RPT];
        f32x4 v[RPT][4], tg[RPT]; int4 sl[RPT]; unsigned y8[RPT][4][4];
#pragma unroll
        for (int rr = 0; rr < RPT; ++rr) { const int row = row0 + rr * NGW; rowv[rr] = row; on[rr] = row < T; const int rowc = on[rr] ? row : row0;
            const int b = rowc / TB, s = rowc - b * TB; const bool isctx = s < CTX; bb[rr] = b; sv[rr] = s; rv[rr] = isctx ? 16 : b; if (MODE == 2 && isctx) on[rr] = false;
            const float* src = (MODE == 0) ? (isctx ? a.in[I_CTX] + ((size_t)b * CTX + s) * D : a.in[I_X] + ((size_t)b * SEQ + (s - CTX)) * D) : X + (size_t)rowc * D;
#pragma unroll
            for (int j = 0; j < 4; ++j) v[rr][j] = *(const f32x4*)(src + 4 * lane + 256 * j);
            if (MODE != 0) { tg[rr] = *(const f32x4*)(TOPG + (size_t)rowc * 4); sl[rr] = *(const int4*)(SLOT + (size_t)rowc * 4); } }
        if (MODE != 0) {
#pragma unroll
            for (int rr = 0; rr < RPT; ++rr) { const int sls[4] = {sl[rr].x, sl[rr].y, sl[rr].z, sl[rr].w};
#pragma unroll
                for (int k = 0; k < 4; ++k)
#pragma unroll
                    for (int j = 0; j < 4; ++j) y8[rr][k][j] = *(const unsigned*)((const unsigned char*)YS + (size_t)sls[k] * D + 4 * lane + 256 * j); }
        }
#pragma unroll
        for (int rr = 0; rr < RPT; ++rr) {
            if (!on[rr]) continue;
            const int row = rowv[rr], r = rv[rr];
            if (MODE != 0) {
                const float* g2 = MOD + ((size_t)(l - 1) * 17 + r) * 6144 + 5120;
#pragma unroll
                for (int j = 0; j < 4; ++j) { f32x4 acc = (f32x4){0.f, 0.f, 0.f, 0.f};
#pragma unroll
                    for (int k = 0; k < 4; ++k) { const unsigned w = y8[rr][k][j]; const f32x2 lo = __builtin_amdgcn_cvt_pk_f32_fp8(w, false), hi = __builtin_amdgcn_cvt_pk_f32_fp8(w, true); acc += tg[rr][k] * (f32x4){lo.x, lo.y, hi.x, hi.y}; }
                    v[rr][j] += *(const f32x4*)(g2 + 4 * lane + 256 * j) * acc; }
            }
            if (MODE == 2) {
                float* o = a.out + ((size_t)bb[rr] * SEQ + (sv[rr] - CTX)) * D;
#pragma unroll
                for (int j = 0; j < 4; ++j) *(f32x4*)(o + 4 * lane + 256 * j) = v[rr][j];
                continue;
            }
            float ss = 0.f;
#pragma unroll
            for (int j = 0; j < 4; ++j) { *(f32x4*)(X + (size_t)row * D + 4 * lane + 256 * j) = v[rr][j]; ss += (v[rr][j].x * v[rr][j].x + v[rr][j].y * v[rr][j].y) + (v[rr][j].z * v[rr][j].z + v[rr][j].w * v[rr][j].w); }
            const float rstd = rsqrtf(wave_sum(ss, lane) * (1.0f / D) + EPS);
            const float* md = MOD + ((size_t)l * 17 + r) * 6144;
#pragma unroll
            for (int j = 0; j < 4; ++j) { const int c = 4 * lane + 256 * j;
                const f32x4 g = *(const f32x4*)(gn + c), sh = *(const f32x4*)(md + c), sc = *(const f32x4*)(md + 1024 + c);
                const f32x4 h = (v[rr][j] * rstd * g) * (sc + 1.0f) + sh;
                v2u o; o.x = cvtpk(h.x, h.y); o.y = cvtpk(h.z, h.w); *(v2u*)(H + (size_t)row * D + c) = o;
                unsigned w8 = 0u; w8 = __builtin_amdgcn_cvt_pk_fp8_f32(h.x, h.y, w8, false); w8 = __builtin_amdgcn_cvt_pk_fp8_f32(h.z, h.w, w8, true);
                *(unsigned*)((unsigned char*)(ws + WS_H8) + (size_t)row * D + c) = w8; }
        }
    }
}

__device__ __forceinline__ void build_gc(CArgs ap, int l, int gt, int NGT) {
    CA& a = *ap; const float* MOD = (const float*)(a.ws + WS_MOD); float* GC = (float*)(a.ws + WS_GC) + (size_t)l * 17 * 1024;
    for (int i = gt; i < 17 * 1024; i += NGT) { const int r = i >> 10, k = i & 1023; GC[i] = a.in[I_N2G][l * D + k] * (1.0f + MOD[((size_t)l * 17 + r) * 6144 + 4096 + k]); }
}

__device__ __forceinline__ void phase_prep(CArgs ap, int l, int lane, int gw, int NGW) {
    CA& a = *ap;
    unsigned char* ws = a.ws;
    const bf16* P = (const bf16*)(ws + WS_PROJ); bf16* YB = (bf16*)(ws + WS_YB); bf16* QN = (bf16*)(ws + WS_QN); bf16* KN = (bf16*)(ws + WS_KN);
    const float* ROPE = (const float*)(ws + WS_ROPE);
    const float* cw = a.in[I_CONVW] + l * 3 * 256;
    const int c4 = 4 * lane, d0 = (lane & 7) * 8;
    const f32x4 w0 = *(const f32x4*)(cw + c4), w1 = *(const f32x4*)(cw + 256 + c4), w2 = *(const f32x4*)(cw + 512 + c4);
    const f32x4 gq0 = *(const f32x4*)(a.in[I_QG] + l * 64 + d0), gq1 = *(const f32x4*)(a.in[I_QG] + l * 64 + d0 + 4), gk0 = *(const f32x4*)(a.in[I_KG] + l * 64 + d0), gk1 = *(const f32x4*)(a.in[I_KG] + l * 64 + d0 + 4);
    const bool first = (lane & 4) == 0;
    constexpr int RPT = 4;
    for (int row0 = gw; row0 < T; row0 += RPT * NGW) {
        v2u cc[RPT][3], cx[RPT][3], cb[RPT]; v4u qw[RPT], kw[RPT]; f32x4 rp[RPT][4]; bool isc[RPT], on[RPT]; int rowv[RPT];
#pragma unroll
        for (int rr = 0; rr < RPT; ++rr) { const int rowt = row0 + rr * NGW; on[rr] = rowt < T; const int row = on[rr] ? rowt : row0; rowv[rr] = row;
            const int b = row / TB, s = row - b * TB; const bool isctx = s < CTX; isc[rr] = isctx;
            const int lo = isctx ? 0 : CTX, hi = isctx ? CTX : TB;
#pragma unroll
            for (int d = 0; d < 3; ++d) { const int s2 = s + d - 1; const bool ok = s2 >= lo && s2 < hi; const bf16* pr = P + (size_t)(ok ? row + d - 1 : row) * DIN;
                cc[rr][d] = *(const v2u*)(pr + OFF_CC + c4); cx[rr][d] = *(const v2u*)(pr + OFF_CX + c4); if (!ok) { cc[rr][d] = (v2u){0u, 0u}; } }
            cb[rr] = *(const v2u*)(P + (size_t)row * DIN + OFF_CB + c4);
            qw[rr] = *(const v4u*)(P + (size_t)row * DIN + OFF_Q + lane * 8); kw[rr] = *(const v4u*)(P + (size_t)row * DIN + OFF_K + (lane & 15) * 8);
            const float* rpp = ROPE + ((size_t)(isctx ? 0 : s - CTX) * 32 + (d0 & 31)) * 2;
#pragma unroll
            for (int i = 0; i < 4; ++i) rp[rr][i] = *(const f32x4*)(rpp + 4 * i); }
#pragma unroll
        for (int rr = 0; rr < RPT; ++rr) {
            if (!on[rr]) continue;
            const int row = rowv[rr];
            { f32x4 zz[3];
#pragma unroll
              for (int d = 0; d < 3; ++d) zz[d] = (f32x4){bflo(cc[rr][d].x) * bflo(cx[rr][d].x), bfhi(cc[rr][d].x) * bfhi(cx[rr][d].x), bflo(cc[rr][d].y) * bflo(cx[rr][d].y), bfhi(cc[rr][d].y) * bfhi(cx[rr][d].y)};
              const f32x4 yv = (f32x4){bflo(cb[rr].x), bfhi(cb[rr].x), bflo(cb[rr].y), bfhi(cb[rr].y)} * (w0 * zz[0] + w1 * zz[1] + w2 * zz[2]);
              v2u o; o.x = cvtpk(yv.x, yv.y); o.y = cvtpk(yv.z, yv.w); *(v2u*)(YB + (size_t)row * 256 + c4) = o; }
#pragma unroll
            for (int pass = 0; pass < 2; ++pass) {
                const v4u w = pass ? kw[rr] : qw[rr];
                float x[8] = {bflo(w.x), bfhi(w.x), bflo(w.y), bfhi(w.y), bflo(w.z), bfhi(w.z), bflo(w.w), bfhi(w.w)};
                float ss = 0.f;
#pragma unroll
                for (int i = 0; i < 8; ++i) ss += x[i] * x[i];
                ss += shx(ss, 1, lane); ss += shx(ss, 2, lane); ss += shx(ss, 4, lane);
                const float rstd = rsqrtf(ss * (1.0f / 64.0f) + EPS) * (pass ? 1.0f : 0.125f);
                const f32x4 ga = pass ? gk0 : gq0, gb = pass ? gk1 : gq1;
#pragma unroll
                for (int i = 0; i < 8; ++i) x[i] = x[i] * rstd * (i < 4 ? ga[i] : gb[i - 4]);
                if (!isc[rr]) {
#pragma unroll
                    for (int i = 0; i < 8; ++i) { const float pr = shx(x[i], 4, lane); const float cs = rp[rr][i >> 1][2 * (i & 1)], sn = rp[rr][i >> 1][2 * (i & 1) + 1];
                        x[i] = first ? (x[i] * cs - pr * sn) : (pr * sn + x[i] * cs); }
                }
                v4u o; o.x = cvtpk(x[0], x[1]); o.y = cvtpk(x[2], x[3]); o.z = cvtpk(x[4], x[5]); o.w = cvtpk(x[6], x[7]);
                if (pass == 0) *(v4u*)(QN + (size_t)row * 512 + lane * 8) = o;
                else if (lane < 16) *(v4u*)(KN + (size_t)row * 128 + lane * 8) = o;
            }
        }
    }
}

typedef short bf16x8v __attribute__((ext_vector_type(8)));
__device__ __forceinline__ f32x4 mfma16(const v4u& a, const v4u& b, const f32x4& c) { return __builtin_amdgcn_mfma_f32_16x16x32_bf16(__builtin_bit_cast(bf16x8v, a), __builtin_bit_cast(bf16x8v, b), c, 0, 0, 0); }

__device__ __forceinline__ void s5_build_mats(CArgs ap, LAS unsigned char* lds, int tid, int l, int g) {
    CA& a = *ap;
    LAS float* LP = (LAS float*)lds;
    LAS float* BB = LP + 2 * 9 * 64 * 2;
    LAS float* CC = BB + 2 * 64 * 16 * 2;
    for (int i = tid; i < 2 * 9 * 64; i += NTHREADS) { const int z = i / 576, d = (i / 64) % 9, p = i & 63; const int pi = (l * 2 + z) * 16 + g;
        const float lre = a.in[I_LRE][pi * 64 + p], lim = a.in[I_LIM][pi * 64 + p], dt = expf(a.in[I_LDT][pi]);
        float sn, cs; sincosf((float)d * lim * dt, &sn, &cs); const float er = expf((float)d * lre * dt);
        LP[2 * i] = er * cs; LP[2 * i + 1] = er * sn; }
    for (int i = tid; i < 2 * 64 * 16; i += NTHREADS) { const int z = i >> 10, p = (i >> 4) & 63, h = i & 15; const int pi = (l * 2 + z) * 16 + g;
        const float lre = a.in[I_LRE][pi * 64 + p], lim = a.in[I_LIM][pi * 64 + p], dt = expf(a.in[I_LDT][pi]);
        float sn, cs; sincosf(lim * dt, &sn, &cs); const float er = expf(lre * dt); const float nr = er * cs - 1.0f, ni = er * sn, d2 = lre * lre + lim * lim;
        const float qr = (nr * lre + ni * lim) / d2, qi = (ni * lre - nr * lim) / d2;
        const float br = a.in[I_BRE][((size_t)pi * 64 + p) * 16 + h], bi = a.in[I_BIM][((size_t)pi * 64 + p) * 16 + h];
        BB[2 * i] = qr * br - qi * bi; BB[2 * i + 1] = qr * bi + qi * br;
        const int hc = (i >> 6) & 15, pc = i & 63;
        CC[2 * i] = a.in[I_CRE][((size_t)pi * 16 + hc) * 64 + pc]; CC[2 * i + 1] = a.in[I_CIM][((size_t)pi * 16 + hc) * 64 + pc]; }
    __syncthreads();
    LAS float* KT = CC + 2 * 16 * 64 * 2;
    { const int e0 = tid * 8; const int z = e0 >> 11, d = (e0 >> 8) & 7, h = (e0 >> 4) & 15, h20 = e0 & 15; float kv[8];
#pragma unroll
      for (int j = 0; j < 8; ++j) kv[j] = 0.f;
      for (int p = 0; p < 64; ++p) { const float cr = CC[2 * ((z * 16 + h) * 64 + p)], ci = CC[2 * ((z * 16 + h) * 64 + p) + 1], lr = LP[2 * ((z * 9 + d) * 64 + p)], li = LP[2 * ((z * 9 + d) * 64 + p) + 1];
          const float tr = cr * lr - ci * li, ti = cr * li + ci * lr;
#pragma unroll
          for (int j = 0; j < 8; ++j) kv[j] += tr * BB[2 * ((z * 64 + p) * 16 + h20 + j)] - ti * BB[2 * ((z * 64 + p) * 16 + h20 + j) + 1]; }
#pragma unroll
      for (int j = 0; j < 8; ++j) KT[e0 + j] = kv[j]; }
    __syncthreads();
    bf16* MS = (bf16*)(a.ws + WS_MS) + (size_t)(l * 16 + g) * 256 * 128; bf16* W = (bf16*)(a.ws + WS_W5) + (size_t)(l * 16 + g) * 128 * 384;
    for (int i = tid; i < 256 * 128; i += NTHREADS) { const int j = i & 7, ln = (i >> 3) & 63, nt = (i >> 9) & 15, ks = i >> 13; const int n = nt * 16 + (ln & 15), k = ks * 32 + (ln >> 4) * 8 + j;
        const int z = n >> 7, part = n & 1, p = (n >> 1) & 63, a2 = k >> 4, h2 = k & 15; const int e = z == 0 ? 7 - a2 : a2;
        const float lr = LP[2 * ((z * 9 + e) * 64 + p)], li = LP[2 * ((z * 9 + e) * 64 + p) + 1], br = BB[2 * ((z * 64 + p) * 16 + h2)], bi = BB[2 * ((z * 64 + p) * 16 + h2) + 1];
        MS[i] = (bf16)f2bf(part == 0 ? lr * br - li * bi : lr * bi + li * br); }
    for (int i = tid; i < 128 * 384; i += NTHREADS) { const int j = i & 7, ln = (i >> 3) & 63, nt = (i >> 9) & 7, ks = i >> 12; const int n = nt * 16 + (ln & 15), k = ks * 32 + (ln >> 4) * 8 + j;
        const int aa = n >> 4, h = n & 15; float v = 0.f;
        if (k < 128) { const int a2 = k >> 4, h2 = k & 15;
            if (a2 <= aa) v += KT[((0 * 8 + (aa - a2)) * 16 + h) * 16 + h2];
            if (a2 >= aa) v += KT[((1 * 8 + (a2 - aa)) * 16 + h) * 16 + h2];
            if (a2 == aa && h2 == h) v += a.in[I_SD][l * 256 + g * 16 + h];
        } else { const int z = (k - 128) >> 7, kk = (k - 128) & 127, part = kk & 1, p = kk >> 1; const int d = z == 0 ? aa + 1 : 8 - aa;
            const float cr = CC[2 * ((z * 16 + h) * 64 + p)], ci = CC[2 * ((z * 16 + h) * 64 + p) + 1], lr = LP[2 * ((z * 9 + d) * 64 + p)], li = LP[2 * ((z * 9 + d) * 64 + p) + 1];
            v = part == 0 ? (cr * lr - ci * li) : -(cr * li + ci * lr); }
        W[i] = (bf16)f2bf(v); }
    __syncthreads();
}

constexpr int S5_ROWS = T / 8, S5_RT = S5_ROWS / 32;
__device__ __forceinline__ void s5a_block(CArgs ap, int l, int blk, LAS unsigned char* lds, int tid, int lane, int wave) {
    CA& a = *ap; unsigned char* ws = a.ws;
    const int g = blk & 15, part = blk >> 4, c = lane & 15, q = lane >> 4;
    { const v4u* src = (const v4u*)((const bf16*)(ws + WS_MS) + (size_t)(l * 16 + g) * 256 * 128); LAS v4u* dst = (LAS v4u*)lds;
#pragma unroll
      for (int i = 0; i < 8; ++i) dst[tid + i * NTHREADS] = src[tid + i * NTHREADS]; }
    __syncthreads();
    const LAS v4u* Bl = (const LAS v4u*)lds + lane;
    for (int mt = wave; mt < 18; mt += NWAVES) {
        const int r0 = part * 288 + mt * 16;
        const bf16* Pu = (const bf16*)(ws + WS_PROJ) + ((size_t)(r0 + c) * 8 + (q >> 1)) * DIN + OFF_U + g * 16 + (q & 1) * 8;
        v4u af[4];
#pragma unroll
        for (int ks = 0; ks < 4; ++ks) af[ks] = *(const v4u*)(Pu + (size_t)2 * ks * DIN);
        f32x4 acc[16];
#pragma unroll
        for (int n = 0; n < 16; ++n) acc[n] = (f32x4){0.f, 0.f, 0.f, 0.f};
#pragma unroll
        for (int ks = 0; ks < 4; ++ks) { v4u bfr[16];
#pragma unroll
            for (int n = 0; n < 16; ++n) bfr[n] = Bl[(ks * 16 + n) * 64];
#pragma unroll
            for (int n = 0; n < 16; ++n) acc[n] = mfma16(bfr[n], af[ks], acc[n]);
            asm volatile("" ::: "memory"); }
        float* Sp = (float*)(ws + WS_S5S) + ((size_t)g * S5_ROWS + r0 + c) * 256 + 4 * q;
#pragma unroll
        for (int n = 0; n < 16; ++n) *(f32x4*)(Sp + n * 16) = acc[n];
    }
    VM_WAIT(); __syncthreads();
}
__device__ __forceinline__ void s5b_unit(CArgs ap, int l, int u, int lane) {
    CA& a = *ap; unsigned char* ws = a.ws;
    const int b = u & 15, z = (u >> 4) & 1, g = u >> 5, p = lane; const int pi = (l * 2 + z) * 16 + g;
    const float lre = a.in[I_LRE][pi * 64 + p], lim = a.in[I_LIM][pi * 64 + p], dt = expf(a.in[I_LDT][pi]);
    float sn, cs; sincosf(8.0f * lim * dt, &sn, &cs); const float er = expf(8.0f * lre * dt); const float l8r = er * cs, l8i = er * sn;
    const f32x2* S = (const f32x2*)((const float*)(ws + WS_S5S) + ((size_t)g * S5_ROWS + b * 288) * 256 + z * 128) + p;
    unsigned* XI = (unsigned*)((bf16*)(ws + WS_XIN) + ((size_t)(z * 16 + g) * S5_ROWS + b * 288) * 128) + p;
    float xr = 0.f, xi = 0.f;
    constexpr int BS = 32;
    f32x2 sv[BS];
#pragma unroll
    for (int j = 0; j < BS; ++j) { const int cc = z == 0 ? j : 31 - j; sv[j] = S[(size_t)cc * 128]; }
    for (int i0 = 0; i0 < 288; i0 += BS) {
        f32x2 nv[BS];
        if (i0 + BS < 288) {
#pragma unroll
            for (int j = 0; j < BS; ++j) { const int i = i0 + BS + j; const int cc = z == 0 ? i : (i < 32 ? 31 - i : 319 - i); nv[j] = S[(size_t)cc * 128]; }
        }
        unsigned ov[BS];
#pragma unroll
        for (int j = 0; j < BS; ++j) { ov[j] = cvtpk(xr, xi);
            const float nr = l8r * xr - l8i * xi + sv[j].x, ni = l8r * xi + l8i * xr + sv[j].y; xr = nr; xi = ni; }
#pragma unroll
        for (int j = 0; j < BS; ++j) { const int i = i0 + j; const int cc = z == 0 ? i : (i < 32 ? 31 - i : 319 - i); XI[(size_t)cc * 64] = ov[j]; }
#pragma unroll
        for (int j = 0; j < BS; ++j) sv[j] = nv[j];
    }
}
__device__ __forceinline__ void s5c_block(CArgs ap, int l, int blk, LAS unsigned char* lds, int tid, int lane, int wave) {
    CA& a = *ap; unsigned char* ws = a.ws;
    const int g = blk & 15, part = blk >> 4, c = lane & 15, q = lane >> 4;
    { const v4u* src = (const v4u*)((const bf16*)(ws + WS_W5) + (size_t)(l * 16 + g) * 128 * 384); LAS v4u* dst = (LAS v4u*)lds;
#pragma unroll
      for (int i = 0; i < 12; ++i) dst[tid + i * NTHREADS] = src[tid + i * NTHREADS]; }
    __syncthreads();
    const LAS v4u* Bl = (const LAS v4u*)lds + lane;
    for (int mt = wave; mt < 18; mt += NWAVES) {
        const int r0 = part * 288 + mt * 16;
        const bf16* Pu = (const bf16*)(ws + WS_PROJ) + ((size_t)(r0 + c) * 8 + (q >> 1)) * DIN + OFF_U + g * 16 + (q & 1) * 8;
        const bf16* X0 = (const bf16*)(ws + WS_XIN) + ((size_t)g * S5_ROWS + r0 + c) * 128 + q * 8; const bf16* X1 = X0 + (size_t)16 * S5_ROWS * 128;
        v4u af[12];
#pragma unroll
        for (int ks = 0; ks < 4; ++ks) { af[ks] = *(const v4u*)(Pu + (size_t)2 * ks * DIN); af[4 + ks] = *(const v4u*)(X0 + ks * 32); af[8 + ks] = *(const v4u*)(X1 + ks * 32); }
        f32x4 acc[8];
#pragma unroll
        for (int n = 0; n < 8; ++n) acc[n] = (f32x4){0.f, 0.f, 0.f, 0.f};
#pragma unroll
        for (int ks = 0; ks < 12; ++ks) { v4u bfr[8];
#pragma unroll
            for (int n = 0; n < 8; ++n) bfr[n] = Bl[(ks * 8 + n) * 64];
#pragma unroll
            for (int n = 0; n < 8; ++n) acc[n] = mfma16(bfr[n], af[ks], acc[n]);
            if (ks & 1) asm volatile("" ::: "memory"); }
        bf16* Zp = (bf16*)(ws + WS_Z) + (size_t)(r0 + c) * 8 * 256 + g * 16 + 4 * q;
#pragma unroll
        for (int n = 0; n < 8; ++n) { const f32x4 y = acc[n]; v2u o; o.x = cvtpk(gelu_tanh(y[0]), gelu_tanh(y[1])); o.y = cvtpk(gelu_tanh(y[2]), gelu_tanh(y[3])); *(v2u*)(Zp + n * 256) = o; }
    }
    __syncthreads();
}

typedef float f32x16 __attribute__((ext_vector_type(16)));
__device__ __forceinline__ f32x16 mfma32(const v4u& a, const v4u& b, const f32x16& c) { return __builtin_amdgcn_mfma_f32_32x32x16_bf16(__builtin_bit_cast(bf16x8v, a), __builtin_bit_cast(bf16x8v, b), c, 0, 0, 0); }
struct AttnFrag { v4u ka[4]; v2u va[2][2][2]; };
__device__ __forceinline__ void attn_load(AttnFrag& f, const bf16* KN, const bf16* VT, int s0, int r) {
#pragma unroll
    for (int ks = 0; ks < 4; ++ks) f.ka[ks] = *(const v4u*)(KN + (size_t)(s0 + r) * 128 + 16 * ks);
#pragma unroll
    for (int mt = 0; mt < 2; ++mt)
#pragma unroll
        for (int s = 0; s < 2; ++s) { f.va[mt][s][0] = *(const v2u*)(VT + (size_t)mt * 32 * TB + s0 + 16 * s); f.va[mt][s][1] = *(const v2u*)(VT + (size_t)mt * 32 * TB + s0 + 16 * s + 8); }
}
__device__ __forceinline__ void attn_item(CArgs ap, int l, bool lat, int idx, int lane) {
    CA& a = *ap; unsigned char* ws = a.ws;
    int b, hp, qg;
    if (lat) { b = idx >> 8; qg = (idx >> 2) & 63; hp = idx & 3; } else { b = idx >> 5; qg = (idx >> 2) & 7; hp = idx & 3; }
    const int g2 = hp >> 1, r = lane & 31, h = lane >> 5, q0 = qg * 32;
    const int qrow = b * TB + (lat ? CTX : 0) + q0 + r;
    const bf16* KN = (const bf16*)(ws + WS_KN) + (size_t)b * TB * 128 + g2 * 64 + 8 * h;
    const bf16* VT = (const bf16*)(ws + WS_VT) + ((size_t)(b * 2 + g2) * 64 + r) * TB + 4 * h;
    v4u bq[2][4];
#pragma unroll
    for (int hh = 0; hh < 2; ++hh)
#pragma unroll
        for (int ks = 0; ks < 4; ++ks) bq[hh][ks] = *(const v4u*)((const bf16*)(ws + WS_QN) + (size_t)qrow * 512 + (2 * hp + hh) * 64 + 16 * ks + 8 * h);
    f32x16 o[2][2];
#pragma unroll
    for (int hh = 0; hh < 2; ++hh)
#pragma unroll
        for (int i = 0; i < 16; ++i) { o[hh][0][i] = 0.f; o[hh][1][i] = 0.f; }
    constexpr float L2E = 1.4426950408889634f;
    float m[2], lsum[2];
#pragma unroll
    for (int hh = 0; hh < 2; ++hh) { m[hh] = a.in[I_SINK][l * 8 + 2 * hp + hh] * L2E; lsum[hh] = h == 0 ? 1.0f : 0.0f; }
    unsigned keep1 = 0u, keep2 = 0u;
#pragma unroll
    for (int i = 0; i < 16; ++i) { const int jj = (i & 3) + 8 * (i >> 2) + 4 * h; keep1 |= (jj >= r ? 1u : 0u) << i; keep2 |= (jj <= r ? 1u : 0u) << i; }
    const int tlo = lat ? (4 - qg > 0 ? 4 - qg : 0) : 9, thi = lat ? (67 - qg < 8 ? 67 - qg : 8) : -1;
    int tt = tlo;
    AttnFrag cur, nxt;
    attn_load(cur, KN, VT, tt < 9 ? CTX + q0 - 128 + 32 * tt : 32 * (tt - 9), r);
    for (;;) {
        const int tn = (tt == thi) ? 9 : tt + 1; const bool more = tn <= 16;
        if (more) attn_load(nxt, KN, VT, tn < 9 ? CTX + q0 - 128 + 32 * tn : 32 * (tn - 9), r);
        const int mode = tt == 0 ? 1 : (tt == 8 ? 2 : 0);
#pragma unroll
        for (int hh = 0; hh < 2; ++hh) {
            f32x16 st;
#pragma unroll
            for (int i = 0; i < 16; ++i) st[i] = 0.f;
#pragma unroll
            for (int ks = 0; ks < 4; ++ks) st = mfma32(cur.ka[ks], bq[hh][ks], st);
            if (mode != 0) {
                asm volatile("" ::: "memory");
                const unsigned kp = mode == 1 ? keep1 : keep2;
#pragma unroll
                for (int i = 0; i < 16; ++i) if (!((kp >> i) & 1u)) st[i] = -INFINITY;
            }
            float mx = st[0];
#pragma unroll
            for (int i = 1; i < 16; ++i) mx = fmaxf(mx, st[i]);
            mx = fmaxf(mx, shx(mx, 32, lane));
            const float mn = fmaxf(m[hh], mx * L2E), al = __builtin_amdgcn_exp2f(m[hh] - mn); m[hh] = mn;
            float ps = 0.f;
#pragma unroll
            for (int i = 0; i < 16; ++i) { st[i] = __builtin_amdgcn_exp2f(__builtin_fmaf(st[i], L2E, -mn)); ps += st[i]; }
            lsum[hh] = lsum[hh] * al + ps;
#pragma unroll
            for (int i = 0; i < 16; ++i) { o[hh][0][i] *= al; o[hh][1][i] *= al; }
#pragma unroll
            for (int s = 0; s < 2; ++s) { v4u pb; pb.x = cvtpk(st[8 * s + 0], st[8 * s + 1]); pb.y = cvtpk(st[8 * s + 2], st[8 * s + 3]); pb.z = cvtpk(st[8 * s + 4], st[8 * s + 5]); pb.w = cvtpk(st[8 * s + 6], st[8 * s + 7]);
                v4u a0; a0.x = cur.va[0][s][0].x; a0.y = cur.va[0][s][0].y; a0.z = cur.va[0][s][1].x; a0.w = cur.va[0][s][1].y;
                v4u a1; a1.x = cur.va[1][s][0].x; a1.y = cur.va[1][s][0].y; a1.z = cur.va[1][s][1].x; a1.w = cur.va[1][s][1].y;
                o[hh][0] = mfma32(a0, pb, o[hh][0]); o[hh][1] = mfma32(a1, pb, o[hh][1]); }
        }
        if (!more) break;
        cur = nxt; tt = tn;
    }
#pragma unroll
    for (int hh = 0; hh < 2; ++hh) {
        const float lt = lsum[hh] + shx(lsum[hh], 32, lane); const float inv = 1.0f / lt;
        bf16* op = (bf16*)(ws + WS_YA) + (size_t)qrow * 512 + (2 * hp + hh) * 64 + 4 * h;
#pragma unroll
        for (int gq = 0; gq < 4; ++gq) { v2u w0; w0.x = cvtpk(o[hh][0][4 * gq] * inv, o[hh][0][4 * gq + 1] * inv); w0.y = cvtpk(o[hh][0][4 * gq + 2] * inv, o[hh][0][4 * gq + 3] * inv); *(v2u*)(op + 8 * gq) = w0;
            v2u w1; w1.x = cvtpk(o[hh][1][4 * gq] * inv, o[hh][1][4 * gq + 1] * inv); w1.y = cvtpk(o[hh][1][4 * gq + 2] * inv, o[hh][1][4 * gq + 3] * inv); *(v2u*)(op + 32 + 8 * gq) = w1; }
    }
}
__device__ __forceinline__ void vt_item(CArgs ap, int item, int lane) {
    CA& a = *ap; unsigned char* ws = a.ws;
    const int tile = item >> 1, g2 = item & 1; const int row = tile * 64 + lane; const int b = row / TB, s = row - b * TB;
    const bf16* vp = (const bf16*)(ws + WS_PROJ) + (size_t)row * DIN + OFF_V + g2 * 64;
    bf16* vt = (bf16*)(ws + WS_VT) + (size_t)(b * 2 + g2) * 64 * TB + s;
#pragma unroll
    for (int i = 0; i < 8; ++i) { const v4u w = *(const v4u*)(vp + 8 * i);
        vt[(size_t)(8 * i + 0) * TB] = (bf16)(w.x & 0xffffu); vt[(size_t)(8 * i + 1) * TB] = (bf16)(w.x >> 16); vt[(size_t)(8 * i + 2) * TB] = (bf16)(w.y & 0xffffu); vt[(size_t)(8 * i + 3) * TB] = (bf16)(w.y >> 16);
        vt[(size_t)(8 * i + 4) * TB] = (bf16)(w.z & 0xffffu); vt[(size_t)(8 * i + 5) * TB] = (bf16)(w.z >> 16); vt[(size_t)(8 * i + 6) * TB] = (bf16)(w.w & 0xffffu); vt[(size_t)(8 * i + 7) * TB] = (bf16)(w.w >> 16); }
}

__device__ __forceinline__ void phase_n2(CArgs ap, int l, LAS unsigned char* lds, int tid, int lane, int wave, int bid, int G) {
    CA& a = *ap;
    unsigned char* ws = a.ws;
    const float* X = (const float*)(ws + WS_X); bf16* H = (bf16*)(ws + WS_H); const float* MOD = (const float*)(ws + WS_MOD);
    float* TOPG = (float*)(ws + WS_TOPG); int* SLOT = (int*)(ws + WS_SLOT); unsigned* CNT = (unsigned*)(ws + WS_CTL) + CW_CNT + l * 32;
    LAS unsigned* lcnt = (LAS unsigned*)(lds + LCNT_OFF);
    { const v4u* src = (const v4u*)((const unsigned*)(ws + WS_WRT) + (size_t)l * 32768); LAS v4u* dst = (LAS v4u*)lds;
#pragma unroll
      for (int i = 0; i < 16; ++i) dst[tid + i * NTHREADS] = src[tid + i * NTHREADS]; }
    if (tid < 32) lcnt[tid] = 0u;
    __syncthreads();
    const LAS v4u* Bl = (const LAS v4u*)lds + lane;
    LAS float* scr = (LAS float*)(lds + SCR_OFF) + wave * (16 * 33);
    const int c = lane & 15, q = lane >> 4;
    const bool skipctx = l == DEPTH - 1;
    const int tpb = (T / 16) / G;
    for (int tl = wave; tl < tpb; tl += NWAVES) {
        const int row0 = (bid * tpb + tl) * 16; const int b = row0 / TB, s0 = row0 - b * TB; const bool isctx = s0 < CTX; const int r = isctx ? 16 : b;
        if (skipctx && isctx) continue;
        const float* xr = X + (size_t)(row0 + c) * D + 8 * q;
        float ss = 0.f;
#pragma unroll 16
        for (int ks = 0; ks < 32; ++ks) { const f32x4 x0 = *(const f32x4*)(xr + 32 * ks), x1 = *(const f32x4*)(xr + 32 * ks + 4);
            ss += (x0.x * x0.x + x0.y * x0.y) + (x0.z * x0.z + x0.w * x0.w) + (x1.x * x1.x + x1.y * x1.y) + (x1.z * x1.z + x1.w * x1.w); }
        ss += shx(ss, 16, lane); ss += shx(ss, 32, lane);
        const float rstd = rsqrtf(ss * (1.0f / D) + EPS);
        const float* md = MOD + ((size_t)l * 17 + r) * 6144 + 3072 + 8 * q; const float* gc = (const float*)(ws + WS_GC) + ((size_t)l * 17 + r) * 1024 + 8 * q;
        unsigned char* h8 = (unsigned char*)(ws + WS_H8) + (size_t)(row0 + c) * D + 8 * q;
        f32x4 acc[2] = {(f32x4){0.f, 0.f, 0.f, 0.f}, (f32x4){0.f, 0.f, 0.f, 0.f}};
#pragma unroll 1
        for (int k4 = 0; k4 < 32; k4 += 4) {
          f32x4 xv[4][2], gv[4][2], hv[4][2];
#pragma unroll
          for (int u = 0; u < 4; ++u) { const int ks = k4 + u;
              xv[u][0] = *(const f32x4*)(xr + 32 * ks); xv[u][1] = *(const f32x4*)(xr + 32 * ks + 4); gv[u][0] = *(const f32x4*)(gc + 32 * ks); gv[u][1] = *(const f32x4*)(gc + 32 * ks + 4);
              hv[u][0] = *(const f32x4*)(md + 32 * ks); hv[u][1] = *(const f32x4*)(md + 32 * ks + 4); }
#pragma unroll
          for (int u = 0; u < 4; ++u) { const int ks = k4 + u;
            const f32x4 y0 = (xv[u][0] * rstd) * gv[u][0] + hv[u][0], y1 = (xv[u][1] * rstd) * gv[u][1] + hv[u][1];
            v4u ahi; ahi.x = cvtpk(y0.x, y0.y); ahi.y = cvtpk(y0.z, y0.w); ahi.z = cvtpk(y1.x, y1.y); ahi.w = cvtpk(y1.z, y1.w);
            { unsigned w0 = 0u, w1 = 0u;
              w0 = __builtin_amdgcn_cvt_pk_fp8_f32(y0.x, y0.y, w0, false); w0 = __builtin_amdgcn_cvt_pk_fp8_f32(y0.z, y0.w, w0, true);
              w1 = __builtin_amdgcn_cvt_pk_fp8_f32(y1.x, y1.y, w1, false); w1 = __builtin_amdgcn_cvt_pk_fp8_f32(y1.z, y1.w, w1, true);
              *(v2u*)(h8 + 32 * ks) = (v2u){w0, w1}; }
            v4u alo; alo.x = cvtpk(y0.x - bflo(ahi.x), y0.y - bfhi(ahi.x)); alo.y = cvtpk(y0.z - bflo(ahi.y), y0.w - bfhi(ahi.y)); alo.z = cvtpk(y1.x - bflo(ahi.z), y1.y - bfhi(ahi.z)); alo.w = cvtpk(y1.z - bflo(ahi.w), y1.w - bfhi(ahi.w));
#pragma unroll
            for (int nt = 0; nt < 2; ++nt) { const v4u whi = Bl[((ks * 2 + nt) * 2 + 0) * 64], wlo = Bl[((ks * 2 + nt) * 2 + 1) * 64];
                acc[nt] = mfma16(whi, ahi, acc[nt]); acc[nt] = mfma16(wlo, ahi, acc[nt]); acc[nt] = mfma16(whi, alo, acc[nt]); }
          }
        }
#pragma unroll
        for (int nt = 0; nt < 2; ++nt) { const f32x4 bb = *(const f32x4*)(a.in[I_BR] + l * 32 + nt * 16 + 4 * q);
#pragma unroll
            for (int j = 0; j < 4; ++j) scr[c * 33 + nt * 16 + 4 * q + j] = acc[nt][j] + bb[j]; }
        LDS_WAIT(); asm volatile("" ::: "memory");
        if (lane < 16) {
            float v0 = -INFINITY, v1 = -INFINITY, v2 = -INFINITY, v3 = -INFINITY; int e0 = 0, e1 = 0, e2 = 0, e3 = 0;
#pragma unroll
            for (int e = 0; e < 32; ++e) { const float x = scr[lane * 33 + e];
                const bool b0 = x > v0, b1 = x > v1, b2 = x > v2, b3 = x > v3;
                v3 = b2 ? v2 : (b3 ? x : v3); e3 = b2 ? e2 : (b3 ? e : e3);
                v2 = b1 ? v1 : (b2 ? x : v2); e2 = b1 ? e1 : (b2 ? e : e2);
                v1 = b0 ? v0 : (b1 ? x : v1); e1 = b0 ? e0 : (b1 ? e : e1);
                v0 = b0 ? x : v0; e0 = b0 ? e : e0; }
            const float x1 = __expf(v1 - v0), x2 = __expf(v2 - v0), x3 = __expf(v3 - v0); const float inv = 1.0f / (1.0f + x1 + x2 + x3);
            const unsigned r0 = __hip_atomic_fetch_add(lcnt + e0, 1u, __ATOMIC_RELAXED, __HIP_MEMORY_SCOPE_WORKGROUP), r1 = __hip_atomic_fetch_add(lcnt + e1, 1u, __ATOMIC_RELAXED, __HIP_MEMORY_SCOPE_WORKGROUP),
                           r2 = __hip_atomic_fetch_add(lcnt + e2, 1u, __ATOMIC_RELAXED, __HIP_MEMORY_SCOPE_WORKGROUP), r3 = __hip_atomic_fetch_add(lcnt + e3, 1u, __ATOMIC_RELAXED, __HIP_MEMORY_SCOPE_WORKGROUP);
            *(f32x4*)(TOPG + (size_t)(row0 + lane) * 4) = (f32x4){inv, x1 * inv, x2 * inv, x3 * inv};
            *(int4*)(SLOT + (size_t)(row0 + lane) * 4) = make_int4((int)(((unsigned)e0 << 24) | r0), (int)(((unsigned)e1 << 24) | r1), (int)(((unsigned)e2 << 24) | r2), (int)(((unsigned)e3 << 24) | r3)); }
        LDS_WAIT(); asm volatile("" ::: "memory");
    }
    __syncthreads();
    if (tid < 32) { const unsigned n = lcnt[tid]; const unsigned base = __hip_atomic_fetch_add(CNT + tid, n, RLX_AGENT); ((unsigned*)(ws + WS_BASE))[bid * 32 + tid] = base; }
    __syncthreads();
}

__device__ __forceinline__ void build_expert_tables(CArgs ap, int l, LAS unsigned char* lds, int tid) {
    CA& a = *ap;
    if (tid == 0) { const unsigned* CNT = (const unsigned*)(a.ws + WS_CTL) + CW_CNT + l * 32; LAS int* pads = (LAS int*)(lds + PADS_OFF); LAS unsigned char* te = lds + TILE_E_OFF;
        int t = 0;
#pragma nounroll
        for (int e = 0; e < 32; ++e) { const int c = (int)__hip_atomic_load(CNT + e, RLX_AGENT); const int nt = (c + 255) >> 8; pads[e] = t * 256;
#pragma nounroll
            for (int i = 0; i < nt; ++i) te[t + i] = (unsigned char)e;
            t += nt; }
        pads[32] = t; }
    __syncthreads();
}

__device__ __forceinline__ void phase_moe_prep(CArgs ap, int l, LAS unsigned char* lds, int tid, int lane, int gw, int NGW) {
    CA& a = *ap;
    unsigned char* ws = a.ws;
    build_expert_tables(ap, l, lds, tid);
    const LAS int* pads = (const LAS int*)(lds + PADS_OFF);
    int* SLOT = (int*)(ws + WS_SLOT); const unsigned* BASE = (const unsigned*)(ws + WS_BASE);
    for (int row0 = gw; row0 < T; row0 += 3 * NGW) {
        int rowv[3]; bool on[3]; int4 sl[3]; v4u hv[3];
#pragma unroll
        for (int rr = 0; rr < 3; ++rr) { const int row = row0 + rr * NGW; on[rr] = row < T && !(l == DEPTH - 1 && (row % TB) < CTX); rowv[rr] = on[rr] ? row : row0;
            sl[rr] = *(const int4*)(SLOT + (size_t)rowv[rr] * 4); hv[rr] = *(const v4u*)((const unsigned char*)(ws + WS_H8) + (size_t)rowv[rr] * D + 16 * lane); }
        unsigned bs[3][4];
#pragma unroll
        for (int rr = 0; rr < 3; ++rr) { const unsigned pk[4] = {(unsigned)sl[rr].x, (unsigned)sl[rr].y, (unsigned)sl[rr].z, (unsigned)sl[rr].w};
#pragma unroll
            for (int k = 0; k < 4; ++k) bs[rr][k] = BASE[((unsigned)rowv[rr] / (unsigned)(T / (NGW >> 3))) * 32 + (pk[k] >> 24)]; }
#pragma unroll
        for (int rr = 0; rr < 3; ++rr) { if (!on[rr]) continue;
            const unsigned pk[4] = {(unsigned)sl[rr].x, (unsigned)sl[rr].y, (unsigned)sl[rr].z, (unsigned)sl[rr].w}; int st[4];
#pragma unroll
            for (int k = 0; k < 4; ++k) st[k] = pads[pk[k] >> 24] + (int)bs[rr][k] + (int)(pk[k] & 0xffffffu);
            if (lane == 0) *(int4*)(SLOT + (size_t)rowv[rr] * 4) = make_int4(st[0], st[1], st[2], st[3]);
#pragma unroll
            for (int k = 0; k < 4; ++k) *(v4u*)((unsigned char*)(ws + WS_XG) + (size_t)st[k] * D + 16 * lane) = hv[rr]; }
    }
}


constexpr int PH_PER_LAYER = 11, NPHASES = 1 + DEPTH * PH_PER_LAYER + 1;
__global__ void __launch_bounds__(NTHREADS, 2) fwd(Args args) {
    extern __shared__ __attribute__((aligned(16))) unsigned char lds_raw[];
    volatile LAS unsigned* MISC = (volatile LAS unsigned*)((LAS unsigned char*)lds_raw + MISC_OFF);
    if (threadIdx.x < 64) MISC[threadIdx.x] = 0u;
    __syncthreads();
    const int lo = args.ph_lo, hi = args.ph_hi;
    const int wave_s = __builtin_amdgcn_readfirstlane(threadIdx.x >> 6);
#if MK_ONE_LAUNCH
    (void)xcd_barrier_post((unsigned*)(args.ws + WS_CTL) + CW_BAR, MISC + 8);
#define SEAM(k) do { if ((k) + 1 < hi) { CArgs ap_ = get_args(); XcdBarrier b_; b_.bar = (unsigned*)(ap_->ws + WS_CTL) + CW_BAR; b_.x = xb_xcc_id(); \
        LAS unsigned char* l_ = (LAS unsigned char*)lds_raw; asm volatile("" : "+s"(l_)); b_.st = (volatile LAS unsigned*)(l_ + MISC_OFF) + 8; \
        unsigned z2_ = 0u; asm volatile("" : "+s"(z2_)); const int ln_ = (int)__builtin_amdgcn_mbcnt_hi(~0u, __builtin_amdgcn_mbcnt_lo(~0u, z2_)); \
        xcd_barrier(b_, wave_s == 0 && ln_ == 0); PROBE_STAMP((k) + 1); } } while (0)
#else
#define SEAM(k) do { } while (0)
#endif
#ifndef DBG_MASK
#define DBG_MASK 0xFFFFu
#endif
#ifndef DBGD
#define DBGD DEPTH
#endif
#define EN(j) (((DBG_MASK) >> (j)) & 1u)
#define IN(k) (lo <= (k) && (k) < hi)
#ifndef PROBE_MASK
#define PROBE_MASK 0
#endif
#ifndef PROBE_FACTOR
#define PROBE_FACTOR 4
#endif
#define PROBE_STAMP(idx) do { if (PROBE_MASK) { if (blockIdx.x == 0 && wave_s == 0) { CArgs apz_ = get_args(); unsigned long long* ts_ = (unsigned long long*)(apz_->ws + WS_CTL) + CW_TS / 2; \
        const unsigned long long now_ = __builtin_amdgcn_s_memrealtime(); if (__builtin_amdgcn_mbcnt_lo(~0u, 0u) == 0u && __builtin_amdgcn_mbcnt_hi(~0u, 0u) == 0u) __hip_atomic_store(ts_ + (idx), now_, RLX_AGENT); } } } while (0)
#define PHASE_CTX() CArgs ap = get_args(); unsigned char* ws = ap->ws; (void)ws; \
    LAS unsigned char* lds = (LAS unsigned char*)lds_raw; asm volatile("" : "+s"(lds)); (void)lds; \
    int wave = wave_s; asm volatile("" : "+s"(wave)); unsigned zero_ = 0u; asm volatile("" : "+s"(zero_)); const int lane = (int)__builtin_amdgcn_mbcnt_hi(~0u, __builtin_amdgcn_mbcnt_lo(~0u, zero_)); const int tid = wave * 64 + lane; (void)tid; \
    int bid = blockIdx.x; asm volatile("" : "+s"(bid)); int G = gridDim.x; asm volatile("" : "+s"(G)); \
    const int gw = bid * NWAVES + wave, NGW = G * NWAVES, gws = wave * G + bid; (void)gw; (void)NGW; (void)gws


    PROBE_STAMP(0);
    if (EN(11) && IN(0)) { PHASE_CTX(); phase_prologue(ap, lds, tid, lane, wave, bid, G); SEAM(0); }

    for (int l = 0; l < DBGD; ++l) {
        const int pb = 1 + PH_PER_LAYER * l;
        if (EN(0) && IN(pb + 0)) { PHASE_CTX(); build_gc(ap, l, bid * NTHREADS + tid, G * NTHREADS); if (l == 0) phase_n1<0>(ap, l, lane, gw, NGW); else phase_n1<1>(ap, l, lane, gw, NGW); SEAM(pb + 0); }
        if (EN(1) && IN(pb + 1)) {
            { PHASE_CTX();
              pg8::Gemm g{(const bf16*)(ws + WS_H), (const bf16*)(ws + WS_WIN) + (size_t)l * 1792 * D, T, 1792, D}; pg8::StaticOrder S; S.init(T, 1792, G, bid);
              pg8::EpiPlain E{(bf16*)(ws + WS_PROJ), DIN};
              pg8::gemm_phase<pg8::EpiPlain, pg8::StaticOrder, true, true>(lds, g, S, E, tid); }
            { PHASE_CTX();
              pg8::Gemm g{(const bf16*)(ws + WS_H8), (const bf16*)(ws + WS_WIN8 + (size_t)l * 3072 * D), T, 3072, D / 2}; pg8::StaticOrder S; S.init(T, 3072, G, bid);
              pg8::EpiPlain8 E{(bf16*)(ws + WS_PROJ) + OFF_GT, DIN};
              pg8::gemm_phase<pg8::EpiPlain8, pg8::StaticOrder, true, false>(lds, g, S, E, tid); }
            SEAM(pb + 1);
        }
        if (EN(2) && IN(pb + 2)) { PHASE_CTX();
            PROBE_SUB(ws, tid, 8);
            for (int blk = bid; blk < 256; blk += G) { s5a_block(ap, l, blk, lds, tid, lane, wave); PROBE_SUB(ws, tid, 9); if (wave < 2) s5b_unit(ap, l, (blk >> 4) | (wave << 4) | ((blk & 15) << 5), lane); }
            PROBE_SUB(ws, tid, 10);
            if (wave >= 2) { const int gw6 = bid * 6 + (wave - 2), NGW6 = G * 6;
                PROBE_SUB(ws, tid - 128, 14);
                phase_prep(ap, l, lane, gw6, NGW6);
                PROBE_SUB(ws, tid - 128, 15);
                for (int it = gw6; it < 1152; it += NGW6) vt_item(ap, it, lane);
                PROBE_SUB(ws, tid - 128, 16); }
            SEAM(pb + 2);
        }
        if (EN(3) && IN(pb + 3)) { PHASE_CTX();
            for (int blk = bid; blk < 256; blk += G) s5c_block(ap, l, blk, lds, tid, lane, wave);
            PROBE_SUB(ws, tid, 4);
            for (int it = gw; it < 4096; it += NGW) attn_item(ap, l, true, it, lane);
            PROBE_SUB(ws, tid, 5);
            if ((gw & 3) == 1 && l < DEPTH - 1) { for (int it = gw >> 2; it < 512; it += NGW >> 2) attn_item(ap, l, false, it, lane); }
            SEAM(pb + 3);
        }
        if (EN(4) && IN(pb + 4)) { PHASE_CTX();
            pg8::Gemm g{(const bf16*)(ws + WS_Z), (const bf16*)(ws + WS_WGLU) + (size_t)l * 256 * 256, T, 256, 256}; pg8::RowOrder S; S.lat = (l == DEPTH - 1); S.init(S.lat ? NB * SEQ : T, 256, G, bid);
            pg8::EpiGlu E{(const bf16*)(ws + WS_Z), (bf16*)(ws + WS_Z2), 256};
            pg8::gemm_phase<pg8::EpiGlu, pg8::RowOrder, true, true>(lds, g, S, E, tid);
            SEAM(pb + 4);
        }
        if (EN(5) && IN(pb + 5)) {
            { PHASE_CTX(); pg8::RowOrder S; S.lat = (l == DEPTH - 1); S.init(S.lat ? NB * SEQ : T, D, G, bid);
              pg8::Gemm g{(const bf16*)(ws + WS_Z2), (const bf16*)(ws + WS_WSO) + (size_t)l * D * 256, T, D, 256};
              pg8::EpiBranch<true> E{(const bf16*)(ws + WS_PROJ) + OFF_GT, DIN, (bf16*)(ws + WS_MM), D}; pg8::gemm_phase<pg8::EpiBranch<true>, pg8::RowOrder, true, true>(lds, g, S, E, tid); }
            { PHASE_CTX(); pg8::RowOrder S; S.lat = (l == DEPTH - 1); S.init(S.lat ? NB * SEQ : T, D, G, bid);
              pg8::Gemm g{(const bf16*)(ws + WS_YB), (const bf16*)(ws + WS_WCO) + (size_t)l * D * 256, T, D, 256};
              pg8::EpiBranch<false> E{(const bf16*)(ws + WS_PROJ) + OFF_GT + D, DIN, (bf16*)(ws + WS_MM), D}; pg8::gemm_phase<pg8::EpiBranch<false>, pg8::RowOrder, true, true>(lds, g, S, E, tid); }
            { PHASE_CTX(); pg8::RowOrder S; S.lat = (l == DEPTH - 1); S.init(S.lat ? NB * SEQ : T, D, G, bid);
              pg8::Gemm g{(const bf16*)(ws + WS_YA), (const bf16*)(ws + WS_WAO) + (size_t)l * D * 512, T, D, 512};
              pg8::EpiBranch<false> E{(const bf16*)(ws + WS_PROJ) + OFF_GT + 2 * D, DIN, (bf16*)(ws + WS_MM), D}; pg8::gemm_phase<pg8::EpiBranch<false>, pg8::RowOrder, true, true>(lds, g, S, E, tid); }
            SEAM(pb + 5);
        }
        if (EN(6) && IN(pb + 6)) { PHASE_CTX();
            pg8::Gemm g{(const bf16*)(ws + WS_MM), (const bf16*)(ws + WS_WO) + (size_t)l * D * D, T, D, D}; pg8::RowOrder S; S.lat = (l == DEPTH - 1); S.init(S.lat ? NB * SEQ : T, D, G, bid);
            pg8::EpiWo E{(float*)(ws + WS_X), (const float*)(ws + WS_MOD) + (size_t)l * 17 * 6144 + 2048};
            pg8::gemm_phase<pg8::EpiWo, pg8::RowOrder, true, true>(lds, g, S, E, tid);
            SEAM(pb + 6);
        }
        if (EN(7) && IN(pb + 7)) { PHASE_CTX(); phase_n2(ap, l, lds, tid, lane, wave, bid, G); SEAM(pb + 7); }
        if (EN(8) && IN(pb + 8)) { PHASE_CTX(); phase_moe_prep(ap, l, lds, tid, lane, gw, NGW); SEAM(pb + 8); }
        if (EN(9) && IN(pb + 9)) { PHASE_CTX();
            build_expert_tables(ap, l, lds, tid);
            const int nt = ((const LAS int*)(lds + PADS_OFF))[32];
            pg8::Gemm g{(const bf16*)(ws + WS_XG), (const bf16*)(ws + WS_WGU + (size_t)l * 32 * 2048 * 1024), nt * 256, 2048, 512};
            pg8::MoeOrder S{8, nt * 8, G, bid, lds + TILE_E_OFF, (size_t)2048 * 1024};
            pg8::EpiSwiglu E{(unsigned char*)(ws + WS_ACT), ap->in[I_BGU] + (size_t)l * 32 * 2048, lds + TILE_E_OFF};
            pg8::gemm_phase<pg8::EpiSwiglu, pg8::MoeOrder, true, false>(lds, g, S, E, tid);
            SEAM(pb + 9);
        }
        if (EN(10) && IN(pb + 10)) { PHASE_CTX();
            build_expert_tables(ap, l, lds, tid);
            const int nt = ((const LAS int*)(lds + PADS_OFF))[32];
            pg8::Gemm g{(const bf16*)(ws + WS_ACT), (const bf16*)(ws + WS_WD + (size_t)l * 32 * 1024 * 1024), nt * 256, 1024, 512};
            pg8::MoeOrder S{4, nt * 4, G, bid, lds + TILE_E_OFF, (size_t)1024 * 1024};
            pg8::EpiDown E{(unsigned char*)(ws + WS_YS8), ap->in[I_BD] + (size_t)l * 32 * 1024, lds + TILE_E_OFF};
            pg8::gemm_phase<pg8::EpiDown, pg8::MoeOrder, true, false>(lds, g, S, E, tid);
            SEAM(pb + 10);
        }
    }
    if (EN(12) && IN(NPHASES - 1)) { PHASE_CTX(); phase_n1<2>(ap, DEPTH, lane, gw, NGW); }
    if (PROBE_MASK || PROBE_SUB_A >= 0) { if (blockIdx.x == 0 && wave_s == 0) { CArgs apz_ = get_args(); unsigned long long* ts_ = (unsigned long long*)(apz_->ws + WS_CTL) + CW_TS / 2;
        asm volatile("s_waitcnt vmcnt(0)" ::: "memory");
        const unsigned long long t_end = __builtin_amdgcn_s_memrealtime(); unsigned long long sum = 0;
        for (int k2 = 0; k2 < NPHASES; ++k2) { const int cls = k2 == 0 ? 0 : (k2 == NPHASES - 1 ? 13 : 1 + (k2 - 1) % PH_PER_LAYER);
            const unsigned long long t0 = __hip_atomic_load(ts_ + k2, RLX_AGENT), t1 = (k2 == NPHASES - 1) ? t_end : __hip_atomic_load(ts_ + k2 + 1, RLX_AGENT);
            if ((PROBE_MASK >> cls) & 1) sum += t1 - t0; }
        if (PROBE_SUB_A >= 0) sum = (unsigned long long)PROBE_SUBF * (__hip_atomic_load(ts_ + 128 + (PROBE_SUB_B < 0 ? 0 : PROBE_SUB_B), RLX_AGENT) - __hip_atomic_load(ts_ + 128 + (PROBE_SUB_A < 0 ? 0 : PROBE_SUB_A), RLX_AGENT)) / PROBE_FACTOR;
        while (__builtin_amdgcn_s_memrealtime() - t_end < (unsigned long long)PROBE_FACTOR * sum) __builtin_amdgcn_s_sleep(8); } }
#undef IN
#undef SEAM
}

extern "C" void kernel_launch(void* const* d_in, const int* in_sizes, int n_in, void* d_out, int out_size, void* d_ws, size_t ws_size, hipStream_t stream) {
    static int grid = 0;
    if (grid == 0) {
        if (n_in != N_IN || out_size != NB * SEQ * D || ws_size < WS_END) { fprintf(stderr, "kernel_launch: unexpected sizes (n_in %d out %d ws %zu, need %zu)\n", n_in, out_size, ws_size, (size_t)WS_END); grid = -1; return; }
        int dev = 0, cus = 0, per_cu = 0;
        if (hipGetDevice(&dev) != hipSuccess || hipDeviceGetAttribute(&cus, hipDeviceAttributeMultiprocessorCount, dev) != hipSuccess) { grid = -1; return; }
        if (hipFuncSetAttribute((const void*)fwd, hipFuncAttributeMaxDynamicSharedMemorySize, LDS_BYTES) != hipSuccess) { fprintf(stderr, "kernel_launch: hipFuncSetAttribute failed\n"); grid = -1; return; }
        if (hipOccupancyMaxActiveBlocksPerMultiprocessor(&per_cu, (const void*)fwd, NTHREADS, LDS_BYTES) != hipSuccess || per_cu < 1) { fprintf(stderr, "kernel_launch: occupancy query says %d\n", per_cu); }
        (void)hipGetLastError();
        grid = cus;
    }
    if (grid < 0) return;
    if (hipMemsetAsync((char*)d_ws + WS_CTL, 0, CTL_ZERO_BYTES, stream) != hipSuccess) return;
    Args a{};
    for (int i = 0; i < N_IN; ++i) a.in[i] = (const float*)d_in[i];
    a.out = (float*)d_out; a.ws = (unsigned char*)d_ws;
#if MK_ONE_LAUNCH
    a.ph_lo = 0; a.ph_hi = NPHASES;
    hipLaunchKernelGGL(fwd, dim3(grid), dim3(NTHREADS), LDS_BYTES, stream, a);
#else
    for (int p = 0; p < NPHASES; ++p) { a.ph_lo = p; a.ph_hi = p + 1; hipLaunchKernelGGL(fwd, dim3(grid), dim3(NTHREADS), LDS_BYTES, stream, a); }
#endif
}
```

```cpp
#include <hip/hip_runtime.h>
#include <cstdio>
#include <cstdint>
namespace pg8 {
#define PG8_LAS __attribute__((address_space(3)))
#define PG8_GAS __attribute__((address_space(1)))
typedef unsigned short bf16_t;
typedef short bf16x8 __attribute__((ext_vector_type(8)));
typedef float f32x4 __attribute__((ext_vector_type(4)));
typedef unsigned u32x4 __attribute__((ext_vector_type(4)));
typedef int pg8_i4 __attribute__((ext_vector_type(4)));
typedef int pg8_i8 __attribute__((ext_vector_type(8)));
constexpr int BM = 256, BK = 64, HALF = 128, HTB = HALF * BK * 2  , STAGE_BYTES = 8 * HTB, NXCD = 8, WGM = 8;

__host__ __device__ __forceinline__ int lds_byte(int r, int c) { const int st = (r >> 4) * 2 + (c >> 5), rr = r & 15, cc = c & 31, ob = rr * 64 + cc * 2; return st * 1024 + (ob ^ (((ob >> 9) & 1) << 5)); }
__host__ __device__ __forceinline__ void stage_rc(int b, int& R, int& C) { const int st = b / 1024, sb = b % 1024, swz = sb ^ (((sb >> 9) & 1) << 5); R = (st >> 1) * 16 + swz / 64; C = (st & 1) * 32 + (swz % 64) / 2; }
__host__ __device__ __forceinline__ int perm32(int rho) { const int n = rho >> 4, i = rho & 15; return 8 * (i >> 2) + 4 * n + (i & 3); }

struct Unit { int pm, pn; };
struct Gemm { const bf16_t* A; const bf16_t* Bt; int M, N, K; };

struct StaticOrder {
    static constexpr bool GATHER = false;
    int nM, nN, nwg, G, c;
    __host__ __device__ void init(int M, int N, int G_, int c_) { nM = M / BM; nN = N / BM; nwg = nM * nN; G = G_; c = c_; }
    __host__ __device__ bool next(int i, Unit& u) const {
        const long L = (long)i * G + c; if (L >= nwg) return false;
        int wgid = (int)L; { const int q = nwg / NXCD, r = nwg % NXCD, xcd = wgid % NXCD, off = wgid / NXCD; wgid = (xcd < r ? xcd * (q + 1) : r * (q + 1) + (xcd - r) * q) + off; }
        const int nig = WGM * nN, gid = wgid / nig, fm = gid * WGM, gsz = (nM - fm) < WGM ? (nM - fm) : WGM;
        u.pm = fm + ((wgid % nig) % gsz); u.pn = (wgid % nig) / gsz; return true;
    }
    __device__ __forceinline__ void a_ready(const Unit&) const {}
    __device__ __forceinline__ void done(const Unit&) const {}
    __device__ __forceinline__ const char* aptr(const Gemm& g, const Unit& u, size_t tstep) const { return (const char*)g.A + (size_t)u.pm * tstep; }
    __device__ __forceinline__ const char* bptr(const Gemm& g, const Unit& u, size_t tstep) const { return (const char*)g.Bt + (size_t)u.pn * tstep; }
};

__device__ __forceinline__ unsigned cvt_pk_bf16(float lo, float hi) { unsigned r; asm volatile("v_cvt_pk_bf16_f32 %0, %1, %2" : "=v"(r) : "v"(lo), "v"(hi)); return r; }
__device__ __forceinline__ float bf_lo(unsigned w) { return __uint_as_float(w << 16); }
__device__ __forceinline__ float bf_hi(unsigned w) { return __uint_as_float(w & 0xffff0000u); }
__device__ __forceinline__ float sigm(float x) { return __builtin_amdgcn_rcpf(1.0f + __expf(-x)); }
#define PG8_FRESH_LANE() { unsigned z_ = 0u; asm volatile("" : "+s"(z_)); const int l_ = (int)__builtin_amdgcn_mbcnt_hi(~0u, __builtin_amdgcn_mbcnt_lo(~0u, z_)); fr = l_ & 15; fq = l_ >> 4; }

struct EpiPlain {
    static constexpr bool PERM = true, AFTER_DRAIN = false, FP8 = false; static constexpr int WSCALE = 0x7f;
    bf16_t* O; int ldc;
    __device__ __forceinline__ void operator()(const f32x4 (&acc)[2][2][4][2], const Unit& u, int wr, int wc, int fr, int fq) const {
        PG8_FRESH_LANE();
        const int row0 = u.pm * BM + wr * 64 + fr, col0 = u.pn * BM + wc * 32 + 8 * fq;
#pragma unroll
        for (int ai = 0; ai < 2; ++ai)
#pragma unroll
            for (int m = 0; m < 4; ++m) { bf16_t* rowp = O + (size_t)(row0 + ai * HALF + m * 16) * ldc + col0;
#pragma unroll
                for (int bj = 0; bj < 2; ++bj) { const f32x4 v0 = acc[ai][bj][m][0], v1 = acc[ai][bj][m][1];
                    u32x4 w; w.x = cvt_pk_bf16(v0[0], v0[1]); w.y = cvt_pk_bf16(v0[2], v0[3]); w.z = cvt_pk_bf16(v1[0], v1[1]); w.w = cvt_pk_bf16(v1[2], v1[3]);
                    *(u32x4*)(rowp + bj * HALF) = w; } }
    }
};
struct EpiPlain8 {
    static constexpr bool PERM = true, AFTER_DRAIN = false, FP8 = true; static constexpr int WSCALE = 0;
    bf16_t* O; int ldc;
    __device__ __forceinline__ void operator()(const f32x4 (&acc)[2][2][4][2], const Unit& u, int wr, int wc, int fr, int fq) const {
        PG8_FRESH_LANE();
        const int row0 = u.pm * BM + wr * 64 + fr, col0 = u.pn * BM + wc * 32 + 8 * fq;
#pragma unroll
        for (int ai = 0; ai < 2; ++ai)
#pragma unroll
            for (int m = 0; m < 4; ++m) { bf16_t* rowp = O + (size_t)(row0 + ai * HALF + m * 16) * ldc + col0;
#pragma unroll
                for (int bj = 0; bj < 2; ++bj) { const f32x4 v0 = acc[ai][bj][m][0] * 0.03125f, v1 = acc[ai][bj][m][1] * 0.03125f;
                    u32x4 w; w.x = cvt_pk_bf16(v0[0], v0[1]); w.y = cvt_pk_bf16(v0[2], v0[3]); w.z = cvt_pk_bf16(v1[0], v1[1]); w.w = cvt_pk_bf16(v1[2], v1[3]);
                    *(u32x4*)(rowp + bj * HALF) = w; } }
    }
};
struct EpiGlu {
    static constexpr bool PERM = true, AFTER_DRAIN = false, FP8 = false; static constexpr int WSCALE = 0x7f;
    const bf16_t* Z; bf16_t* O; int ldc;
    __device__ __forceinline__ void operator()(const f32x4 (&acc)[2][2][4][2], const Unit& u, int wr, int wc, int fr, int fq) const {
        PG8_FRESH_LANE();
        const int row0 = u.pm * BM + wr * 64 + fr, col0 = u.pn * BM + wc * 32 + 8 * fq;
#pragma unroll
        for (int ai = 0; ai < 2; ++ai) {
            u32x4 z[4][2];
#pragma unroll
            for (int m = 0; m < 4; ++m)
#pragma unroll
                for (int bj = 0; bj < 2; ++bj) z[m][bj] = *(const u32x4*)(Z + (size_t)(row0 + ai * HALF + m * 16) * ldc + col0 + bj * HALF);
#pragma unroll
            for (int m = 0; m < 4; ++m)
#pragma unroll
                for (int bj = 0; bj < 2; ++bj) { const f32x4 v0 = acc[ai][bj][m][0], v1 = acc[ai][bj][m][1]; const u32x4 zz = z[m][bj];
                    u32x4 w; w.x = cvt_pk_bf16(bf_lo(zz.x) * sigm(v0[0]), bf_hi(zz.x) * sigm(v0[1])); w.y = cvt_pk_bf16(bf_lo(zz.y) * sigm(v0[2]), bf_hi(zz.y) * sigm(v0[3]));
                    w.z = cvt_pk_bf16(bf_lo(zz.z) * sigm(v1[0]), bf_hi(zz.z) * sigm(v1[1])); w.w = cvt_pk_bf16(bf_lo(zz.w) * sigm(v1[2]), bf_hi(zz.w) * sigm(v1[3]));
                    *(u32x4*)(O + (size_t)(row0 + ai * HALF + m * 16) * ldc + col0 + bj * HALF) = w; }
            asm volatile("" ::: "memory"); }
    }
};
template <bool FIRST> struct EpiBranch {
    static constexpr bool PERM = true, AFTER_DRAIN = false, FP8 = false; static constexpr int WSCALE = 0x7f;
    const bf16_t* GT; int ldg; bf16_t* MM; int ldc;
    __device__ __forceinline__ void operator()(const f32x4 (&acc)[2][2][4][2], const Unit& u, int wr, int wc, int fr, int fq) const {
        PG8_FRESH_LANE();
        const unsigned row0 = u.pm * BM + wr * 64 + fr, col0 = u.pn * BM + wc * 32 + 8 * fq;
#pragma unroll
        for (int ai = 0; ai < 2; ++ai) {
            u32x4 g[4][2], pv[4][2];
#pragma unroll
            for (int m = 0; m < 4; ++m)
#pragma unroll
                for (int bj = 0; bj < 2; ++bj) { const unsigned row = row0 + ai * HALF + m * 16;
                    g[m][bj] = *(const u32x4*)(GT + row * (unsigned)ldg + col0 + bj * HALF);
                    if (!FIRST) pv[m][bj] = *(const u32x4*)(MM + row * (unsigned)ldc + col0 + bj * HALF); }
#pragma unroll
            for (int m = 0; m < 4; ++m)
#pragma unroll
                for (int bj = 0; bj < 2; ++bj) { const unsigned row = row0 + ai * HALF + m * 16; const f32x4 v0 = acc[ai][bj][m][0], v1 = acc[ai][bj][m][1]; const u32x4 gg = g[m][bj];
                    float o[8];
                    o[0] = sigm(bf_lo(gg.x)) * v0[0]; o[1] = sigm(bf_hi(gg.x)) * v0[1]; o[2] = sigm(bf_lo(gg.y)) * v0[2]; o[3] = sigm(bf_hi(gg.y)) * v0[3];
                    o[4] = sigm(bf_lo(gg.z)) * v1[0]; o[5] = sigm(bf_hi(gg.z)) * v1[1]; o[6] = sigm(bf_lo(gg.w)) * v1[2]; o[7] = sigm(bf_hi(gg.w)) * v1[3];
                    if (!FIRST) { const u32x4 p = pv[m][bj];
                        o[0] += bf_lo(p.x); o[1] += bf_hi(p.x); o[2] += bf_lo(p.y); o[3] += bf_hi(p.y); o[4] += bf_lo(p.z); o[5] += bf_hi(p.z); o[6] += bf_lo(p.w); o[7] += bf_hi(p.w); }
                    u32x4 w; w.x = cvt_pk_bf16(o[0], o[1]); w.y = cvt_pk_bf16(o[2], o[3]); w.z = cvt_pk_bf16(o[4], o[5]); w.w = cvt_pk_bf16(o[6], o[7]);
                    *(u32x4*)(MM + row * (unsigned)ldc + col0 + bj * HALF) = w; }
            asm volatile("" ::: "memory"); }
    }
};
struct EpiWo {
    static constexpr bool PERM = false, AFTER_DRAIN = false, FP8 = false; static constexpr int WSCALE = 0x7f;
    float* X; const float* g1base;
    __device__ __forceinline__ void operator()(const f32x4 (&acc)[2][2][4][2], const Unit& u, int wr, int wc, int fr, int fq) const {
        PG8_FRESH_LANE();
        const int row0 = u.pm * BM + wr * 64 + fr, col0 = u.pn * BM + wc * 32 + 4 * fq;
        const int r = (u.pm % 9 == 0) ? 16 : u.pm / 9; const float* g1 = g1base + (size_t)r * 6144 + col0;
        f32x4 gv[2][2];
#pragma unroll
        for (int bj = 0; bj < 2; ++bj)
#pragma unroll
            for (int n = 0; n < 2; ++n) gv[bj][n] = *(const f32x4*)(g1 + bj * HALF + n * 16);
#pragma unroll
        for (int ai = 0; ai < 2; ++ai)
#pragma unroll
            for (int mh = 0; mh < 2; ++mh) {
                f32x4 xv[2][2][2];
#pragma unroll
                for (int mm = 0; mm < 2; ++mm)
#pragma unroll
                    for (int bj = 0; bj < 2; ++bj)
#pragma unroll
                        for (int n = 0; n < 2; ++n) xv[mm][bj][n] = *(const f32x4*)(X + (size_t)(row0 + ai * HALF + (2 * mh + mm) * 16) * 1024 + col0 + bj * HALF + n * 16);
#pragma unroll
                for (int mm = 0; mm < 2; ++mm)
#pragma unroll
                    for (int bj = 0; bj < 2; ++bj)
#pragma unroll
                        for (int n = 0; n < 2; ++n) *(f32x4*)(X + (size_t)(row0 + ai * HALF + (2 * mh + mm) * 16) * 1024 + col0 + bj * HALF + n * 16) = xv[mm][bj][n] + gv[bj][n] * acc[ai][bj][2 * mh + mm][n];
                asm volatile("" ::: "memory"); }
    }
};
struct EpiSwiglu {
    static constexpr bool PERM = true, AFTER_DRAIN = false, FP8 = true; static constexpr int WSCALE = 0;
    unsigned char* O; const float* bias; const PG8_LAS unsigned char* tile_e;
    __device__ __forceinline__ void operator()(const f32x4 (&acc)[2][2][4][2], const Unit& u, int wr, int wc, int fr, int fq) const {
        PG8_FRESH_LANE();
        const int row0 = u.pm * BM + wr * 64 + fr, acol0 = u.pn * HALF + wc * 32 + 8 * fq;
        const int e = tile_e[u.pm]; const float* bb = bias + (size_t)e * 2048 + 2 * acol0;
        const f32x4 b0 = *(const f32x4*)(bb), b1 = *(const f32x4*)(bb + 4), b2 = *(const f32x4*)(bb + 8), b3 = *(const f32x4*)(bb + 12);
        const float bg[8] = {b0[0], b0[2], b1[0], b1[2], b2[0], b2[2], b3[0], b3[2]}, bu[8] = {b0[1], b0[3], b1[1], b1[3], b2[1], b2[3], b3[1], b3[3]};
#pragma unroll
        for (int ai = 0; ai < 2; ++ai)
#pragma unroll
            for (int m = 0; m < 4; ++m) { unsigned char* rowp = O + (size_t)(row0 + ai * HALF + m * 16) * 1024 + acol0;
                float o[8];
#pragma unroll
                for (int j = 0; j < 8; ++j) { const float gt = acc[ai][0][m][j >> 2][j & 3] * 0.03125f + bg[j], up = acc[ai][1][m][j >> 2][j & 3] * 0.03125f + bu[j];
                    const float glu = fminf(gt, 7.0f), upc = fminf(fmaxf(up, -7.0f), 7.0f);
                    o[j] = glu * sigm(1.702f * glu) * (upc + 1.0f); }
                unsigned w0 = 0u, w1 = 0u;
                w0 = __builtin_amdgcn_cvt_pk_fp8_f32(o[0], o[1], w0, false); w0 = __builtin_amdgcn_cvt_pk_fp8_f32(o[2], o[3], w0, true);
                w1 = __builtin_amdgcn_cvt_pk_fp8_f32(o[4], o[5], w1, false); w1 = __builtin_amdgcn_cvt_pk_fp8_f32(o[6], o[7], w1, true);
                typedef unsigned u32x2 __attribute__((ext_vector_type(2)));
                *(u32x2*)rowp = (u32x2){w0, w1}; }
    }
};
struct EpiDown {
    static constexpr bool PERM = true, AFTER_DRAIN = false, FP8 = true; static constexpr int WSCALE = 0;
    unsigned char* O; const float* bias; const PG8_LAS unsigned char* tile_e;
    __device__ __forceinline__ void operator()(const f32x4 (&acc)[2][2][4][2], const Unit& u, int wr, int wc, int fr, int fq) const {
        PG8_FRESH_LANE();
        const int row0 = u.pm * BM + wr * 64 + fr, col0 = u.pn * BM + wc * 32 + 8 * fq;
        const int e = tile_e[u.pm]; const float* bb = bias + (size_t)e * 1024 + col0;
        f32x4 bv[2][2];
#pragma unroll
        for (int bj = 0; bj < 2; ++bj)
#pragma unroll
            for (int n = 0; n < 2; ++n) bv[bj][n] = *(const f32x4*)(bb + bj * HALF + 4 * n);
        typedef unsigned u32x2 __attribute__((ext_vector_type(2)));
#pragma unroll
        for (int ai = 0; ai < 2; ++ai)
#pragma unroll
            for (int m = 0; m < 4; ++m) { unsigned char* rowp = O + (size_t)(row0 + ai * HALF + m * 16) * 1024 + col0;
#pragma unroll
                for (int bj = 0; bj < 2; ++bj) { const f32x4 v0 = acc[ai][bj][m][0] * 0.03125f + bv[bj][0], v1 = acc[ai][bj][m][1] * 0.03125f + bv[bj][1];
                    unsigned w0 = 0u, w1 = 0u;
                    w0 = __builtin_amdgcn_cvt_pk_fp8_f32(v0[0], v0[1], w0, false); w0 = __builtin_amdgcn_cvt_pk_fp8_f32(v0[2], v0[3], w0, true);
                    w1 = __builtin_amdgcn_cvt_pk_fp8_f32(v1[0], v1[1], w1, false); w1 = __builtin_amdgcn_cvt_pk_fp8_f32(v1[2], v1[3], w1, true);
                    *(u32x2*)(rowp + bj * HALF) = (u32x2){w0, w1}; } }
    }
};
struct RowOrder : StaticOrder {
    int lat;
    __device__ __forceinline__ bool next(int i, Unit& u) const { if (!StaticOrder::next(i, u)) return false; if (lat) u.pm = (u.pm >> 3) * 9 + 1 + (u.pm & 7); return true; }
};
struct PanelOrder {
    static constexpr bool GATHER = false;
    int pm, nN;
    __device__ __forceinline__ bool next(int i, Unit& u) const { if (i >= nN) return false; u.pm = pm; u.pn = i; return true; }
    __device__ __forceinline__ void a_ready(const Unit&) const {}
    __device__ __forceinline__ void done(const Unit&) const {}
    __device__ __forceinline__ const char* aptr(const Gemm& g, const Unit& u, size_t tstep) const { const char* p = (const char*)g.A + (size_t)u.pm * tstep; asm volatile("" : "+s"(p)); return p; }
    __device__ __forceinline__ const char* bptr(const Gemm& g, const Unit& u, size_t tstep) const { return (const char*)g.Bt + (size_t)u.pn * tstep; }
};
struct MoeOrder {
    static constexpr bool GATHER = false;
    int nN, total, G, c; const PG8_LAS unsigned char* tile_e; size_t estride;
    __device__ __forceinline__ bool next(int i, Unit& u) const {
        if ((G & 7) == 0 && ((G >> 3) % nN) == 0) { const int x = c & 7, j = c >> 3, rpx = (G >> 3) / nN; u.pm = i * (G / nN) + x * rpx + j / nN; u.pn = j % nN; return u.pm * nN < total; }
        const int L = i * G + c; if (L >= total) return false; u.pm = L / nN; u.pn = L - u.pm * nN; return true; }
    __device__ __forceinline__ void a_ready(const Unit&) const {}
    __device__ __forceinline__ void done(const Unit&) const {}
    __device__ __forceinline__ const char* aptr(const Gemm& g, const Unit& u, size_t tstep) const { return (const char*)g.A + (size_t)u.pm * tstep; }
    __device__ __forceinline__ const char* bptr(const Gemm& g, const Unit& u, size_t tstep) const { return (const char*)g.Bt + (size_t)tile_e[u.pm] * estride + (size_t)u.pn * tstep; }
};

struct MoeGatherOrder : MoeOrder {
    static constexpr bool GATHER = true;
    const int* rows;
    __device__ __forceinline__ const char* aptr(const Gemm& g, const Unit&, size_t) const { return (const char*)g.A; }
    __device__ __forceinline__ void load_raw(const Unit& u, int (&raw)[2][2], int tid) const {
#pragma unroll
        for (int i = 0; i < 2; ++i) { int R, C; stage_rc(tid * 16 + i * 8192, R, C);
#pragma unroll
            for (int h = 0; h < 2; ++h) raw[h][i] = rows[u.pm * BM + h * HALF + R]; }
    }
    __device__ __forceinline__ void raw_to_off(const int (&raw)[2][2], unsigned (&voff)[2][2], int tid, int K) const {
#pragma unroll
        for (int i = 0; i < 2; ++i) { int R, C; stage_rc(tid * 16 + i * 8192, R, C);
#pragma unroll
            for (int h = 0; h < 2; ++h) voff[h][i] = ((unsigned)raw[h][i] * (unsigned)K + (unsigned)C) * 2u; }
    }
};

template <class Epi, class Sched, bool ALIGN_EPI = false, bool SP2 = false>
__device__ __forceinline__ void gemm_phase(PG8_LAS unsigned char* lds, const Gemm g, const Sched& S, const Epi& E, int tid_in) {
    int tid_ = tid_in; asm volatile("" : "+v"(tid_));
    const int tid = tid_, wid = __builtin_amdgcn_readfirstlane(tid >> 6), lane = tid & 63, wr = wid >> 2, wc = wid & 3, fr = lane & 15, fq = lane >> 4;
    const int K = g.K, nt = K / BK;
    unsigned voffA[2], voffB[2];
#pragma unroll
    for (int i = 0; i < 2; ++i) { int R, C; stage_rc(tid * 16 + i * 8192, R, C); const int Rb = Epi::PERM ? ((R & ~31) + perm32(R & 31)) : R;
        voffA[i] = (unsigned)(R * K + C) * 2u; voffB[i] = (unsigned)(Rb * K + C) * 2u; }
    const size_t kstep = (size_t)(BK * 2);
    const size_t hstep = (size_t)HALF * K * 2;
    const size_t tstep = 2 * hstep;
    const unsigned ldsw = (unsigned)wid * 1024u;
    const int aoff = lds_byte(wr * 64 + fr, fq * 8), boff = lds_byte(wc * 32 + fr, fq * 8);
#define PG8_SA(b, h) (((b) * 2 + (h)) * HTB)
#define PG8_SB(b, h) ((4 + (b) * 2 + (h)) * HTB)
#define PG8_STAGE(bufoff, gbase, voff) do { _Pragma("unroll") for (int _i = 0; _i < 2; ++_i) \
        __builtin_amdgcn_global_load_lds((const PG8_GAS unsigned*)((const PG8_GAS char*)(gbase) + (voff)[_i]), (PG8_LAS unsigned*)(lds + (bufoff) + ldsw + _i * 8192), 16, 0, 0); } while (0)
#define PG8_STAGE_A(bufoff, p, h, nx) do { if constexpr (Sched::GATHER) { _Pragma("unroll") for (int _i = 0; _i < 2; ++_i) \
            __builtin_amdgcn_global_load_lds((const PG8_GAS unsigned*)((const PG8_GAS char*)(p) + ((nx) ? voffGN[h][_i] : voffGC[h][_i])), (PG8_LAS unsigned*)(lds + (bufoff) + ldsw + _i * 8192), 16, 0, 0); } \
        else PG8_STAGE(bufoff, (p) + (h) * hstep, voffA); } while (0)
#define PG8_LD8(p) __builtin_shufflevector(*(const PG8_LAS pg8_i4*)(p), *(const PG8_LAS pg8_i4*)((p) + 1024), 0, 1, 2, 3, 4, 5, 6, 7)
#define PG8_LDA(dst, b, h) do { if constexpr (Epi::FP8) { _Pragma("unroll") for (int m = 0; m < 4; ++m) { dst##8[m].lo = *(const PG8_LAS pg8_i4*)(lds + PG8_SA(b, h) + aoff + m * 2048); dst##8[m].hi = *(const PG8_LAS pg8_i4*)(lds + PG8_SA(b, h) + aoff + m * 2048 + 1024); } } \
    else { _Pragma("unroll") for (int m = 0; m < 4; ++m) _Pragma("unroll") for (int k = 0; k < 2; ++k) dst[m][k] = *(const PG8_LAS bf16x8*)(lds + PG8_SA(b, h) + aoff + m * 2048 + k * 1024); } } while (0)
#define PG8_LDB(dst, b, h) do { if constexpr (Epi::FP8) { _Pragma("unroll") for (int n = 0; n < 2; ++n) { dst##8[n].lo = *(const PG8_LAS pg8_i4*)(lds + PG8_SB(b, h) + boff + n * 2048); dst##8[n].hi = *(const PG8_LAS pg8_i4*)(lds + PG8_SB(b, h) + boff + n * 2048 + 1024); } } \
    else { _Pragma("unroll") for (int n = 0; n < 2; ++n) _Pragma("unroll") for (int k = 0; k < 2; ++k) dst[n][k] = *(const PG8_LAS bf16x8*)(lds + PG8_SB(b, h) + boff + n * 2048 + k * 1024); } } while (0)
#define PG8_CAT8(lo, hi) __builtin_shufflevector(__builtin_bit_cast(pg8_i4, lo), __builtin_bit_cast(pg8_i4, hi), 0, 1, 2, 3, 4, 5, 6, 7)
#define PG8_MMA(ai, bj, At, Bt) do { __builtin_amdgcn_s_setprio(1); if constexpr (Epi::FP8) { __builtin_amdgcn_sched_barrier(0); _Pragma("unroll") for (int m = 0; m < 4; ++m) _Pragma("unroll") for (int n = 0; n < 2; ++n) \
        acc[ai][bj][m][n] = __builtin_amdgcn_mfma_scale_f32_16x16x128_f8f6f4(Bt##8[n], At##8[m], acc[ai][bj][m][n], 0, 0, 0, 0, 0, 0); \
          \
        asm volatile("" : "+v"(acc[ai][bj][0][0]), "+v"(acc[ai][bj][0][1]), "+v"(acc[ai][bj][1][0]), "+v"(acc[ai][bj][1][1]), "+v"(acc[ai][bj][2][0]), "+v"(acc[ai][bj][2][1]), "+v"(acc[ai][bj][3][0]), "+v"(acc[ai][bj][3][1])); \
        __builtin_amdgcn_sched_barrier(0); } \
    else { _Pragma("unroll") for (int m = 0; m < 4; ++m) _Pragma("unroll") for (int n = 0; n < 2; ++n) _Pragma("unroll") for (int k = 0; k < 2; ++k) \
        acc[ai][bj][m][n] = __builtin_amdgcn_mfma_f32_16x16x32_bf16(Bt[n][k], At[m][k], acc[ai][bj][m][n], 0, 0, 0); } __builtin_amdgcn_s_setprio(0); } while (0)
#define PG8_WAIT_V(n) asm volatile("s_waitcnt vmcnt(" #n ")" ::: "memory")
#define PG8_WAIT_L(n) asm volatile("s_waitcnt lgkmcnt(" #n ")" ::: "memory")
#define PG8_BAR __builtin_amdgcn_s_barrier()
#define PG8_SCHED __builtin_amdgcn_sched_barrier(0)
    Unit cur, nxt; int ui = 0;
    if (!S.next(0, cur)) return;
    f32x4 acc[2][2][4][2];
#pragma unroll
    for (int a = 0; a < 2; ++a)
#pragma unroll
        for (int b = 0; b < 2; ++b)
#pragma unroll
            for (int m = 0; m < 4; ++m)
#pragma unroll
                for (int n = 0; n < 2; ++n) acc[a][b][m][n] = (f32x4){0.f, 0.f, 0.f, 0.f};
    bf16x8 At[4][2], B0[2][2], B1[2][2];
    pg8_i8 At8[4], B08[2], B18[2];
    (void)At; (void)B0; (void)B1; (void)At8; (void)B08; (void)B18;
    const char* cA = S.aptr(g, cur, tstep); const char* cB = S.bptr(g, cur, tstep);
    unsigned voffGC[2][2] = {{0u, 0u}, {0u, 0u}}, voffGN[2][2] = {{0u, 0u}, {0u, 0u}}; int rawN[2][2] = {{0, 0}, {0, 0}};
    if constexpr (Sched::GATHER) { S.load_raw(cur, rawN, tid); S.raw_to_off(rawN, voffGC, tid, K); }
    S.a_ready(cur);
    if constexpr (SP2) {
        PG8_STAGE(PG8_SB(0, 0), cB, voffB); PG8_STAGE(PG8_SB(0, 1), cB + hstep, voffB); PG8_STAGE_A(PG8_SA(0, 0), cA, 0, false); PG8_STAGE_A(PG8_SA(0, 1), cA, 1, false);
        if (wr == 1) PG8_BAR;
        PG8_WAIT_V(2); PG8_BAR;
        PG8_STAGE(PG8_SB(1, 0), cB + kstep, voffB); PG8_STAGE_A(PG8_SA(1, 0), cA + kstep, 0, false); PG8_STAGE(PG8_SB(1, 1), cB + hstep + kstep, voffB);
        PG8_WAIT_V(6); PG8_BAR;
    } else {
        PG8_STAGE(PG8_SB(0, 0), cB, voffB); PG8_STAGE_A(PG8_SA(0, 0), cA, 0, false); PG8_STAGE(PG8_SB(0, 1), cB + hstep, voffB); PG8_STAGE_A(PG8_SA(0, 1), cA, 1, false);
        if (wr == 1) PG8_BAR;
        PG8_WAIT_V(4); PG8_BAR;
        PG8_STAGE(PG8_SB(1, 0), cB + kstep, voffB); PG8_STAGE_A(PG8_SA(1, 0), cA + kstep, 0, false); PG8_STAGE(PG8_SB(1, 1), cB + hstep + kstep, voffB);
        PG8_WAIT_V(6); PG8_BAR;
    }
    for (;;) {
        const bool has_next = S.next(ui + 1, nxt);
        const char* nA = has_next ? S.aptr(g, nxt, tstep) : cA; const char* nB = has_next ? S.bptr(g, nxt, tstep) : cB;
        for (int t = 0; t < nt; t += 2) {
            const bool last = (t == nt - 2);
            const char* a1 = cA + (size_t)(t + 1) * kstep;
            const char* a2 = last ? nA : cA + (size_t)(t + 2) * kstep; const char* b2 = last ? nB : cB + (size_t)(t + 2) * kstep;
            const char* a3 = a2 + kstep; const char* b3 = b2 + kstep;
            if (last && has_next) S.a_ready(nxt);
            if constexpr (Sched::GATHER) {
                if (t == nt - 4 && has_next) S.load_raw(nxt, rawN, tid);
                if (last) { if (has_next) S.raw_to_off(rawN, voffGN, tid, K); else { voffGN[0][0] = voffGC[0][0]; voffGN[0][1] = voffGC[0][1]; voffGN[1][0] = voffGC[1][0]; voffGN[1][1] = voffGC[1][1]; } } }
            if constexpr (SP2) {
            PG8_LDB(B0, 0, 0); PG8_LDB(B1, 0, 1); PG8_SCHED; PG8_LDA(At, 0, 0); PG8_STAGE_A(PG8_SA(1, 1), a1, 1, false);
            PG8_WAIT_V(8); PG8_WAIT_L(0); PG8_BAR; PG8_MMA(0, 0, At, B0); PG8_MMA(0, 1, At, B1); PG8_BAR; PG8_SCHED;
            PG8_LDA(At, 0, 1); PG8_STAGE(PG8_SB(0, 0), b2, voffB); PG8_STAGE(PG8_SB(0, 1), b2 + hstep, voffB); PG8_STAGE_A(PG8_SA(0, 0), a2, 0, last);
            PG8_WAIT_V(8); PG8_WAIT_L(0); PG8_BAR; PG8_MMA(1, 0, At, B0); PG8_MMA(1, 1, At, B1); PG8_BAR; PG8_SCHED;
            PG8_LDB(B0, 1, 0); PG8_LDB(B1, 1, 1); PG8_SCHED; PG8_LDA(At, 1, 0); PG8_STAGE_A(PG8_SA(0, 1), a2, 1, last);
            PG8_WAIT_V(8); PG8_WAIT_L(0); PG8_BAR; PG8_MMA(0, 0, At, B0); PG8_MMA(0, 1, At, B1); PG8_BAR; PG8_SCHED;
            PG8_LDA(At, 1, 1); PG8_STAGE(PG8_SB(1, 0), b3, voffB); PG8_STAGE(PG8_SB(1, 1), b3 + hstep, voffB); PG8_STAGE_A(PG8_SA(1, 0), a3, 0, last);
            PG8_WAIT_V(8); PG8_WAIT_L(0); PG8_BAR; PG8_MMA(1, 0, At, B0); PG8_MMA(1, 1, At, B1); PG8_BAR; PG8_SCHED;
            } else {
            PG8_LDB(B0, 0, 0); PG8_SCHED; PG8_LDA(At, 0, 0); PG8_STAGE_A(PG8_SA(1, 1), a1, 1, false);
            PG8_WAIT_L(8); PG8_BAR; PG8_WAIT_L(0); PG8_MMA(0, 0, At, B0); PG8_BAR; PG8_SCHED;
            PG8_LDB(B1, 0, 1); PG8_STAGE(PG8_SB(0, 0), b2, voffB);
            PG8_BAR; PG8_WAIT_L(0); PG8_MMA(0, 1, At, B1); PG8_BAR;
            PG8_LDA(At, 0, 1); PG8_STAGE_A(PG8_SA(0, 0), a2, 0, last);
            PG8_BAR; PG8_WAIT_L(0); PG8_MMA(1, 0, At, B0); PG8_BAR; PG8_SCHED;
            PG8_STAGE(PG8_SB(0, 1), b2 + hstep, voffB);
            PG8_WAIT_V(6); PG8_BAR; PG8_MMA(1, 1, At, B1); PG8_BAR;
            PG8_LDB(B0, 1, 0); PG8_SCHED; PG8_LDA(At, 1, 0); PG8_STAGE_A(PG8_SA(0, 1), a2, 1, last);
            PG8_WAIT_L(8); PG8_BAR; PG8_WAIT_L(0); PG8_MMA(0, 0, At, B0); PG8_BAR; PG8_SCHED;
            PG8_LDB(B1, 1, 1); PG8_STAGE(PG8_SB(1, 0), b3, voffB);
            PG8_BAR; PG8_WAIT_L(0); PG8_MMA(0, 1, At, B1); PG8_BAR;
            PG8_LDA(At, 1, 1); PG8_STAGE_A(PG8_SA(1, 0), a3, 0, last);
            PG8_BAR; PG8_WAIT_L(0); PG8_MMA(1, 0, At, B0); PG8_BAR; PG8_SCHED;
            PG8_STAGE(PG8_SB(1, 1), b3 + hstep, voffB);
            PG8_WAIT_V(6); PG8_BAR; PG8_MMA(1, 1, At, B1); PG8_BAR;
            }
        }
        if constexpr (ALIGN_EPI) { if (wr == 0) PG8_BAR; }
        if constexpr (!Epi::AFTER_DRAIN) { E(acc, cur, wr, wc, fr, fq); S.done(cur); }
        if (!has_next) break;
#pragma unroll
        for (int a = 0; a < 2; ++a)
#pragma unroll
            for (int b = 0; b < 2; ++b)
#pragma unroll
                for (int m = 0; m < 4; ++m)
#pragma unroll
                    for (int n = 0; n < 2; ++n) acc[a][b][m][n] = (f32x4){0.f, 0.f, 0.f, 0.f};
        cur = nxt; cA = nA; cB = nB; ++ui;
        if constexpr (Sched::GATHER) { voffGC[0][0] = voffGN[0][0]; voffGC[0][1] = voffGN[0][1]; voffGC[1][0] = voffGN[1][0]; voffGC[1][1] = voffGN[1][1]; }
        if constexpr (ALIGN_EPI) { if (wr == 1) PG8_BAR; }
    }
    PG8_WAIT_V(0);
    if constexpr (!ALIGN_EPI) { if (wr == 0) PG8_BAR; }
    PG8_BAR;
    if constexpr (Epi::AFTER_DRAIN) { E.fused(acc, cur, wr, wc, fr, fq, lds, wid, lane); S.done(cur); }
#undef PG8_SA
#undef PG8_SB
#undef PG8_STAGE
#undef PG8_CAT8
#undef PG8_LD8
#undef PG8_STAGE_A
#undef PG8_LDA
#undef PG8_LDB
#undef PG8_MMA
#undef PG8_WAIT_V
#undef PG8_WAIT_L
#undef PG8_BAR
#undef PG8_SCHED
}
}

#ifndef MK_ONE_LAUNCH
#define MK_ONE_LAUNCH 1
#endif
constexpr int NWAVES = 8, NTHREADS = 512;
constexpr int NB = 16, SEQ = 2048, CTX = 256, TB = SEQ + CTX, T = NB * TB, D = 1024, DIN = 4864, DEPTH = 4;
constexpr int OFF_U = 0, OFF_CB = 256, OFF_CC = 512, OFF_CX = 768, OFF_Q = 1024, OFF_K = 1536, OFF_V = 1664, OFF_GT = 1792;
constexpr int NE = 32, MAX_TILES = (T * 4 + NE * 255) / 256, MAX_SLOTS = MAX_TILES * 256;
constexpr float EPS = 1e-6f;
enum { I_X = 0, I_C, I_CTX, I_CCTX, I_WMOD, I_BMOD, I_N1G, I_N2G, I_WIN, I_LRE, I_LIM, I_LDT, I_BRE, I_BIM, I_CRE, I_CIM, I_SD, I_WGLU, I_WSO, I_CONVW, I_WCO, I_QG, I_KG, I_SINK, I_WAO, I_WO,
       I_WR, I_BR, I_WGU, I_BGU, I_WD, I_BD, N_IN };
constexpr size_t MiB = 1u << 20;
constexpr size_t WS_CTL = 0, CTL_ZERO_BYTES = 1 * MiB;
constexpr size_t WS_MOD = 1 * MiB;
constexpr size_t WS_WRT = 3 * MiB;
constexpr size_t WS_ROPE = 4 * MiB;
constexpr size_t WS_WGLU = 5 * MiB;
constexpr size_t WS_WSO = 6 * MiB;
constexpr size_t WS_WCO = 8 * MiB;
constexpr size_t WS_WAO = 10 * MiB;
constexpr size_t WS_WO = 14 * MiB;
constexpr size_t WS_WIN = 22 * MiB;
constexpr size_t WS_WGU = 60 * MiB;
constexpr size_t WS_WD = 572 * MiB;
constexpr size_t WS_X = 828 * MiB;
constexpr size_t WS_H = 972 * MiB;
constexpr size_t WS_PROJ = 1044 * MiB;
constexpr size_t WS_QN = 1386 * MiB;
constexpr size_t WS_KN = 1422 * MiB;
constexpr size_t WS_Z = 1431 * MiB;
constexpr size_t WS_Z2 = 1449 * MiB;
constexpr size_t WS_YB = 1467 * MiB;
constexpr size_t WS_YA = 1485 * MiB;
constexpr size_t WS_MM = 1521 * MiB;
constexpr size_t WS_XG = 1593 * MiB;
constexpr size_t WS_ACT = 1897 * MiB;
constexpr size_t WS_TOPG = 2201 * MiB;
constexpr size_t WS_SLOT = 2202 * MiB;
constexpr size_t WS_S5S = 2203 * MiB;
constexpr size_t WS_XIN = 2275 * MiB;
constexpr size_t WS_VT = 2311 * MiB;
constexpr size_t WS_MS = 2320 * MiB;
constexpr size_t WS_W5 = 2324 * MiB;
constexpr size_t WS_BASE = 2330 * MiB;
constexpr size_t WS_STOK = 2331 * MiB;
constexpr size_t WS_GC = 2334 * MiB;
constexpr size_t WS_H8 = 2335 * MiB;
constexpr size_t WS_WIN8 = 2371 * MiB;
constexpr size_t WS_YS8 = 2383 * MiB;
constexpr size_t WS_END = 2535 * MiB;
static_assert(WS_WIN + (size_t)4 * DIN * D * 2 <= WS_WGU && WS_PROJ + (size_t)T * DIN * 2 <= WS_QN && WS_XG + (size_t)MAX_SLOTS * D * 2 <= WS_ACT && WS_ACT + (size_t)MAX_SLOTS * D * 2 <= WS_TOPG, "d_ws map");
static_assert(WS_X + (size_t)T * D * 4 <= WS_H && WS_H + (size_t)T * D * 2 <= WS_PROJ && WS_S5S + (size_t)16 * 4608 * 256 * 4 <= WS_XIN && WS_XIN + (size_t)32 * 4608 * 128 * 2 <= WS_VT && WS_VT + (size_t)32 * 64 * TB * 2 <= WS_MS && WS_W5 + (size_t)64 * 128 * 384 * 2 <= WS_END, "d_ws map 2");
constexpr int CW_CNT = 64;
constexpr int CW_BAR = 4096;
constexpr int CW_TS = 16384;
constexpr int RING_BYTES = 131072, MISC_OFF = RING_BYTES, LCNT_OFF = MISC_OFF + 128, TILE_E_OFF = MISC_OFF + 256, PADS_OFF = MISC_OFF + 1024, SCR_OFF = MISC_OFF + 2048, LDS_BYTES = 155648;

#define GAS __attribute__((address_space(1)))
#define LAS __attribute__((address_space(3)))
typedef unsigned short bf16;
typedef unsigned v4u __attribute__((ext_vector_type(4)));
typedef unsigned v2u __attribute__((ext_vector_type(2)));
typedef float f32x4 __attribute__((ext_vector_type(4)));
typedef float f32x2 __attribute__((ext_vector_type(2)));
typedef GAS unsigned gu32;
#define RLX_AGENT __ATOMIC_RELAXED, __HIP_MEMORY_SCOPE_AGENT
#define LDS_WAIT() asm volatile("s_waitcnt lgkmcnt(0)" ::: "memory")
#define VM_WAIT() asm volatile("s_waitcnt vmcnt(0)" ::: "memory")
__device__ __forceinline__ unsigned f2bf(float f) { unsigned u = __builtin_bit_cast(unsigned, f); return (u + 0x7fffu + ((u >> 16) & 1u)) >> 16; }
__device__ __forceinline__ unsigned pk2(float lo, float hi) { return f2bf(lo) | (f2bf(hi) << 16); }
__device__ __forceinline__ float bflo(unsigned w) { return __uint_as_float(w << 16); }
__device__ __forceinline__ float bfhi(unsigned w) { return __uint_as_float(w & 0xffff0000u); }

#define XB_TMO      128
#define XB_XCNT(j)  (256  + 64 * (j))
#define XB_XSUB(j)  (1280 + 64 * (j))
#define XB_XGEN(j)  (2304 + 64 * (j))
#define XB_TOP      3328
#define XB_TOPGEN   3392
#define XCD_BAR_WORDS 3456
#define XB_SPIN_CAP (1u << 18)

__device__ __forceinline__ unsigned xb_ld(unsigned* p)              { return __hip_atomic_load(p, __ATOMIC_RELAXED, __HIP_MEMORY_SCOPE_AGENT); }
__device__ __forceinline__ unsigned xb_add(unsigned* p, unsigned v) { return __hip_atomic_fetch_add(p, v, __ATOMIC_RELAXED, __HIP_MEMORY_SCOPE_AGENT); }
__device__ __forceinline__ unsigned xb_xcc_id() { return (unsigned)__builtin_amdgcn_s_getreg((3 << 11) | 20) & 0xFu; }
#define XB_SPIN(cond, bar) do { unsigned _sp = 0; while (cond) { __builtin_amdgcn_s_sleep(1); \
    if ((++_sp & 255u) == 0u) { if (xb_ld(&(bar)[XB_TMO])) break; if (_sp > XB_SPIN_CAP) { atomicAdd(&(bar)[XB_TMO], 1u); break; } } } } while (0)

struct XcdBarrier {
    unsigned* bar; unsigned x;
    volatile LAS unsigned* st;
};

__device__ __forceinline__ XcdBarrier xcd_barrier_post(unsigned* bar, volatile LAS unsigned* st) {
    XcdBarrier b; b.bar = bar; b.x = xb_xcc_id(); b.st = st;
    if (threadIdx.x == 0) (void)xb_add(&bar[XB_XCNT(b.x)], 1u);
    return b;
}
__device__ __forceinline__ void xcd_barrier_complete(unsigned* bar, unsigned x, unsigned& nloc, unsigned& nx) {
    const unsigned G = gridDim.x * gridDim.y * gridDim.z;
    unsigned sum, cnt, mine, sp = 0u;
    for (;;) {
        sum = 0u; cnt = 0u; mine = 0u;
#pragma unroll
        for (unsigned j = 0; j < 16; ++j) { const unsigned c = xb_ld(&bar[XB_XCNT(j)]); sum += c; cnt += (c > 0u) ? 1u : 0u; mine = (j == x) ? c : mine; }
        if (sum == G) break;
        __builtin_amdgcn_s_sleep(1);
        if ((++sp & 255u) == 0u) { if (xb_ld(&bar[XB_TMO])) break; if (sp > XB_SPIN_CAP) { atomicAdd(&bar[XB_TMO], 1u); break; } }
    }
    nloc = mine > 0u ? mine : 1u; nx = cnt > 0u ? cnt : 1u;
}

__device__ __forceinline__ void xcd_barrier(const XcdBarrier& b, const bool leader) {
    asm volatile("s_waitcnt vmcnt(0)" ::: "memory");
    __syncthreads();
    if (leader) {
        unsigned* bar = b.bar;
        __builtin_amdgcn_s_waitcnt(0);
        unsigned nloc = b.st[0], nx = b.st[1];
        if (nloc == 0u) { xcd_barrier_complete(bar, b.x, nloc, nx); b.st[0] = nloc; b.st[1] = nx; }
        const unsigned old = xb_add(&bar[XB_XSUB(b.x)], 1u);
        const unsigned gen = old / nloc;
        if (old + 1u == (gen + 1u) * nloc) {
            __builtin_amdgcn_fence(__ATOMIC_RELEASE, "agent");
            asm volatile("s_waitcnt vmcnt(0)" ::: "memory");
            const unsigned og = xb_add(&bar[XB_TOP], 1u);
            const unsigned tg = og / nx;
            if (og + 1u == (tg + 1u) * nx) xb_add(&bar[XB_TOPGEN], 1u);
            else XB_SPIN(xb_ld(&bar[XB_TOPGEN]) == tg, bar);
            __builtin_amdgcn_fence(__ATOMIC_ACQUIRE, "agent");
            xb_add(&bar[XB_XGEN(b.x)], 1u);
            asm volatile("s_waitcnt vmcnt(0)" ::: "memory");
        } else {
            XB_SPIN(xb_ld(&bar[XB_XGEN(b.x)]) == gen, bar);
            __builtin_amdgcn_fence(__ATOMIC_ACQUIRE, "agent");
            asm volatile("s_waitcnt vmcnt(0)" ::: "memory");
        }
    }
    __syncthreads();
}

struct Args { const float* in[N_IN]; float* out; unsigned char* ws; int ph_lo, ph_hi; };
typedef const __attribute__((address_space(4))) Args CA;
typedef CA* CArgs;
__device__ __forceinline__ CArgs get_args() { CArgs p = (CArgs)__builtin_amdgcn_kernarg_segment_ptr(); asm volatile("" : "+s"(p)); return p; }

__device__ __forceinline__ float shx(float v, int m, int lane) { return __builtin_bit_cast(float, __builtin_amdgcn_ds_bpermute((lane ^ m) << 2, __builtin_bit_cast(int, v))); }
#define DPPF(v, ctrl) __builtin_bit_cast(float, __builtin_amdgcn_update_dpp(0, __builtin_bit_cast(int, (v)), (ctrl), 0xF, 0xF, true))
__device__ __forceinline__ float sum8(float v) { v += DPPF(v, 0xB1); v += DPPF(v, 0x4E); v += DPPF(v, 0x141); return v; }
__device__ __forceinline__ float xor4(float v, int lane) { const float up = DPPF(v, 0x104), dn = DPPF(v, 0x114); return (lane & 4) ? dn : up; }
__device__ __forceinline__ float wave_sum(float v, int lane) {
    v += DPPF(v, 0xB1); v += DPPF(v, 0x4E); v += DPPF(v, 0x141); v += DPPF(v, 0x140);
    v += shx(v, 16, lane); v += shx(v, 32, lane); return v;
}
__device__ __forceinline__ float wave_sum_bp(float v, int lane) {
#pragma unroll
    for (int o = 1; o < 64; o <<= 1) v += shx(v, o, lane);
    return v;
}
__device__ __forceinline__ float wave_max(float v, int lane) {
#pragma unroll
    for (int o = 1; o < 64; o <<= 1) v = fmaxf(v, shx(v, o, lane));
    return v;
}
typedef float f32x2_t __attribute__((ext_vector_type(2))); typedef __bf16 bf16x2_t __attribute__((ext_vector_type(2)));
__device__ __forceinline__ unsigned cvtpk(float lo, float hi) { f32x2_t v = {lo, hi}; bf16x2_t b = __builtin_convertvector(v, bf16x2_t); return __builtin_bit_cast(unsigned, b); }
#ifndef PROBE_MASK
#define PROBE_MASK 0
#endif
#ifndef PROBE_SUB_A
#define PROBE_SUB_A -1
#endif
#ifndef PROBE_SUB_B
#define PROBE_SUB_B -1
#endif
#ifndef PROBE_SUBF
#define PROBE_SUBF 16
#endif
#ifndef PROBE_BLK
#define PROBE_BLK 0
#endif
#define PROBE_SUB(ws_, tid_, i_) do { if (PROBE_MASK || PROBE_SUB_A >= 0) { if (blockIdx.x == PROBE_BLK && (tid_) == 0) { asm volatile("s_waitcnt vmcnt(0) lgkmcnt(0)" ::: "memory"); \
        __hip_atomic_store((unsigned long long*)((ws_) + WS_CTL) + CW_TS / 2 + 128 + (i_), (unsigned long long)__builtin_amdgcn_s_memrealtime(), RLX_AGENT); } } } while (0)
__device__ __forceinline__ float gelu_tanh(float x) {
    const float y = 0.7978845608028654f * (x + 0.044715f * x * x * x);
    const float t = 1.0f - 2.0f * __builtin_amdgcn_rcpf(1.0f + __expf(2.0f * y));
    return 0.5f * x * (1.0f + t);
}

__device__ __forceinline__ void s5_build_mats(CArgs ap, LAS unsigned char* lds, int tid, int l, int g);
template <int MODE>
__device__ __forceinline__ void transpose_item(const float* W, int K, int N, bf16* WT, LAS float* scr, int item, int lane) {
    const int nblk = N / 32, kb = item / nblk, nb = item - kb * nblk, k0 = 64 * kb, n0 = 32 * nb;
#pragma unroll 8
    for (int i = 0; i < 32; ++i) { const int kk = 2 * i + (lane >> 5); scr[kk * 33 + (lane & 31)] = W[(size_t)(k0 + kk) * N + n0 + (lane & 31)]; }
    LDS_WAIT(); asm volatile("" ::: "memory");
    const int c = lane & 7;
#pragma unroll
    for (int j = 0; j < 4; ++j) { const int n = (lane >> 3) + 8 * j; const LAS float* s = scr + (8 * c) * 33 + n;
        const int nn = n0 + n; const int jj = nn >> 1;
        const int drow = (MODE == 0 || MODE == 2) ? nn : ((jj >> 7) * 256 + (nn & 1) * 128 + (jj & 127));
        if (MODE >= 1) {
            unsigned w0 = 0u, w1 = 0u;
            w0 = __builtin_amdgcn_cvt_pk_fp8_f32(32.0f * s[0 * 33], 32.0f * s[1 * 33], w0, false); w0 = __builtin_amdgcn_cvt_pk_fp8_f32(32.0f * s[2 * 33], 32.0f * s[3 * 33], w0, true);
            w1 = __builtin_amdgcn_cvt_pk_fp8_f32(32.0f * s[4 * 33], 32.0f * s[5 * 33], w1, false); w1 = __builtin_amdgcn_cvt_pk_fp8_f32(32.0f * s[6 * 33], 32.0f * s[7 * 33], w1, true);
            *(GAS v2u*)((unsigned char*)WT + (size_t)drow * K + k0 + 8 * c) = (v2u){w0, w1};
        } else {
            v4u o; o.x = pk2(s[0 * 33], s[1 * 33]); o.y = pk2(s[2 * 33], s[3 * 33]); o.z = pk2(s[4 * 33], s[5 * 33]); o.w = pk2(s[6 * 33], s[7 * 33]);
            *(GAS v4u*)(WT + (size_t)drow * K + k0 + 8 * c) = o; } }
    LDS_WAIT(); asm volatile("" ::: "memory");
}

__device__ __forceinline__ void phase_prologue(CArgs ap, LAS unsigned char* lds, int tid, int lane, int wave, int bid, int G) {
    CA& a = *ap;
    unsigned char* ws = a.ws;
    PROBE_SUB(ws, tid, 11);
    if (bid < 192) {
        LAS float* S = (LAS float*)lds;
        LAS float* R = (LAS float*)(lds + 17 * 1024 * 4);
        for (int idx = tid; idx < 17 * 1024; idx += NTHREADS) { const int r = idx >> 10, k = idx & 1023; const float v = r < 16 ? a.in[I_C][r * 1024 + k] : a.in[I_CCTX][k]; S[idx] = v / (1.0f + __expf(-v)); }
        __syncthreads();
        const int l = bid / 48, c0 = (bid % 48) * 128, col = tid & 127, kq = tid >> 7;
        float acc[17];
#pragma unroll
        for (int r = 0; r < 17; ++r) acc[r] = 0.f;
        const float* wp = a.in[I_WMOD] + ((size_t)l * 1024 + kq * 256) * 6144 + c0 + col;
#pragma unroll 4
        for (int k = 0; k < 256; ++k) { const float w = wp[(size_t)k * 6144];
#pragma unroll
            for (int r = 0; r < 17; ++r) acc[r] += S[r * 1024 + kq * 256 + k] * w; }
#pragma unroll
        for (int r = 0; r < 17; ++r) R[(kq * 17 + r) * 128 + col] = acc[r];
        __syncthreads();
        float* MOD = (float*)(ws + WS_MOD);
        for (int idx = tid; idx < 17 * 128; idx += NTHREADS) { const int r = idx >> 7, cc = idx & 127;
            const float v = R[(0 * 17 + r) * 128 + cc] + R[(1 * 17 + r) * 128 + cc] + R[(2 * 17 + r) * 128 + cc] + R[(3 * 17 + r) * 128 + cc] + a.in[I_BMOD][l * 6144 + c0 + cc];
            MOD[((size_t)l * 17 + r) * 6144 + c0 + cc] = v; }
    }
    else s5_build_mats(ap, lds, tid, (bid - 192) >> 4, (bid - 192) & 15);
    PROBE_SUB(ws, tid, 12);
    __syncthreads();
    {
        LAS float* scr = (LAS float*)(lds + wave * 16384);
        const int gw = bid * NWAVES + wave, NGW = G * NWAVES;
        constexpr int N_WGU = 128 * 1024, N_WD = 128 * 512, N_WIN = 4 * 2432, N_WO = 4 * 512, N_WAO = 4 * 256, N_WSO = 4 * 128, N_WCO = 4 * 128, N_WGLU = 4 * 32;
        constexpr int NITEMS = N_WGU + N_WD + N_WIN + N_WO + N_WAO + N_WSO + N_WCO + N_WGLU;
        for (int it = gw; it < NITEMS; it += NGW) {
            int r = it;
            if (r < N_WGU) { const int m = r >> 10; transpose_item<1>(a.in[I_WGU] + (size_t)m * 1024 * 2048, 1024, 2048, (bf16*)(ws + WS_WGU + (size_t)m * 2048 * 1024), scr, r & 1023, lane); continue; } r -= N_WGU;
            if (r < N_WD) { const int m = r >> 9; transpose_item<2>(a.in[I_WD] + (size_t)m * 1024 * 1024, 1024, 1024, (bf16*)(ws + WS_WD + (size_t)m * 1024 * 1024), scr, r & 511, lane); continue; } r -= N_WD;
            if (r < N_WIN) { const int m = r / 2432, it2 = r - m * 2432;
                if ((it2 % 152) < 56) transpose_item<0>(a.in[I_WIN] + (size_t)m * 1024 * DIN, 1024, DIN, (bf16*)(ws + WS_WIN) + (size_t)m * 1792 * 1024, scr, it2, lane);
                else transpose_item<2>(a.in[I_WIN] + (size_t)m * 1024 * DIN, 1024, DIN, (bf16*)(ws + WS_WIN8 + (size_t)m * 3072 * 1024 - (size_t)1792 * 1024), scr, it2, lane);
                continue; } r -= N_WIN;
            if (r < N_WO) { const int m = r >> 9; transpose_item<0>(a.in[I_WO] + (size_t)m * 1024 * 1024, 1024, 1024, (bf16*)(ws + WS_WO) + (size_t)m * 1024 * 1024, scr, r & 511, lane); continue; } r -= N_WO;
            if (r < N_WAO) { const int m = r >> 8; transpose_item<0>(a.in[I_WAO] + (size_t)m * 512 * 1024, 512, 1024, (bf16*)(ws + WS_WAO) + (size_t)m * 1024 * 512, scr, r & 255, lane); continue; } r -= N_WAO;
            if (r < N_WSO) { const int m = r >> 7; transpose_item<0>(a.in[I_WSO] + (size_t)m * 256 * 1024, 256, 1024, (bf16*)(ws + WS_WSO) + (size_t)m * 1024 * 256, scr, r & 127, lane); continue; } r -= N_WSO;
            if (r < N_WCO) { const int m = r >> 7; transpose_item<0>(a.in[I_WCO] + (size_t)m * 256 * 1024, 256, 1024, (bf16*)(ws + WS_WCO) + (size_t)m * 1024 * 256, scr, r & 127, lane); continue; } r -= N_WCO;
            { const int m = r >> 5; transpose_item<0>(a.in[I_WGLU] + (size_t)m * 256 * 256, 256, 256, (bf16*)(ws + WS_WGLU) + (size_t)m * 256 * 256, scr, r & 31, lane); }
        }
    }
    PROBE_SUB(ws, tid, 13);
    {
        const int gt = bid * NTHREADS + tid, NGT = G * NTHREADS;
        unsigned* WRF = (unsigned*)(ws + WS_WRT);
        for (int i = gt; i < 4 * 32 * 2 * 64 * 4; i += NGT) { const int jp = i & 3, ln = (i >> 2) & 63, nt = (i >> 8) & 1, ks = (i >> 9) & 31, l = i >> 14;
            const int e = nt * 16 + (ln & 15), k = 32 * ks + 8 * (ln >> 4) + 2 * jp;
            const float w0 = a.in[I_WR][((size_t)l * 1024 + k) * 32 + e], w1 = a.in[I_WR][((size_t)l * 1024 + k + 1) * 32 + e];
            const unsigned hi = cvtpk(w0, w1); const unsigned lo = cvtpk(w0 - bflo(hi), w1 - bfhi(hi));
            const size_t base = ((((size_t)l * 32 + ks) * 2 + nt) * 2) * 256 + ln * 4 + jp;
            WRF[base] = hi; WRF[base + 256] = lo; }
        float* ROPE = (float*)(ws + WS_ROPE);
        for (int i = gt; i < 2048 * 32; i += NGT) { const int t = i >> 5, p = i & 31; const float pos = (float)(p < 16 ? (t >> 6) : (t & 63));
            const float inv = powf(10000.0f, -(float)(p & 15) / 16.0f); float sn, cs; sincosf(pos * inv, &sn, &cs); ROPE[2 * i] = cs; ROPE[2 * i + 1] = sn; }
    }
}

template <int MODE>
__device__ __forceinline__ void phase_n1(CArgs ap, int l, int lane, int gw, int NGW) {
    CA& a = *ap;
    unsigned char* ws = a.ws;
    float* X = (float*)(ws + WS_X); bf16* H = (bf16*)(ws + WS_H);
    const float* MOD = (const float*)(ws + WS_MOD);
    const unsigned char* YS = (const unsigned char*)(ws + WS_YS8); const float* TOPG = (const float*)(ws + WS_TOPG); const int* SLOT = (const int*)(ws + WS_SLOT);
    const float* gn = a.in[I_N1G] + (l < DEPTH ? l : 0) * D;
    constexpr int RPT = 3;
    for (int row0 = gw; row0 < T; row0 += RPT * NGW) {
        int rowv[RPT], bb[RPT], sv[RPT], rv[RPT]; bool on[RPT];
        f32x4 v[RPT][4], tg[RPT]; int4 sl[RPT]; unsigned y8[RPT][4][4];
#pragma unroll
        for (int rr = 0; rr < RPT; ++rr) { const int row = row0 + rr * NGW; rowv[rr] = row; on[rr] = row < T; const int rowc = on[rr] ? row : row0;
            const int b = rowc / TB, s = rowc - b * TB; const bool isctx = s < CTX; bb[rr] = b; sv[rr] = s; rv[rr] = isctx ? 16 : b; if (MODE == 2 && isctx) on[rr] = false;
            const float* src = (MODE == 0) ? (isctx ? a.in[I_CTX] + ((size_t)b * CTX + s) * D : a.in[I_X] + ((size_t)b * SEQ + (s - CTX)) * D) : X + (size_t)rowc * D;
#pragma unroll
            for (int j = 0; j < 4; ++j) v[rr][j] = *(const f32x4*)(src + 4 * lane + 256 * j);
            if (MODE != 0) { tg[rr] = *(const f32x4*)(TOPG + (size_t)rowc * 4); sl[rr] = *(const int4*)(SLOT + (size_t)rowc * 4); } }
        if (MODE != 0) {
#pragma unroll
            for (int rr = 0; rr < RPT; ++rr) { const int sls[4] = {sl[rr].x, sl[rr].y, sl[rr].z, sl[rr].w};
#pragma unroll
                for (int k = 0; k < 4; ++k)
#pragma unroll
                    for (int j = 0; j < 4; ++j) y8[rr][k][j] = *(const unsigned*)((const unsigned char*)YS + (size_t)sls[k] * D + 4 * lane + 256 * j); }
        }
#pragma unroll
        for (int rr = 0; rr < RPT; ++rr) {
            if (!on[rr]) continue;
            const int row = rowv[rr], r = rv[rr];
            if (MODE != 0) {
                const float* g2 = MOD + ((size_t)(l - 1) * 17 + r) * 6144 + 5120;
#pragma unroll
                for (int j = 0; j < 4; ++j) { f32x4 acc = (f32x4){0.f, 0.f, 0.f, 0.f};
#pragma unroll
                    for (int k = 0; k < 4; ++k) { const unsigned w = y8[rr][k][j]; const f32x2 lo = __builtin_amdgcn_cvt_pk_f32_fp8(w, false), hi = __builtin_amdgcn_cvt_pk_f32_fp8(w, true); acc += tg[rr][k] * (f32x4){lo.x, lo.y, hi.x, hi.y}; }
                    v[rr][j] += *(const f32x4*)(g2 + 4 * lane + 256 * j) * acc; }
            }
            if (MODE == 2) {
                float* o = a.out + ((size_t)bb[rr] * SEQ + (sv[rr] - CTX)) * D;
#pragma unroll
                for (int j = 0; j < 4; ++j) *(f32x4*)(o + 4 * lane + 256 * j) = v[rr][j];
                continue;
            }
            float ss = 0.f;
#pragma unroll
            for (int j = 0; j < 4; ++j) { *(f32x4*)(X + (size_t)row * D + 4 * lane + 256 * j) = v[rr][j]; ss += (v[rr][j].x * v[rr][j].x + v[rr][j].y * v[rr][j].y) + (v[rr][j].z * v[rr][j].z + v[rr][j].w * v[rr][j].w); }
            const float rstd = rsqrtf(wave_sum(ss, lane) * (1.0f / D) + EPS);
            const float* md = MOD + ((size_t)l * 17 + r) * 6144;
#pragma unroll
            for (int j = 0; j < 4; ++j) { const int c = 4 * lane + 256 * j;
                const f32x4 g = *(const f32x4*)(gn + c), sh = *(const f32x4*)(md + c), sc = *(const f32x4*)(md + 1024 + c);
                const f32x4 h = (v[rr][j] * rstd * g) * (sc + 1.0f) + sh;
                v2u o; o.x = cvtpk(h.x, h.y); o.y = cvtpk(h.z, h.w); *(v2u*)(H + (size_t)row * D + c) = o;
                unsigned w8 = 0u; w8 = __builtin_amdgcn_cvt_pk_fp8_f32(h.x, h.y, w8, false); w8 = __builtin_amdgcn_cvt_pk_fp8_f32(h.z, h.w, w8, true);
                *(unsigned*)((unsigned char*)(ws + WS_H8) + (size_t)row * D + c) = w8; }
        }
    }
}

__device__ __forceinline__ void build_gc(CArgs ap, int l, int gt, int NGT) {
    CA& a = *ap; const float* MOD = (const float*)(a.ws + WS_MOD); float* GC = (float*)(a.ws + WS_GC) + (size_t)l * 17 * 1024;
    for (int i = gt; i < 17 * 1024; i += NGT) { const int r = i >> 10, k = i & 1023; GC[i] = a.in[I_N2G][l * D + k] * (1.0f + MOD[((size_t)l * 17 + r) * 6144 + 4096 + k]); }
}

__device__ __forceinline__ void phase_prep(CArgs ap, int l, int lane, int gw, int NGW) {
    CA& a = *ap;
    unsigned char* ws = a.ws;
    const bf16* P = (const bf16*)(ws + WS_PROJ); bf16* YB = (bf16*)(ws + WS_YB); bf16* QN = (bf16*)(ws + WS_QN); bf16* KN = (bf16*)(ws + WS_KN);
    const float* ROPE = (const float*)(ws + WS_ROPE);
    const float* cw = a.in[I_CONVW] + l * 3 * 256;
    const int c4 = 4 * lane, d0 = (lane & 7) * 8;
    const f32x4 w0 = *(const f32x4*)(cw + c4), w1 = *(const f32x4*)(cw + 256 + c4), w2 = *(const f32x4*)(cw + 512 + c4);
    const f32x4 gq0 = *(const f32x4*)(a.in[I_QG] + l * 64 + d0), gq1 = *(const f32x4*)(a.in[I_QG] + l * 64 + d0 + 4), gk0 = *(const f32x4*)(a.in[I_KG] + l * 64 + d0), gk1 = *(const f32x4*)(a.in[I_KG] + l * 64 + d0 + 4);
    const bool first = (lane & 4) == 0;
    constexpr int RPT = 4;
    for (int row0 = gw; row0 < T; row0 += RPT * NGW) {
        v2u cc[RPT][3], cx[RPT][3], cb[RPT]; v4u qw[RPT], kw[RPT]; f32x4 rp[RPT][4]; bool isc[RPT], on[RPT]; int rowv[RPT];
#pragma unroll
        for (int rr = 0; rr < RPT; ++rr) { const int rowt = row0 + rr * NGW; on[rr] = rowt < T; const int row = on[rr] ? rowt : row0; rowv[rr] = row;
            const int b = row / TB, s = row - b * TB; const bool isctx = s < CTX; isc[rr] = isctx;
            const int lo = isctx ? 0 : CTX, hi = isctx ? CTX : TB;
#pragma unroll
            for (int d = 0; d < 3; ++d) { const int s2 = s + d - 1; const bool ok = s2 >= lo && s2 < hi; const bf16* pr = P + (size_t)(ok ? row + d - 1 : row) * DIN;
                cc[rr][d] = *(const v2u*)(pr + OFF_CC + c4); cx[rr][d] = *(const v2u*)(pr + OFF_CX + c4); if (!ok) { cc[rr][d] = (v2u){0u, 0u}; } }
            cb[rr] = *(const v2u*)(P + (size_t)row * DIN + OFF_CB + c4);
            qw[rr] = *(const v4u*)(P + (size_t)row * DIN + OFF_Q + lane * 8); kw[rr] = *(const v4u*)(P + (size_t)row * DIN + OFF_K + (lane & 15) * 8);
            const float* rpp = ROPE + ((size_t)(isctx ? 0 : s - CTX) * 32 + (d0 & 31)) * 2;
#pragma unroll
            for (int i = 0; i < 4; ++i) rp[rr][i] = *(const f32x4*)(rpp + 4 * i); }
#pragma unroll
        for (int rr = 0; rr < RPT; ++rr) {
            if (!on[rr]) continue;
            const int row = rowv[rr];
            { f32x4 zz[3];
#pragma unroll
              for (int d = 0; d < 3; ++d) zz[d] = (f32x4){bflo(cc[rr][d].x) * bflo(cx[rr][d].x), bfhi(cc[rr][d].x) * bfhi(cx[rr][d].x), bflo(cc[rr][d].y) * bflo(cx[rr][d].y), bfhi(cc[rr][d].y) * bfhi(cx[rr][d].y)};
              const f32x4 yv = (f32x4){bflo(cb[rr].x), bfhi(cb[rr].x), bflo(cb[rr].y), bfhi(cb[rr].y)} * (w0 * zz[0] + w1 * zz[1] + w2 * zz[2]);
              v2u o; o.x = cvtpk(yv.x, yv.y); o.y = cvtpk(yv.z, yv.w); *(v2u*)(YB + (size_t)row * 256 + c4) = o; }
#pragma unroll
            for (int pass = 0; pass < 2; ++pass) {
                const v4u w = pass ? kw[rr] : qw[rr];
                float x[8] = {bflo(w.x), bfhi(w.x), bflo(w.y), bfhi(w.y), bflo(w.z), bfhi(w.z), bflo(w.w), bfhi(w.w)};
                float ss = 0.f;
#pragma unroll
                for (int i = 0; i < 8; ++i) ss += x[i] * x[i];
                ss = sum8(ss);
                const float rstd = rsqrtf(ss * (1.0f / 64.0f) + EPS) * (pass ? 1.0f : 0.125f);
                const f32x4 ga = pass ? gk0 : gq0, gb = pass ? gk1 : gq1;
#pragma unroll
                for (int i = 0; i < 8; ++i) x[i] = x[i] * rstd * (i < 4 ? ga[i] : gb[i - 4]);
                if (!isc[rr]) {
#pragma unroll
                    for (int i = 0; i < 8; ++i) { const float pr = xor4(x[i], lane); const float cs = rp[rr][i >> 1][2 * (i & 1)], sn = rp[rr][i >> 1][2 * (i & 1) + 1];
                        x[i] = first ? (x[i] * cs - pr * sn) : (pr * sn + x[i] * cs); }
                }
                v4u o; o.x = cvtpk(x[0], x[1]); o.y = cvtpk(x[2], x[3]); o.z = cvtpk(x[4], x[5]); o.w = cvtpk(x[6], x[7]);
                if (pass == 0) *(v4u*)(QN + (size_t)row * 512 + lane * 8) = o;
                else if (lane < 16) *(v4u*)(KN + (size_t)row * 128 + lane * 8) = o;
            }
        }
    }
}

typedef short bf16x8v __attribute__((ext_vector_type(8)));
__device__ __forceinline__ f32x4 mfma16(const v4u& a, const v4u& b, const f32x4& c) { return __builtin_amdgcn_mfma_f32_16x16x32_bf16(__builtin_bit_cast(bf16x8v, a), __builtin_bit_cast(bf16x8v, b), c, 0, 0, 0); }

__device__ __forceinline__ void s5_build_mats(CArgs ap, LAS unsigned char* lds, int tid, int l, int g) {
    CA& a = *ap;
    LAS float* LP = (LAS float*)lds;
    LAS float* BB = LP + 2 * 9 * 64 * 2;
    LAS float* CC = BB + 2 * 64 * 16 * 2;
    for (int i = tid; i < 2 * 9 * 64; i += NTHREADS) { const int z = i / 576, d = (i / 64) % 9, p = i & 63; const int pi = (l * 2 + z) * 16 + g;
        const float lre = a.in[I_LRE][pi * 64 + p], lim = a.in[I_LIM][pi * 64 + p], dt = expf(a.in[I_LDT][pi]);
        float sn, cs; sincosf((float)d * lim * dt, &sn, &cs); const float er = expf((float)d * lre * dt);
        LP[2 * i] = er * cs; LP[2 * i + 1] = er * sn; }
    for (int i = tid; i < 2 * 64 * 16; i += NTHREADS) { const int z = i >> 10, p = (i >> 4) & 63, h = i & 15; const int pi = (l * 2 + z) * 16 + g;
        const float lre = a.in[I_LRE][pi * 64 + p], lim = a.in[I_LIM][pi * 64 + p], dt = expf(a.in[I_LDT][pi]);
        float sn, cs; sincosf(lim * dt, &sn, &cs); const float er = expf(lre * dt); const float nr = er * cs - 1.0f, ni = er * sn, d2 = lre * lre + lim * lim;
        const float qr = (nr * lre + ni * lim) / d2, qi = (ni * lre - nr * lim) / d2;
        const float br = a.in[I_BRE][((size_t)pi * 64 + p) * 16 + h], bi = a.in[I_BIM][((size_t)pi * 64 + p) * 16 + h];
        BB[2 * i] = qr * br - qi * bi; BB[2 * i + 1] = qr * bi + qi * br;
        const int hc = (i >> 6) & 15, pc = i & 63;
        CC[2 * i] = a.in[I_CRE][((size_t)pi * 16 + hc) * 64 + pc]; CC[2 * i + 1] = a.in[I_CIM][((size_t)pi * 16 + hc) * 64 + pc]; }
    __syncthreads();
    LAS float* KT = CC + 2 * 16 * 64 * 2;
    { const int e0 = tid * 8; const int z = e0 >> 11, d = (e0 >> 8) & 7, h = (e0 >> 4) & 15, h20 = e0 & 15; float kv[8];
#pragma unroll
      for (int j = 0; j < 8; ++j) kv[j] = 0.f;
      for (int p = 0; p < 64; ++p) { const float cr = CC[2 * ((z * 16 + h) * 64 + p)], ci = CC[2 * ((z * 16 + h) * 64 + p) + 1], lr = LP[2 * ((z * 9 + d) * 64 + p)], li = LP[2 * ((z * 9 + d) * 64 + p) + 1];
          const float tr = cr * lr - ci * li, ti = cr * li + ci * lr;
#pragma unroll
          for (int j = 0; j < 8; ++j) kv[j] += tr * BB[2 * ((z * 64 + p) * 16 + h20 + j)] - ti * BB[2 * ((z * 64 + p) * 16 + h20 + j) + 1]; }
#pragma unroll
      for (int j = 0; j < 8; ++j) KT[e0 + j] = kv[j]; }
    __syncthreads();
    bf16* MS = (bf16*)(a.ws + WS_MS) + (size_t)(l * 16 + g) * 256 * 128; bf16* W = (bf16*)(a.ws + WS_W5) + (size_t)(l * 16 + g) * 128 * 384;
    for (int i = tid; i < 256 * 128; i += NTHREADS) { const int j = i & 7, ln = (i >> 3) & 63, nt = (i >> 9) & 15, ks = i >> 13; const int n = nt * 16 + (ln & 15), k = ks * 32 + (ln >> 4) * 8 + j;
        const int z = n >> 7, part = n & 1, p = (n >> 1) & 63, a2 = k >> 4, h2 = k & 15; const int e = z == 0 ? 7 - a2 : a2;
        const float lr = LP[2 * ((z * 9 + e) * 64 + p)], li = LP[2 * ((z * 9 + e) * 64 + p) + 1], br = BB[2 * ((z * 64 + p) * 16 + h2)], bi = BB[2 * ((z * 64 + p) * 16 + h2) + 1];
        MS[i] = (bf16)f2bf(part == 0 ? lr * br - li * bi : lr * bi + li * br); }
    for (int i = tid; i < 128 * 384; i += NTHREADS) { const int j = i & 7, ln = (i >> 3) & 63, nt = (i >> 9) & 7, ks = i >> 12; const int n = nt * 16 + (ln & 15), k = ks * 32 + (ln >> 4) * 8 + j;
        const int aa = n >> 4, h = n & 15; float v = 0.f;
        if (k < 128) { const int a2 = k >> 4, h2 = k & 15;
            if (a2 <= aa) v += KT[((0 * 8 + (aa - a2)) * 16 + h) * 16 + h2];
            if (a2 >= aa) v += KT[((1 * 8 + (a2 - aa)) * 16 + h) * 16 + h2];
            if (a2 == aa && h2 == h) v += a.in[I_SD][l * 256 + g * 16 + h];
        } else { const int z = (k - 128) >> 7, kk = (k - 128) & 127, part = kk & 1, p = kk >> 1; const int d = z == 0 ? aa + 1 : 8 - aa;
            const float cr = CC[2 * ((z * 16 + h) * 64 + p)], ci = CC[2 * ((z * 16 + h) * 64 + p) + 1], lr = LP[2 * ((z * 9 + d) * 64 + p)], li = LP[2 * ((z * 9 + d) * 64 + p) + 1];
            v = part == 0 ? (cr * lr - ci * li) : -(cr * li + ci * lr); }
        W[i] = (bf16)f2bf(v); }
    __syncthreads();
}

constexpr int S5_ROWS = T / 8, S5_RT = S5_ROWS / 32;
__device__ __forceinline__ void s5a_block(CArgs ap, int l, int blk, LAS unsigned char* lds, int tid, int lane, int wave) {
    CA& a = *ap; unsigned char* ws = a.ws;
    const int g = blk & 15, part = blk >> 4, c = lane & 15, q = lane >> 4;
    { const v4u* src = (const v4u*)((const bf16*)(ws + WS_MS) + (size_t)(l * 16 + g) * 256 * 128); LAS v4u* dst = (LAS v4u*)lds;
#pragma unroll
      for (int i = 0; i < 8; ++i) dst[tid + i * NTHREADS] = src[tid + i * NTHREADS]; }
    __syncthreads();
    const LAS v4u* Bl = (const LAS v4u*)lds + lane;
    for (int mt = wave; mt < 18; mt += NWAVES) {
        const int r0 = part * 288 + mt * 16;
        const bf16* Pu = (const bf16*)(ws + WS_PROJ) + ((size_t)(r0 + c) * 8 + (q >> 1)) * DIN + OFF_U + g * 16 + (q & 1) * 8;
        v4u af[4];
#pragma unroll
        for (int ks = 0; ks < 4; ++ks) af[ks] = *(const v4u*)(Pu + (size_t)2 * ks * DIN);
        f32x4 acc[16];
#pragma unroll
        for (int n = 0; n < 16; ++n) acc[n] = (f32x4){0.f, 0.f, 0.f, 0.f};
#pragma unroll
        for (int ks = 0; ks < 4; ++ks) { v4u bfr[16];
#pragma unroll
            for (int n = 0; n < 16; ++n) bfr[n] = Bl[(ks * 16 + n) * 64];
#pragma unroll
            for (int n = 0; n < 16; ++n) acc[n] = mfma16(bfr[n], af[ks], acc[n]);
            asm volatile("" ::: "memory"); }
        float* Sp = (float*)(ws + WS_S5S) + ((size_t)g * S5_ROWS + r0 + c) * 256 + 4 * q;
#pragma unroll
        for (int n = 0; n < 16; ++n) *(f32x4*)(Sp + n * 16) = acc[n];
    }
    VM_WAIT(); __syncthreads();
}
__device__ __forceinline__ void s5b_unit(CArgs ap, int l, int u, int lane) {
    CA& a = *ap; unsigned char* ws = a.ws;
    const int b = u & 15, z = (u >> 4) & 1, g = u >> 5, p = lane; const int pi = (l * 2 + z) * 16 + g;
    const float lre = a.in[I_LRE][pi * 64 + p], lim = a.in[I_LIM][pi * 64 + p], dt = expf(a.in[I_LDT][pi]);
    float sn, cs; sincosf(8.0f * lim * dt, &sn, &cs); const float er = expf(8.0f * lre * dt); const float l8r = er * cs, l8i = er * sn;
    const f32x2* S = (const f32x2*)((const float*)(ws + WS_S5S) + ((size_t)g * S5_ROWS + b * 288) * 256 + z * 128) + p;
    unsigned* XI = (unsigned*)((bf16*)(ws + WS_XIN) + ((size_t)(z * 16 + g) * S5_ROWS + b * 288) * 128) + p;
    float xr = 0.f, xi = 0.f;
    constexpr int BS = 32;
    f32x2 sv[BS];
#pragma unroll
    for (int j = 0; j < BS; ++j) { const int cc = z == 0 ? j : 31 - j; sv[j] = S[(size_t)cc * 128]; }
    for (int i0 = 0; i0 < 288; i0 += BS) {
        f32x2 nv[BS];
        if (i0 + BS < 288) {
#pragma unroll
            for (int j = 0; j < BS; ++j) { const int i = i0 + BS + j; const int cc = z == 0 ? i : (i < 32 ? 31 - i : 319 - i); nv[j] = S[(size_t)cc * 128]; }
        }
        unsigned ov[BS];
#pragma unroll
        for (int j = 0; j < BS; ++j) { ov[j] = cvtpk(xr, xi);
            const float nr = l8r * xr - l8i * xi + sv[j].x, ni = l8r * xi + l8i * xr + sv[j].y; xr = nr; xi = ni; }
#pragma unroll
        for (int j = 0; j < BS; ++j) { const int i = i0 + j; const int cc = z == 0 ? i : (i < 32 ? 31 - i : 319 - i); XI[(size_t)cc * 64] = ov[j]; }
#pragma unroll
        for (int j = 0; j < BS; ++j) sv[j] = nv[j];
    }
}
__device__ __forceinline__ void s5c_block(CArgs ap, int l, int blk, LAS unsigned char* lds, int tid, int lane, int wave) {
    CA& a = *ap; unsigned char* ws = a.ws;
    const int g = blk & 15, part = blk >> 4, c = lane & 15, q = lane >> 4;
    { const v4u* src = (const v4u*)((const bf16*)(ws + WS_W5) + (size_t)(l * 16 + g) * 128 * 384); LAS v4u* dst = (LAS v4u*)lds;
#pragma unroll
      for (int i = 0; i < 12; ++i) dst[tid + i * NTHREADS] = src[tid + i * NTHREADS]; }
    __syncthreads();
    const LAS v4u* Bl = (const LAS v4u*)lds + lane;
    for (int mt = wave; mt < 18; mt += NWAVES) {
        const int r0 = part * 288 + mt * 16;
        const bf16* Pu = (const bf16*)(ws + WS_PROJ) + ((size_t)(r0 + c) * 8 + (q >> 1)) * DIN + OFF_U + g * 16 + (q & 1) * 8;
        const bf16* X0 = (const bf16*)(ws + WS_XIN) + ((size_t)g * S5_ROWS + r0 + c) * 128 + q * 8; const bf16* X1 = X0 + (size_t)16 * S5_ROWS * 128;
        v4u af[12];
#pragma unroll
        for (int ks = 0; ks < 4; ++ks) { af[ks] = *(const v4u*)(Pu + (size_t)2 * ks * DIN); af[4 + ks] = *(const v4u*)(X0 + ks * 32); af[8 + ks] = *(const v4u*)(X1 + ks * 32); }
        f32x4 acc[8];
#pragma unroll
        for (int n = 0; n < 8; ++n) acc[n] = (f32x4){0.f, 0.f, 0.f, 0.f};
#pragma unroll
        for (int ks = 0; ks < 12; ++ks) { v4u bfr[8];
#pragma unroll
            for (int n = 0; n < 8; ++n) bfr[n] = Bl[(ks * 8 + n) * 64];
#pragma unroll
            for (int n = 0; n < 8; ++n) acc[n] = mfma16(bfr[n], af[ks], acc[n]);
            if (ks & 1) asm volatile("" ::: "memory"); }
        bf16* Zp = (bf16*)(ws + WS_Z) + (size_t)(r0 + c) * 8 * 256 + g * 16 + 4 * q;
#pragma unroll
        for (int n = 0; n < 8; ++n) { const f32x4 y = acc[n]; v2u o; o.x = cvtpk(gelu_tanh(y[0]), gelu_tanh(y[1])); o.y = cvtpk(gelu_tanh(y[2]), gelu_tanh(y[3])); *(v2u*)(Zp + n * 256) = o; }
    }
    __syncthreads();
}

typedef float f32x16 __attribute__((ext_vector_type(16)));
__device__ __forceinline__ f32x16 mfma32(const v4u& a, const v4u& b, const f32x16& c) { return __builtin_amdgcn_mfma_f32_32x32x16_bf16(__builtin_bit_cast(bf16x8v, a), __builtin_bit_cast(bf16x8v, b), c, 0, 0, 0); }
struct AttnFrag { v4u ka[4]; v2u va[2][2][2]; };
__device__ __forceinline__ void attn_load(AttnFrag& f, const bf16* KN, const bf16* VT, int s0, int r) {
#pragma unroll
    for (int ks = 0; ks < 4; ++ks) f.ka[ks] = *(const v4u*)(KN + (size_t)(s0 + r) * 128 + 16 * ks);
#pragma unroll
    for (int mt = 0; mt < 2; ++mt)
#pragma unroll
        for (int s = 0; s < 2; ++s) { f.va[mt][s][0] = *(const v2u*)(VT + (size_t)mt * 32 * TB + s0 + 16 * s); f.va[mt][s][1] = *(const v2u*)(VT + (size_t)mt * 32 * TB + s0 + 16 * s + 8); }
}
__device__ __forceinline__ void attn_item(CArgs ap, int l, bool lat, int idx, int lane) {
    CA& a = *ap; unsigned char* ws = a.ws;
    int b, hp, qg;
    if (lat) { b = idx >> 8; qg = (idx >> 2) & 63; hp = idx & 3; } else { b = idx >> 5; qg = (idx >> 2) & 7; hp = idx & 3; }
    const int g2 = hp >> 1, r = lane & 31, h = lane >> 5, q0 = qg * 32;
    const int qrow = b * TB + (lat ? CTX : 0) + q0 + r;
    const bf16* KN = (const bf16*)(ws + WS_KN) + (size_t)b * TB * 128 + g2 * 64 + 8 * h;
    const bf16* VT = (const bf16*)(ws + WS_VT) + ((size_t)(b * 2 + g2) * 64 + r) * TB + 4 * h;
    v4u bq[2][4];
#pragma unroll
    for (int hh = 0; hh < 2; ++hh)
#pragma unroll
        for (int ks = 0; ks < 4; ++ks) bq[hh][ks] = *(const v4u*)((const bf16*)(ws + WS_QN) + (size_t)qrow * 512 + (2 * hp + hh) * 64 + 16 * ks + 8 * h);
    f32x16 o[2][2];
#pragma unroll
    for (int hh = 0; hh < 2; ++hh)
#pragma unroll
        for (int i = 0; i < 16; ++i) { o[hh][0][i] = 0.f; o[hh][1][i] = 0.f; }
    constexpr float L2E = 1.4426950408889634f;
    float m[2], lsum[2];
#pragma unroll
    for (int hh = 0; hh < 2; ++hh) { m[hh] = a.in[I_SINK][l * 8 + 2 * hp + hh] * L2E; lsum[hh] = h == 0 ? 1.0f : 0.0f; }
    unsigned keep1 = 0u, keep2 = 0u;
#pragma unroll
    for (int i = 0; i < 16; ++i) { const int jj = (i & 3) + 8 * (i >> 2) + 4 * h; keep1 |= (jj >= r ? 1u : 0u) << i; keep2 |= (jj <= r ? 1u : 0u) << i; }
    const int tlo = lat ? (4 - qg > 0 ? 4 - qg : 0) : 9, thi = lat ? (67 - qg < 8 ? 67 - qg : 8) : -1;
    int tt = tlo;
    AttnFrag cur, nxt;
    attn_load(cur, KN, VT, tt < 9 ? CTX + q0 - 128 + 32 * tt : 32 * (tt - 9), r);
    for (;;) {
        const int tn = (tt == thi) ? 9 : tt + 1; const bool more = tn <= 16;
        if (more) attn_load(nxt, KN, VT, tn < 9 ? CTX + q0 - 128 + 32 * tn : 32 * (tn - 9), r);
        const int mode = tt == 0 ? 1 : (tt == 8 ? 2 : 0);
#pragma unroll
        for (int hh = 0; hh < 2; ++hh) {
            f32x16 st;
#pragma unroll
            for (int i = 0; i < 16; ++i) st[i] = 0.f;
#pragma unroll
            for (int ks = 0; ks < 4; ++ks) st = mfma32(cur.ka[ks], bq[hh][ks], st);
            if (mode != 0) {
                asm volatile("" ::: "memory");
                const unsigned kp = mode == 1 ? keep1 : keep2;
#pragma unroll
                for (int i = 0; i < 16; ++i) if (!((kp >> i) & 1u)) st[i] = -INFINITY;
            }
            float mx = st[0];
#pragma unroll
            for (int i = 1; i < 16; ++i) mx = fmaxf(mx, st[i]);
            mx = fmaxf(mx, shx(mx, 32, lane));
            const float mn = fmaxf(m[hh], mx * L2E), al = __builtin_amdgcn_exp2f(m[hh] - mn); m[hh] = mn;
            float ps = 0.f;
#pragma unroll
            for (int i = 0; i < 16; ++i) { st[i] = __builtin_amdgcn_exp2f(__builtin_fmaf(st[i], L2E, -mn)); ps += st[i]; }
            lsum[hh] = lsum[hh] * al + ps;
#pragma unroll
            for (int i = 0; i < 16; ++i) { o[hh][0][i] *= al; o[hh][1][i] *= al; }
#pragma unroll
            for (int s = 0; s < 2; ++s) { v4u pb; pb.x = cvtpk(st[8 * s + 0], st[8 * s + 1]); pb.y = cvtpk(st[8 * s + 2], st[8 * s + 3]); pb.z = cvtpk(st[8 * s + 4], st[8 * s + 5]); pb.w = cvtpk(st[8 * s + 6], st[8 * s + 7]);
                v4u a0; a0.x = cur.va[0][s][0].x; a0.y = cur.va[0][s][0].y; a0.z = cur.va[0][s][1].x; a0.w = cur.va[0][s][1].y;
                v4u a1; a1.x = cur.va[1][s][0].x; a1.y = cur.va[1][s][0].y; a1.z = cur.va[1][s][1].x; a1.w = cur.va[1][s][1].y;
                o[hh][0] = mfma32(a0, pb, o[hh][0]); o[hh][1] = mfma32(a1, pb, o[hh][1]); }
        }
        if (!more) break;
        cur = nxt; tt = tn;
    }
#pragma unroll
    for (int hh = 0; hh < 2; ++hh) {
        const float lt = lsum[hh] + shx(lsum[hh], 32, lane); const float inv = 1.0f / lt;
        bf16* op = (bf16*)(ws + WS_YA) + (size_t)qrow * 512 + (2 * hp + hh) * 64 + 4 * h;
#pragma unroll
        for (int gq = 0; gq < 4; ++gq) { v2u w0; w0.x = cvtpk(o[hh][0][4 * gq] * inv, o[hh][0][4 * gq + 1] * inv); w0.y = cvtpk(o[hh][0][4 * gq + 2] * inv, o[hh][0][4 * gq + 3] * inv); *(v2u*)(op + 8 * gq) = w0;
            v2u w1; w1.x = cvtpk(o[hh][1][4 * gq] * inv, o[hh][1][4 * gq + 1] * inv); w1.y = cvtpk(o[hh][1][4 * gq + 2] * inv, o[hh][1][4 * gq + 3] * inv); *(v2u*)(op + 32 + 8 * gq) = w1; }
    }
}
__device__ __forceinline__ void vt_item(CArgs ap, int item, int lane) {
    CA& a = *ap; unsigned char* ws = a.ws;
    const int tile = item >> 1, g2 = item & 1; const int row = tile * 64 + lane; const int b = row / TB, s = row - b * TB;
    const bf16* vp = (const bf16*)(ws + WS_PROJ) + (size_t)row * DIN + OFF_V + g2 * 64;
    bf16* vt = (bf16*)(ws + WS_VT) + (size_t)(b * 2 + g2) * 64 * TB + s;
#pragma unroll
    for (int i = 0; i < 8; ++i) { const v4u w = *(const v4u*)(vp + 8 * i);
        vt[(size_t)(8 * i + 0) * TB] = (bf16)(w.x & 0xffffu); vt[(size_t)(8 * i + 1) * TB] = (bf16)(w.x >> 16); vt[(size_t)(8 * i + 2) * TB] = (bf16)(w.y & 0xffffu); vt[(size_t)(8 * i + 3) * TB] = (bf16)(w.y >> 16);
        vt[(size_t)(8 * i + 4) * TB] = (bf16)(w.z & 0xffffu); vt[(size_t)(8 * i + 5) * TB] = (bf16)(w.z >> 16); vt[(size_t)(8 * i + 6) * TB] = (bf16)(w.w & 0xffffu); vt[(size_t)(8 * i + 7) * TB] = (bf16)(w.w >> 16); }
}

__device__ __forceinline__ void phase_n2(CArgs ap, int l, LAS unsigned char* lds, int tid, int lane, int wave, int bid, int G) {
    CA& a = *ap;
    unsigned char* ws = a.ws;
    const float* X = (const float*)(ws + WS_X); bf16* H = (bf16*)(ws + WS_H); const float* MOD = (const float*)(ws + WS_MOD);
    float* TOPG = (float*)(ws + WS_TOPG); int* SLOT = (int*)(ws + WS_SLOT); unsigned* CNT = (unsigned*)(ws + WS_CTL) + CW_CNT + l * 32;
    LAS unsigned* lcnt = (LAS unsigned*)(lds + LCNT_OFF);
    { const v4u* src = (const v4u*)((const unsigned*)(ws + WS_WRT) + (size_t)l * 32768); LAS v4u* dst = (LAS v4u*)lds;
#pragma unroll
      for (int i = 0; i < 16; ++i) dst[tid + i * NTHREADS] = src[tid + i * NTHREADS]; }
    if (tid < 32) lcnt[tid] = 0u;
    __syncthreads();
    const LAS v4u* Bl = (const LAS v4u*)lds + lane;
    LAS float* scr = (LAS float*)(lds + SCR_OFF) + wave * (16 * 33);
    const int c = lane & 15, q = lane >> 4;
    const bool skipctx = l == DEPTH - 1;
    const int tpb = (T / 16) / G;
    for (int tl = wave; tl < tpb; tl += NWAVES) {
        const int row0 = (bid * tpb + tl) * 16; const int b = row0 / TB, s0 = row0 - b * TB; const bool isctx = s0 < CTX; const int r = isctx ? 16 : b;
        if (skipctx && isctx) continue;
        const float* xr = X + (size_t)(row0 + c) * D + 8 * q;
        float ss = 0.f;
#pragma unroll 16
        for (int ks = 0; ks < 32; ++ks) { const f32x4 x0 = *(const f32x4*)(xr + 32 * ks), x1 = *(const f32x4*)(xr + 32 * ks + 4);
            ss += (x0.x * x0.x + x0.y * x0.y) + (x0.z * x0.z + x0.w * x0.w) + (x1.x * x1.x + x1.y * x1.y) + (x1.z * x1.z + x1.w * x1.w); }
        ss += shx(ss, 16, lane); ss += shx(ss, 32, lane);
        const float rstd = rsqrtf(ss * (1.0f / D) + EPS);
        const float* md = MOD + ((size_t)l * 17 + r) * 6144 + 3072 + 8 * q; const float* gc = (const float*)(ws + WS_GC) + ((size_t)l * 17 + r) * 1024 + 8 * q;
        unsigned char* h8 = (unsigned char*)(ws + WS_H8) + (size_t)(row0 + c) * D + 8 * q;
        f32x4 acc[2] = {(f32x4){0.f, 0.f, 0.f, 0.f}, (f32x4){0.f, 0.f, 0.f, 0.f}};
#pragma unroll 1
        for (int k4 = 0; k4 < 32; k4 += 4) {
          f32x4 xv[4][2], gv[4][2], hv[4][2];
#pragma unroll
          for (int u = 0; u < 4; ++u) { const int ks = k4 + u;
              xv[u][0] = *(const f32x4*)(xr + 32 * ks); xv[u][1] = *(const f32x4*)(xr + 32 * ks + 4); gv[u][0] = *(const f32x4*)(gc + 32 * ks); gv[u][1] = *(const f32x4*)(gc + 32 * ks + 4);
              hv[u][0] = *(const f32x4*)(md + 32 * ks); hv[u][1] = *(const f32x4*)(md + 32 * ks + 4); }
#pragma unroll
          for (int u = 0; u < 4; ++u) { const int ks = k4 + u;
            const f32x4 y0 = (xv[u][0] * rstd) * gv[u][0] + hv[u][0], y1 = (xv[u][1] * rstd) * gv[u][1] + hv[u][1];
            v4u ahi; ahi.x = cvtpk(y0.x, y0.y); ahi.y = cvtpk(y0.z, y0.w); ahi.z = cvtpk(y1.x, y1.y); ahi.w = cvtpk(y1.z, y1.w);
            { unsigned w0 = 0u, w1 = 0u;
              w0 = __builtin_amdgcn_cvt_pk_fp8_f32(y0.x, y0.y, w0, false); w0 = __builtin_amdgcn_cvt_pk_fp8_f32(y0.z, y0.w, w0, true);
              w1 = __builtin_amdgcn_cvt_pk_fp8_f32(y1.x, y1.y, w1, false); w1 = __builtin_amdgcn_cvt_pk_fp8_f32(y1.z, y1.w, w1, true);
              *(v2u*)(h8 + 32 * ks) = (v2u){w0, w1}; }
            v4u alo; alo.x = cvtpk(y0.x - bflo(ahi.x), y0.y - bfhi(ahi.x)); alo.y = cvtpk(y0.z - bflo(ahi.y), y0.w - bfhi(ahi.y)); alo.z = cvtpk(y1.x - bflo(ahi.z), y1.y - bfhi(ahi.z)); alo.w = cvtpk(y1.z - bflo(ahi.w), y1.w - bfhi(ahi.w));
#pragma unroll
            for (int nt = 0; nt < 2; ++nt) { const v4u whi = Bl[((ks * 2 + nt) * 2 + 0) * 64], wlo = Bl[((ks * 2 + nt) * 2 + 1) * 64];
                acc[nt] = mfma16(whi, ahi, acc[nt]); acc[nt] = mfma16(wlo, ahi, acc[nt]); acc[nt] = mfma16(whi, alo, acc[nt]); }
          }
        }
#pragma unroll
        for (int nt = 0; nt < 2; ++nt) { const f32x4 bb = *(const f32x4*)(a.in[I_BR] + l * 32 + nt * 16 + 4 * q);
#pragma unroll
            for (int j = 0; j < 4; ++j) scr[c * 33 + nt * 16 + 4 * q + j] = acc[nt][j] + bb[j]; }
        LDS_WAIT(); asm volatile("" ::: "memory");
        if (lane < 16) {
            float v0 = -INFINITY, v1 = -INFINITY, v2 = -INFINITY, v3 = -INFINITY; int e0 = 0, e1 = 0, e2 = 0, e3 = 0;
#pragma unroll
            for (int e = 0; e < 32; ++e) { const float x = scr[lane * 33 + e];
                const bool b0 = x > v0, b1 = x > v1, b2 = x > v2, b3 = x > v3;
                v3 = b2 ? v2 : (b3 ? x : v3); e3 = b2 ? e2 : (b3 ? e : e3);
                v2 = b1 ? v1 : (b2 ? x : v2); e2 = b1 ? e1 : (b2 ? e : e2);
                v1 = b0 ? v0 : (b1 ? x : v1); e1 = b0 ? e0 : (b1 ? e : e1);
                v0 = b0 ? x : v0; e0 = b0 ? e : e0; }
            const float x1 = __expf(v1 - v0), x2 = __expf(v2 - v0), x3 = __expf(v3 - v0); const float inv = 1.0f / (1.0f + x1 + x2 + x3);
            const unsigned r0 = __hip_atomic_fetch_add(lcnt + e0, 1u, __ATOMIC_RELAXED, __HIP_MEMORY_SCOPE_WORKGROUP), r1 = __hip_atomic_fetch_add(lcnt + e1, 1u, __ATOMIC_RELAXED, __HIP_MEMORY_SCOPE_WORKGROUP),
                           r2 = __hip_atomic_fetch_add(lcnt + e2, 1u, __ATOMIC_RELAXED, __HIP_MEMORY_SCOPE_WORKGROUP), r3 = __hip_atomic_fetch_add(lcnt + e3, 1u, __ATOMIC_RELAXED, __HIP_MEMORY_SCOPE_WORKGROUP);
            *(f32x4*)(TOPG + (size_t)(row0 + lane) * 4) = (f32x4){inv, x1 * inv, x2 * inv, x3 * inv};
            *(int4*)(SLOT + (size_t)(row0 + lane) * 4) = make_int4((int)(((unsigned)e0 << 24) | r0), (int)(((unsigned)e1 << 24) | r1), (int)(((unsigned)e2 << 24) | r2), (int)(((unsigned)e3 << 24) | r3)); }
        LDS_WAIT(); asm volatile("" ::: "memory");
    }
    __syncthreads();
    if (tid < 32) { const unsigned n = lcnt[tid]; const unsigned base = __hip_atomic_fetch_add(CNT + tid, n, RLX_AGENT); ((unsigned*)(ws + WS_BASE))[bid * 32 + tid] = base; }
    __syncthreads();
}

__device__ __forceinline__ void build_expert_tables(CArgs ap, int l, LAS unsigned char* lds, int tid) {
    CA& a = *ap;
    if (tid == 0) { const unsigned* CNT = (const unsigned*)(a.ws + WS_CTL) + CW_CNT + l * 32; LAS int* pads = (LAS int*)(lds + PADS_OFF); LAS unsigned char* te = lds + TILE_E_OFF;
        int t = 0;
#pragma nounroll
        for (int e = 0; e < 32; ++e) { const int c = (int)__hip_atomic_load(CNT + e, RLX_AGENT); const int nt = (c + 255) >> 8; pads[e] = t * 256;
#pragma nounroll
            for (int i = 0; i < nt; ++i) te[t + i] = (unsigned char)e;
            t += nt; }
        pads[32] = t; }
    __syncthreads();
}

__device__ __forceinline__ void phase_moe_prep(CArgs ap, int l, LAS unsigned char* lds, int tid, int lane, int gw, int NGW) {
    CA& a = *ap;
    unsigned char* ws = a.ws;
    build_expert_tables(ap, l, lds, tid);
    const LAS int* pads = (const LAS int*)(lds + PADS_OFF);
    int* SLOT = (int*)(ws + WS_SLOT); const unsigned* BASE = (const unsigned*)(ws + WS_BASE);
    for (int row0 = gw; row0 < T; row0 += 3 * NGW) {
        int rowv[3]; bool on[3]; int4 sl[3]; v4u hv[3];
#pragma unroll
        for (int rr = 0; rr < 3; ++rr) { const int row = row0 + rr * NGW; on[rr] = row < T && !(l == DEPTH - 1 && (row % TB) < CTX); rowv[rr] = on[rr] ? row : row0;
            sl[rr] = *(const int4*)(SLOT + (size_t)rowv[rr] * 4); hv[rr] = *(const v4u*)((const unsigned char*)(ws + WS_H8) + (size_t)rowv[rr] * D + 16 * lane); }
        unsigned bs[3][4];
#pragma unroll
        for (int rr = 0; rr < 3; ++rr) { const unsigned pk[4] = {(unsigned)sl[rr].x, (unsigned)sl[rr].y, (unsigned)sl[rr].z, (unsigned)sl[rr].w};
#pragma unroll
            for (int k = 0; k < 4; ++k) bs[rr][k] = BASE[((unsigned)rowv[rr] / (unsigned)(T / (NGW >> 3))) * 32 + (pk[k] >> 24)]; }
#pragma unroll
        for (int rr = 0; rr < 3; ++rr) { if (!on[rr]) continue;
            const unsigned pk[4] = {(unsigned)sl[rr].x, (unsigned)sl[rr].y, (unsigned)sl[rr].z, (unsigned)sl[rr].w}; int st[4];
#pragma unroll
            for (int k = 0; k < 4; ++k) st[k] = pads[pk[k] >> 24] + (int)bs[rr][k] + (int)(pk[k] & 0xffffffu);
            if (lane == 0) *(int4*)(SLOT + (size_t)rowv[rr] * 4) = make_int4(st[0], st[1], st[2], st[3]);
#pragma unroll
            for (int k = 0; k < 4; ++k) *(v4u*)((unsigned char*)(ws + WS_XG) + (size_t)st[k] * D + 16 * lane) = hv[rr]; }
    }
}


constexpr int PH_PER_LAYER = 11, NPHASES = 1 + DEPTH * PH_PER_LAYER + 1;
__global__ void __launch_bounds__(NTHREADS, 2) fwd(Args args) {
    extern __shared__ __attribute__((aligned(16))) unsigned char lds_raw[];
    volatile LAS unsigned* MISC = (volatile LAS unsigned*)((LAS unsigned char*)lds_raw + MISC_OFF);
    if (threadIdx.x < 64) MISC[threadIdx.x] = 0u;
    __syncthreads();
    const int lo = args.ph_lo, hi = args.ph_hi;
    const int wave_s = __builtin_amdgcn_readfirstlane(threadIdx.x >> 6);
#if MK_ONE_LAUNCH
    (void)xcd_barrier_post((unsigned*)(args.ws + WS_CTL) + CW_BAR, MISC + 8);
#define SEAM(k) do { if ((k) + 1 < hi) { CArgs ap_ = get_args(); XcdBarrier b_; b_.bar = (unsigned*)(ap_->ws + WS_CTL) + CW_BAR; b_.x = xb_xcc_id(); \
        LAS unsigned char* l_ = (LAS unsigned char*)lds_raw; asm volatile("" : "+s"(l_)); b_.st = (volatile LAS unsigned*)(l_ + MISC_OFF) + 8; \
        unsigned z2_ = 0u; asm volatile("" : "+s"(z2_)); const int ln_ = (int)__builtin_amdgcn_mbcnt_hi(~0u, __builtin_amdgcn_mbcnt_lo(~0u, z2_)); \
        xcd_barrier(b_, wave_s == 0 && ln_ == 0); PROBE_STAMP((k) + 1); } } while (0)
#else
#define SEAM(k) do { } while (0)
#endif
#ifndef DBG_MASK
#define DBG_MASK 0xFFFFu
#endif
#ifndef DBGD
#define DBGD DEPTH
#endif
#define EN(j) (((DBG_MASK) >> (j)) & 1u)
#define IN(k) (lo <= (k) && (k) < hi)
#ifndef PROBE_MASK
#define PROBE_MASK 0
#endif
#ifndef PROBE_FACTOR
#define PROBE_FACTOR 4
#endif
#define PROBE_STAMP(idx) do { if (PROBE_MASK) { if (blockIdx.x == 0 && wave_s == 0) { CArgs apz_ = get_args(); unsigned long long* ts_ = (unsigned long long*)(apz_->ws + WS_CTL) + CW_TS / 2; \
        const unsigned long long now_ = __builtin_amdgcn_s_memrealtime(); if (__builtin_amdgcn_mbcnt_lo(~0u, 0u) == 0u && __builtin_amdgcn_mbcnt_hi(~0u, 0u) == 0u) __hip_atomic_store(ts_ + (idx), now_, RLX_AGENT); } } } while (0)
#define PHASE_CTX() CArgs ap = get_args(); unsigned char* ws = ap->ws; (void)ws; \
    LAS unsigned char* lds = (LAS unsigned char*)lds_raw; asm volatile("" : "+s"(lds)); (void)lds; \
    int wave = wave_s; asm volatile("" : "+s"(wave)); unsigned zero_ = 0u; asm volatile("" : "+s"(zero_)); const int lane = (int)__builtin_amdgcn_mbcnt_hi(~0u, __builtin_amdgcn_mbcnt_lo(~0u, zero_)); const int tid = wave * 64 + lane; (void)tid; \
    int bid = blockIdx.x; asm volatile("" : "+s"(bid)); int G = gridDim.x; asm volatile("" : "+s"(G)); \
    const int gw = bid * NWAVES + wave, NGW = G * NWAVES, gws = wave * G + bid; (void)gw; (void)NGW; (void)gws


    PROBE_STAMP(0);
    if (EN(11) && IN(0)) { PHASE_CTX(); phase_prologue(ap, lds, tid, lane, wave, bid, G); SEAM(0); }

    for (int l = 0; l < DBGD; ++l) {
        const int pb = 1 + PH_PER_LAYER * l;
        if (EN(0) && IN(pb + 0)) { PHASE_CTX(); build_gc(ap, l, bid * NTHREADS + tid, G * NTHREADS); if (l == 0) phase_n1<0>(ap, l, lane, gw, NGW); else phase_n1<1>(ap, l, lane, gw, NGW); SEAM(pb + 0); }
        if (EN(1) && IN(pb + 1)) {
            { PHASE_CTX();
              pg8::Gemm g{(const bf16*)(ws + WS_H), (const bf16*)(ws + WS_WIN) + (size_t)l * 1792 * D, T, 1792, D}; pg8::StaticOrder S; S.init(T, 1792, G, bid);
              pg8::EpiPlain E{(bf16*)(ws + WS_PROJ), DIN};
              pg8::gemm_phase<pg8::EpiPlain, pg8::StaticOrder, true, true>(lds, g, S, E, tid); }
            { PHASE_CTX();
              pg8::Gemm g{(const bf16*)(ws + WS_H8), (const bf16*)(ws + WS_WIN8 + (size_t)l * 3072 * D), T, 3072, D / 2}; pg8::StaticOrder S; S.init(T, 3072, G, bid);
              pg8::EpiPlain8 E{(bf16*)(ws + WS_PROJ) + OFF_GT, DIN};
              pg8::gemm_phase<pg8::EpiPlain8, pg8::StaticOrder, true, false>(lds, g, S, E, tid); }
            SEAM(pb + 1);
        }
        if (EN(2) && IN(pb + 2)) { PHASE_CTX();
            PROBE_SUB(ws, tid, 8);
            for (int blk = bid; blk < 256; blk += G) { s5a_block(ap, l, blk, lds, tid, lane, wave); PROBE_SUB(ws, tid, 9); if (wave < 2) s5b_unit(ap, l, (blk >> 4) | (wave << 4) | ((blk & 15) << 5), lane); }
            PROBE_SUB(ws, tid, 10);
            if (wave >= 2) { const int gw6 = bid * 6 + (wave - 2), NGW6 = G * 6;
                PROBE_SUB(ws, tid - 128, 14);
                phase_prep(ap, l, lane, gw6, NGW6);
                PROBE_SUB(ws, tid - 128, 15);
                for (int it = gw6; it < 1152; it += NGW6) vt_item(ap, it, lane);
                PROBE_SUB(ws, tid - 128, 16); }
            SEAM(pb + 2);
        }
        if (EN(3) && IN(pb + 3)) { PHASE_CTX();
            for (int blk = bid; blk < 256; blk += G) s5c_block(ap, l, blk, lds, tid, lane, wave);
            PROBE_SUB(ws, tid, 4);
            for (int it = gw; it < 4096; it += NGW) attn_item(ap, l, true, it, lane);
            PROBE_SUB(ws, tid, 5);
            if ((gw & 3) == 1 && l < DEPTH - 1) { for (int it = gw >> 2; it < 512; it += NGW >> 2) attn_item(ap, l, false, it, lane); }
            SEAM(pb + 3);
        }
        if (EN(4) && IN(pb + 4)) { PHASE_CTX();
            pg8::Gemm g{(const bf16*)(ws + WS_Z), (const bf16*)(ws + WS_WGLU) + (size_t)l * 256 * 256, T, 256, 256}; pg8::RowOrder S; S.lat = (l == DEPTH - 1); S.init(S.lat ? NB * SEQ : T, 256, G, bid);
            pg8::EpiGlu E{(const bf16*)(ws + WS_Z), (bf16*)(ws + WS_Z2), 256};
            pg8::gemm_phase<pg8::EpiGlu, pg8::RowOrder, true, true>(lds, g, S, E, tid);
            SEAM(pb + 4);
        }
        if (EN(5) && IN(pb + 5)) {
            { PHASE_CTX(); pg8::RowOrder S; S.lat = (l == DEPTH - 1); S.init(S.lat ? NB * SEQ : T, D, G, bid);
              pg8::Gemm g{(const bf16*)(ws + WS_Z2), (const bf16*)(ws + WS_WSO) + (size_t)l * D * 256, T, D, 256};
              pg8::EpiBranch<true> E{(const bf16*)(ws + WS_PROJ) + OFF_GT, DIN, (bf16*)(ws + WS_MM), D}; pg8::gemm_phase<pg8::EpiBranch<true>, pg8::RowOrder, true, true>(lds, g, S, E, tid); }
            { PHASE_CTX(); pg8::RowOrder S; S.lat = (l == DEPTH - 1); S.init(S.lat ? NB * SEQ : T, D, G, bid);
              pg8::Gemm g{(const bf16*)(ws + WS_YB), (const bf16*)(ws + WS_WCO) + (size_t)l * D * 256, T, D, 256};
              pg8::EpiBranch<false> E{(const bf16*)(ws + WS_PROJ) + OFF_GT + D, DIN, (bf16*)(ws + WS_MM), D}; pg8::gemm_phase<pg8::EpiBranch<false>, pg8::RowOrder, true, true>(lds, g, S, E, tid); }
            { PHASE_CTX(); pg8::RowOrder S; S.lat = (l == DEPTH - 1); S.init(S.lat ? NB * SEQ : T, D, G, bid);
              pg8::Gemm g{(const bf16*)(ws + WS_YA), (const bf16*)(ws + WS_WAO) + (size_t)l * D * 512, T, D, 512};
              pg8::EpiBranch<false> E{(const bf16*)(ws + WS_PROJ) + OFF_GT + 2 * D, DIN, (bf16*)(ws + WS_MM), D}; pg8::gemm_phase<pg8::EpiBranch<false>, pg8::RowOrder, true, true>(lds, g, S, E, tid); }
            SEAM(pb + 5);
        }
        if (EN(6) && IN(pb + 6)) { PHASE_CTX();
            pg8::Gemm g{(const bf16*)(ws + WS_MM), (const bf16*)(ws + WS_WO) + (size_t)l * D * D, T, D, D}; pg8::RowOrder S; S.lat = (l == DEPTH - 1); S.init(S.lat ? NB * SEQ : T, D, G, bid);
            pg8::EpiWo E{(float*)(ws + WS_X), (const float*)(ws + WS_MOD) + (size_t)l * 17 * 6144 + 2048};
            pg8::gemm_phase<pg8::EpiWo, pg8::RowOrder, true, true>(lds, g, S, E, tid);
            SEAM(pb + 6);
        }
        if (EN(7) && IN(pb + 7)) { PHASE_CTX(); phase_n2(ap, l, lds, tid, lane, wave, bid, G); SEAM(pb + 7); }
        if (EN(8) && IN(pb + 8)) { PHASE_CTX(); phase_moe_prep(ap, l, lds, tid, lane, gw, NGW); SEAM(pb + 8); }
        if (EN(9) && IN(pb + 9)) { PHASE_CTX();
            build_expert_tables(ap, l, lds, tid);
            const int nt = ((const LAS int*)(lds + PADS_OFF))[32];
            pg8::Gemm g{(const bf16*)(ws + WS_XG), (const bf16*)(ws + WS_WGU + (size_t)l * 32 * 2048 * 1024), nt * 256, 2048, 512};
            pg8::MoeOrder S{8, nt * 8, G, bid, lds + TILE_E_OFF, (size_t)2048 * 1024};
            pg8::EpiSwiglu E{(unsigned char*)(ws + WS_ACT), ap->in[I_BGU] + (size_t)l * 32 * 2048, lds + TILE_E_OFF};
            pg8::gemm_phase<pg8::EpiSwiglu, pg8::MoeOrder, true, false>(lds, g, S, E, tid);
            SEAM(pb + 9);
        }
        if (EN(10) && IN(pb + 10)) { PHASE_CTX();
            build_expert_tables(ap, l, lds, tid);
            const int nt = ((const LAS int*)(lds + PADS_OFF))[32];
            pg8::Gemm g{(const bf16*)(ws + WS_ACT), (const bf16*)(ws + WS_WD + (size_t)l * 32 * 1024 * 1024), nt * 256, 1024, 512};
            pg8::MoeOrder S{4, nt * 4, G, bid, lds + TILE_E_OFF, (size_t)1024 * 1024};
            pg8::EpiDown E{(unsigned char*)(ws + WS_YS8), ap->in[I_BD] + (size_t)l * 32 * 1024, lds + TILE_E_OFF};
            pg8::gemm_phase<pg8::EpiDown, pg8::MoeOrder, true, false>(lds, g, S, E, tid);
            SEAM(pb + 10);
        }
    }
    if (EN(12) && IN(NPHASES - 1)) { PHASE_CTX(); phase_n1<2>(ap, DEPTH, lane, gw, NGW); }
    if (PROBE_MASK || PROBE_SUB_A >= 0) { if (blockIdx.x == 0 && wave_s == 0) { CArgs apz_ = get_args(); unsigned long long* ts_ = (unsigned long long*)(apz_->ws + WS_CTL) + CW_TS / 2;
        asm volatile("s_waitcnt vmcnt(0)" ::: "memory");
        const unsigned long long t_end = __builtin_amdgcn_s_memrealtime(); unsigned long long sum = 0;
        for (int k2 = 0; k2 < NPHASES; ++k2) { const int cls = k2 == 0 ? 0 : (k2 == NPHASES - 1 ? 13 : 1 + (k2 - 1) % PH_PER_LAYER);
            const unsigned long long t0 = __hip_atomic_load(ts_ + k2, RLX_AGENT), t1 = (k2 == NPHASES - 1) ? t_end : __hip_atomic_load(ts_ + k2 + 1, RLX_AGENT);
            if ((PROBE_MASK >> cls) & 1) sum += t1 - t0; }
        if (PROBE_SUB_A >= 0) sum = (unsigned long long)PROBE_SUBF * (__hip_atomic_load(ts_ + 128 + (PROBE_SUB_B < 0 ? 0 : PROBE_SUB_B), RLX_AGENT) - __hip_atomic_load(ts_ + 128 + (PROBE_SUB_A < 0 ? 0 : PROBE_SUB_A), RLX_AGENT)) / PROBE_FACTOR;
        while (__builtin_amdgcn_s_memrealtime() - t_end < (unsigned long long)PROBE_FACTOR * sum) __builtin_amdgcn_s_sleep(8); } }
#undef IN
#undef SEAM
}

extern "C" void kernel_launch(void* const* d_in, const int* in_sizes, int n_in, void* d_out, int out_size, void* d_ws, size_t ws_size, hipStream_t stream) {
    static int grid = 0;
    if (grid == 0) {
        if (n_in != N_IN || out_size != NB * SEQ * D || ws_size < WS_END) { fprintf(stderr, "kernel_launch: unexpected sizes (n_in %d out %d ws %zu, need %zu)\n", n_in, out_size, ws_size, (size_t)WS_END); grid = -1; return; }
        int dev = 0, cus = 0, per_cu = 0;
        if (hipGetDevice(&dev) != hipSuccess || hipDeviceGetAttribute(&cus, hipDeviceAttributeMultiprocessorCount, dev) != hipSuccess) { grid = -1; return; }
        if (hipFuncSetAttribute((const void*)fwd, hipFuncAttributeMaxDynamicSharedMemorySize, LDS_BYTES) != hipSuccess) { fprintf(stderr, "kernel_launch: hipFuncSetAttribute failed\n"); grid = -1; return; }
        if (hipOccupancyMaxActiveBlocksPerMultiprocessor(&per_cu, (const void*)fwd, NTHREADS, LDS_BYTES) != hipSuccess || per_cu < 1) { fprintf(stderr, "kernel_launch: occupancy query says %d\n", per_cu); }
        (void)hipGetLastError();
        grid = cus;
    }
    if (grid < 0) return;
    if (hipMemsetAsync((char*)d_ws + WS_CTL, 0, CTL_ZERO_BYTES, stream) != hipSuccess) return;
    Args a{};
    for (int i = 0; i < N_IN; ++i) a.in[i] = (const float*)d_in[i];
    a.out = (float*)d_out; a.ws = (unsigned char*)d_ws;
#if MK_ONE_LAUNCH
    a.ph_lo = 0; a.ph_hi = NPHASES;
    hipLaunchKernelGGL(fwd, dim3(grid), dim3(NTHREADS), LDS_BYTES, stream, a);
#else
    for (int p = 0; p < NPHASES; ++p) { a.ph_lo = p; a.ph_hi = p + 1; hipLaunchKernelGGL(fwd, dim3(grid), dim3(NTHREADS), LDS_BYTES, stream, a); }
#endif
}
```

```cpp
#include <hip/hip_runtime.h>
#include <cstdio>
#include <cstdint>
namespace pg8 {
#define PG8_LAS __attribute__((address_space(3)))
#define PG8_GAS __attribute__((address_space(1)))
typedef unsigned short bf16_t;
typedef short bf16x8 __attribute__((ext_vector_type(8)));
typedef float f32x4 __attribute__((ext_vector_type(4)));
typedef unsigned u32x4 __attribute__((ext_vector_type(4)));
typedef int pg8_i4 __attribute__((ext_vector_type(4)));
typedef int pg8_i8 __attribute__((ext_vector_type(8)));
constexpr int BM = 256, BK = 64, HALF = 128, HTB = HALF * BK * 2  , STAGE_BYTES = 8 * HTB, NXCD = 8, WGM = 8;

__host__ __device__ __forceinline__ int lds_byte(int r, int c) { const int st = (r >> 4) * 2 + (c >> 5), rr = r & 15, cc = c & 31, ob = rr * 64 + cc * 2; return st * 1024 + (ob ^ (((ob >> 9) & 1) << 5)); }
__host__ __device__ __forceinline__ void stage_rc(int b, int& R, int& C) { const int st = b / 1024, sb = b % 1024, swz = sb ^ (((sb >> 9) & 1) << 5); R = (st >> 1) * 16 + swz / 64; C = (st & 1) * 32 + (swz % 64) / 2; }
__host__ __device__ __forceinline__ int perm32(int rho) { const int n = rho >> 4, i = rho & 15; return 8 * (i >> 2) + 4 * n + (i & 3); }

struct Unit { int pm, pn; };
struct Gemm { const bf16_t* A; const bf16_t* Bt; int M, N, K; };

struct StaticOrder {
    static constexpr bool GATHER = false;
    int nM, nN, nwg, G, c;
    __host__ __device__ void init(int M, int N, int G_, int c_) { nM = M / BM; nN = N / BM; nwg = nM * nN; G = G_; c = c_; }
    __host__ __device__ bool next(int i, Unit& u) const {
        const long L = (long)i * G + c; if (L >= nwg) return false;
        int wgid = (int)L; { const int q = nwg / NXCD, r = nwg % NXCD, xcd = wgid % NXCD, off = wgid / NXCD; wgid = (xcd < r ? xcd * (q + 1) : r * (q + 1) + (xcd - r) * q) + off; }
        const int nig = WGM * nN, gid = wgid / nig, fm = gid * WGM, gsz = (nM - fm) < WGM ? (nM - fm) : WGM;
        u.pm = fm + ((wgid % nig) % gsz); u.pn = (wgid % nig) / gsz; return true;
    }
    __device__ __forceinline__ void a_ready(const Unit&) const {}
    __device__ __forceinline__ void done(const Unit&) const {}
    __device__ __forceinline__ const char* aptr(const Gemm& g, const Unit& u, size_t tstep) const { return (const char*)g.A + (size_t)u.pm * tstep; }
    __device__ __forceinline__ const char* bptr(const Gemm& g, const Unit& u, size_t tstep) const { return (const char*)g.Bt + (size_t)u.pn * tstep; }
};

__device__ __forceinline__ unsigned cvt_pk_bf16(float lo, float hi) { unsigned r; asm volatile("v_cvt_pk_bf16_f32 %0, %1, %2" : "=v"(r) : "v"(lo), "v"(hi)); return r; }
__device__ __forceinline__ float bf_lo(unsigned w) { return __uint_as_float(w << 16); }
__device__ __forceinline__ float bf_hi(unsigned w) { return __uint_as_float(w & 0xffff0000u); }
__device__ __forceinline__ float sigm(float x) { return __builtin_amdgcn_rcpf(1.0f + __expf(-x)); }
#define PG8_FRESH_LANE() { unsigned z_ = 0u; asm volatile("" : "+s"(z_)); const int l_ = (int)__builtin_amdgcn_mbcnt_hi(~0u, __builtin_amdgcn_mbcnt_lo(~0u, z_)); fr = l_ & 15; fq = l_ >> 4; }

struct EpiPlain {
    static constexpr bool PERM = true, AFTER_DRAIN = false, FP8 = false; static constexpr int WSCALE = 0x7f;
    bf16_t* O; int ldc;
    __device__ __forceinline__ void operator()(const f32x4 (&acc)[2][2][4][2], const Unit& u, int wr, int wc, int fr, int fq) const {
        PG8_FRESH_LANE();
        const int row0 = u.pm * BM + wr * 64 + fr, col0 = u.pn * BM + wc * 32 + 8 * fq;
#pragma unroll
        for (int ai = 0; ai < 2; ++ai)
#pragma unroll
            for (int m = 0; m < 4; ++m) { bf16_t* rowp = O + (size_t)(row0 + ai * HALF + m * 16) * ldc + col0;
#pragma unroll
                for (int bj = 0; bj < 2; ++bj) { const f32x4 v0 = acc[ai][bj][m][0], v1 = acc[ai][bj][m][1];
                    u32x4 w; w.x = cvt_pk_bf16(v0[0], v0[1]); w.y = cvt_pk_bf16(v0[2], v0[3]); w.z = cvt_pk_bf16(v1[0], v1[1]); w.w = cvt_pk_bf16(v1[2], v1[3]);
                    *(u32x4*)(rowp + bj * HALF) = w; } }
    }
};
struct EpiPlain8 {
    static constexpr bool PERM = true, AFTER_DRAIN = false, FP8 = true; static constexpr int WSCALE = 0;
    bf16_t* O; int ldc;
    __device__ __forceinline__ void operator()(const f32x4 (&acc)[2][2][4][2], const Unit& u, int wr, int wc, int fr, int fq) const {
        PG8_FRESH_LANE();
        const int row0 = u.pm * BM + wr * 64 + fr, col0 = u.pn * BM + wc * 32 + 8 * fq;
#pragma unroll
        for (int ai = 0; ai < 2; ++ai)
#pragma unroll
            for (int m = 0; m < 4; ++m) { bf16_t* rowp = O + (size_t)(row0 + ai * HALF + m * 16) * ldc + col0;
#pragma unroll
                for (int bj = 0; bj < 2; ++bj) { const f32x4 v0 = acc[ai][bj][m][0] * 0.03125f, v1 = acc[ai][bj][m][1] * 0.03125f;
                    u32x4 w; w.x = cvt_pk_bf16(v0[0], v0[1]); w.y = cvt_pk_bf16(v0[2], v0[3]); w.z = cvt_pk_bf16(v1[0], v1[1]); w.w = cvt_pk_bf16(v1[2], v1[3]);
                    *(u32x4*)(rowp + bj * HALF) = w; } }
    }
};
struct EpiGlu {
    static constexpr bool PERM = true, AFTER_DRAIN = false, FP8 = false; static constexpr int WSCALE = 0x7f;
    const bf16_t* Z; bf16_t* O; int ldc;
    __device__ __forceinline__ void operator()(const f32x4 (&acc)[2][2][4][2], const Unit& u, int wr, int wc, int fr, int fq) const {
        PG8_FRESH_LANE();
        const int row0 = u.pm * BM + wr * 64 + fr, col0 = u.pn * BM + wc * 32 + 8 * fq;
#pragma unroll
        for (int ai = 0; ai < 2; ++ai) {
            u32x4 z[4][2];
#pragma unroll
            for (int m = 0; m < 4; ++m)
#pragma unroll
                for (int bj = 0; bj < 2; ++bj) z[m][bj] = *(const u32x4*)(Z + (size_t)(row0 + ai * HALF + m * 16) * ldc + col0 + bj * HALF);
#pragma unroll
            for (int m = 0; m < 4; ++m)
#pragma unroll
                for (int bj = 0; bj < 2; ++bj) { const f32x4 v0 = acc[ai][bj][m][0], v1 = acc[ai][bj][m][1]; const u32x4 zz = z[m][bj];
                    u32x4 w; w.x = cvt_pk_bf16(bf_lo(zz.x) * sigm(v0[0]), bf_hi(zz.x) * sigm(v0[1])); w.y = cvt_pk_bf16(bf_lo(zz.y) * sigm(v0[2]), bf_hi(zz.y) * sigm(v0[3]));
                    w.z = cvt_pk_bf16(bf_lo(zz.z) * sigm(v1[0]), bf_hi(zz.z) * sigm(v1[1])); w.w = cvt_pk_bf16(bf_lo(zz.w) * sigm(v1[2]), bf_hi(zz.w) * sigm(v1[3]));
                    *(u32x4*)(O + (size_t)(row0 + ai * HALF + m * 16) * ldc + col0 + bj * HALF) = w; }
            asm volatile("" ::: "memory"); }
    }
};
template <bool FIRST> struct EpiBranch {
    static constexpr bool PERM = true, AFTER_DRAIN = false, FP8 = false; static constexpr int WSCALE = 0x7f;
    const bf16_t* GT; int ldg; bf16_t* MM; int ldc;
    __device__ __forceinline__ void operator()(const f32x4 (&acc)[2][2][4][2], const Unit& u, int wr, int wc, int fr, int fq) const {
        PG8_FRESH_LANE();
        const unsigned row0 = u.pm * BM + wr * 64 + fr, col0 = u.pn * BM + wc * 32 + 8 * fq;
#pragma unroll
        for (int ai = 0; ai < 2; ++ai) {
            u32x4 g[4][2], pv[4][2];
#pragma unroll
            for (int m = 0; m < 4; ++m)
#pragma unroll
                for (int bj = 0; bj < 2; ++bj) { const unsigned row = row0 + ai * HALF + m * 16;
                    g[m][bj] = *(const u32x4*)(GT + row * (unsigned)ldg + col0 + bj * HALF);
                    if (!FIRST) pv[m][bj] = *(const u32x4*)(MM + row * (unsigned)ldc + col0 + bj * HALF); }
#pragma unroll
            for (int m = 0; m < 4; ++m)
#pragma unroll
                for (int bj = 0; bj < 2; ++bj) { const unsigned row = row0 + ai * HALF + m * 16; const f32x4 v0 = acc[ai][bj][m][0], v1 = acc[ai][bj][m][1]; const u32x4 gg = g[m][bj];
                    float o[8];
                    o[0] = sigm(bf_lo(gg.x)) * v0[0]; o[1] = sigm(bf_hi(gg.x)) * v0[1]; o[2] = sigm(bf_lo(gg.y)) * v0[2]; o[3] = sigm(bf_hi(gg.y)) * v0[3];
                    o[4] = sigm(bf_lo(gg.z)) * v1[0]; o[5] = sigm(bf_hi(gg.z)) * v1[1]; o[6] = sigm(bf_lo(gg.w)) * v1[2]; o[7] = sigm(bf_hi(gg.w)) * v1[3];
                    if (!FIRST) { const u32x4 p = pv[m][bj];
                        o[0] += bf_lo(p.x); o[1] += bf_hi(p.x); o[2] += bf_lo(p.y); o[3] += bf_hi(p.y); o[4] += bf_lo(p.z); o[5] += bf_hi(p.z); o[6] += bf_lo(p.w); o[7] += bf_hi(p.w); }
                    u32x4 w; w.x = cvt_pk_bf16(o[0], o[1]); w.y = cvt_pk_bf16(o[2], o[3]); w.z = cvt_pk_bf16(o[4], o[5]); w.w = cvt_pk_bf16(o[6], o[7]);
                    *(u32x4*)(MM + row * (unsigned)ldc + col0 + bj * HALF) = w; }
            asm volatile("" ::: "memory"); }
    }
};
struct EpiWo {
    static constexpr bool PERM = false, AFTER_DRAIN = false, FP8 = false; static constexpr int WSCALE = 0x7f;
    float* X; const float* g1base;
    __device__ __forceinline__ void operator()(const f32x4 (&acc)[2][2][4][2], const Unit& u, int wr, int wc, int fr, int fq) const {
        PG8_FRESH_LANE();
        const int row0 = u.pm * BM + wr * 64 + fr, col0 = u.pn * BM + wc * 32 + 4 * fq;
        const int r = (u.pm % 9 == 0) ? 16 : u.pm / 9; const float* g1 = g1base + (size_t)r * 6144 + col0;
        f32x4 gv[2][2];
#pragma unroll
        for (int bj = 0; bj < 2; ++bj)
#pragma unroll
            for (int n = 0; n < 2; ++n) gv[bj][n] = *(const f32x4*)(g1 + bj * HALF + n * 16);
#pragma unroll
        for (int ai = 0; ai < 2; ++ai)
#pragma unroll
            for (int mh = 0; mh < 2; ++mh) {
                f32x4 xv[2][2][2];
#pragma unroll
                for (int mm = 0; mm < 2; ++mm)
#pragma unroll
                    for (int bj = 0; bj < 2; ++bj)
#pragma unroll
                        for (int n = 0; n < 2; ++n) xv[mm][bj][n] = *(const f32x4*)(X + (size_t)(row0 + ai * HALF + (2 * mh + mm) * 16) * 1024 + col0 + bj * HALF + n * 16);
#pragma unroll
                for (int mm = 0; mm < 2; ++mm)
#pragma unroll
                    for (int bj = 0; bj < 2; ++bj)
#pragma unroll
                        for (int n = 0; n < 2; ++n) *(f32x4*)(X + (size_t)(row0 + ai * HALF + (2 * mh + mm) * 16) * 1024 + col0 + bj * HALF + n * 16) = xv[mm][bj][n] + gv[bj][n] * acc[ai][bj][2 * mh + mm][n];
                asm volatile("" ::: "memory"); }
    }
};
struct EpiSwiglu {
    static constexpr bool PERM = true, AFTER_DRAIN = false, FP8 = true; static constexpr int WSCALE = 0;
    unsigned char* O; const float* bias; const PG8_LAS unsigned char* tile_e;
    __device__ __forceinline__ void operator()(const f32x4 (&acc)[2][2][4][2], const Unit& u, int wr, int wc, int fr, int fq) const {
        PG8_FRESH_LANE();
        const int row0 = u.pm * BM + wr * 64 + fr, acol0 = u.pn * HALF + wc * 32 + 8 * fq;
        const int e = tile_e[u.pm]; const float* bb = bias + (size_t)e * 2048 + 2 * acol0;
        const f32x4 b0 = *(const f32x4*)(bb), b1 = *(const f32x4*)(bb + 4), b2 = *(const f32x4*)(bb + 8), b3 = *(const f32x4*)(bb + 12);
        const float bg[8] = {b0[0], b0[2], b1[0], b1[2], b2[0], b2[2], b3[0], b3[2]}, bu[8] = {b0[1], b0[3], b1[1], b1[3], b2[1], b2[3], b3[1], b3[3]};
#pragma unroll
        for (int ai = 0; ai < 2; ++ai)
#pragma unroll
            for (int m = 0; m < 4; ++m) { unsigned char* rowp = O + (size_t)(row0 + ai * HALF + m * 16) * 1024 + acol0;
                float o[8];
#pragma unroll
                for (int j = 0; j < 8; ++j) { const float gt = acc[ai][0][m][j >> 2][j & 3] * 0.03125f + bg[j], up = acc[ai][1][m][j >> 2][j & 3] * 0.03125f + bu[j];
                    const float glu = fminf(gt, 7.0f), upc = fminf(fmaxf(up, -7.0f), 7.0f);
                    o[j] = glu * sigm(1.702f * glu) * (upc + 1.0f); }
                unsigned w0 = 0u, w1 = 0u;
                w0 = __builtin_amdgcn_cvt_pk_fp8_f32(o[0], o[1], w0, false); w0 = __builtin_amdgcn_cvt_pk_fp8_f32(o[2], o[3], w0, true);
                w1 = __builtin_amdgcn_cvt_pk_fp8_f32(o[4], o[5], w1, false); w1 = __builtin_amdgcn_cvt_pk_fp8_f32(o[6], o[7], w1, true);
                typedef unsigned u32x2 __attribute__((ext_vector_type(2)));
                *(u32x2*)rowp = (u32x2){w0, w1}; }
    }
};
struct EpiDown {
    static constexpr bool PERM = true, AFTER_DRAIN = false, FP8 = true; static constexpr int WSCALE = 0;
    unsigned char* O; const float* bias; const PG8_LAS unsigned char* tile_e;
    __device__ __forceinline__ void operator()(const f32x4 (&acc)[2][2][4][2], const Unit& u, int wr, int wc, int fr, int fq) const {
        PG8_FRESH_LANE();
        const int row0 = u.pm * BM + wr * 64 + fr, col0 = u.pn * BM + wc * 32 + 8 * fq;
        const int e = tile_e[u.pm]; const float* bb = bias + (size_t)e * 1024 + col0;
        f32x4 bv[2][2];
#pragma unroll
        for (int bj = 0; bj < 2; ++bj)
#pragma unroll
            for (int n = 0; n < 2; ++n) bv[bj][n] = *(const f32x4*)(bb + bj * HALF + 4 * n);
        typedef unsigned u32x2 __attribute__((ext_vector_type(2)));
#pragma unroll
        for (int ai = 0; ai < 2; ++ai)
#pragma unroll
            for (int m = 0; m < 4; ++m) { unsigned char* rowp = O + (size_t)(row0 + ai * HALF + m * 16) * 1024 + col0;
#pragma unroll
                for (int bj = 0; bj < 2; ++bj) { const f32x4 v0 = acc[ai][bj][m][0] * 0.03125f + bv[bj][0], v1 = acc[ai][bj][m][1] * 0.03125f + bv[bj][1];
                    unsigned w0 = 0u, w1 = 0u;
                    w0 = __builtin_amdgcn_cvt_pk_fp8_f32(v0[0], v0[1], w0, false); w0 = __builtin_amdgcn_cvt_pk_fp8_f32(v0[2], v0[3], w0, true);
                    w1 = __builtin_amdgcn_cvt_pk_fp8_f32(v1[0], v1[1], w1, false); w1 = __builtin_amdgcn_cvt_pk_fp8_f32(v1[2], v1[3], w1, true);
                    *(u32x2*)(rowp + bj * HALF) = (u32x2){w0, w1}; } }
    }
};
struct RowOrder : StaticOrder {
    int lat;
    __device__ __forceinline__ bool next(int i, Unit& u) const { if (!StaticOrder::next(i, u)) return false; if (lat) u.pm = (u.pm >> 3) * 9 + 1 + (u.pm & 7); return true; }
};
struct PanelOrder {
    static constexpr bool GATHER = false;
    int pm, nN;
    __device__ __forceinline__ bool next(int i, Unit& u) const { if (i >= nN) return false; u.pm = pm; u.pn = i; return true; }
    __device__ __forceinline__ void a_ready(const Unit&) const {}
    __device__ __forceinline__ void done(const Unit&) const {}
    __device__ __forceinline__ const char* aptr(const Gemm& g, const Unit& u, size_t tstep) const { const char* p = (const char*)g.A + (size_t)u.pm * tstep; asm volatile("" : "+s"(p)); return p; }
    __device__ __forceinline__ const char* bptr(const Gemm& g, const Unit& u, size_t tstep) const { return (const char*)g.Bt + (size_t)u.pn * tstep; }
};
struct MoeOrder {
    static constexpr bool GATHER = false;
    int nN, total, G, c; const PG8_LAS unsigned char* tile_e; size_t estride;
    __device__ __forceinline__ bool next(int i, Unit& u) const {
        if ((G & 7) == 0 && ((G >> 3) % nN) == 0) { const int x = c & 7, j = c >> 3, rpx = (G >> 3) / nN; u.pm = i * (G / nN) + x * rpx + j / nN; u.pn = j % nN; return u.pm * nN < total; }
        const int L = i * G + c; if (L >= total) return false; u.pm = L / nN; u.pn = L - u.pm * nN; return true; }
    __device__ __forceinline__ void a_ready(const Unit&) const {}
    __device__ __forceinline__ void done(const Unit&) const {}
    __device__ __forceinline__ const char* aptr(const Gemm& g, const Unit& u, size_t tstep) const { return (const char*)g.A + (size_t)u.pm * tstep; }
    __device__ __forceinline__ const char* bptr(const Gemm& g, const Unit& u, size_t tstep) const { return (const char*)g.Bt + (size_t)tile_e[u.pm] * estride + (size_t)u.pn * tstep; }
};

struct MoeGatherOrder : MoeOrder {
    static constexpr bool GATHER = true;
    const int* rows;
    __device__ __forceinline__ const char* aptr(const Gemm& g, const Unit&, size_t) const { return (const char*)g.A; }
    __device__ __forceinline__ void load_raw(const Unit& u, int (&raw)[2][2], int tid) const {
#pragma unroll
        for (int i = 0; i < 2; ++i) { int R, C; stage_rc(tid * 16 + i * 8192, R, C);
#pragma unroll
            for (int h = 0; h < 2; ++h) raw[h][i] = rows[u.pm * BM + h * HALF + R]; }
    }
    __device__ __forceinline__ void raw_to_off(const int (&raw)[2][2], unsigned (&voff)[2][2], int tid, int K) const {
#pragma unroll
        for (int i = 0; i < 2; ++i) { int R, C; stage_rc(tid * 16 + i * 8192, R, C);
#pragma unroll
            for (int h = 0; h < 2; ++h) voff[h][i] = ((unsigned)raw[h][i] * (unsigned)K + (unsigned)C) * 2u; }
    }
};

template <class Epi, class Sched, bool ALIGN_EPI = false, bool SP2 = false>
__device__ __forceinline__ void gemm_phase(PG8_LAS unsigned char* lds, const Gemm g, const Sched& S, const Epi& E, int tid_in) {
    int tid_ = tid_in; asm volatile("" : "+v"(tid_));
    const int tid = tid_, wid = __builtin_amdgcn_readfirstlane(tid >> 6), lane = tid & 63, wr = wid >> 2, wc = wid & 3, fr = lane & 15, fq = lane >> 4;
    const int K = g.K, nt = K / BK;
    unsigned voffA[2], voffB[2];
#pragma unroll
    for (int i = 0; i < 2; ++i) { int R, C; stage_rc(tid * 16 + i * 8192, R, C); const int Rb = Epi::PERM ? ((R & ~31) + perm32(R & 31)) : R;
        voffA[i] = (unsigned)(R * K + C) * 2u; voffB[i] = (unsigned)(Rb * K + C) * 2u; }
    const size_t kstep = (size_t)(BK * 2);
    const size_t hstep = (size_t)HALF * K * 2;
    const size_t tstep = 2 * hstep;
    const unsigned ldsw = (unsigned)wid * 1024u;
    const int aoff = lds_byte(wr * 64 + fr, fq * 8), boff = lds_byte(wc * 32 + fr, fq * 8);
#define PG8_SA(b, h) (((b) * 2 + (h)) * HTB)
#define PG8_SB(b, h) ((4 + (b) * 2 + (h)) * HTB)
#define PG8_STAGE(bufoff, gbase, voff) do { _Pragma("unroll") for (int _i = 0; _i < 2; ++_i) \
        __builtin_amdgcn_global_load_lds((const PG8_GAS unsigned*)((const PG8_GAS char*)(gbase) + (voff)[_i]), (PG8_LAS unsigned*)(lds + (bufoff) + ldsw + _i * 8192), 16, 0, 0); } while (0)
#define PG8_STAGE_A(bufoff, p, h, nx) do { if constexpr (Sched::GATHER) { _Pragma("unroll") for (int _i = 0; _i < 2; ++_i) \
            __builtin_amdgcn_global_load_lds((const PG8_GAS unsigned*)((const PG8_GAS char*)(p) + ((nx) ? voffGN[h][_i] : voffGC[h][_i])), (PG8_LAS unsigned*)(lds + (bufoff) + ldsw + _i * 8192), 16, 0, 0); } \
        else PG8_STAGE(bufoff, (p) + (h) * hstep, voffA); } while (0)
#define PG8_LD8(p) __builtin_shufflevector(*(const PG8_LAS pg8_i4*)(p), *(const PG8_LAS pg8_i4*)((p) + 1024), 0, 1, 2, 3, 4, 5, 6, 7)
#define PG8_LDA(dst, b, h) do { if constexpr (Epi::FP8) { _Pragma("unroll") for (int m = 0; m < 4; ++m) { dst##8[m].lo = *(const PG8_LAS pg8_i4*)(lds + PG8_SA(b, h) + aoff + m * 2048); dst##8[m].hi = *(const PG8_LAS pg8_i4*)(lds + PG8_SA(b, h) + aoff + m * 2048 + 1024); } } \
    else { _Pragma("unroll") for (int m = 0; m < 4; ++m) _Pragma("unroll") for (int k = 0; k < 2; ++k) dst[m][k] = *(const PG8_LAS bf16x8*)(lds + PG8_SA(b, h) + aoff + m * 2048 + k * 1024); } } while (0)
#define PG8_LDB(dst, b, h) do { if constexpr (Epi::FP8) { _Pragma("unroll") for (int n = 0; n < 2; ++n) { dst##8[n].lo = *(const PG8_LAS pg8_i4*)(lds + PG8_SB(b, h) + boff + n * 2048); dst##8[n].hi = *(const PG8_LAS pg8_i4*)(lds + PG8_SB(b, h) + boff + n * 2048 + 1024); } } \
    else { _Pragma("unroll") for (int n = 0; n < 2; ++n) _Pragma("unroll") for (int k = 0; k < 2; ++k) dst[n][k] = *(const PG8_LAS bf16x8*)(lds + PG8_SB(b, h) + boff + n * 2048 + k * 1024); } } while (0)
#define PG8_CAT8(lo, hi) __builtin_shufflevector(__builtin_bit_cast(pg8_i4, lo), __builtin_bit_cast(pg8_i4, hi), 0, 1, 2, 3, 4, 5, 6, 7)
#define PG8_MMA(ai, bj, At, Bt) do { __builtin_amdgcn_s_setprio(1); if constexpr (Epi::FP8) { __builtin_amdgcn_sched_barrier(0); _Pragma("unroll") for (int m = 0; m < 4; ++m) _Pragma("unroll") for (int n = 0; n < 2; ++n) \
        acc[ai][bj][m][n] = __builtin_amdgcn_mfma_scale_f32_16x16x128_f8f6f4(Bt##8[n], At##8[m], acc[ai][bj][m][n], 0, 0, 0, 0, 0, 0); \
          \
        asm volatile("" : "+v"(acc[ai][bj][0][0]), "+v"(acc[ai][bj][0][1]), "+v"(acc[ai][bj][1][0]), "+v"(acc[ai][bj][1][1]), "+v"(acc[ai][bj][2][0]), "+v"(acc[ai][bj][2][1]), "+v"(acc[ai][bj][3][0]), "+v"(acc[ai][bj][3][1])); \
        __builtin_amdgcn_sched_barrier(0); } \
    else { _Pragma("unroll") for (int m = 0; m < 4; ++m) _Pragma("unroll") for (int n = 0; n < 2; ++n) _Pragma("unroll") for (int k = 0; k < 2; ++k) \
        acc[ai][bj][m][n] = __builtin_amdgcn_mfma_f32_16x16x32_bf16(Bt[n][k], At[m][k], acc[ai][bj][m][n], 0, 0, 0); } __builtin_amdgcn_s_setprio(0); } while (0)
#define PG8_WAIT_V(n) asm volatile("s_waitcnt vmcnt(" #n ")" ::: "memory")
#define PG8_WAIT_L(n) asm volatile("s_waitcnt lgkmcnt(" #n ")" ::: "memory")
#define PG8_BAR __builtin_amdgcn_s_barrier()
#define PG8_SCHED __builtin_amdgcn_sched_barrier(0)
    Unit cur, nxt; int ui = 0;
    if (!S.next(0, cur)) return;
    f32x4 acc[2][2][4][2];
#pragma unroll
    for (int a = 0; a < 2; ++a)
#pragma unroll
        for (int b = 0; b < 2; ++b)
#pragma unroll
            for (int m = 0; m < 4; ++m)
#pragma unroll
                for (int n = 0; n < 2; ++n) acc[a][b][m][n] = (f32x4){0.f, 0.f, 0.f, 0.f};
    bf16x8 At[4][2], B0[2][2], B1[2][2];
    pg8_i8 At8[4], B08[2], B18[2];
    (void)At; (void)B0; (void)B1; (void)At8; (void)B08; (void)B18;
    const char* cA = S.aptr(g, cur, tstep); const char* cB = S.bptr(g, cur, tstep);
    unsigned voffGC[2][2] = {{0u, 0u}, {0u, 0u}}, voffGN[2][2] = {{0u, 0u}, {0u, 0u}}; int rawN[2][2] = {{0, 0}, {0, 0}};
    if constexpr (Sched::GATHER) { S.load_raw(cur, rawN, tid); S.raw_to_off(rawN, voffGC, tid, K); }
    S.a_ready(cur);
    if constexpr (SP2) {
        PG8_STAGE(PG8_SB(0, 0), cB, voffB); PG8_STAGE(PG8_SB(0, 1), cB + hstep, voffB); PG8_STAGE_A(PG8_SA(0, 0), cA, 0, false); PG8_STAGE_A(PG8_SA(0, 1), cA, 1, false);
        if (wr == 1) PG8_BAR;
        PG8_WAIT_V(2); PG8_BAR;
        PG8_STAGE(PG8_SB(1, 0), cB + kstep, voffB); PG8_STAGE_A(PG8_SA(1, 0), cA + kstep, 0, false); PG8_STAGE(PG8_SB(1, 1), cB + hstep + kstep, voffB);
        PG8_WAIT_V(6); PG8_BAR;
    } else {
        PG8_STAGE(PG8_SB(0, 0), cB, voffB); PG8_STAGE_A(PG8_SA(0, 0), cA, 0, false); PG8_STAGE(PG8_SB(0, 1), cB + hstep, voffB); PG8_STAGE_A(PG8_SA(0, 1), cA, 1, false);
        if (wr == 1) PG8_BAR;
        PG8_WAIT_V(4); PG8_BAR;
        PG8_STAGE(PG8_SB(1, 0), cB + kstep, voffB); PG8_STAGE_A(PG8_SA(1, 0), cA + kstep, 0, false); PG8_STAGE(PG8_SB(1, 1), cB + hstep + kstep, voffB);
        PG8_WAIT_V(6); PG8_BAR;
    }
    for (;;) {
        const bool has_next = S.next(ui + 1, nxt);
        const char* nA = has_next ? S.aptr(g, nxt, tstep) : cA; const char* nB = has_next ? S.bptr(g, nxt, tstep) : cB;
        for (int t = 0; t < nt; t += 2) {
            const bool last = (t == nt - 2);
            const char* a1 = cA + (size_t)(t + 1) * kstep;
            const char* a2 = last ? nA : cA + (size_t)(t + 2) * kstep; const char* b2 = last ? nB : cB + (size_t)(t + 2) * kstep;
            const char* a3 = a2 + kstep; const char* b3 = b2 + kstep;
            if (last && has_next) S.a_ready(nxt);
            if constexpr (Sched::GATHER) {
                if (t == nt - 4 && has_next) S.load_raw(nxt, rawN, tid);
                if (last) { if (has_next) S.raw_to_off(rawN, voffGN, tid, K); else { voffGN[0][0] = voffGC[0][0]; voffGN[0][1] = voffGC[0][1]; voffGN[1][0] = voffGC[1][0]; voffGN[1][1] = voffGC[1][1]; } } }
            if constexpr (SP2) {
            PG8_LDB(B0, 0, 0); PG8_LDB(B1, 0, 1); PG8_SCHED; PG8_LDA(At, 0, 0); PG8_STAGE_A(PG8_SA(1, 1), a1, 1, false);
            PG8_WAIT_V(8); PG8_WAIT_L(0); PG8_BAR; PG8_MMA(0, 0, At, B0); PG8_MMA(0, 1, At, B1); PG8_BAR; PG8_SCHED;
            PG8_LDA(At, 0, 1); PG8_STAGE(PG8_SB(0, 0), b2, voffB); PG8_STAGE(PG8_SB(0, 1), b2 + hstep, voffB); PG8_STAGE_A(PG8_SA(0, 0), a2, 0, last);
            PG8_WAIT_V(8); PG8_WAIT_L(0); PG8_BAR; PG8_MMA(1, 0, At, B0); PG8_MMA(1, 1, At, B1); PG8_BAR; PG8_SCHED;
            PG8_LDB(B0, 1, 0); PG8_LDB(B1, 1, 1); PG8_SCHED; PG8_LDA(At, 1, 0); PG8_STAGE_A(PG8_SA(0, 1), a2, 1, last);
            PG8_WAIT_V(8); PG8_WAIT_L(0); PG8_BAR; PG8_MMA(0, 0, At, B0); PG8_MMA(0, 1, At, B1); PG8_BAR; PG8_SCHED;
            PG8_LDA(At, 1, 1); PG8_STAGE(PG8_SB(1, 0), b3, voffB); PG8_STAGE(PG8_SB(1, 1), b3 + hstep, voffB); PG8_STAGE_A(PG8_SA(1, 0), a3, 0, last);
            PG8_WAIT_V(8); PG8_WAIT_L(0); PG8_BAR; PG8_MMA(1, 0, At, B0); PG8_MMA(1, 1, At, B1); PG8_BAR; PG8_SCHED;
            } else {
            PG8_LDB(B0, 0, 0); PG8_SCHED; PG8_LDA(At, 0, 0); PG8_STAGE_A(PG8_SA(1, 1), a1, 1, false);
            PG8_WAIT_L(8); PG8_BAR; PG8_WAIT_L(0); PG8_MMA(0, 0, At, B0); PG8_BAR; PG8_SCHED;
            PG8_LDB(B1, 0, 1); PG8_STAGE(PG8_SB(0, 0), b2, voffB);
            PG8_BAR; PG8_WAIT_L(0); PG8_MMA(0, 1, At, B1); PG8_BAR;
            PG8_LDA(At, 0, 1); PG8_STAGE_A(PG8_SA(0, 0), a2, 0, last);
            PG8_BAR; PG8_WAIT_L(0); PG8_MMA(1, 0, At, B0); PG8_BAR; PG8_SCHED;
            PG8_STAGE(PG8_SB(0, 1), b2 + hstep, voffB);
            PG8_WAIT_V(6); PG8_BAR; PG8_MMA(1, 1, At, B1); PG8_BAR;
            PG8_LDB(B0, 1, 0); PG8_SCHED; PG8_LDA(At, 1, 0); PG8_STAGE_A(PG8_SA(0, 1), a2, 1, last);
            PG8_WAIT_L(8); PG8_BAR; PG8_WAIT_L(0); PG8_MMA(0, 0, At, B0); PG8_BAR; PG8_SCHED;
            PG8_LDB(B1, 1, 1); PG8_STAGE(PG8_SB(1, 0), b3, voffB);
            PG8_BAR; PG8_WAIT_L(0); PG8_MMA(0, 1, At, B1); PG8_BAR;
            PG8_LDA(At, 1, 1); PG8_STAGE_A(PG8_SA(1, 0), a3, 0, last);
            PG8_BAR; PG8_WAIT_L(0); PG8_MMA(1, 0, At, B0); PG8_BAR; PG8_SCHED;
            PG8_STAGE(PG8_SB(1, 1), b3 + hstep, voffB);
            PG8_WAIT_V(6); PG8_BAR; PG8_MMA(1, 1, At, B1); PG8_BAR;
            }
        }
        if constexpr (ALIGN_EPI) { if (wr == 0) PG8_BAR; }
        if constexpr (!Epi::AFTER_DRAIN) { E(acc, cur, wr, wc, fr, fq); S.done(cur); }
        if (!has_next) break;
#pragma unroll
        for (int a = 0; a < 2; ++a)
#pragma unroll
            for (int b = 0; b < 2; ++b)
#pragma unroll
                for (int m = 0; m < 4; ++m)
#pragma unroll
                    for (int n = 0; n < 2; ++n) acc[a][b][m][n] = (f32x4){0.f, 0.f, 0.f, 0.f};
        cur = nxt; cA = nA; cB = nB; ++ui;
        if constexpr (Sched::GATHER) { voffGC[0][0] = voffGN[0][0]; voffGC[0][1] = voffGN[0][1]; voffGC[1][0] = voffGN[1][0]; voffGC[1][1] = voffGN[1][1]; }
        if constexpr (ALIGN_EPI) { if (wr == 1) PG8_BAR; }
    }
    PG8_WAIT_V(0);
    if constexpr (!ALIGN_EPI) { if (wr == 0) PG8_BAR; }
    PG8_BAR;
    if constexpr (Epi::AFTER_DRAIN) { E.fused(acc, cur, wr, wc, fr, fq, lds, wid, lane); S.done(cur); }
#undef PG8_SA
#undef PG8_SB
#undef PG8_STAGE
#undef PG8_CAT8
#undef PG8_LD8
#undef PG8_STAGE_A
#undef PG8_LDA
#undef PG8_LDB
#undef PG8_MMA
#undef PG8_WAIT_V
#undef PG8_WAIT_L
#undef PG8_BAR
#undef PG8_SCHED
}
}

#ifndef MK_ONE_LAUNCH
#define MK_ONE_LAUNCH 1
#endif
constexpr int NWAVES = 8, NTHREADS = 512;
constexpr int NB = 16, SEQ = 2048, CTX = 256, TB = SEQ + CTX, T = NB * TB, D = 1024, DIN = 4864, DEPTH = 4;
constexpr int OFF_U = 0, OFF_CB = 256, OFF_CC = 512, OFF_CX = 768, OFF_Q = 1024, OFF_K = 1536, OFF_V = 1664, OFF_GT = 1792;
constexpr int NE = 32, MAX_TILES = (T * 4 + NE * 255) / 256, MAX_SLOTS = MAX_TILES * 256;
constexpr float EPS = 1e-6f;
enum { I_X = 0, I_C, I_CTX, I_CCTX, I_WMOD, I_BMOD, I_N1G, I_N2G, I_WIN, I_LRE, I_LIM, I_LDT, I_BRE, I_BIM, I_CRE, I_CIM, I_SD, I_WGLU, I_WSO, I_CONVW, I_WCO, I_QG, I_KG, I_SINK, I_WAO, I_WO,
       I_WR, I_BR, I_WGU, I_BGU, I_WD, I_BD, N_IN };
constexpr size_t MiB = 1u << 20;
constexpr size_t WS_CTL = 0, CTL_ZERO_BYTES = 1 * MiB;
constexpr size_t WS_MOD = 1 * MiB;
constexpr size_t WS_WRT = 3 * MiB;
constexpr size_t WS_ROPE = 4 * MiB;
constexpr size_t WS_WGLU = 5 * MiB;
constexpr size_t WS_WSO = 6 * MiB;
constexpr size_t WS_WCO = 8 * MiB;
constexpr size_t WS_WAO = 10 * MiB;
constexpr size_t WS_WO = 14 * MiB;
constexpr size_t WS_WIN = 22 * MiB;
constexpr size_t WS_WGU = 60 * MiB;
constexpr size_t WS_WD = 572 * MiB;
constexpr size_t WS_X = 828 * MiB;
constexpr size_t WS_H = 972 * MiB;
constexpr size_t WS_PROJ = 1044 * MiB;
constexpr size_t WS_QN = 1386 * MiB;
constexpr size_t WS_KN = 1422 * MiB;
constexpr size_t WS_Z = 1431 * MiB;
constexpr size_t WS_Z2 = 1449 * MiB;
constexpr size_t WS_YB = 1467 * MiB;
constexpr size_t WS_YA = 1485 * MiB;
constexpr size_t WS_MM = 1521 * MiB;
constexpr size_t WS_XG = 1593 * MiB;
constexpr size_t WS_ACT = 1897 * MiB;
constexpr size_t WS_TOPG = 2201 * MiB;
constexpr size_t WS_SLOT = 2202 * MiB;
constexpr size_t WS_S5S = 2203 * MiB;
constexpr size_t WS_XIN = 2275 * MiB;
constexpr size_t WS_VT = 2311 * MiB;
constexpr size_t WS_MS = 2320 * MiB;
constexpr size_t WS_W5 = 2324 * MiB;
constexpr size_t WS_BASE = 2330 * MiB;
constexpr size_t WS_STOK = 2331 * MiB;
constexpr size_t WS_GC = 2334 * MiB;
constexpr size_t WS_H8 = 2335 * MiB;
constexpr size_t WS_WIN8 = 2371 * MiB;
constexpr size_t WS_YS8 = 2383 * MiB;
constexpr size_t WS_END = 2535 * MiB;
static_assert(WS_WIN + (size_t)4 * DIN * D * 2 <= WS_WGU && WS_PROJ + (size_t)T * DIN * 2 <= WS_QN && WS_XG + (size_t)MAX_SLOTS * D * 2 <= WS_ACT && WS_ACT + (size_t)MAX_SLOTS * D * 2 <= WS_TOPG, "d_ws map");
static_assert(WS_X + (size_t)T * D * 4 <= WS_H && WS_H + (size_t)T * D * 2 <= WS_PROJ && WS_S5S + (size_t)16 * 4608 * 256 * 4 <= WS_XIN && WS_XIN + (size_t)32 * 4608 * 128 * 2 <= WS_VT && WS_VT + (size_t)32 * 64 * TB * 2 <= WS_MS && WS_W5 + (size_t)64 * 128 * 384 * 2 <= WS_END, "d_ws map 2");
constexpr int CW_CNT = 64;
constexpr int CW_BAR = 4096;
constexpr int CW_TS = 16384;
constexpr int RING_BYTES = 131072, MISC_OFF = RING_BYTES, LCNT_OFF = MISC_OFF + 128, TILE_E_OFF = MISC_OFF + 256, PADS_OFF = MISC_OFF + 1024, SCR_OFF = MISC_OFF + 2048, LDS_BYTES = 155648;

#define GAS __attribute__((address_space(1)))
#define LAS __attribute__((address_space(3)))
typedef unsigned short bf16;
typedef unsigned v4u __attribute__((ext_vector_type(4)));
typedef unsigned v2u __attribute__((ext_vector_type(2)));
typedef float f32x4 __attribute__((ext_vector_type(4)));
typedef float f32x2 __attribute__((ext_vector_type(2)));
typedef GAS unsigned gu32;
#define RLX_AGENT __ATOMIC_RELAXED, __HIP_MEMORY_SCOPE_AGENT
#define LDS_WAIT() asm volatile("s_waitcnt lgkmcnt(0)" ::: "memory")
#define VM_WAIT() asm volatile("s_waitcnt vmcnt(0)" ::: "memory")
__device__ __forceinline__ unsigned f2bf(float f) { unsigned u = __builtin_bit_cast(unsigned, f); return (u + 0x7fffu + ((u >> 16) & 1u)) >> 16; }
__device__ __forceinline__ unsigned pk2(float lo, float hi) { return f2bf(lo) | (f2bf(hi) << 16); }
__device__ __forceinline__ float bflo(unsigned w) { return __uint_as_float(w << 16); }
__device__ __forceinline__ float bfhi(unsigned w) { return __uint_as_float(w & 0xffff0000u); }

#define XB_TMO      128
#define XB_XCNT(j)  (256  + 64 * (j))
#define XB_XSUB(j)  (1280 + 64 * (j))
#define XB_XGEN(j)  (2304 + 64 * (j))
#define XB_TOP      3328
#define XB_TOPGEN   3392
#define XCD_BAR_WORDS 3456
#define XB_SPIN_CAP (1u << 18)

__device__ __forceinline__ unsigned xb_ld(unsigned* p)              { return __hip_atomic_load(p, __ATOMIC_RELAXED, __HIP_MEMORY_SCOPE_AGENT); }
__device__ __forceinline__ unsigned xb_add(unsigned* p, unsigned v) { return __hip_atomic_fetch_add(p, v, __ATOMIC_RELAXED, __HIP_MEMORY_SCOPE_AGENT); }
__device__ __forceinline__ unsigned xb_xcc_id() { return (unsigned)__builtin_amdgcn_s_getreg((3 << 11) | 20) & 0xFu; }
#define XB_SPIN(cond, bar) do { unsigned _sp = 0; while (cond) { __builtin_amdgcn_s_sleep(1); \
    if ((++_sp & 255u) == 0u) { if (xb_ld(&(bar)[XB_TMO])) break; if (_sp > XB_SPIN_CAP) { atomicAdd(&(bar)[XB_TMO], 1u); break; } } } } while (0)

struct XcdBarrier {
    unsigned* bar; unsigned x;
    volatile LAS unsigned* st;
};

__device__ __forceinline__ XcdBarrier xcd_barrier_post(unsigned* bar, volatile LAS unsigned* st) {
    XcdBarrier b; b.bar = bar; b.x = xb_xcc_id(); b.st = st;
    if (threadIdx.x == 0) (void)xb_add(&bar[XB_XCNT(b.x)], 1u);
    return b;
}
__device__ __forceinline__ void xcd_barrier_complete(unsigned* bar, unsigned x, unsigned& nloc, unsigned& nx) {
    const unsigned G = gridDim.x * gridDim.y * gridDim.z;
    unsigned sum, cnt, mine, sp = 0u;
    for (;;) {
        sum = 0u; cnt = 0u; mine = 0u;
#pragma unroll
        for (unsigned j = 0; j < 16; ++j) { const unsigned c = xb_ld(&bar[XB_XCNT(j)]); sum += c; cnt += (c > 0u) ? 1u : 0u; mine = (j == x) ? c : mine; }
        if (sum == G) break;
        __builtin_amdgcn_s_sleep(1);
        if ((++sp & 255u) == 0u) { if (xb_ld(&bar[XB_TMO])) break; if (sp > XB_SPIN_CAP) { atomicAdd(&bar[XB_TMO], 1u); break; } }
    }
    nloc = mine > 0u ? mine : 1u; nx = cnt > 0u ? cnt : 1u;
}

__device__ __forceinline__ void xcd_barrier(const XcdBarrier& b, const bool leader) {
    asm volatile("s_waitcnt vmcnt(0)" ::: "memory");
    __syncthreads();
    if (leader) {
        unsigned* bar = b.bar;
        __builtin_amdgcn_s_waitcnt(0);
        unsigned nloc = b.st[0], nx = b.st[1];
        if (nloc == 0u) { xcd_barrier_complete(bar, b.x, nloc, nx); b.st[0] = nloc; b.st[1] = nx; }
        const unsigned old = xb_add(&bar[XB_XSUB(b.x)], 1u);
        const unsigned gen = old / nloc;
        if (old + 1u == (gen + 1u) * nloc) {
            __builtin_amdgcn_fence(__ATOMIC_RELEASE, "agent");
            asm volatile("s_waitcnt vmcnt(0)" ::: "memory");
            const unsigned og = xb_add(&bar[XB_TOP], 1u);
            const unsigned tg = og / nx;
            if (og + 1u == (tg + 1u) * nx) xb_add(&bar[XB_TOPGEN], 1u);
            else XB_SPIN(xb_ld(&bar[XB_TOPGEN]) == tg, bar);
            __builtin_amdgcn_fence(__ATOMIC_ACQUIRE, "agent");
            xb_add(&bar[XB_XGEN(b.x)], 1u);
            asm volatile("s_waitcnt vmcnt(0)" ::: "memory");
        } else {
            XB_SPIN(xb_ld(&bar[XB_XGEN(b.x)]) == gen, bar);
            __builtin_amdgcn_fence(__ATOMIC_ACQUIRE, "agent");
            asm volatile("s_waitcnt vmcnt(0)" ::: "memory");
        }
    }
    __syncthreads();
}

struct Args { const float* in[N_IN]; float* out; unsigned char* ws; int ph_lo, ph_hi; };
typedef const __attribute__((address_space(4))) Args CA;
typedef CA* CArgs;
__device__ __forceinline__ CArgs get_args() { CArgs p = (CArgs)__builtin_amdgcn_kernarg_segment_ptr(); asm volatile("" : "+s"(p)); return p; }

__device__ __forceinline__ float shx(float v, int m, int lane) { return __builtin_bit_cast(float, __builtin_amdgcn_ds_bpermute((lane ^ m) << 2, __builtin_bit_cast(int, v))); }
#define DPPF(v, ctrl) __builtin_bit_cast(float, __builtin_amdgcn_update_dpp(0, __builtin_bit_cast(int, (v)), (ctrl), 0xF, 0xF, true))
__device__ __forceinline__ float sum8(float v) { v += DPPF(v, 0xB1); v += DPPF(v, 0x4E); v += DPPF(v, 0x141); return v; }
__device__ __forceinline__ float xor4(float v, int lane) { const float up = DPPF(v, 0x104), dn = DPPF(v, 0x114); return (lane & 4) ? dn : up; }
__device__ __forceinline__ float wave_sum(float v, int lane) {
    v += DPPF(v, 0xB1); v += DPPF(v, 0x4E); v += DPPF(v, 0x141); v += DPPF(v, 0x140);
    v += shx(v, 16, lane); v += shx(v, 32, lane); return v;
}
__device__ __forceinline__ float wave_sum_bp(float v, int lane) {
#pragma unroll
    for (int o = 1; o < 64; o <<= 1) v += shx(v, o, lane);
    return v;
}
__device__ __forceinline__ float wave_max(float v, int lane) {
#pragma unroll
    for (int o = 1; o < 64; o <<= 1) v = fmaxf(v, shx(v, o, lane));
    return v;
}
typedef float f32x2_t __attribute__((ext_vector_type(2))); typedef __bf16 bf16x2_t __attribute__((ext_vector_type(2)));
__device__ __forceinline__ unsigned cvtpk(float lo, float hi) { f32x2_t v = {lo, hi}; bf16x2_t b = __builtin_convertvector(v, bf16x2_t); return __builtin_bit_cast(unsigned, b); }
#ifndef PROBE_MASK
#define PROBE_MASK 0
#endif
#ifndef PROBE_SUB_A
#define PROBE_SUB_A -1
#endif
#ifndef PROBE_SUB_B
#define PROBE_SUB_B -1
#endif
#ifndef PROBE_SUBF
#define PROBE_SUBF 16
#endif
#ifndef PROBE_BLK
#define PROBE_BLK 0
#endif
#define PROBE_SUB(ws_, tid_, i_) do { if (PROBE_MASK || PROBE_SUB_A >= 0) { if (blockIdx.x == PROBE_BLK && (tid_) == 0) { asm volatile("s_waitcnt vmcnt(0) lgkmcnt(0)" ::: "memory"); \
        __hip_atomic_store((unsigned long long*)((ws_) + WS_CTL) + CW_TS / 2 + 128 + (i_), (unsigned long long)__builtin_amdgcn_s_memrealtime(), RLX_AGENT); } } } while (0)
__device__ __forceinline__ float gelu_tanh(float x) {
    const float y = 0.7978845608028654f * (x + 0.044715f * x * x * x);
    const float t = 1.0f - 2.0f * __builtin_amdgcn_rcpf(1.0f + __expf(2.0f * y));
    return 0.5f * x * (1.0f + t);
}

__device__ __forceinline__ void s5_build_mats(CArgs ap, LAS unsigned char* lds, int tid, int l, int g);
template <int MODE>
__device__ __forceinline__ void transpose_item(const float* W, int K, int N, bf16* WT, LAS float* scr, int item, int lane) {
    const int nblk = N / 32, kb = item / nblk, nb = item - kb * nblk, k0 = 64 * kb, n0 = 32 * nb;
#pragma unroll 8
    for (int i = 0; i < 32; ++i) { const int kk = 2 * i + (lane >> 5); scr[kk * 33 + (lane & 31)] = W[(size_t)(k0 + kk) * N + n0 + (lane & 31)]; }
    LDS_WAIT(); asm volatile("" ::: "memory");
    const int c = lane & 7;
#pragma unroll
    for (int j = 0; j < 4; ++j) { const int n = (lane >> 3) + 8 * j; const LAS float* s = scr + (8 * c) * 33 + n;
        const int nn = n0 + n; const int jj = nn >> 1;
        const int drow = (MODE == 0 || MODE == 2) ? nn : ((jj >> 7) * 256 + (nn & 1) * 128 + (jj & 127));
        if (MODE >= 1) {
            unsigned w0 = 0u, w1 = 0u;
            w0 = __builtin_amdgcn_cvt_pk_fp8_f32(32.0f * s[0 * 33], 32.0f * s[1 * 33], w0, false); w0 = __builtin_amdgcn_cvt_pk_fp8_f32(32.0f * s[2 * 33], 32.0f * s[3 * 33], w0, true);
            w1 = __builtin_amdgcn_cvt_pk_fp8_f32(32.0f * s[4 * 33], 32.0f * s[5 * 33], w1, false); w1 = __builtin_amdgcn_cvt_pk_fp8_f32(32.0f * s[6 * 33], 32.0f * s[7 * 33], w1, true);
            *(GAS v2u*)((unsigned char*)WT + (size_t)drow * K + k0 + 8 * c) = (v2u){w0, w1};
        } else {
            v4u o; o.x = pk2(s[0 * 33], s[1 * 33]); o.y = pk2(s[2 * 33], s[3 * 33]); o.z = pk2(s[4 * 33], s[5 * 33]); o.w = pk2(s[6 * 33], s[7 * 33]);
            *(GAS v4u*)(WT + (size_t)drow * K + k0 + 8 * c) = o; } }
    LDS_WAIT(); asm volatile("" ::: "memory");
}

__device__ __forceinline__ void phase_prologue(CArgs ap, LAS unsigned char* lds, int tid, int lane, int wave, int bid, int G) {
    CA& a = *ap;
    unsigned char* ws = a.ws;
    PROBE_SUB(ws, tid, 11);
    if (bid < 192) {
        LAS float* S = (LAS float*)lds;
        LAS float* R = (LAS float*)(lds + 17 * 1024 * 4);
        for (int idx = tid; idx < 17 * 1024; idx += NTHREADS) { const int r = idx >> 10, k = idx & 1023; const float v = r < 16 ? a.in[I_C][r * 1024 + k] : a.in[I_CCTX][k]; S[idx] = v / (1.0f + __expf(-v)); }
        __syncthreads();
        const int l = bid / 48, c0 = (bid % 48) * 128, col = tid & 127, kq = tid >> 7;
        float acc[17];
#pragma unroll
        for (int r = 0; r < 17; ++r) acc[r] = 0.f;
        const float* wp = a.in[I_WMOD] + ((size_t)l * 1024 + kq * 256) * 6144 + c0 + col;
#pragma unroll 4
        for (int k = 0; k < 256; ++k) { const float w = wp[(size_t)k * 6144];
#pragma unroll
            for (int r = 0; r < 17; ++r) acc[r] += S[r * 1024 + kq * 256 + k] * w; }
#pragma unroll
        for (int r = 0; r < 17; ++r) R[(kq * 17 + r) * 128 + col] = acc[r];
        __syncthreads();
        float* MOD = (float*)(ws + WS_MOD);
        for (int idx = tid; idx < 17 * 128; idx += NTHREADS) { const int r = idx >> 7, cc = idx & 127;
            const float v = R[(0 * 17 + r) * 128 + cc] + R[(1 * 17 + r) * 128 + cc] + R[(2 * 17 + r) * 128 + cc] + R[(3 * 17 + r) * 128 + cc] + a.in[I_BMOD][l * 6144 + c0 + cc];
            MOD[((size_t)l * 17 + r) * 6144 + c0 + cc] = v; }
    }
    else s5_build_mats(ap, lds, tid, (bid - 192) >> 4, (bid - 192) & 15);
    PROBE_SUB(ws, tid, 12);
    __syncthreads();
    {
        LAS float* scr = (LAS float*)(lds + wave * 16384);
        const int gw = bid * NWAVES + wave, NGW = G * NWAVES;
        constexpr int N_WGU = 128 * 1024, N_WD = 128 * 512, N_WIN = 4 * 2432, N_WO = 4 * 512, N_WAO = 4 * 256, N_WSO = 4 * 128, N_WCO = 4 * 128, N_WGLU = 4 * 32;
        constexpr int NITEMS = N_WGU + N_WD + N_WIN + N_WO + N_WAO + N_WSO + N_WCO + N_WGLU;
        for (int it = gw; it < NITEMS; it += NGW) {
            int r = it;
            if (r < N_WGU) { const int m = r >> 10; transpose_item<1>(a.in[I_WGU] + (size_t)m * 1024 * 2048, 1024, 2048, (bf16*)(ws + WS_WGU + (size_t)m * 2048 * 1024), scr, r & 1023, lane); continue; } r -= N_WGU;
            if (r < N_WD) { const int m = r >> 9; transpose_item<2>(a.in[I_WD] + (size_t)m * 1024 * 1024, 1024, 1024, (bf16*)(ws + WS_WD + (size_t)m * 1024 * 1024), scr, r & 511, lane); continue; } r -= N_WD;
            if (r < N_WIN) { const int m = r / 2432, it2 = r - m * 2432;
                if ((it2 % 152) < 56) transpose_item<0>(a.in[I_WIN] + (size_t)m * 1024 * DIN, 1024, DIN, (bf16*)(ws + WS_WIN) + (size_t)m * 1792 * 1024, scr, it2, lane);
                else transpose_item<2>(a.in[I_WIN] + (size_t)m * 1024 * DIN, 1024, DIN, (bf16*)(ws + WS_WIN8 + (size_t)m * 3072 * 1024 - (size_t)1792 * 1024), scr, it2, lane);
                continue; } r -= N_WIN;
            if (r < N_WO) { const int m = r >> 9; transpose_item<0>(a.in[I_WO] + (size_t)m * 1024 * 1024, 1024, 1024, (bf16*)(ws + WS_WO) + (size_t)m * 1024 * 1024, scr, r & 511, lane); continue; } r -= N_WO;
            if (r < N_WAO) { const int m = r >> 8; transpose_item<0>(a.in[I_WAO] + (size_t)m * 512 * 1024, 512, 1024, (bf16*)(ws + WS_WAO) + (size_t)m * 1024 * 512, scr, r & 255, lane); continue; } r -= N_WAO;
            if (r < N_WSO) { const int m = r >> 7; transpose_item<0>(a.in[I_WSO] + (size_t)m * 256 * 1024, 256, 1024, (bf16*)(ws + WS_WSO) + (size_t)m * 1024 * 256, scr, r & 127, lane); continue; } r -= N_WSO;
            if (r < N_WCO) { const int m = r >> 7; transpose_item<0>(a.in[I_WCO] + (size_t)m * 256 * 1024, 256, 1024, (bf16*)(ws + WS_WCO) + (size_t)m * 1024 * 256, scr, r & 127, lane); continue; } r -= N_WCO;
            { const int m = r >> 5; transpose_item<0>(a.in[I_WGLU] + (size_t)m * 256 * 256, 256, 256, (bf16*)(ws + WS_WGLU) + (size_t)m * 256 * 256, scr, r & 31, lane); }
        }
    }
    PROBE_SUB(ws, tid, 13);
    {
        const int gt = bid * NTHREADS + tid, NGT = G * NTHREADS;
        unsigned* WRF = (unsigned*)(ws + WS_WRT);
        for (int i = gt; i < 4 * 32 * 2 * 64 * 4; i += NGT) { const int jp = i & 3, ln = (i >> 2) & 63, nt = (i >> 8) & 1, ks = (i >> 9) & 31, l = i >> 14;
            const int e = nt * 16 + (ln & 15), k = 32 * ks + 8 * (ln >> 4) + 2 * jp;
            const float w0 = a.in[I_WR][((size_t)l * 1024 + k) * 32 + e], w1 = a.in[I_WR][((size_t)l * 1024 + k + 1) * 32 + e];
            const unsigned hi = cvtpk(w0, w1); const unsigned lo = cvtpk(w0 - bflo(hi), w1 - bfhi(hi));
            const size_t base = ((((size_t)l * 32 + ks) * 2 + nt) * 2) * 256 + ln * 4 + jp;
            WRF[base] = hi; WRF[base + 256] = lo; }
        float* ROPE = (float*)(ws + WS_ROPE);
        for (int i = gt; i < 2048 * 32; i += NGT) { const int t = i >> 5, p = i & 31; const float pos = (float)(p < 16 ? (t >> 6) : (t & 63));
            const float inv = powf(10000.0f, -(float)(p & 15) / 16.0f); float sn, cs; sincosf(pos * inv, &sn, &cs); ROPE[2 * i] = cs; ROPE[2 * i + 1] = sn; }
    }
}

template <int MODE>
__device__ __forceinline__ void phase_n1(CArgs ap, int l, int lane, int gw, int NGW) {
    CA& a = *ap;
    unsigned char* ws = a.ws;
    float* X = (float*)(ws + WS_X); bf16* H = (bf16*)(ws + WS_H);
    const float* MOD = (const float*)(ws + WS_MOD);
    const unsigned char* YS = (const unsigned char*)(ws + WS_YS8); const float* TOPG = (const float*)(ws + WS_TOPG); const int* SLOT = (const int*)(ws + WS_SLOT);
    const float* gn = a.in[I_N1G] + (l < DEPTH ? l : 0) * D;
    constexpr int RPT = 3;
    for (int row0 = gw; row0 < T; row0 += RPT * NGW) {
        int rowv[RPT], bb[RPT], sv[RPT], rv[RPT]; bool on[RPT];
        f32x4 v[RPT][4], tg[RPT]; int4 sl[RPT]; unsigned y8[RPT][4][4];
#pragma unroll
        for (int rr = 0; rr < RPT; ++rr) { const int row = row0 + rr * NGW; rowv[rr] = row; on[rr] = row < T; const int rowc = on[rr] ? row : row0;
            const int b = rowc / TB, s = rowc - b * TB; const bool isctx = s < CTX; bb[rr] = b; sv[rr] = s; rv[rr] = isctx ? 16 : b; if (MODE == 2 && isctx) on[rr] = false;
            const float* src = (MODE == 0) ? (isctx ? a.in[I_CTX] + ((size_t)b * CTX + s) * D : a.in[I_X] + ((size_t)b * SEQ + (s - CTX)) * D) : X + (size_t)rowc * D;
#pragma unroll
            for (int j = 0; j < 4; ++j) v[rr][j] = *(const f32x4*)(src + 4 * lane + 256 * j);
            if (MODE != 0) { tg[rr] = *(const f32x4*)(TOPG + (size_t)rowc * 4); sl[rr] = *(const int4*)(SLOT + (size_t)rowc * 4); } }
        if (MODE != 0) {
#pragma unroll
            for (int rr = 0; rr < RPT; ++rr) { const int sls[4] = {sl[rr].x, sl[rr].y, sl[rr].z, sl[rr].w};
#pragma unroll
                for (int k = 0; k < 4; ++k)
#pragma unroll
                    for (int j = 0; j < 4; ++j) y8[rr][k][j] = *(const unsigned*)((const unsigned char*)YS + (size_t)sls[k] * D + 4 * lane + 256 * j); }
        }
#pragma unroll
        for (int rr = 0; rr < RPT; ++rr) {
            if (!on[rr]) continue;
            const int row = rowv[rr], r = rv[rr];
            if (MODE != 0) {
                const float* g2 = MOD + ((size_t)(l - 1) * 17 + r) * 6144 + 5120;
#pragma unroll
                for (int j = 0; j < 4; ++j) { f32x4 acc = (f32x4){0.f, 0.f, 0.f, 0.f};
#pragma unroll
                    for (int k = 0; k < 4; ++k) { const unsigned w = y8[rr][k][j]; const f32x2 lo = __builtin_amdgcn_cvt_pk_f32_fp8(w, false), hi = __builtin_amdgcn_cvt_pk_f32_fp8(w, true); acc += tg[rr][k] * (f32x4){lo.x, lo.y, hi.x, hi.y}; }
                    v[rr][j] += *(const f32x4*)(g2 + 4 * lane + 256 * j) * acc; }
            }
            if (MODE == 2) {
                float* o = a.out + ((size_t)bb[rr] * SEQ + (sv[rr] - CTX)) * D;
#pragma unroll
                for (int j = 0; j < 4; ++j) *(f32x4*)(o + 4 * lane + 256 * j) = v[rr][j];
                continue;
            }
            float ss = 0.f;
#pragma unroll
            for (int j = 0; j < 4; ++j) { *(f32x4*)(X + (size_t)row * D + 4 * lane + 256 * j) = v[rr][j]; ss += (v[rr][j].x * v[rr][j].x + v[rr][j].y * v[rr][j].y) + (v[rr][j].z * v[rr][j].z + v[rr][j].w * v[rr][j].w); }
            const float rstd = rsqrtf(wave_sum(ss, lane) * (1.0f / D) + EPS);
            const float* md = MOD + ((size_t)l * 17 + r) * 6144;
#pragma unroll
            for (int j = 0; j < 4; ++j) { const int c = 4 * lane + 256 * j;
                const f32x4 g = *(const f32x4*)(gn + c), sh = *(const f32x4*)(md + c), sc = *(const f32x4*)(md + 1024 + c);
                const f32x4 h = (v[rr][j] * rstd * g) * (sc + 1.0f) + sh;
                v2u o; o.x = cvtpk(h.x, h.y); o.y = cvtpk(h.z, h.w); *(v2u*)(H + (size_t)row * D + c) = o;
                unsigned w8 = 0u; w8 = __builtin_amdgcn_cvt_pk_fp8_f32(h.x, h.y, w8, false); w8 = __builtin_amdgcn_cvt_pk_fp8_f32(h.z, h.w, w8, true);
                *(unsigned*)((unsigned char*)(ws + WS_H8) + (size_t)row * D + c) = w8; }
        }
    }
}

__device__ __forceinline__ void build_gc(CArgs ap, int l, int gt, int NGT) {
    CA& a = *ap; const float* MOD = (const float*)(a.ws + WS_MOD); float* GC = (float*)(a.ws + WS_GC) + (size_t)l * 17 * 1024;
    for (int i = gt; i < 17 * 1024; i += NGT) { const int r = i >> 10, k = i & 1023; GC[i] = a.in[I_N2G][l * D + k] * (1.0f + MOD[((size_t)l * 17 + r) * 6144 + 4096 + k]); }
}

__device__ __forceinline__ void phase_prep(CArgs ap, int l, int lane, int gw, int NGW) {
    CA& a = *ap;
    unsigned char* ws = a.ws;
    const bf16* P = (const bf16*)(ws + WS_PROJ); bf16* YB = (bf16*)(ws + WS_YB); bf16* QN = (bf16*)(ws + WS_QN); bf16* KN = (bf16*)(ws + WS_KN);
    const float* ROPE = (const float*)(ws + WS_ROPE);
    const float* cw = a.in[I_CONVW] + l * 3 * 256;
    const int c4 = 4 * lane, d0 = (lane & 7) * 8;
    const f32x4 w0 = *(const f32x4*)(cw + c4), w1 = *(const f32x4*)(cw + 256 + c4), w2 = *(const f32x4*)(cw + 512 + c4);
    const f32x4 gq0 = *(const f32x4*)(a.in[I_QG] + l * 64 + d0), gq1 = *(const f32x4*)(a.in[I_QG] + l * 64 + d0 + 4), gk0 = *(const f32x4*)(a.in[I_KG] + l * 64 + d0), gk1 = *(const f32x4*)(a.in[I_KG] + l * 64 + d0 + 4);
    const bool first = (lane & 4) == 0;
    constexpr int RPT = 4;
    for (int row0 = gw; row0 < T; row0 += RPT * NGW) {
        v2u cc[RPT][3], cx[RPT][3], cb[RPT]; v4u qw[RPT], kw[RPT]; f32x4 rp[RPT][4]; bool isc[RPT], on[RPT]; int rowv[RPT];
#pragma unroll
        for (int rr = 0; rr < RPT; ++rr) { const int rowt = row0 + rr * NGW; on[rr] = rowt < T; const int row = on[rr] ? rowt : row0; rowv[rr] = row;
            const int b = row / TB, s = row - b * TB; const bool isctx = s < CTX; isc[rr] = isctx;
            const int lo = isctx ? 0 : CTX, hi = isctx ? CTX : TB;
#pragma unroll
            for (int d = 0; d < 3; ++d) { const int s2 = s + d - 1; const bool ok = s2 >= lo && s2 < hi; const bf16* pr = P + (size_t)(ok ? row + d - 1 : row) * DIN;
                cc[rr][d] = *(const v2u*)(pr + OFF_CC + c4); cx[rr][d] = *(const v2u*)(pr + OFF_CX + c4); if (!ok) { cc[rr][d] = (v2u){0u, 0u}; } }
            cb[rr] = *(const v2u*)(P + (size_t)row * DIN + OFF_CB + c4);
            qw[rr] = *(const v4u*)(P + (size_t)row * DIN + OFF_Q + lane * 8); kw[rr] = *(const v4u*)(P + (size_t)row * DIN + OFF_K + (lane & 15) * 8);
            const float* rpp = ROPE + ((size_t)(isctx ? 0 : s - CTX) * 32 + (d0 & 31)) * 2;
#pragma unroll
            for (int i = 0; i < 4; ++i) rp[rr][i] = *(const f32x4*)(rpp + 4 * i); }
#pragma unroll
        for (int rr = 0; rr < RPT; ++rr) {
            if (!on[rr]) continue;
            const int row = rowv[rr];
            { f32x4 zz[3];
#pragma unroll
              for (int d = 0; d < 3; ++d) zz[d] = (f32x4){bflo(cc[rr][d].x) * bflo(cx[rr][d].x), bfhi(cc[rr][d].x) * bfhi(cx[rr][d].x), bflo(cc[rr][d].y) * bflo(cx[rr][d].y), bfhi(cc[rr][d].y) * bfhi(cx[rr][d].y)};
              const f32x4 yv = (f32x4){bflo(cb[rr].x), bfhi(cb[rr].x), bflo(cb[rr].y), bfhi(cb[rr].y)} * (w0 * zz[0] + w1 * zz[1] + w2 * zz[2]);
              v2u o; o.x = cvtpk(yv.x, yv.y); o.y = cvtpk(yv.z, yv.w); *(v2u*)(YB + (size_t)row * 256 + c4) = o; }
#pragma unroll
            for (int pass = 0; pass < 2; ++pass) {
                const v4u w = pass ? kw[rr] : qw[rr];
                float x[8] = {bflo(w.x), bfhi(w.x), bflo(w.y), bfhi(w.y), bflo(w.z), bfhi(w.z), bflo(w.w), bfhi(w.w)};
                float ss = 0.f;
#pragma unroll
                for (int i = 0; i < 8; ++i) ss += x[i] * x[i];
                ss = sum8(ss);
                const float rstd = rsqrtf(ss * (1.0f / 64.0f) + EPS) * (pass ? 1.0f : 0.125f);
                const f32x4 ga = pass ? gk0 : gq0, gb = pass ? gk1 : gq1;
#pragma unroll
                for (int i = 0; i < 8; ++i) x[i] = x[i] * rstd * (i < 4 ? ga[i] : gb[i - 4]);
                if (!isc[rr]) {
#pragma unroll
                    for (int i = 0; i < 8; ++i) { const float pr = xor4(x[i], lane); const float cs = rp[rr][i >> 1][2 * (i & 1)], sn = rp[rr][i >> 1][2 * (i & 1) + 1];
                        x[i] = first ? (x[i] * cs - pr * sn) : (pr * sn + x[i] * cs); }
                }
                v4u o; o.x = cvtpk(x[0], x[1]); o.y = cvtpk(x[2], x[3]); o.z = cvtpk(x[4], x[5]); o.w = cvtpk(x[6], x[7]);
                if (pass == 0) *(v4u*)(QN + (size_t)row * 512 + lane * 8) = o;
                else if (lane < 16) *(v4u*)(KN + (size_t)row * 128 + lane * 8) = o;
            }
        }
    }
}

typedef short bf16x8v __attribute__((ext_vector_type(8)));
__device__ __forceinline__ f32x4 mfma16(const v4u& a, const v4u& b, const f32x4& c) { return __builtin_amdgcn_mfma_f32_16x16x32_bf16(__builtin_bit_cast(bf16x8v, a), __builtin_bit_cast(bf16x8v, b), c, 0, 0, 0); }

__device__ __forceinline__ void s5_build_mats(CArgs ap, LAS unsigned char* lds, int tid, int l, int g) {
    CA& a = *ap;
    LAS float* LP = (LAS float*)lds;
    LAS float* BB = LP + 2 * 9 * 64 * 2;
    LAS float* CC = BB + 2 * 64 * 16 * 2;
    for (int i = tid; i < 2 * 9 * 64; i += NTHREADS) { const int z = i / 576, d = (i / 64) % 9, p = i & 63; const int pi = (l * 2 + z) * 16 + g;
        const float lre = a.in[I_LRE][pi * 64 + p], lim = a.in[I_LIM][pi * 64 + p], dt = expf(a.in[I_LDT][pi]);
        float sn, cs; sincosf((float)d * lim * dt, &sn, &cs); const float er = expf((float)d * lre * dt);
        LP[2 * i] = er * cs; LP[2 * i + 1] = er * sn; }
    for (int i = tid; i < 2 * 64 * 16; i += NTHREADS) { const int z = i >> 10, p = (i >> 4) & 63, h = i & 15; const int pi = (l * 2 + z) * 16 + g;
        const float lre = a.in[I_LRE][pi * 64 + p], lim = a.in[I_LIM][pi * 64 + p], dt = expf(a.in[I_LDT][pi]);
        float sn, cs; sincosf(lim * dt, &sn, &cs); const float er = expf(lre * dt); const float nr = er * cs - 1.0f, ni = er * sn, d2 = lre * lre + lim * lim;
        const float qr = (nr * lre + ni * lim) / d2, qi = (ni * lre - nr * lim) / d2;
        const float br = a.in[I_BRE][((size_t)pi * 64 + p) * 16 + h], bi = a.in[I_BIM][((size_t)pi * 64 + p) * 16 + h];
        BB[2 * i] = qr * br - qi * bi; BB[2 * i + 1] = qr * bi + qi * br;
        const int hc = (i >> 6) & 15, pc = i & 63;
        CC[2 * i] = a.in[I_CRE][((size_t)pi * 16 + hc) * 64 + pc]; CC[2 * i + 1] = a.in[I_CIM][((size_t)pi * 16 + hc) * 64 + pc]; }
    __syncthreads();
    LAS float* KT = CC + 2 * 16 * 64 * 2;
    { const int e0 = tid * 8; const int z = e0 >> 11, d = (e0 >> 8) & 7, h = (e0 >> 4) & 15, h20 = e0 & 15; float kv[8];
#pragma unroll
      for (int j = 0; j < 8; ++j) kv[j] = 0.f;
      for (int p = 0; p < 64; ++p) { const float cr = CC[2 * ((z * 16 + h) * 64 + p)], ci = CC[2 * ((z * 16 + h) * 64 + p) + 1], lr = LP[2 * ((z * 9 + d) * 64 + p)], li = LP[2 * ((z * 9 + d) * 64 + p) + 1];
          const float tr = cr * lr - ci * li, ti = cr * li + ci * lr;
#pragma unroll
          for (int j = 0; j < 8; ++j) kv[j] += tr * BB[2 * ((z * 64 + p) * 16 + h20 + j)] - ti * BB[2 * ((z * 64 + p) * 16 + h20 + j) + 1]; }
#pragma unroll
      for (int j = 0; j < 8; ++j) KT[e0 + j] = kv[j]; }
    __syncthreads();
    bf16* MS = (bf16*)(a.ws + WS_MS) + (size_t)(l * 16 + g) * 256 * 128; bf16* W = (bf16*)(a.ws + WS_W5) + (size_t)(l * 16 + g) * 128 * 384;
    for (int i = tid; i < 256 * 128; i += NTHREADS) { const int j = i & 7, ln = (i >> 3) & 63, nt = (i >> 9) & 15, ks = i >> 13; const int n = nt * 16 + (ln & 15), k = ks * 32 + (ln >> 4) * 8 + j;
        const int z = n >> 7, part = n & 1, p = (n >> 1) & 63, a2 = k >> 4, h2 = k & 15; const int e = z == 0 ? 7 - a2 : a2;
        const float lr = LP[2 * ((z * 9 + e) * 64 + p)], li = LP[2 * ((z * 9 + e) * 64 + p) + 1], br = BB[2 * ((z * 64 + p) * 16 + h2)], bi = BB[2 * ((z * 64 + p) * 16 + h2) + 1];
        MS[i] = (bf16)f2bf(part == 0 ? lr * br - li * bi : lr * bi + li * br); }
    for (int i = tid; i < 128 * 384; i += NTHREADS) { const int j = i & 7, ln = (i >> 3) & 63, nt = (i >> 9) & 7, ks = i >> 12; const int n = nt * 16 + (ln & 15), k = ks * 32 + (ln >> 4) * 8 + j;
        const int aa = n >> 4, h = n & 15; float v = 0.f;
        if (k < 128) { const int a2 = k >> 4, h2 = k & 15;
            if (a2 <= aa) v += KT[((0 * 8 + (aa - a2)) * 16 + h) * 16 + h2];
            if (a2 >= aa) v += KT[((1 * 8 + (a2 - aa)) * 16 + h) * 16 + h2];
            if (a2 == aa && h2 == h) v += a.in[I_SD][l * 256 + g * 16 + h];
        } else { const int z = (k - 128) >> 7, kk = (k - 128) & 127, part = kk & 1, p = kk >> 1; const int d = z == 0 ? aa + 1 : 8 - aa;
            const float cr = CC[2 * ((z * 16 + h) * 64 + p)], ci = CC[2 * ((z * 16 + h) * 64 + p) + 1], lr = LP[2 * ((z * 9 + d) * 64 + p)], li = LP[2 * ((z * 9 + d) * 64 + p) + 1];
            v = part == 0 ? (cr * lr - ci * li) : -(cr * li + ci * lr); }
        W[i] = (bf16)f2bf(v); }
    __syncthreads();
}

constexpr int S5_ROWS = T / 8, S5_RT = S5_ROWS / 32;
__device__ __forceinline__ void s5a_block(CArgs ap, int l, int blk, LAS unsigned char* lds, int tid, int lane, int wave) {
    CA& a = *ap; unsigned char* ws = a.ws;
    const int g = blk & 15, part = blk >> 4, c = lane & 15, q = lane >> 4;
    { const v4u* src = (const v4u*)((const bf16*)(ws + WS_MS) + (size_t)(l * 16 + g) * 256 * 128); LAS v4u* dst = (LAS v4u*)lds;
#pragma unroll
      for (int i = 0; i < 8; ++i) dst[tid + i * NTHREADS] = src[tid + i * NTHREADS]; }
    __syncthreads();
    const LAS v4u* Bl = (const LAS v4u*)lds + lane;
    for (int mt = wave; mt < 18; mt += NWAVES) {
        const int r0 = part * 288 + mt * 16;
        const bf16* Pu = (const bf16*)(ws + WS_PROJ) + ((size_t)(r0 + c) * 8 + (q >> 1)) * DIN + OFF_U + g * 16 + (q & 1) * 8;
        v4u af[4];
#pragma unroll
        for (int ks = 0; ks < 4; ++ks) af[ks] = *(const v4u*)(Pu + (size_t)2 * ks * DIN);
        f32x4 acc[16];
#pragma unroll
        for (int n = 0; n < 16; ++n) acc[n] = (f32x4){0.f, 0.f, 0.f, 0.f};
#pragma unroll
        for (int ks = 0; ks < 4; ++ks) { v4u bfr[16];
#pragma unroll
            for (int n = 0; n < 16; ++n) bfr[n] = Bl[(ks * 16 + n) * 64];
#pragma unroll
            for (int n = 0; n < 16; ++n) acc[n] = mfma16(bfr[n], af[ks], acc[n]);
            asm volatile("" ::: "memory"); }
        float* Sp = (float*)(ws + WS_S5S) + ((size_t)g * S5_ROWS + r0 + c) * 256 + 4 * q;
#pragma unroll
        for (int n = 0; n < 16; ++n) *(f32x4*)(Sp + n * 16) = acc[n];
    }
    VM_WAIT(); __syncthreads();
}
__device__ __forceinline__ void s5b_unit(CArgs ap, int l, int u, int lane) {
    CA& a = *ap; unsigned char* ws = a.ws;
    const int b = u & 15, z = (u >> 4) & 1, g = u >> 5, p = lane; const int pi = (l * 2 + z) * 16 + g;
    const float lre = a.in[I_LRE][pi * 64 + p], lim = a.in[I_LIM][pi * 64 + p], dt = expf(a.in[I_LDT][pi]);
    float sn, cs; sincosf(8.0f * lim * dt, &sn, &cs); const float er = expf(8.0f * lre * dt); const float l8r = er * cs, l8i = er * sn;
    const f32x2* S = (const f32x2*)((const float*)(ws + WS_S5S) + ((size_t)g * S5_ROWS + b * 288) * 256 + z * 128) + p;
    unsigned* XI = (unsigned*)((bf16*)(ws + WS_XIN) + ((size_t)(z * 16 + g) * S5_ROWS + b * 288) * 128) + p;
    float xr = 0.f, xi = 0.f;
    constexpr int BS = 32;
    f32x2 sv[BS];
#pragma unroll
    for (int j = 0; j < BS; ++j) { const int cc = z == 0 ? j : 31 - j; sv[j] = S[(size_t)cc * 128]; }
    for (int i0 = 0; i0 < 288; i0 += BS) {
        f32x2 nv[BS];
        if (i0 + BS < 288) {
#pragma unroll
            for (int j = 0; j < BS; ++j) { const int i = i0 + BS + j; const int cc = z == 0 ? i : (i < 32 ? 31 - i : 319 - i); nv[j] = S[(size_t)cc * 128]; }
        }
        unsigned ov[BS];
#pragma unroll
        for (int j = 0; j < BS; ++j) { ov[j] = cvtpk(xr, xi);
            const float nr = l8r * xr - l8i * xi + sv[j].x, ni = l8r * xi + l8i * xr + sv[j].y; xr = nr; xi = ni; }
#pragma unroll
        for (int j = 0; j < BS; ++j) { const int i = i0 + j; const int cc = z == 0 ? i : (i < 32 ? 31 - i : 319 - i); XI[(size_t)cc * 64] = ov[j]; }
#pragma unroll
        for (int j = 0; j < BS; ++j) sv[j] = nv[j];
    }
}
__device__ __forceinline__ void s5c_block(CArgs ap, int l, int blk, LAS unsigned char* lds, int tid, int lane, int wave) {
    CA& a = *ap; unsigned char* ws = a.ws;
    const int g = blk & 15, part = blk >> 4, c = lane & 15, q = lane >> 4;
    { const v4u* src = (const v4u*)((const bf16*)(ws + WS_W5) + (size_t)(l * 16 + g) * 128 * 384); LAS v4u* dst = (LAS v4u*)lds;
#pragma unroll
      for (int i = 0; i < 12; ++i) dst[tid + i * NTHREADS] = src[tid + i * NTHREADS]; }
    __syncthreads();
    const LAS v4u* Bl = (const LAS v4u*)lds + lane;
    for (int mt = wave; mt < 18; mt += NWAVES) {
        const int r0 = part * 288 + mt * 16;
        const bf16* Pu = (const bf16*)(ws + WS_PROJ) + ((size_t)(r0 + c) * 8 + (q >> 1)) * DIN + OFF_U + g * 16 + (q & 1) * 8;
        const bf16* X0 = (const bf16*)(ws + WS_XIN) + ((size_t)g * S5_ROWS + r0 + c) * 128 + q * 8; const bf16* X1 = X0 + (size_t)16 * S5_ROWS * 128;
        v4u af[12];
#pragma unroll
        for (int ks = 0; ks < 4; ++ks) { af[ks] = *(const v4u*)(Pu + (size_t)2 * ks * DIN); af[4 + ks] = *(const v4u*)(X0 + ks * 32); af[8 + ks] = *(const v4u*)(X1 + ks * 32); }
        f32x4 acc[8];
#pragma unroll
        for (int n = 0; n < 8; ++n) acc[n] = (f32x4){0.f, 0.f, 0.f, 0.f};
#pragma unroll
        for (int ks = 0; ks < 12; ++ks) { v4u bfr[8];
#pragma unroll
            for (int n = 0; n < 8; ++n) bfr[n] = Bl[(ks * 8 + n) * 64];
#pragma unroll
            for (int n = 0; n < 8; ++n) acc[n] = mfma16(bfr[n], af[ks], acc[n]);
            if (ks & 1) asm volatile("" ::: "memory"); }
        bf16* Zp = (bf16*)(ws + WS_Z) + (size_t)(r0 + c) * 8 * 256 + g * 16 + 4 * q;
#pragma unroll
        for (int n = 0; n < 8; ++n) { const f32x4 y = acc[n]; v2u o; o.x = cvtpk(gelu_tanh(y[0]), gelu_tanh(y[1])); o.y = cvtpk(gelu_tanh(y[2]), gelu_tanh(y[3])); *(v2u*)(Zp + n * 256) = o; }
    }
    __syncthreads();
}

typedef float f32x16 __attribute__((ext_vector_type(16)));
__device__ __forceinline__ f32x16 mfma32(const v4u& a, const v4u& b, const f32x16& c) { return __builtin_amdgcn_mfma_f32_32x32x16_bf16(__builtin_bit_cast(bf16x8v, a), __builtin_bit_cast(bf16x8v, b), c, 0, 0, 0); }
struct AttnFrag { v4u ka[4]; v4u va[2][2]; };
__device__ __forceinline__ void attn_load(AttnFrag& f, const bf16* KN, const bf16* VT, int s0, int r) {
#pragma unroll
    for (int ks = 0; ks < 4; ++ks) f.ka[ks] = *(const v4u*)(KN + (size_t)(s0 + r) * 128 + 16 * ks);
#pragma unroll
    for (int mt = 0; mt < 2; ++mt)
#pragma unroll
        for (int s = 0; s < 2; ++s) f.va[mt][s] = *(const v4u*)(VT + (size_t)mt * 32 * TB + s0 + 16 * s);
}
__device__ __forceinline__ void attn_item(CArgs ap, int l, bool lat, int idx, int lane) {
    CA& a = *ap; unsigned char* ws = a.ws;
    int b, hp, qg;
    if (lat) { b = idx >> 8; qg = (idx >> 2) & 63; hp = idx & 3; } else { b = idx >> 5; qg = (idx >> 2) & 7; hp = idx & 3; }
    const int g2 = hp >> 1, r = lane & 31, h = lane >> 5, q0 = qg * 32;
    const int qrow = b * TB + (lat ? CTX : 0) + q0 + r;
    const bf16* KN = (const bf16*)(ws + WS_KN) + (size_t)b * TB * 128 + g2 * 64 + 8 * h;
    const bf16* VT = (const bf16*)(ws + WS_VT) + ((size_t)(b * 2 + g2) * 64 + r) * TB + 8 * h;
    v4u bq[2][4];
#pragma unroll
    for (int hh = 0; hh < 2; ++hh)
#pragma unroll
        for (int ks = 0; ks < 4; ++ks) bq[hh][ks] = *(const v4u*)((const bf16*)(ws + WS_QN) + (size_t)qrow * 512 + (2 * hp + hh) * 64 + 16 * ks + 8 * h);
    f32x16 o[2][2];
#pragma unroll
    for (int hh = 0; hh < 2; ++hh)
#pragma unroll
        for (int i = 0; i < 16; ++i) { o[hh][0][i] = 0.f; o[hh][1][i] = 0.f; }
    constexpr float L2E = 1.4426950408889634f;
    float m[2], lsum[2];
#pragma unroll
    for (int hh = 0; hh < 2; ++hh) { m[hh] = a.in[I_SINK][l * 8 + 2 * hp + hh] * L2E; lsum[hh] = h == 0 ? 1.0f : 0.0f; }
    unsigned keep1 = 0u, keep2 = 0u;
#pragma unroll
    for (int i = 0; i < 16; ++i) { const int jj = (i & 3) + 8 * (i >> 2) + 4 * h; keep1 |= (jj >= r ? 1u : 0u) << i; keep2 |= (jj <= r ? 1u : 0u) << i; }
    const int tlo = lat ? (4 - qg > 0 ? 4 - qg : 0) : 9, thi = lat ? (67 - qg < 8 ? 67 - qg : 8) : -1;
    int tt = tlo;
    AttnFrag cur, nxt;
    attn_load(cur, KN, VT, tt < 9 ? CTX + q0 - 128 + 32 * tt : 32 * (tt - 9), r);
    for (;;) {
        const int tn = (tt == thi) ? 9 : tt + 1; const bool more = tn <= 16;
        if (more) attn_load(nxt, KN, VT, tn < 9 ? CTX + q0 - 128 + 32 * tn : 32 * (tn - 9), r);
        const int mode = tt == 0 ? 1 : (tt == 8 ? 2 : 0);
#pragma unroll
        for (int hh = 0; hh < 2; ++hh) {
            f32x16 st;
#pragma unroll
            for (int i = 0; i < 16; ++i) st[i] = 0.f;
#pragma unroll
            for (int ks = 0; ks < 4; ++ks) st = mfma32(cur.ka[ks], bq[hh][ks], st);
            if (mode != 0) {
                asm volatile("" ::: "memory");
                const unsigned kp = mode == 1 ? keep1 : keep2;
#pragma unroll
                for (int i = 0; i < 16; ++i) if (!((kp >> i) & 1u)) st[i] = -INFINITY;
            }
            float mx = st[0];
#pragma unroll
            for (int i = 1; i < 16; ++i) mx = fmaxf(mx, st[i]);
            mx = fmaxf(mx, shx(mx, 32, lane));
            const float mn = fmaxf(m[hh], mx * L2E), al = __builtin_amdgcn_exp2f(m[hh] - mn); m[hh] = mn;
            float ps = 0.f;
#pragma unroll
            for (int i = 0; i < 16; ++i) { st[i] = __builtin_amdgcn_exp2f(__builtin_fmaf(st[i], L2E, -mn)); ps += st[i]; }
            lsum[hh] = lsum[hh] * al + ps;
#pragma unroll
            for (int i = 0; i < 16; ++i) { o[hh][0][i] *= al; o[hh][1][i] *= al; }
#pragma unroll
            for (int s = 0; s < 2; ++s) { v4u pb; pb.x = cvtpk(st[8 * s + 0], st[8 * s + 1]); pb.y = cvtpk(st[8 * s + 2], st[8 * s + 3]); pb.z = cvtpk(st[8 * s + 4], st[8 * s + 5]); pb.w = cvtpk(st[8 * s + 6], st[8 * s + 7]);
                o[hh][0] = mfma32(cur.va[0][s], pb, o[hh][0]); o[hh][1] = mfma32(cur.va[1][s], pb, o[hh][1]); }
        }
        if (!more) break;
        cur = nxt; tt = tn;
    }
#pragma unroll
    for (int hh = 0; hh < 2; ++hh) {
        const float lt = lsum[hh] + shx(lsum[hh], 32, lane); const float inv = 1.0f / lt;
        bf16* op = (bf16*)(ws + WS_YA) + (size_t)qrow * 512 + (2 * hp + hh) * 64 + 4 * h;
#pragma unroll
        for (int gq = 0; gq < 4; ++gq) { v2u w0; w0.x = cvtpk(o[hh][0][4 * gq] * inv, o[hh][0][4 * gq + 1] * inv); w0.y = cvtpk(o[hh][0][4 * gq + 2] * inv, o[hh][0][4 * gq + 3] * inv); *(v2u*)(op + 8 * gq) = w0;
            v2u w1; w1.x = cvtpk(o[hh][1][4 * gq] * inv, o[hh][1][4 * gq + 1] * inv); w1.y = cvtpk(o[hh][1][4 * gq + 2] * inv, o[hh][1][4 * gq + 3] * inv); *(v2u*)(op + 32 + 8 * gq) = w1; }
    }
}
__device__ __forceinline__ void vt_item(CArgs ap, int item, int lane) {
    CA& a = *ap; unsigned char* ws = a.ws;
    const int tile = item >> 1, g2 = item & 1; const int row = tile * 64 + lane; const int b = row / TB, s = row - b * TB;
    const bf16* vp = (const bf16*)(ws + WS_PROJ) + (size_t)row * DIN + OFF_V + g2 * 64;
    const int k16 = s & 15, sp = (s & ~15) | ((((k16 >> 2) & 1) << 3) | (((k16 >> 3) & 1) << 2) | (k16 & 3));
    bf16* vt = (bf16*)(ws + WS_VT) + (size_t)(b * 2 + g2) * 64 * TB + sp;
#pragma unroll
    for (int i = 0; i < 8; ++i) { const v4u w = *(const v4u*)(vp + 8 * i);
        vt[(size_t)(8 * i + 0) * TB] = (bf16)(w.x & 0xffffu); vt[(size_t)(8 * i + 1) * TB] = (bf16)(w.x >> 16); vt[(size_t)(8 * i + 2) * TB] = (bf16)(w.y & 0xffffu); vt[(size_t)(8 * i + 3) * TB] = (bf16)(w.y >> 16);
        vt[(size_t)(8 * i + 4) * TB] = (bf16)(w.z & 0xffffu); vt[(size_t)(8 * i + 5) * TB] = (bf16)(w.z >> 16); vt[(size_t)(8 * i + 6) * TB] = (bf16)(w.w & 0xffffu); vt[(size_t)(8 * i + 7) * TB] = (bf16)(w.w >> 16); }
}

__device__ __forceinline__ void phase_n2(CArgs ap, int l, LAS unsigned char* lds, int tid, int lane, int wave, int bid, int G) {
    CA& a = *ap;
    unsigned char* ws = a.ws;
    const float* X = (const float*)(ws + WS_X); bf16* H = (bf16*)(ws + WS_H); const float* MOD = (const float*)(ws + WS_MOD);
    float* TOPG = (float*)(ws + WS_TOPG); int* SLOT = (int*)(ws + WS_SLOT); unsigned* CNT = (unsigned*)(ws + WS_CTL) + CW_CNT + l * 32;
    LAS unsigned* lcnt = (LAS unsigned*)(lds + LCNT_OFF);
    { const v4u* src = (const v4u*)((const unsigned*)(ws + WS_WRT) + (size_t)l * 32768); LAS v4u* dst = (LAS v4u*)lds;
#pragma unroll
      for (int i = 0; i < 16; ++i) dst[tid + i * NTHREADS] = src[tid + i * NTHREADS]; }
    if (tid < 32) lcnt[tid] = 0u;
    __syncthreads();
    const LAS v4u* Bl = (const LAS v4u*)lds + lane;
    LAS float* scr = (LAS float*)(lds + SCR_OFF) + wave * (16 * 33);
    const int c = lane & 15, q = lane >> 4;
    const bool skipctx = l == DEPTH - 1;
    const int tpb = (T / 16) / G;
    for (int tl = wave; tl < tpb; tl += NWAVES) {
        const int row0 = (bid * tpb + tl) * 16; const int b = row0 / TB, s0 = row0 - b * TB; const bool isctx = s0 < CTX; const int r = isctx ? 16 : b;
        if (skipctx && isctx) continue;
        const float* xr = X + (size_t)(row0 + c) * D + 8 * q;
        float ss = 0.f;
#pragma unroll 16
        for (int ks = 0; ks < 32; ++ks) { const f32x4 x0 = *(const f32x4*)(xr + 32 * ks), x1 = *(const f32x4*)(xr + 32 * ks + 4);
            ss += (x0.x * x0.x + x0.y * x0.y) + (x0.z * x0.z + x0.w * x0.w) + (x1.x * x1.x + x1.y * x1.y) + (x1.z * x1.z + x1.w * x1.w); }
        ss += shx(ss, 16, lane); ss += shx(ss, 32, lane);
        const float rstd = rsqrtf(ss * (1.0f / D) + EPS);
        const float* md = MOD + ((size_t)l * 17 + r) * 6144 + 3072 + 8 * q; const float* gc = (const float*)(ws + WS_GC) + ((size_t)l * 17 + r) * 1024 + 8 * q;
        unsigned char* h8 = (unsigned char*)(ws + WS_H8) + (size_t)(row0 + c) * D + 8 * q;
        f32x4 acc[2] = {(f32x4){0.f, 0.f, 0.f, 0.f}, (f32x4){0.f, 0.f, 0.f, 0.f}};
#pragma unroll 1
        for (int k4 = 0; k4 < 32; k4 += 4) {
          f32x4 xv[4][2], gv[4][2], hv[4][2];
#pragma unroll
          for (int u = 0; u < 4; ++u) { const int ks = k4 + u;
              xv[u][0] = *(const f32x4*)(xr + 32 * ks); xv[u][1] = *(const f32x4*)(xr + 32 * ks + 4); gv[u][0] = *(const f32x4*)(gc + 32 * ks); gv[u][1] = *(const f32x4*)(gc + 32 * ks + 4);
              hv[u][0] = *(const f32x4*)(md + 32 * ks); hv[u][1] = *(const f32x4*)(md + 32 * ks + 4); }
#pragma unroll
          for (int u = 0; u < 4; ++u) { const int ks = k4 + u;
            const f32x4 y0 = (xv[u][0] * rstd) * gv[u][0] + hv[u][0], y1 = (xv[u][1] * rstd) * gv[u][1] + hv[u][1];
            v4u ahi; ahi.x = cvtpk(y0.x, y0.y); ahi.y = cvtpk(y0.z, y0.w); ahi.z = cvtpk(y1.x, y1.y); ahi.w = cvtpk(y1.z, y1.w);
            { unsigned w0 = 0u, w1 = 0u;
              w0 = __builtin_amdgcn_cvt_pk_fp8_f32(y0.x, y0.y, w0, false); w0 = __builtin_amdgcn_cvt_pk_fp8_f32(y0.z, y0.w, w0, true);
              w1 = __builtin_amdgcn_cvt_pk_fp8_f32(y1.x, y1.y, w1, false); w1 = __builtin_amdgcn_cvt_pk_fp8_f32(y1.z, y1.w, w1, true);
              *(v2u*)(h8 + 32 * ks) = (v2u){w0, w1}; }
            v4u alo; alo.x = cvtpk(y0.x - bflo(ahi.x), y0.y - bfhi(ahi.x)); alo.y = cvtpk(y0.z - bflo(ahi.y), y0.w - bfhi(ahi.y)); alo.z = cvtpk(y1.x - bflo(ahi.z), y1.y - bfhi(ahi.z)); alo.w = cvtpk(y1.z - bflo(ahi.w), y1.w - bfhi(ahi.w));
#pragma unroll
            for (int nt = 0; nt < 2; ++nt) { const v4u whi = Bl[((ks * 2 + nt) * 2 + 0) * 64], wlo = Bl[((ks * 2 + nt) * 2 + 1) * 64];
                acc[nt] = mfma16(whi, ahi, acc[nt]); acc[nt] = mfma16(wlo, ahi, acc[nt]); acc[nt] = mfma16(whi, alo, acc[nt]); }
          }
        }
#pragma unroll
        for (int nt = 0; nt < 2; ++nt) { const f32x4 bb = *(const f32x4*)(a.in[I_BR] + l * 32 + nt * 16 + 4 * q);
#pragma unroll
            for (int j = 0; j < 4; ++j) scr[c * 33 + nt * 16 + 4 * q + j] = acc[nt][j] + bb[j]; }
        LDS_WAIT(); asm volatile("" ::: "memory");
        if (lane < 16) {
            float v0 = -INFINITY, v1 = -INFINITY, v2 = -INFINITY, v3 = -INFINITY; int e0 = 0, e1 = 0, e2 = 0, e3 = 0;
#pragma unroll
            for (int e = 0; e < 32; ++e) { const float x = scr[lane * 33 + e];
                const bool b0 = x > v0, b1 = x > v1, b2 = x > v2, b3 = x > v3;
                v3 = b2 ? v2 : (b3 ? x : v3); e3 = b2 ? e2 : (b3 ? e : e3);
                v2 = b1 ? v1 : (b2 ? x : v2); e2 = b1 ? e1 : (b2 ? e : e2);
                v1 = b0 ? v0 : (b1 ? x : v1); e1 = b0 ? e0 : (b1 ? e : e1);
                v0 = b0 ? x : v0; e0 = b0 ? e : e0; }
            const float x1 = __expf(v1 - v0), x2 = __expf(v2 - v0), x3 = __expf(v3 - v0); const float inv = 1.0f / (1.0f + x1 + x2 + x3);
            const unsigned r0 = __hip_atomic_fetch_add(lcnt + e0, 1u, __ATOMIC_RELAXED, __HIP_MEMORY_SCOPE_WORKGROUP), r1 = __hip_atomic_fetch_add(lcnt + e1, 1u, __ATOMIC_RELAXED, __HIP_MEMORY_SCOPE_WORKGROUP),
                           r2 = __hip_atomic_fetch_add(lcnt + e2, 1u, __ATOMIC_RELAXED, __HIP_MEMORY_SCOPE_WORKGROUP), r3 = __hip_atomic_fetch_add(lcnt + e3, 1u, __ATOMIC_RELAXED, __HIP_MEMORY_SCOPE_WORKGROUP);
            *(f32x4*)(TOPG + (size_t)(row0 + lane) * 4) = (f32x4){inv, x1 * inv, x2 * inv, x3 * inv};
            *(int4*)(SLOT + (size_t)(row0 + lane) * 4) = make_int4((int)(((unsigned)e0 << 24) | r0), (int)(((unsigned)e1 << 24) | r1), (int)(((unsigned)e2 << 24) | r2), (int)(((unsigned)e3 << 24) | r3)); }
        LDS_WAIT(); asm volatile("" ::: "memory");
    }
    __syncthreads();
    if (tid < 32) { const unsigned n = lcnt[tid]; const unsigned base = __hip_atomic_fetch_add(CNT + tid, n, RLX_AGENT); ((unsigned*)(ws + WS_BASE))[bid * 32 + tid] = base; }
    __syncthreads();
}

__device__ __forceinline__ void build_expert_tables(CArgs ap, int l, LAS unsigned char* lds, int tid) {
    CA& a = *ap;
    if (tid == 0) { const unsigned* CNT = (const unsigned*)(a.ws + WS_CTL) + CW_CNT + l * 32; LAS int* pads = (LAS int*)(lds + PADS_OFF); LAS unsigned char* te = lds + TILE_E_OFF;
        int t = 0;
#pragma nounroll
        for (int e = 0; e < 32; ++e) { const int c = (int)__hip_atomic_load(CNT + e, RLX_AGENT); const int nt = (c + 255) >> 8; pads[e] = t * 256;
#pragma nounroll
            for (int i = 0; i < nt; ++i) te[t + i] = (unsigned char)e;
            t += nt; }
        pads[32] = t; }
    __syncthreads();
}

__device__ __forceinline__ void phase_moe_prep(CArgs ap, int l, LAS unsigned char* lds, int tid, int lane, int gw, int NGW) {
    CA& a = *ap;
    unsigned char* ws = a.ws;
    build_expert_tables(ap, l, lds, tid);
    const LAS int* pads = (const LAS int*)(lds + PADS_OFF);
    int* SLOT = (int*)(ws + WS_SLOT); const unsigned* BASE = (const unsigned*)(ws + WS_BASE);
    for (int row0 = gw; row0 < T; row0 += 3 * NGW) {
        int rowv[3]; bool on[3]; int4 sl[3]; v4u hv[3];
#pragma unroll
        for (int rr = 0; rr < 3; ++rr) { const int row = row0 + rr * NGW; on[rr] = row < T && !(l == DEPTH - 1 && (row % TB) < CTX); rowv[rr] = on[rr] ? row : row0;
            sl[rr] = *(const int4*)(SLOT + (size_t)rowv[rr] * 4); hv[rr] = *(const v4u*)((const unsigned char*)(ws + WS_H8) + (size_t)rowv[rr] * D + 16 * lane); }
        unsigned bs[3][4];
#pragma unroll
        for (int rr = 0; rr < 3; ++rr) { const unsigned pk[4] = {(unsigned)sl[rr].x, (unsigned)sl[rr].y, (unsigned)sl[rr].z, (unsigned)sl[rr].w};
#pragma unroll
            for (int k = 0; k < 4; ++k) bs[rr][k] = BASE[((unsigned)rowv[rr] / (unsigned)(T / (NGW >> 3))) * 32 + (pk[k] >> 24)]; }
#pragma unroll
        for (int rr = 0; rr < 3; ++rr) { if (!on[rr]) continue;
            const unsigned pk[4] = {(unsigned)sl[rr].x, (unsigned)sl[rr].y, (unsigned)sl[rr].z, (unsigned)sl[rr].w}; int st[4];
#pragma unroll
            for (int k = 0; k < 4; ++k) st[k] = pads[pk[k] >> 24] + (int)bs[rr][k] + (int)(pk[k] & 0xffffffu);
            if (lane == 0) *(int4*)(SLOT + (size_t)rowv[rr] * 4) = make_int4(st[0], st[1], st[2], st[3]);
#pragma unroll
            for (int k = 0; k < 4; ++k) *(v4u*)((unsigned char*)(ws + WS_XG) + (size_t)st[k] * D + 16 * lane) = hv[rr]; }
    }
}


constexpr int PH_PER_LAYER = 11, NPHASES = 1 + DEPTH * PH_PER_LAYER + 1;
__global__ void __launch_bounds__(NTHREADS, 2) fwd(Args args) {
    extern __shared__ __attribute__((aligned(16))) unsigned char lds_raw[];
    volatile LAS unsigned* MISC = (volatile LAS unsigned*)((LAS unsigned char*)lds_raw + MISC_OFF);
    if (threadIdx.x < 64) MISC[threadIdx.x] = 0u;
    __syncthreads();
    const int lo = args.ph_lo, hi = args.ph_hi;
    const int wave_s = __builtin_amdgcn_readfirstlane(threadIdx.x >> 6);
#if MK_ONE_LAUNCH
    (void)xcd_barrier_post((unsigned*)(args.ws + WS_CTL) + CW_BAR, MISC + 8);
#define SEAM(k) do { if ((k) + 1 < hi) { CArgs ap_ = get_args(); XcdBarrier b_; b_.bar = (unsigned*)(ap_->ws + WS_CTL) + CW_BAR; b_.x = xb_xcc_id(); \
        LAS unsigned char* l_ = (LAS unsigned char*)lds_raw; asm volatile("" : "+s"(l_)); b_.st = (volatile LAS unsigned*)(l_ + MISC_OFF) + 8; \
        unsigned z2_ = 0u; asm volatile("" : "+s"(z2_)); const int ln_ = (int)__builtin_amdgcn_mbcnt_hi(~0u, __builtin_amdgcn_mbcnt_lo(~0u, z2_)); \
        xcd_barrier(b_, wave_s == 0 && ln_ == 0); PROBE_STAMP((k) + 1); } } while (0)
#else
#define SEAM(k) do { } while (0)
#endif
#ifndef DBG_MASK
#define DBG_MASK 0xFFFFu
#endif
#ifndef DBGD
#define DBGD DEPTH
#endif
#define EN(j) (((DBG_MASK) >> (j)) & 1u)
#define IN(k) (lo <= (k) && (k) < hi)
#ifndef PROBE_MASK
#define PROBE_MASK 0
#endif
#ifndef PROBE_FACTOR
#define PROBE_FACTOR 4
#endif
#define PROBE_STAMP(idx) do { if (PROBE_MASK) { if (blockIdx.x == 0 && wave_s == 0) { CArgs apz_ = get_args(); unsigned long long* ts_ = (unsigned long long*)(apz_->ws + WS_CTL) + CW_TS / 2; \
        const unsigned long long now_ = __builtin_amdgcn_s_memrealtime(); if (__builtin_amdgcn_mbcnt_lo(~0u, 0u) == 0u && __builtin_amdgcn_mbcnt_hi(~0u, 0u) == 0u) __hip_atomic_store(ts_ + (idx), now_, RLX_AGENT); } } } while (0)
#define PHASE_CTX() CArgs ap = get_args(); unsigned char* ws = ap->ws; (void)ws; \
    LAS unsigned char* lds = (LAS unsigned char*)lds_raw; asm volatile("" : "+s"(lds)); (void)lds; \
    int wave = wave_s; asm volatile("" : "+s"(wave)); unsigned zero_ = 0u; asm volatile("" : "+s"(zero_)); const int lane = (int)__builtin_amdgcn_mbcnt_hi(~0u, __builtin_amdgcn_mbcnt_lo(~0u, zero_)); const int tid = wave * 64 + lane; (void)tid; \
    int bid = blockIdx.x; asm volatile("" : "+s"(bid)); int G = gridDim.x; asm volatile("" : "+s"(G)); \
    const int gw = bid * NWAVES + wave, NGW = G * NWAVES, gws = wave * G + bid; (void)gw; (void)NGW; (void)gws


    PROBE_STAMP(0);
    if (EN(11) && IN(0)) { PHASE_CTX(); phase_prologue(ap, lds, tid, lane, wave, bid, G); SEAM(0); }

    for (int l = 0; l < DBGD; ++l) {
        const int pb = 1 + PH_PER_LAYER * l;
        if (EN(0) && IN(pb + 0)) { PHASE_CTX(); build_gc(ap, l, bid * NTHREADS + tid, G * NTHREADS); if (l == 0) phase_n1<0>(ap, l, lane, gw, NGW); else phase_n1<1>(ap, l, lane, gw, NGW); SEAM(pb + 0); }
        if (EN(1) && IN(pb + 1)) {
            { PHASE_CTX();
              pg8::Gemm g{(const bf16*)(ws + WS_H), (const bf16*)(ws + WS_WIN) + (size_t)l * 1792 * D, T, 1792, D}; pg8::StaticOrder S; S.init(T, 1792, G, bid);
              pg8::EpiPlain E{(bf16*)(ws + WS_PROJ), DIN};
              pg8::gemm_phase<pg8::EpiPlain, pg8::StaticOrder, true, true>(lds, g, S, E, tid); }
            { PHASE_CTX();
              pg8::Gemm g{(const bf16*)(ws + WS_H8), (const bf16*)(ws + WS_WIN8 + (size_t)l * 3072 * D), T, 3072, D / 2}; pg8::StaticOrder S; S.init(T, 3072, G, bid);
              pg8::EpiPlain8 E{(bf16*)(ws + WS_PROJ) + OFF_GT, DIN};
              pg8::gemm_phase<pg8::EpiPlain8, pg8::StaticOrder, true, false>(lds, g, S, E, tid); }
            SEAM(pb + 1);
        }
        if (EN(2) && IN(pb + 2)) { PHASE_CTX();
            PROBE_SUB(ws, tid, 8);
            for (int blk = bid; blk < 256; blk += G) { s5a_block(ap, l, blk, lds, tid, lane, wave); PROBE_SUB(ws, tid, 9); if (wave < 2) s5b_unit(ap, l, (blk >> 4) | (wave << 4) | ((blk & 15) << 5), lane); }
            PROBE_SUB(ws, tid, 10);
            if (wave >= 2) { const int gw6 = bid * 6 + (wave - 2), NGW6 = G * 6;
                PROBE_SUB(ws, tid - 128, 14);
                phase_prep(ap, l, lane, gw6, NGW6);
                PROBE_SUB(ws, tid - 128, 15);
                for (int it = gw6; it < 1152; it += NGW6) vt_item(ap, it, lane);
                PROBE_SUB(ws, tid - 128, 16); }
            SEAM(pb + 2);
        }
        if (EN(3) && IN(pb + 3)) { PHASE_CTX();
            for (int blk = bid; blk < 256; blk += G) s5c_block(ap, l, blk, lds, tid, lane, wave);
            PROBE_SUB(ws, tid, 4);
            for (int it = gw; it < 4096; it += NGW) attn_item(ap, l, true, it, lane);
            PROBE_SUB(ws, tid, 5);
            if ((gw & 3) == 1 && l < DEPTH - 1) { for (int it = gw >> 2; it < 512; it += NGW >> 2) attn_item(ap, l, false, it, lane); }
            SEAM(pb + 3);
        }
        if (EN(4) && IN(pb + 4)) { PHASE_CTX();
            pg8::Gemm g{(const bf16*)(ws + WS_Z), (const bf16*)(ws + WS_WGLU) + (size_t)l * 256 * 256, T, 256, 256}; pg8::RowOrder S; S.lat = (l == DEPTH - 1); S.init(S.lat ? NB * SEQ : T, 256, G, bid);
            pg8::EpiGlu E{(const bf16*)(ws + WS_Z), (bf16*)(ws + WS_Z2), 256};
            pg8::gemm_phase<pg8::EpiGlu, pg8::RowOrder, true, true>(lds, g, S, E, tid);
            SEAM(pb + 4);
        }
        if (EN(5) && IN(pb + 5)) {
            { PHASE_CTX(); pg8::RowOrder S; S.lat = (l == DEPTH - 1); S.init(S.lat ? NB * SEQ : T, D, G, bid);
              pg8::Gemm g{(const bf16*)(ws + WS_Z2), (const bf16*)(ws + WS_WSO) + (size_t)l * D * 256, T, D, 256};
              pg8::EpiBranch<true> E{(const bf16*)(ws + WS_PROJ) + OFF_GT, DIN, (bf16*)(ws + WS_MM), D}; pg8::gemm_phase<pg8::EpiBranch<true>, pg8::RowOrder, true, true>(lds, g, S, E, tid); }
            { PHASE_CTX(); pg8::RowOrder S; S.lat = (l == DEPTH - 1); S.init(S.lat ? NB * SEQ : T, D, G, bid);
              pg8::Gemm g{(const bf16*)(ws + WS_YB), (const bf16*)(ws + WS_WCO) + (size_t)l * D * 256, T, D, 256};
              pg8::EpiBranch<false> E{(const bf16*)(ws + WS_PROJ) + OFF_GT + D, DIN, (bf16*)(ws + WS_MM), D}; pg8::gemm_phase<pg8::EpiBranch<false>, pg8::RowOrder, true, true>(lds, g, S, E, tid); }
            { PHASE_CTX(); pg8::RowOrder S; S.lat = (l == DEPTH - 1); S.init(S.lat ? NB * SEQ : T, D, G, bid);
              pg8::Gemm g{(const bf16*)(ws + WS_YA), (const bf16*)(ws + WS_WAO) + (size_t)l * D * 512, T, D, 512};
              pg8::EpiBranch<false> E{(const bf16*)(ws + WS_PROJ) + OFF_GT + 2 * D, DIN, (bf16*)(ws + WS_MM), D}; pg8::gemm_phase<pg8::EpiBranch<false>, pg8::RowOrder, true, true>(lds, g, S, E, tid); }
            SEAM(pb + 5);
        }
        if (EN(6) && IN(pb + 6)) { PHASE_CTX();
            pg8::Gemm g{(const bf16*)(ws + WS_MM), (const bf16*)(ws + WS_WO) + (size_t)l * D * D, T, D, D}; pg8::RowOrder S; S.lat = (l == DEPTH - 1); S.init(S.lat ? NB * SEQ : T, D, G, bid);
            pg8::EpiWo E{(float*)(ws + WS_X), (const float*)(ws + WS_MOD) + (size_t)l * 17 * 6144 + 2048};
            pg8::gemm_phase<pg8::EpiWo, pg8::RowOrder, true, true>(lds, g, S, E, tid);
            SEAM(pb + 6);
        }
        if (EN(7) && IN(pb + 7)) { PHASE_CTX(); phase_n2(ap, l, lds, tid, lane, wave, bid, G); SEAM(pb + 7); }
        if (EN(8) && IN(pb + 8)) { PHASE_CTX(); phase_moe_prep(ap, l, lds, tid, lane, gw, NGW); SEAM(pb + 8); }
        if (EN(9) && IN(pb + 9)) { PHASE_CTX();
            build_expert_tables(ap, l, lds, tid);
            const int nt = ((const LAS int*)(lds + PADS_OFF))[32];
            pg8::Gemm g{(const bf16*)(ws + WS_XG), (const bf16*)(ws + WS_WGU + (size_t)l * 32 * 2048 * 1024), nt * 256, 2048, 512};
            pg8::MoeOrder S{8, nt * 8, G, bid, lds + TILE_E_OFF, (size_t)2048 * 1024};
            pg8::EpiSwiglu E{(unsigned char*)(ws + WS_ACT), ap->in[I_BGU] + (size_t)l * 32 * 2048, lds + TILE_E_OFF};
            pg8::gemm_phase<pg8::EpiSwiglu, pg8::MoeOrder, true, false>(lds, g, S, E, tid);
            SEAM(pb + 9);
        }
        if (EN(10) && IN(pb + 10)) { PHASE_CTX();
            build_expert_tables(ap, l, lds, tid);
            const int nt = ((const LAS int*)(lds + PADS_OFF))[32];
            pg8::Gemm g{(const bf16*)(ws + WS_ACT), (const bf16*)(ws + WS_WD + (size_t)l * 32 * 1024 * 1024), nt * 256, 1024, 512};
            pg8::MoeOrder S{4, nt * 4, G, bid, lds + TILE_E_OFF, (size_t)1024 * 1024};
            pg8::EpiDown E{(unsigned char*)(ws + WS_YS8), ap->in[I_BD] + (size_t)l * 32 * 1024, lds + TILE_E_OFF};
            pg8::gemm_phase<pg8::EpiDown, pg8::MoeOrder, true, false>(lds, g, S, E, tid);
            SEAM(pb + 10);
        }
    }
    if (EN(12) && IN(NPHASES - 1)) { PHASE_CTX(); phase_n1<2>(ap, DEPTH, lane, gw, NGW); }
    if (PROBE_MASK || PROBE_SUB_A >= 0) { if (blockIdx.x == 0 && wave_s == 0) { CArgs apz_ = get_args(); unsigned long long* ts_ = (unsigned long long*)(apz_->ws + WS_CTL) + CW_TS / 2;
        asm volatile("s_waitcnt vmcnt(0)" ::: "memory");
        const unsigned long long t_end = __builtin_amdgcn_s_memrealtime(); unsigned long long sum = 0;
        for (int k2 = 0; k2 < NPHASES; ++k2) { const int cls = k2 == 0 ? 0 : (k2 == NPHASES - 1 ? 13 : 1 + (k2 - 1) % PH_PER_LAYER);
            const unsigned long long t0 = __hip_atomic_load(ts_ + k2, RLX_AGENT), t1 = (k2 == NPHASES - 1) ? t_end : __hip_atomic_load(ts_ + k2 + 1, RLX_AGENT);
            if ((PROBE_MASK >> cls) & 1) sum += t1 - t0; }
        if (PROBE_SUB_A >= 0) sum = (unsigned long long)PROBE_SUBF * (__hip_atomic_load(ts_ + 128 + (PROBE_SUB_B < 0 ? 0 : PROBE_SUB_B), RLX_AGENT) - __hip_atomic_load(ts_ + 128 + (PROBE_SUB_A < 0 ? 0 : PROBE_SUB_A), RLX_AGENT)) / PROBE_FACTOR;
        while (__builtin_amdgcn_s_memrealtime() - t_end < (unsigned long long)PROBE_FACTOR * sum) __builtin_amdgcn_s_sleep(8); } }
#undef IN
#undef SEAM
}

extern "C" void kernel_launch(void* const* d_in, const int* in_sizes, int n_in, void* d_out, int out_size, void* d_ws, size_t ws_size, hipStream_t stream) {
    static int grid = 0;
    if (grid == 0) {
        if (n_in != N_IN || out_size != NB * SEQ * D || ws_size < WS_END) { fprintf(stderr, "kernel_launch: unexpected sizes (n_in %d out %d ws %zu, need %zu)\n", n_in, out_size, ws_size, (size_t)WS_END); grid = -1; return; }
        int dev = 0, cus = 0, per_cu = 0;
        if (hipGetDevice(&dev) != hipSuccess || hipDeviceGetAttribute(&cus, hipDeviceAttributeMultiprocessorCount, dev) != hipSuccess) { grid = -1; return; }
        if (hipFuncSetAttribute((const void*)fwd, hipFuncAttributeMaxDynamicSharedMemorySize, LDS_BYTES) != hipSuccess) { fprintf(stderr, "kernel_launch: hipFuncSetAttribute failed\n"); grid = -1; return; }
        if (hipOccupancyMaxActiveBlocksPerMultiprocessor(&per_cu, (const void*)fwd, NTHREADS, LDS_BYTES) != hipSuccess || per_cu < 1) { fprintf(stderr, "kernel_launch: occupancy query says %d\n", per_cu); }
        (void)hipGetLastError();
        grid = cus;
    }
    if (grid < 0) return;
    if (hipMemsetAsync((char*)d_ws + WS_CTL, 0, CTL_ZERO_BYTES, stream) != hipSuccess) return;
    Args a{};
    for (int i = 0; i < N_IN; ++i) a.in[i] = (const float*)d_in[i];
    a.out = (float*)d_out; a.ws = (unsigned char*)d_ws;
#if MK_ONE_LAUNCH
    a.ph_lo = 0; a.ph_hi = NPHASES;
    hipLaunchKernelGGL(fwd, dim3(grid), dim3(NTHREADS), LDS_BYTES, stream, a);
#else
    for (int p = 0; p < NPHASES; ++p) { a.ph_lo = p; a.ph_hi = p + 1; hipLaunchKernelGGL(fwd, dim3(grid), dim3(NTHREADS), LDS_BYTES, stream, a); }
#endif
}
```

```cpp
#include <hip/hip_runtime.h>
#include <cstdio>
#include <cstdint>
namespace pg8 {
#define PG8_LAS __attribute__((address_space(3)))
#define PG8_GAS __attribute__((address_space(1)))
typedef unsigned short bf16_t;
typedef short bf16x8 __attribute__((ext_vector_type(8)));
typedef float f32x4 __attribute__((ext_vector_type(4)));
typedef unsigned u32x4 __attribute__((ext_vector_type(4)));
typedef int pg8_i4 __attribute__((ext_vector_type(4)));
typedef int pg8_i8 __attribute__((ext_vector_type(8)));
constexpr int BM = 256, BK = 64, HALF = 128, HTB = HALF * BK * 2  , STAGE_BYTES = 8 * HTB, NXCD = 8, WGM = 8;

__host__ __device__ __forceinline__ int lds_byte(int r, int c) { const int st = (r >> 4) * 2 + (c >> 5), rr = r & 15, cc = c & 31, ob = rr * 64 + cc * 2; return st * 1024 + (ob ^ (((ob >> 9) & 1) << 5)); }
__host__ __device__ __forceinline__ void stage_rc(int b, int& R, int& C) { const int st = b / 1024, sb = b % 1024, swz = sb ^ (((sb >> 9) & 1) << 5); R = (st >> 1) * 16 + swz / 64; C = (st & 1) * 32 + (swz % 64) / 2; }
__host__ __device__ __forceinline__ int perm32(int rho) { const int n = rho >> 4, i = rho & 15; return 8 * (i >> 2) + 4 * n + (i & 3); }

struct Unit { int pm, pn; };
struct Gemm { const bf16_t* A; const bf16_t* Bt; int M, N, K; };

struct StaticOrder {
    static constexpr bool GATHER = false;
    int nM, nN, nwg, G, c;
    __host__ __device__ void init(int M, int N, int G_, int c_) { nM = M / BM; nN = N / BM; nwg = nM * nN; G = G_; c = c_; }
    __host__ __device__ bool next(int i, Unit& u) const {
        const long L = (long)i * G + c; if (L >= nwg) return false;
        int wgid = (int)L; { const int q = nwg / NXCD, r = nwg % NXCD, xcd = wgid % NXCD, off = wgid / NXCD; wgid = (xcd < r ? xcd * (q + 1) : r * (q + 1) + (xcd - r) * q) + off; }
        const int nig = WGM * nN, gid = wgid / nig, fm = gid * WGM, gsz = (nM - fm) < WGM ? (nM - fm) : WGM;
        u.pm = fm + ((wgid % nig) % gsz); u.pn = (wgid % nig) / gsz; return true;
    }
    __device__ __forceinline__ void a_ready(const Unit&) const {}
    __device__ __forceinline__ void done(const Unit&) const {}
    __device__ __forceinline__ const char* aptr(const Gemm& g, const Unit& u, size_t tstep) const { return (const char*)g.A + (size_t)u.pm * tstep; }
    __device__ __forceinline__ const char* bptr(const Gemm& g, const Unit& u, size_t tstep) const { return (const char*)g.Bt + (size_t)u.pn * tstep; }
};

__device__ __forceinline__ unsigned cvt_pk_bf16(float lo, float hi) { unsigned r; asm volatile("v_cvt_pk_bf16_f32 %0, %1, %2" : "=v"(r) : "v"(lo), "v"(hi)); return r; }
__device__ __forceinline__ float bf_lo(unsigned w) { return __uint_as_float(w << 16); }
__device__ __forceinline__ float bf_hi(unsigned w) { return __uint_as_float(w & 0xffff0000u); }
__device__ __forceinline__ float sigm(float x) { return __builtin_amdgcn_rcpf(1.0f + __expf(-x)); }
#define PG8_FRESH_LANE() { unsigned z_ = 0u; asm volatile("" : "+s"(z_)); const int l_ = (int)__builtin_amdgcn_mbcnt_hi(~0u, __builtin_amdgcn_mbcnt_lo(~0u, z_)); fr = l_ & 15; fq = l_ >> 4; }

struct EpiPlain {
    static constexpr bool PERM = true, AFTER_DRAIN = false, FP8 = false; static constexpr int WSCALE = 0x7f;
    bf16_t* O; int ldc;
    __device__ __forceinline__ void operator()(const f32x4 (&acc)[2][2][4][2], const Unit& u, int wr, int wc, int fr, int fq) const {
        PG8_FRESH_LANE();
        const int row0 = u.pm * BM + wr * 64 + fr, col0 = u.pn * BM + wc * 32 + 8 * fq;
#pragma unroll
        for (int ai = 0; ai < 2; ++ai)
#pragma unroll
            for (int m = 0; m < 4; ++m) { bf16_t* rowp = O + (size_t)(row0 + ai * HALF + m * 16) * ldc + col0;
#pragma unroll
                for (int bj = 0; bj < 2; ++bj) { const f32x4 v0 = acc[ai][bj][m][0], v1 = acc[ai][bj][m][1];
                    u32x4 w; w.x = cvt_pk_bf16(v0[0], v0[1]); w.y = cvt_pk_bf16(v0[2], v0[3]); w.z = cvt_pk_bf16(v1[0], v1[1]); w.w = cvt_pk_bf16(v1[2], v1[3]);
                    *(u32x4*)(rowp + bj * HALF) = w; } }
    }
};
struct EpiPlain8 {
    static constexpr bool PERM = true, AFTER_DRAIN = false, FP8 = true; static constexpr int WSCALE = 0;
    bf16_t* O; int ldc;
    __device__ __forceinline__ void operator()(const f32x4 (&acc)[2][2][4][2], const Unit& u, int wr, int wc, int fr, int fq) const {
        PG8_FRESH_LANE();
        const int row0 = u.pm * BM + wr * 64 + fr, col0 = u.pn * BM + wc * 32 + 8 * fq;
#pragma unroll
        for (int ai = 0; ai < 2; ++ai)
#pragma unroll
            for (int m = 0; m < 4; ++m) { bf16_t* rowp = O + (size_t)(row0 + ai * HALF + m * 16) * ldc + col0;
#pragma unroll
                for (int bj = 0; bj < 2; ++bj) { const f32x4 v0 = acc[ai][bj][m][0] * 0.03125f, v1 = acc[ai][bj][m][1] * 0.03125f;
                    u32x4 w; w.x = cvt_pk_bf16(v0[0], v0[1]); w.y = cvt_pk_bf16(v0[2], v0[3]); w.z = cvt_pk_bf16(v1[0], v1[1]); w.w = cvt_pk_bf16(v1[2], v1[3]);
                    *(u32x4*)(rowp + bj * HALF) = w; } }
    }
};
struct EpiGlu {
    static constexpr bool PERM = true, AFTER_DRAIN = false, FP8 = false; static constexpr int WSCALE = 0x7f;
    const bf16_t* Z; bf16_t* O; int ldc;
    __device__ __forceinline__ void operator()(const f32x4 (&acc)[2][2][4][2], const Unit& u, int wr, int wc, int fr, int fq) const {
        PG8_FRESH_LANE();
        const int row0 = u.pm * BM + wr * 64 + fr, col0 = u.pn * BM + wc * 32 + 8 * fq;
#pragma unroll
        for (int ai = 0; ai < 2; ++ai) {
            u32x4 z[4][2];
#pragma unroll
            for (int m = 0; m < 4; ++m)
#pragma unroll
                for (int bj = 0; bj < 2; ++bj) z[m][bj] = *(const u32x4*)(Z + (size_t)(row0 + ai * HALF + m * 16) * ldc + col0 + bj * HALF);
#pragma unroll
            for (int m = 0; m < 4; ++m)
#pragma unroll
                for (int bj = 0; bj < 2; ++bj) { const f32x4 v0 = acc[ai][bj][m][0], v1 = acc[ai][bj][m][1]; const u32x4 zz = z[m][bj];
                    u32x4 w; w.x = cvt_pk_bf16(bf_lo(zz.x) * sigm(v0[0]), bf_hi(zz.x) * sigm(v0[1])); w.y = cvt_pk_bf16(bf_lo(zz.y) * sigm(v0[2]), bf_hi(zz.y) * sigm(v0[3]));
                    w.z = cvt_pk_bf16(bf_lo(zz.z) * sigm(v1[0]), bf_hi(zz.z) * sigm(v1[1])); w.w = cvt_pk_bf16(bf_lo(zz.w) * sigm(v1[2]), bf_hi(zz.w) * sigm(v1[3]));
                    *(u32x4*)(O + (size_t)(row0 + ai * HALF + m * 16) * ldc + col0 + bj * HALF) = w; }
            asm volatile("" ::: "memory"); }
    }
};
template <bool FIRST> struct EpiBranch {
    static constexpr bool PERM = true, AFTER_DRAIN = false, FP8 = false; static constexpr int WSCALE = 0x7f;
    const bf16_t* GT; int ldg; bf16_t* MM; int ldc;
    __device__ __forceinline__ void operator()(const f32x4 (&acc)[2][2][4][2], const Unit& u, int wr, int wc, int fr, int fq) const {
        PG8_FRESH_LANE();
        const unsigned row0 = u.pm * BM + wr * 64 + fr, col0 = u.pn * BM + wc * 32 + 8 * fq;
#pragma unroll
        for (int ai = 0; ai < 2; ++ai) {
            u32x4 g[4][2], pv[4][2];
#pragma unroll
            for (int m = 0; m < 4; ++m)
#pragma unroll
                for (int bj = 0; bj < 2; ++bj) { const unsigned row = row0 + ai * HALF + m * 16;
                    g[m][bj] = *(const u32x4*)(GT + row * (unsigned)ldg + col0 + bj * HALF);
                    if (!FIRST) pv[m][bj] = *(const u32x4*)(MM + row * (unsigned)ldc + col0 + bj * HALF); }
#pragma unroll
            for (int m = 0; m < 4; ++m)
#pragma unroll
                for (int bj = 0; bj < 2; ++bj) { const unsigned row = row0 + ai * HALF + m * 16; const f32x4 v0 = acc[ai][bj][m][0], v1 = acc[ai][bj][m][1]; const u32x4 gg = g[m][bj];
                    float o[8];
                    o[0] = sigm(bf_lo(gg.x)) * v0[0]; o[1] = sigm(bf_hi(gg.x)) * v0[1]; o[2] = sigm(bf_lo(gg.y)) * v0[2]; o[3] = sigm(bf_hi(gg.y)) * v0[3];
                    o[4] = sigm(bf_lo(gg.z)) * v1[0]; o[5] = sigm(bf_hi(gg.z)) * v1[1]; o[6] = sigm(bf_lo(gg.w)) * v1[2]; o[7] = sigm(bf_hi(gg.w)) * v1[3];
                    if (!FIRST) { const u32x4 p = pv[m][bj];
                        o[0] += bf_lo(p.x); o[1] += bf_hi(p.x); o[2] += bf_lo(p.y); o[3] += bf_hi(p.y); o[4] += bf_lo(p.z); o[5] += bf_hi(p.z); o[6] += bf_lo(p.w); o[7] += bf_hi(p.w); }
                    u32x4 w; w.x = cvt_pk_bf16(o[0], o[1]); w.y = cvt_pk_bf16(o[2], o[3]); w.z = cvt_pk_bf16(o[4], o[5]); w.w = cvt_pk_bf16(o[6], o[7]);
                    *(u32x4*)(MM + row * (unsigned)ldc + col0 + bj * HALF) = w; }
            asm volatile("" ::: "memory"); }
    }
};
struct EpiWo {
    static constexpr bool PERM = false, AFTER_DRAIN = false, FP8 = false; static constexpr int WSCALE = 0x7f;
    float* X; const float* g1base;
    __device__ __forceinline__ void operator()(const f32x4 (&acc)[2][2][4][2], const Unit& u, int wr, int wc, int fr, int fq) const {
        PG8_FRESH_LANE();
        const int row0 = u.pm * BM + wr * 64 + fr, col0 = u.pn * BM + wc * 32 + 4 * fq;
        const int r = (u.pm % 9 == 0) ? 16 : u.pm / 9; const float* g1 = g1base + (size_t)r * 6144 + col0;
        f32x4 gv[2][2];
#pragma unroll
        for (int bj = 0; bj < 2; ++bj)
#pragma unroll
            for (int n = 0; n < 2; ++n) gv[bj][n] = *(const f32x4*)(g1 + bj * HALF + n * 16);
#pragma unroll
        for (int ai = 0; ai < 2; ++ai)
#pragma unroll
            for (int mh = 0; mh < 2; ++mh) {
                f32x4 xv[2][2][2];
#pragma unroll
                for (int mm = 0; mm < 2; ++mm)
#pragma unroll
                    for (int bj = 0; bj < 2; ++bj)
#pragma unroll
                        for (int n = 0; n < 2; ++n) xv[mm][bj][n] = *(const f32x4*)(X + (size_t)(row0 + ai * HALF + (2 * mh + mm) * 16) * 1024 + col0 + bj * HALF + n * 16);
#pragma unroll
                for (int mm = 0; mm < 2; ++mm)
#pragma unroll
                    for (int bj = 0; bj < 2; ++bj)
#pragma unroll
                        for (int n = 0; n < 2; ++n) *(f32x4*)(X + (size_t)(row0 + ai * HALF + (2 * mh + mm) * 16) * 1024 + col0 + bj * HALF + n * 16) = xv[mm][bj][n] + gv[bj][n] * acc[ai][bj][2 * mh + mm][n];
                asm volatile("" ::: "memory"); }
    }
};
struct EpiSwiglu {
    static constexpr bool PERM = true, AFTER_DRAIN = false, FP8 = true; static constexpr int WSCALE = 0;
    unsigned char* O; const float* bias; const PG8_LAS unsigned char* tile_e;
    __device__ __forceinline__ void operator()(const f32x4 (&acc)[2][2][4][2], const Unit& u, int wr, int wc, int fr, int fq) const {
        PG8_FRESH_LANE();
        const int row0 = u.pm * BM + wr * 64 + fr, acol0 = u.pn * HALF + wc * 32 + 8 * fq;
        const int e = tile_e[u.pm]; const float* bb = bias + (size_t)e * 2048 + 2 * acol0;
        const f32x4 b0 = *(const f32x4*)(bb), b1 = *(const f32x4*)(bb + 4), b2 = *(const f32x4*)(bb + 8), b3 = *(const f32x4*)(bb + 12);
        const float bg[8] = {b0[0], b0[2], b1[0], b1[2], b2[0], b2[2], b3[0], b3[2]}, bu[8] = {b0[1], b0[3], b1[1], b1[3], b2[1], b2[3], b3[1], b3[3]};
#pragma unroll
        for (int ai = 0; ai < 2; ++ai)
#pragma unroll
            for (int m = 0; m < 4; ++m) { unsigned char* rowp = O + (size_t)(row0 + ai * HALF + m * 16) * 1024 + acol0;
                float o[8];
#pragma unroll
                for (int j = 0; j < 8; ++j) { const float gt = acc[ai][0][m][j >> 2][j & 3] * 0.03125f + bg[j], up = acc[ai][1][m][j >> 2][j & 3] * 0.03125f + bu[j];
                    const float glu = fminf(gt, 7.0f), upc = fminf(fmaxf(up, -7.0f), 7.0f);
                    o[j] = glu * sigm(1.702f * glu) * (upc + 1.0f); }
                unsigned w0 = 0u, w1 = 0u;
                w0 = __builtin_amdgcn_cvt_pk_fp8_f32(o[0], o[1], w0, false); w0 = __builtin_amdgcn_cvt_pk_fp8_f32(o[2], o[3], w0, true);
                w1 = __builtin_amdgcn_cvt_pk_fp8_f32(o[4], o[5], w1, false); w1 = __builtin_amdgcn_cvt_pk_fp8_f32(o[6], o[7], w1, true);
                typedef unsigned u32x2 __attribute__((ext_vector_type(2)));
                *(u32x2*)rowp = (u32x2){w0, w1}; }
    }
};
struct EpiDown {
    static constexpr bool PERM = true, AFTER_DRAIN = false, FP8 = true; static constexpr int WSCALE = 0;
    unsigned char* O; const float* bias; const PG8_LAS unsigned char* tile_e;
    __device__ __forceinline__ void operator()(const f32x4 (&acc)[2][2][4][2], const Unit& u, int wr, int wc, int fr, int fq) const {
        PG8_FRESH_LANE();
        const int row0 = u.pm * BM + wr * 64 + fr, col0 = u.pn * BM + wc * 32 + 8 * fq;
        const int e = tile_e[u.pm]; const float* bb = bias + (size_t)e * 1024 + col0;
        f32x4 bv[2][2];
#pragma unroll
        for (int bj = 0; bj < 2; ++bj)
#pragma unroll
            for (int n = 0; n < 2; ++n) bv[bj][n] = *(const f32x4*)(bb + bj * HALF + 4 * n);
        typedef unsigned u32x2 __attribute__((ext_vector_type(2)));
#pragma unroll
        for (int ai = 0; ai < 2; ++ai)
#pragma unroll
            for (int m = 0; m < 4; ++m) { unsigned char* rowp = O + (size_t)(row0 + ai * HALF + m * 16) * 1024 + col0;
#pragma unroll
                for (int bj = 0; bj < 2; ++bj) { const f32x4 v0 = acc[ai][bj][m][0] * 0.03125f + bv[bj][0], v1 = acc[ai][bj][m][1] * 0.03125f + bv[bj][1];
                    unsigned w0 = 0u, w1 = 0u;
                    w0 = __builtin_amdgcn_cvt_pk_fp8_f32(v0[0], v0[1], w0, false); w0 = __builtin_amdgcn_cvt_pk_fp8_f32(v0[2], v0[3], w0, true);
                    w1 = __builtin_amdgcn_cvt_pk_fp8_f32(v1[0], v1[1], w1, false); w1 = __builtin_amdgcn_cvt_pk_fp8_f32(v1[2], v1[3], w1, true);
                    *(u32x2*)(rowp + bj * HALF) = (u32x2){w0, w1}; } }
    }
};
struct RowOrder : StaticOrder {
    int lat;
    __device__ __forceinline__ bool next(int i, Unit& u) const { if (!StaticOrder::next(i, u)) return false; if (lat) u.pm = (u.pm >> 3) * 9 + 1 + (u.pm & 7); return true; }
};
struct PanelOrder {
    static constexpr bool GATHER = false;
    int pm, nN;
    __device__ __forceinline__ bool next(int i, Unit& u) const { if (i >= nN) return false; u.pm = pm; u.pn = i; return true; }
    __device__ __forceinline__ void a_ready(const Unit&) const {}
    __device__ __forceinline__ void done(const Unit&) const {}
    __device__ __forceinline__ const char* aptr(const Gemm& g, const Unit& u, size_t tstep) const { const char* p = (const char*)g.A + (size_t)u.pm * tstep; asm volatile("" : "+s"(p)); return p; }
    __device__ __forceinline__ const char* bptr(const Gemm& g, const Unit& u, size_t tstep) const { return (const char*)g.Bt + (size_t)u.pn * tstep; }
};
struct MoeOrder {
    static constexpr bool GATHER = false;
    int nN, total, G, c; const PG8_LAS unsigned char* tile_e; size_t estride;
    __device__ __forceinline__ bool next(int i, Unit& u) const {
        if ((G & 7) == 0 && ((G >> 3) % nN) == 0) { const int x = c & 7, j = c >> 3, rpx = (G >> 3) / nN; u.pm = i * (G / nN) + x * rpx + j / nN; u.pn = j % nN; return u.pm * nN < total; }
        const int L = i * G + c; if (L >= total) return false; u.pm = L / nN; u.pn = L - u.pm * nN; return true; }
    __device__ __forceinline__ void a_ready(const Unit&) const {}
    __device__ __forceinline__ void done(const Unit&) const {}
    __device__ __forceinline__ const char* aptr(const Gemm& g, const Unit& u, size_t tstep) const { return (const char*)g.A + (size_t)u.pm * tstep; }
    __device__ __forceinline__ const char* bptr(const Gemm& g, const Unit& u, size_t tstep) const { return (const char*)g.Bt + (size_t)tile_e[u.pm] * estride + (size_t)u.pn * tstep; }
};

struct MoeGatherOrder : MoeOrder {
    static constexpr bool GATHER = true;
    const int* rows;
    __device__ __forceinline__ const char* aptr(const Gemm& g, const Unit&, size_t) const { return (const char*)g.A; }
    __device__ __forceinline__ void load_raw(const Unit& u, int (&raw)[2][2], int tid) const {
#pragma unroll
        for (int i = 0; i < 2; ++i) { int R, C; stage_rc(tid * 16 + i * 8192, R, C);
#pragma unroll
            for (int h = 0; h < 2; ++h) raw[h][i] = rows[u.pm * BM + h * HALF + R]; }
    }
    __device__ __forceinline__ void raw_to_off(const int (&raw)[2][2], unsigned (&voff)[2][2], int tid, int K) const {
#pragma unroll
        for (int i = 0; i < 2; ++i) { int R, C; stage_rc(tid * 16 + i * 8192, R, C);
#pragma unroll
            for (int h = 0; h < 2; ++h) voff[h][i] = ((unsigned)raw[h][i] * (unsigned)K + (unsigned)C) * 2u; }
    }
};

template <class Epi, class Sched, bool ALIGN_EPI = false, bool SP2 = false>
__device__ __forceinline__ void gemm_phase(PG8_LAS unsigned char* lds, const Gemm g, const Sched& S, const Epi& E, int tid_in) {
    int tid_ = tid_in; asm volatile("" : "+v"(tid_));
    const int tid = tid_, wid = __builtin_amdgcn_readfirstlane(tid >> 6), lane = tid & 63, wr = wid >> 2, wc = wid & 3, fr = lane & 15, fq = lane >> 4;
    const int K = g.K, nt = K / BK;
    unsigned voffA[2], voffB[2];
#pragma unroll
    for (int i = 0; i < 2; ++i) { int R, C; stage_rc(tid * 16 + i * 8192, R, C); const int Rb = Epi::PERM ? ((R & ~31) + perm32(R & 31)) : R;
        voffA[i] = (unsigned)(R * K + C) * 2u; voffB[i] = (unsigned)(Rb * K + C) * 2u; }
    const size_t kstep = (size_t)(BK * 2);
    const size_t hstep = (size_t)HALF * K * 2;
    const size_t tstep = 2 * hstep;
    const unsigned ldsw = (unsigned)wid * 1024u;
    const int aoff = lds_byte(wr * 64 + fr, fq * 8), boff = lds_byte(wc * 32 + fr, fq * 8);
#define PG8_SA(b, h) (((b) * 2 + (h)) * HTB)
#define PG8_SB(b, h) ((4 + (b) * 2 + (h)) * HTB)
#define PG8_STAGE(bufoff, gbase, voff) do { _Pragma("unroll") for (int _i = 0; _i < 2; ++_i) \
        __builtin_amdgcn_global_load_lds((const PG8_GAS unsigned*)((const PG8_GAS char*)(gbase) + (voff)[_i]), (PG8_LAS unsigned*)(lds + (bufoff) + ldsw + _i * 8192), 16, 0, 0); } while (0)
#define PG8_STAGE_A(bufoff, p, h, nx) do { if constexpr (Sched::GATHER) { _Pragma("unroll") for (int _i = 0; _i < 2; ++_i) \
            __builtin_amdgcn_global_load_lds((const PG8_GAS unsigned*)((const PG8_GAS char*)(p) + ((nx) ? voffGN[h][_i] : voffGC[h][_i])), (PG8_LAS unsigned*)(lds + (bufoff) + ldsw + _i * 8192), 16, 0, 0); } \
        else PG8_STAGE(bufoff, (p) + (h) * hstep, voffA); } while (0)
#define PG8_LD8(p) __builtin_shufflevector(*(const PG8_LAS pg8_i4*)(p), *(const PG8_LAS pg8_i4*)((p) + 1024), 0, 1, 2, 3, 4, 5, 6, 7)
#define PG8_LDA(dst, b, h) do { if constexpr (Epi::FP8) { _Pragma("unroll") for (int m = 0; m < 4; ++m) { dst##8[m].lo = *(const PG8_LAS pg8_i4*)(lds + PG8_SA(b, h) + aoff + m * 2048); dst##8[m].hi = *(const PG8_LAS pg8_i4*)(lds + PG8_SA(b, h) + aoff + m * 2048 + 1024); } } \
    else { _Pragma("unroll") for (int m = 0; m < 4; ++m) _Pragma("unroll") for (int k = 0; k < 2; ++k) dst[m][k] = *(const PG8_LAS bf16x8*)(lds + PG8_SA(b, h) + aoff + m * 2048 + k * 1024); } } while (0)
#define PG8_LDB(dst, b, h) do { if constexpr (Epi::FP8) { _Pragma("unroll") for (int n = 0; n < 2; ++n) { dst##8[n].lo = *(const PG8_LAS pg8_i4*)(lds + PG8_SB(b, h) + boff + n * 2048); dst##8[n].hi = *(const PG8_LAS pg8_i4*)(lds + PG8_SB(b, h) + boff + n * 2048 + 1024); } } \
    else { _Pragma("unroll") for (int n = 0; n < 2; ++n) _Pragma("unroll") for (int k = 0; k < 2; ++k) dst[n][k] = *(const PG8_LAS bf16x8*)(lds + PG8_SB(b, h) + boff + n * 2048 + k * 1024); } } while (0)
#define PG8_CAT8(lo, hi) __builtin_shufflevector(__builtin_bit_cast(pg8_i4, lo), __builtin_bit_cast(pg8_i4, hi), 0, 1, 2, 3, 4, 5, 6, 7)
#define PG8_MMA(ai, bj, At, Bt) do { __builtin_amdgcn_s_setprio(1); if constexpr (Epi::FP8) { __builtin_amdgcn_sched_barrier(0); _Pragma("unroll") for (int m = 0; m < 4; ++m) _Pragma("unroll") for (int n = 0; n < 2; ++n) \
        acc[ai][bj][m][n] = __builtin_amdgcn_mfma_scale_f32_16x16x128_f8f6f4(Bt##8[n], At##8[m], acc[ai][bj][m][n], 0, 0, 0, 0, 0, 0); \
          \
        asm volatile("" : "+v"(acc[ai][bj][0][0]), "+v"(acc[ai][bj][0][1]), "+v"(acc[ai][bj][1][0]), "+v"(acc[ai][bj][1][1]), "+v"(acc[ai][bj][2][0]), "+v"(acc[ai][bj][2][1]), "+v"(acc[ai][bj][3][0]), "+v"(acc[ai][bj][3][1])); \
        __builtin_amdgcn_sched_barrier(0); } \
    else { _Pragma("unroll") for (int m = 0; m < 4; ++m) _Pragma("unroll") for (int n = 0; n < 2; ++n) _Pragma("unroll") for (int k = 0; k < 2; ++k) \
        acc[ai][bj][m][n] = __builtin_amdgcn_mfma_f32_16x16x32_bf16(Bt[n][k], At[m][k], acc[ai][bj][m][n], 0, 0, 0); } __builtin_amdgcn_s_setprio(0); } while (0)
#define PG8_WAIT_V(n) asm volatile("s_waitcnt vmcnt(" #n ")" ::: "memory")
#define PG8_WAIT_L(n) asm volatile("s_waitcnt lgkmcnt(" #n ")" ::: "memory")
#define PG8_BAR __builtin_amdgcn_s_barrier()
#define PG8_SCHED __builtin_amdgcn_sched_barrier(0)
    Unit cur, nxt; int ui = 0;
    if (!S.next(0, cur)) return;
    f32x4 acc[2][2][4][2];
#pragma unroll
    for (int a = 0; a < 2; ++a)
#pragma unroll
        for (int b = 0; b < 2; ++b)
#pragma unroll
            for (int m = 0; m < 4; ++m)
#pragma unroll
                for (int n = 0; n < 2; ++n) acc[a][b][m][n] = (f32x4){0.f, 0.f, 0.f, 0.f};
    bf16x8 At[4][2], B0[2][2], B1[2][2];
    pg8_i8 At8[4], B08[2], B18[2];
    (void)At; (void)B0; (void)B1; (void)At8; (void)B08; (void)B18;
    const char* cA = S.aptr(g, cur, tstep); const char* cB = S.bptr(g, cur, tstep);
    unsigned voffGC[2][2] = {{0u, 0u}, {0u, 0u}}, voffGN[2][2] = {{0u, 0u}, {0u, 0u}}; int rawN[2][2] = {{0, 0}, {0, 0}};
    if constexpr (Sched::GATHER) { S.load_raw(cur, rawN, tid); S.raw_to_off(rawN, voffGC, tid, K); }
    S.a_ready(cur);
    if constexpr (SP2) {
        PG8_STAGE(PG8_SB(0, 0), cB, voffB); PG8_STAGE(PG8_SB(0, 1), cB + hstep, voffB); PG8_STAGE_A(PG8_SA(0, 0), cA, 0, false); PG8_STAGE_A(PG8_SA(0, 1), cA, 1, false);
        if (wr == 1) PG8_BAR;
        PG8_WAIT_V(2); PG8_BAR;
        PG8_STAGE(PG8_SB(1, 0), cB + kstep, voffB); PG8_STAGE_A(PG8_SA(1, 0), cA + kstep, 0, false); PG8_STAGE(PG8_SB(1, 1), cB + hstep + kstep, voffB);
        PG8_WAIT_V(6); PG8_BAR;
    } else {
        PG8_STAGE(PG8_SB(0, 0), cB, voffB); PG8_STAGE_A(PG8_SA(0, 0), cA, 0, false); PG8_STAGE(PG8_SB(0, 1), cB + hstep, voffB); PG8_STAGE_A(PG8_SA(0, 1), cA, 1, false);
        if (wr == 1) PG8_BAR;
        PG8_WAIT_V(4); PG8_BAR;
        PG8_STAGE(PG8_SB(1, 0), cB + kstep, voffB); PG8_STAGE_A(PG8_SA(1, 0), cA + kstep, 0, false); PG8_STAGE(PG8_SB(1, 1), cB + hstep + kstep, voffB);
        PG8_WAIT_V(6); PG8_BAR;
    }
    for (;;) {
        const bool has_next = S.next(ui + 1, nxt);
        const char* nA = has_next ? S.aptr(g, nxt, tstep) : cA; const char* nB = has_next ? S.bptr(g, nxt, tstep) : cB;
        for (int t = 0; t < nt; t += 2) {
            const bool last = (t == nt - 2);
            const char* a1 = cA + (size_t)(t + 1) * kstep;
            const char* a2 = last ? nA : cA + (size_t)(t + 2) * kstep; const char* b2 = last ? nB : cB + (size_t)(t + 2) * kstep;
            const char* a3 = a2 + kstep; const char* b3 = b2 + kstep;
            if (last && has_next) S.a_ready(nxt);
            if constexpr (Sched::GATHER) {
                if (t == nt - 4 && has_next) S.load_raw(nxt, rawN, tid);
                if (last) { if (has_next) S.raw_to_off(rawN, voffGN, tid, K); else { voffGN[0][0] = voffGC[0][0]; voffGN[0][1] = voffGC[0][1]; voffGN[1][0] = voffGC[1][0]; voffGN[1][1] = voffGC[1][1]; } } }
            if constexpr (SP2) {
            PG8_LDB(B0, 0, 0); PG8_LDB(B1, 0, 1); PG8_SCHED; PG8_LDA(At, 0, 0); PG8_STAGE_A(PG8_SA(1, 1), a1, 1, false);
            PG8_WAIT_V(8); PG8_WAIT_L(0); PG8_BAR; PG8_MMA(0, 0, At, B0); PG8_MMA(0, 1, At, B1); PG8_BAR; PG8_SCHED;
            PG8_LDA(At, 0, 1); PG8_STAGE(PG8_SB(0, 0), b2, voffB); PG8_STAGE(PG8_SB(0, 1), b2 + hstep, voffB); PG8_STAGE_A(PG8_SA(0, 0), a2, 0, last);
            PG8_WAIT_V(8); PG8_WAIT_L(0); PG8_BAR; PG8_MMA(1, 0, At, B0); PG8_MMA(1, 1, At, B1); PG8_BAR; PG8_SCHED;
            PG8_LDB(B0, 1, 0); PG8_LDB(B1, 1, 1); PG8_SCHED; PG8_LDA(At, 1, 0); PG8_STAGE_A(PG8_SA(0, 1), a2, 1, last);
            PG8_WAIT_V(8); PG8_WAIT_L(0); PG8_BAR; PG8_MMA(0, 0, At, B0); PG8_MMA(0, 1, At, B1); PG8_BAR; PG8_SCHED;
            PG8_LDA(At, 1, 1); PG8_STAGE(PG8_SB(1, 0), b3, voffB); PG8_STAGE(PG8_SB(1, 1), b3 + hstep, voffB); PG8_STAGE_A(PG8_SA(1, 0), a3, 0, last);
            PG8_WAIT_V(8); PG8_WAIT_L(0); PG8_BAR; PG8_MMA(1, 0, At, B0); PG8_MMA(1, 1, At, B1); PG8_BAR; PG8_SCHED;
            } else {
            PG8_LDB(B0, 0, 0); PG8_SCHED; PG8_LDA(At, 0, 0); PG8_STAGE_A(PG8_SA(1, 1), a1, 1, false);
            PG8_WAIT_L(8); PG8_BAR; PG8_WAIT_L(0); PG8_MMA(0, 0, At, B0); PG8_BAR; PG8_SCHED;
            PG8_LDB(B1, 0, 1); PG8_STAGE(PG8_SB(0, 0), b2, voffB);
            PG8_BAR; PG8_WAIT_L(0); PG8_MMA(0, 1, At, B1); PG8_BAR;
            PG8_LDA(At, 0, 1); PG8_STAGE_A(PG8_SA(0, 0), a2, 0, last);
            PG8_BAR; PG8_WAIT_L(0); PG8_MMA(1, 0, At, B0); PG8_BAR; PG8_SCHED;
            PG8_STAGE(PG8_SB(0, 1), b2 + hstep, voffB);
            PG8_WAIT_V(6); PG8_BAR; PG8_MMA(1, 1, At, B1); PG8_BAR;
            PG8_LDB(B0, 1, 0); PG8_SCHED; PG8_LDA(At, 1, 0); PG8_STAGE_A(PG8_SA(0, 1), a2, 1, last);
            PG8_WAIT_L(8); PG8_BAR; PG8_WAIT_L(0); PG8_MMA(0, 0, At, B0); PG8_BAR; PG8_SCHED;
            PG8_LDB(B1, 1, 1); PG8_STAGE(PG8_SB(1, 0), b3, voffB);
            PG8_BAR; PG8_WAIT_L(0); PG8_MMA(0, 1, At, B1); PG8_BAR;
            PG8_LDA(At, 1, 1); PG8_STAGE_A(PG8_SA(1, 0), a3, 0, last);
            PG8_BAR; PG8_WAIT_L(0); PG8_MMA(1, 0, At, B0); PG8_BAR; PG8_SCHED;
            PG8_STAGE(PG8_SB(1, 1), b3 + hstep, voffB);
            PG8_WAIT_V(6); PG8_BAR; PG8_MMA(1, 1, At, B1); PG8_BAR;
            }
        }
        if constexpr (ALIGN_EPI) { if (wr == 0) PG8_BAR; }
        if constexpr (!Epi::AFTER_DRAIN) { E(acc, cur, wr, wc, fr, fq); S.done(cur); }
        if (!has_next) break;
#pragma unroll
        for (int a = 0; a < 2; ++a)
#pragma unroll
            for (int b = 0; b < 2; ++b)
#pragma unroll
                for (int m = 0; m < 4; ++m)
#pragma unroll
                    for (int n = 0; n < 2; ++n) acc[a][b][m][n] = (f32x4){0.f, 0.f, 0.f, 0.f};
        cur = nxt; cA = nA; cB = nB; ++ui;
        if constexpr (Sched::GATHER) { voffGC[0][0] = voffGN[0][0]; voffGC[0][1] = voffGN[0][1]; voffGC[1][0] = voffGN[1][0]; voffGC[1][1] = voffGN[1][1]; }
        if constexpr (ALIGN_EPI) { if (wr == 1) PG8_BAR; }
    }
    PG8_WAIT_V(0);
    if constexpr (!ALIGN_EPI) { if (wr == 0) PG8_BAR; }
    PG8_BAR;
    if constexpr (Epi::AFTER_DRAIN) { E.fused(acc, cur, wr, wc, fr, fq, lds, wid, lane); S.done(cur); }
#undef PG8_SA
#undef PG8_SB
#undef PG8_STAGE
#undef PG8_CAT8
#undef PG8_LD8
#undef PG8_STAGE_A
#undef PG8_LDA
#undef PG8_LDB
#undef PG8_MMA
#undef PG8_WAIT_V
#undef PG8_WAIT_L
#undef PG8_BAR
#undef PG8_SCHED
}
}

#ifndef MK_ONE_LAUNCH
#define MK_ONE_LAUNCH 1
#endif
constexpr int NWAVES = 8, NTHREADS = 512;
constexpr int NB = 16, SEQ = 2048, CTX = 256, TB = SEQ + CTX, T = NB * TB, D = 1024, DIN = 4864, DEPTH = 4;
constexpr int OFF_U = 0, OFF_CB = 256, OFF_CC = 512, OFF_CX = 768, OFF_Q = 1024, OFF_K = 1536, OFF_V = 1664, OFF_GT = 1792;
constexpr int NE = 32, MAX_TILES = (T * 4 + NE * 255) / 256, MAX_SLOTS = MAX_TILES * 256;
constexpr float EPS = 1e-6f;
enum { I_X = 0, I_C, I_CTX, I_CCTX, I_WMOD, I_BMOD, I_N1G, I_N2G, I_WIN, I_LRE, I_LIM, I_LDT, I_BRE, I_BIM, I_CRE, I_CIM, I_SD, I_WGLU, I_WSO, I_CONVW, I_WCO, I_QG, I_KG, I_SINK, I_WAO, I_WO,
       I_WR, I_BR, I_WGU, I_BGU, I_WD, I_BD, N_IN };
constexpr size_t MiB = 1u << 20;
constexpr size_t WS_CTL = 0, CTL_ZERO_BYTES = 1 * MiB;
constexpr size_t WS_MOD = 1 * MiB;
constexpr size_t WS_WRT = 3 * MiB;
constexpr size_t WS_ROPE = 4 * MiB;
constexpr size_t WS_WGLU = 5 * MiB;
constexpr size_t WS_WSO = 6 * MiB;
constexpr size_t WS_WCO = 8 * MiB;
constexpr size_t WS_WAO = 10 * MiB;
constexpr size_t WS_WO = 14 * MiB;
constexpr size_t WS_WIN = 22 * MiB;
constexpr size_t WS_WGU = 60 * MiB;
constexpr size_t WS_WD = 572 * MiB;
constexpr size_t WS_X = 828 * MiB;
constexpr size_t WS_H = 972 * MiB;
constexpr size_t WS_PROJ = 1044 * MiB;
constexpr size_t WS_QN = 1386 * MiB;
constexpr size_t WS_KN = 1422 * MiB;
constexpr size_t WS_Z = 1431 * MiB;
constexpr size_t WS_Z2 = 1449 * MiB;
constexpr size_t WS_YB = 1467 * MiB;
constexpr size_t WS_YA = 1485 * MiB;
constexpr size_t WS_MM = 1521 * MiB;
constexpr size_t WS_XG = 1593 * MiB;
constexpr size_t WS_ACT = 1897 * MiB;
constexpr size_t WS_TOPG = 2201 * MiB;
constexpr size_t WS_SLOT = 2202 * MiB;
constexpr size_t WS_S5S = 2203 * MiB;
constexpr size_t WS_XIN = 2275 * MiB;
constexpr size_t WS_VT = 2311 * MiB;
constexpr size_t WS_MS = 2320 * MiB;
constexpr size_t WS_W5 = 2324 * MiB;
constexpr size_t WS_BASE = 2330 * MiB;
constexpr size_t WS_STOK = 2331 * MiB;
constexpr size_t WS_GC = 2334 * MiB;
constexpr size_t WS_H8 = 2335 * MiB;
constexpr size_t WS_WIN8 = 2371 * MiB;
constexpr size_t WS_YS8 = 2383 * MiB;
constexpr size_t WS_END = 2535 * MiB;
static_assert(WS_WIN + (size_t)4 * DIN * D * 2 <= WS_WGU && WS_PROJ + (size_t)T * DIN * 2 <= WS_QN && WS_XG + (size_t)MAX_SLOTS * D * 2 <= WS_ACT && WS_ACT + (size_t)MAX_SLOTS * D * 2 <= WS_TOPG, "d_ws map");
static_assert(WS_X + (size_t)T * D * 4 <= WS_H && WS_H + (size_t)T * D * 2 <= WS_PROJ && WS_S5S + (size_t)16 * 4608 * 256 * 4 <= WS_XIN && WS_XIN + (size_t)32 * 4608 * 128 * 2 <= WS_VT && WS_VT + (size_t)32 * 64 * TB * 2 <= WS_MS && WS_W5 + (size_t)64 * 128 * 384 * 2 <= WS_END, "d_ws map 2");
constexpr int CW_CNT = 64;
constexpr int CW_BAR = 4096;
constexpr int CW_TS = 16384;
constexpr int RING_BYTES = 131072, MISC_OFF = RING_BYTES, LCNT_OFF = MISC_OFF + 128, TILE_E_OFF = MISC_OFF + 256, PADS_OFF = MISC_OFF + 1024, SCR_OFF = MISC_OFF + 2048, LDS_BYTES = 155648;

#define GAS __attribute__((address_space(1)))
#define LAS __attribute__((address_space(3)))
typedef unsigned short bf16;
typedef unsigned v4u __attribute__((ext_vector_type(4)));
typedef unsigned v2u __attribute__((ext_vector_type(2)));
typedef float f32x4 __attribute__((ext_vector_type(4)));
typedef float f32x2 __attribute__((ext_vector_type(2)));
typedef GAS unsigned gu32;
#define RLX_AGENT __ATOMIC_RELAXED, __HIP_MEMORY_SCOPE_AGENT
#define LDS_WAIT() asm volatile("s_waitcnt lgkmcnt(0)" ::: "memory")
#define VM_WAIT() asm volatile("s_waitcnt vmcnt(0)" ::: "memory")
__device__ __forceinline__ unsigned f2bf(float f) { unsigned u = __builtin_bit_cast(unsigned, f); return (u + 0x7fffu + ((u >> 16) & 1u)) >> 16; }
__device__ __forceinline__ unsigned pk2(float lo, float hi) { return f2bf(lo) | (f2bf(hi) << 16); }
__device__ __forceinline__ float bflo(unsigned w) { return __uint_as_float(w << 16); }
__device__ __forceinline__ float bfhi(unsigned w) { return __uint_as_float(w & 0xffff0000u); }

#define XB_TMO      128
#define XB_XCNT(j)  (256  + 64 * (j))
#define XB_XSUB(j)  (1280 + 64 * (j))
#define XB_XGEN(j)  (2304 + 64 * (j))
#define XB_TOP      3328
#define XB_TOPGEN   3392
#define XCD_BAR_WORDS 3456
#define XB_SPIN_CAP (1u << 18)

__device__ __forceinline__ unsigned xb_ld(unsigned* p)              { return __hip_atomic_load(p, __ATOMIC_RELAXED, __HIP_MEMORY_SCOPE_AGENT); }
__device__ __forceinline__ unsigned xb_add(unsigned* p, unsigned v) { return __hip_atomic_fetch_add(p, v, __ATOMIC_RELAXED, __HIP_MEMORY_SCOPE_AGENT); }
__device__ __forceinline__ unsigned xb_xcc_id() { return (unsigned)__builtin_amdgcn_s_getreg((3 << 11) | 20) & 0xFu; }
#define XB_SPIN(cond, bar) do { unsigned _sp = 0; while (cond) { __builtin_amdgcn_s_sleep(1); \
    if ((++_sp & 255u) == 0u) { if (xb_ld(&(bar)[XB_TMO])) break; if (_sp > XB_SPIN_CAP) { atomicAdd(&(bar)[XB_TMO], 1u); break; } } } } while (0)

struct XcdBarrier {
    unsigned* bar; unsigned x;
    volatile LAS unsigned* st;
};

__device__ __forceinline__ XcdBarrier xcd_barrier_post(unsigned* bar, volatile LAS unsigned* st) {
    XcdBarrier b; b.bar = bar; b.x = xb_xcc_id(); b.st = st;
    if (threadIdx.x == 0) (void)xb_add(&bar[XB_XCNT(b.x)], 1u);
    return b;
}
__device__ __forceinline__ void xcd_barrier_complete(unsigned* bar, unsigned x, unsigned& nloc, unsigned& nx) {
    const unsigned G = gridDim.x * gridDim.y * gridDim.z;
    unsigned sum, cnt, mine, sp = 0u;
    for (;;) {
        sum = 0u; cnt = 0u; mine = 0u;
#pragma unroll
        for (unsigned j = 0; j < 16; ++j) { const unsigned c = xb_ld(&bar[XB_XCNT(j)]); sum += c; cnt += (c > 0u) ? 1u : 0u; mine = (j == x) ? c : mine; }
        if (sum == G) break;
        __builtin_amdgcn_s_sleep(1);
        if ((++sp & 255u) == 0u) { if (xb_ld(&bar[XB_TMO])) break; if (sp > XB_SPIN_CAP) { atomicAdd(&bar[XB_TMO], 1u); break; } }
    }
    nloc = mine > 0u ? mine : 1u; nx = cnt > 0u ? cnt : 1u;
}

__device__ __forceinline__ void xcd_barrier(const XcdBarrier& b, const bool leader) {
    asm volatile("s_waitcnt vmcnt(0)" ::: "memory");
    __syncthreads();
    if (leader) {
        unsigned* bar = b.bar;
        __builtin_amdgcn_s_waitcnt(0);
        unsigned nloc = b.st[0], nx = b.st[1];
        if (nloc == 0u) { xcd_barrier_complete(bar, b.x, nloc, nx); b.st[0] = nloc; b.st[1] = nx; }
        const unsigned old = xb_add(&bar[XB_XSUB(b.x)], 1u);
        const unsigned gen = old / nloc;
        if (old + 1u == (gen + 1u) * nloc) {
            __builtin_amdgcn_fence(__ATOMIC_RELEASE, "agent");
            asm volatile("s_waitcnt vmcnt(0)" ::: "memory");
            const unsigned og = xb_add(&bar[XB_TOP], 1u);
            const unsigned tg = og / nx;
            if (og + 1u == (tg + 1u) * nx) xb_add(&bar[XB_TOPGEN], 1u);
            else XB_SPIN(xb_ld(&bar[XB_TOPGEN]) == tg, bar);
            __builtin_amdgcn_fence(__ATOMIC_ACQUIRE, "agent");
            xb_add(&bar[XB_XGEN(b.x)], 1u);
            asm volatile("s_waitcnt vmcnt(0)" ::: "memory");
        } else {
            XB_SPIN(xb_ld(&bar[XB_XGEN(b.x)]) == gen, bar);
            __builtin_amdgcn_fence(__ATOMIC_ACQUIRE, "agent");
            asm volatile("s_waitcnt vmcnt(0)" ::: "memory");
        }
    }
    __syncthreads();
}

struct Args { const float* in[N_IN]; float* out; unsigned char* ws; int ph_lo, ph_hi; };
typedef const __attribute__((address_space(4))) Args CA;
typedef CA* CArgs;
__device__ __forceinline__ CArgs get_args() { CArgs p = (CArgs)__builtin_amdgcn_kernarg_segment_ptr(); asm volatile("" : "+s"(p)); return p; }

__device__ __forceinline__ float shx(float v, int m, int lane) { return __builtin_bit_cast(float, __builtin_amdgcn_ds_bpermute((lane ^ m) << 2, __builtin_bit_cast(int, v))); }
#define DPPF(v, ctrl) __builtin_bit_cast(float, __builtin_amdgcn_update_dpp(0, __builtin_bit_cast(int, (v)), (ctrl), 0xF, 0xF, true))
__device__ __forceinline__ float sum8(float v) { v += DPPF(v, 0xB1); v += DPPF(v, 0x4E); v += DPPF(v, 0x141); return v; }
__device__ __forceinline__ float xor4(float v, int lane) { const float up = DPPF(v, 0x104), dn = DPPF(v, 0x114); return (lane & 4) ? dn : up; }
__device__ __forceinline__ float wave_sum(float v, int lane) {
    v += DPPF(v, 0xB1); v += DPPF(v, 0x4E); v += DPPF(v, 0x141); v += DPPF(v, 0x140);
    v += shx(v, 16, lane); v += shx(v, 32, lane); return v;
}
__device__ __forceinline__ float wave_sum_bp(float v, int lane) {
#pragma unroll
    for (int o = 1; o < 64; o <<= 1) v += shx(v, o, lane);
    return v;
}
__device__ __forceinline__ float wave_max(float v, int lane) {
#pragma unroll
    for (int o = 1; o < 64; o <<= 1) v = fmaxf(v, shx(v, o, lane));
    return v;
}
typedef float f32x2_t __attribute__((ext_vector_type(2))); typedef __bf16 bf16x2_t __attribute__((ext_vector_type(2)));
__device__ __forceinline__ unsigned cvtpk(float lo, float hi) { f32x2_t v = {lo, hi}; bf16x2_t b = __builtin_convertvector(v, bf16x2_t); return __builtin_bit_cast(unsigned, b); }
#ifndef PROBE_MASK
#define PROBE_MASK 0
#endif
#ifndef PROBE_SUB_A
#define PROBE_SUB_A -1
#endif
#ifndef PROBE_SUB_B
#define PROBE_SUB_B -1
#endif
#ifndef PROBE_SUBF
#define PROBE_SUBF 16
#endif
#ifndef PROBE_BLK
#define PROBE_BLK 0
#endif
#define PROBE_SUB(ws_, tid_, i_) do { if (PROBE_MASK || PROBE_SUB_A >= 0) { if (blockIdx.x == PROBE_BLK && (tid_) == 0) { asm volatile("s_waitcnt vmcnt(0) lgkmcnt(0)" ::: "memory"); \
        __hip_atomic_store((unsigned long long*)((ws_) + WS_CTL) + CW_TS / 2 + 128 + (i_), (unsigned long long)__builtin_amdgcn_s_memrealtime(), RLX_AGENT); } } } while (0)
__device__ __forceinline__ float gelu_tanh(float x) {
    const float y = 0.7978845608028654f * (x + 0.044715f * x * x * x);
    const float t = 1.0f - 2.0f * __builtin_amdgcn_rcpf(1.0f + __expf(2.0f * y));
    return 0.5f * x * (1.0f + t);
}

__device__ __forceinline__ void s5_build_mats(CArgs ap, LAS unsigned char* lds, int tid, int l, int g);
template <int MODE>
__device__ __forceinline__ void transpose_item(const float* W, int K, int N, bf16* WT, LAS float* scr, int item, int lane) {
    const int nblk = N / 32, kb = item / nblk, nb = item - kb * nblk, k0 = 64 * kb, n0 = 32 * nb;
#pragma unroll 8
    for (int i = 0; i < 32; ++i) { const int kk = 2 * i + (lane >> 5); scr[kk * 33 + (lane & 31)] = W[(size_t)(k0 + kk) * N + n0 + (lane & 31)]; }
    LDS_WAIT(); asm volatile("" ::: "memory");
    const int c = lane & 7;
#pragma unroll
    for (int j = 0; j < 4; ++j) { const int n = (lane >> 3) + 8 * j; const LAS float* s = scr + (8 * c) * 33 + n;
        const int nn = n0 + n; const int jj = nn >> 1;
        const int drow = (MODE == 0 || MODE == 2) ? nn : ((jj >> 7) * 256 + (nn & 1) * 128 + (jj & 127));
        if (MODE >= 1) {
            unsigned w0 = 0u, w1 = 0u;
            w0 = __builtin_amdgcn_cvt_pk_fp8_f32(32.0f * s[0 * 33], 32.0f * s[1 * 33], w0, false); w0 = __builtin_amdgcn_cvt_pk_fp8_f32(32.0f * s[2 * 33], 32.0f * s[3 * 33], w0, true);
            w1 = __builtin_amdgcn_cvt_pk_fp8_f32(32.0f * s[4 * 33], 32.0f * s[5 * 33], w1, false); w1 = __builtin_amdgcn_cvt_pk_fp8_f32(32.0f * s[6 * 33], 32.0f * s[7 * 33], w1, true);
            *(GAS v2u*)((unsigned char*)WT + (size_t)drow * K + k0 + 8 * c) = (v2u){w0, w1};
        } else {
            v4u o; o.x = pk2(s[0 * 33], s[1 * 33]); o.y = pk2(s[2 * 33], s[3 * 33]); o.z = pk2(s[4 * 33], s[5 * 33]); o.w = pk2(s[6 * 33], s[7 * 33]);
            *(GAS v4u*)(WT + (size_t)drow * K + k0 + 8 * c) = o; } }
    LDS_WAIT(); asm volatile("" ::: "memory");
}

__device__ __forceinline__ void phase_prologue(CArgs ap, LAS unsigned char* lds, int tid, int lane, int wave, int bid, int G) {
    CA& a = *ap;
    unsigned char* ws = a.ws;
    PROBE_SUB(ws, tid, 11);
    if (bid < 192) {
        LAS float* S = (LAS float*)lds;
        LAS float* R = (LAS float*)(lds + 17 * 1024 * 4);
        for (int idx = tid; idx < 17 * 1024; idx += NTHREADS) { const int r = idx >> 10, k = idx & 1023; const float v = r < 16 ? a.in[I_C][r * 1024 + k] : a.in[I_CCTX][k]; S[idx] = v / (1.0f + __expf(-v)); }
        __syncthreads();
        const int l = bid / 48, c0 = (bid % 48) * 128, col = tid & 127, kq = tid >> 7;
        float acc[17];
#pragma unroll
        for (int r = 0; r < 17; ++r) acc[r] = 0.f;
        const float* wp = a.in[I_WMOD] + ((size_t)l * 1024 + kq * 256) * 6144 + c0 + col;
#pragma unroll 4
        for (int k = 0; k < 256; ++k) { const float w = wp[(size_t)k * 6144];
#pragma unroll
            for (int r = 0; r < 17; ++r) acc[r] += S[r * 1024 + kq * 256 + k] * w; }
#pragma unroll
        for (int r = 0; r < 17; ++r) R[(kq * 17 + r) * 128 + col] = acc[r];
        __syncthreads();
        float* MOD = (float*)(ws + WS_MOD);
        for (int idx = tid; idx < 17 * 128; idx += NTHREADS) { const int r = idx >> 7, cc = idx & 127;
            const float v = R[(0 * 17 + r) * 128 + cc] + R[(1 * 17 + r) * 128 + cc] + R[(2 * 17 + r) * 128 + cc] + R[(3 * 17 + r) * 128 + cc] + a.in[I_BMOD][l * 6144 + c0 + cc];
            MOD[((size_t)l * 17 + r) * 6144 + c0 + cc] = v; }
    }
    else s5_build_mats(ap, lds, tid, (bid - 192) >> 4, (bid - 192) & 15);
    PROBE_SUB(ws, tid, 12);
    __syncthreads();
    {
        LAS float* scr = (LAS float*)(lds + wave * 16384);
        const int gw = bid * NWAVES + wave, NGW = G * NWAVES;
        constexpr int N_WGU = 128 * 1024, N_WD = 128 * 512, N_WIN = 4 * 2432, N_WO = 4 * 512, N_WAO = 4 * 256, N_WSO = 4 * 128, N_WCO = 4 * 128, N_WGLU = 4 * 32;
        constexpr int NITEMS = N_WGU + N_WD + N_WIN + N_WO + N_WAO + N_WSO + N_WCO + N_WGLU;
        for (int it = gw; it < NITEMS; it += NGW) {
            int r = it;
            if (r < N_WGU) { const int m = r >> 10; transpose_item<1>(a.in[I_WGU] + (size_t)m * 1024 * 2048, 1024, 2048, (bf16*)(ws + WS_WGU + (size_t)m * 2048 * 1024), scr, r & 1023, lane); continue; } r -= N_WGU;
            if (r < N_WD) { const int m = r >> 9; transpose_item<2>(a.in[I_WD] + (size_t)m * 1024 * 1024, 1024, 1024, (bf16*)(ws + WS_WD + (size_t)m * 1024 * 1024), scr, r & 511, lane); continue; } r -= N_WD;
            if (r < N_WIN) { const int m = r / 2432, it2 = r - m * 2432;
                if ((it2 % 152) < 56) transpose_item<0>(a.in[I_WIN] + (size_t)m * 1024 * DIN, 1024, DIN, (bf16*)(ws + WS_WIN) + (size_t)m * 1792 * 1024, scr, it2, lane);
                else transpose_item<2>(a.in[I_WIN] + (size_t)m * 1024 * DIN, 1024, DIN, (bf16*)(ws + WS_WIN8 + (size_t)m * 3072 * 1024 - (size_t)1792 * 1024), scr, it2, lane);
                continue; } r -= N_WIN;
            if (r < N_WO) { const int m = r >> 9; transpose_item<0>(a.in[I_WO] + (size_t)m * 1024 * 1024, 1024, 1024, (bf16*)(ws + WS_WO) + (size_t)m * 1024 * 1024, scr, r & 511, lane); continue; } r -= N_WO;
            if (r < N_WAO) { const int m = r >> 8; transpose_item<0>(a.in[I_WAO] + (size_t)m * 512 * 1024, 512, 1024, (bf16*)(ws + WS_WAO) + (size_t)m * 1024 * 512, scr, r & 255, lane); continue; } r -= N_WAO;
            if (r < N_WSO) { const int m = r >> 7; transpose_item<0>(a.in[I_WSO] + (size_t)m * 256 * 1024, 256, 1024, (bf16*)(ws + WS_WSO) + (size_t)m * 1024 * 256, scr, r & 127, lane); continue; } r -= N_WSO;
            if (r < N_WCO) { const int m = r >> 7; transpose_item<0>(a.in[I_WCO] + (size_t)m * 256 * 1024, 256, 1024, (bf16*)(ws + WS_WCO) + (size_t)m * 1024 * 256, scr, r & 127, lane); continue; } r -= N_WCO;
            { const int m = r >> 5; transpose_item<0>(a.in[I_WGLU] + (size_t)m * 256 * 256, 256, 256, (bf16*)(ws + WS_WGLU) + (size_t)m * 256 * 256, scr, r & 31, lane); }
        }
    }
    PROBE_SUB(ws, tid, 13);
    {
        const int gt = bid * NTHREADS + tid, NGT = G * NTHREADS;
        unsigned* WRF = (unsigned*)(ws + WS_WRT);
        for (int i = gt; i < 4 * 32 * 2 * 64 * 4; i += NGT) { const int jp = i & 3, ln = (i >> 2) & 63, nt = (i >> 8) & 1, ks = (i >> 9) & 31, l = i >> 14;
            const int e = nt * 16 + (ln & 15), k = 32 * ks + 8 * (ln >> 4) + 2 * jp;
            const float w0 = a.in[I_WR][((size_t)l * 1024 + k) * 32 + e], w1 = a.in[I_WR][((size_t)l * 1024 + k + 1) * 32 + e];
            const unsigned hi = cvtpk(w0, w1); const unsigned lo = cvtpk(w0 - bflo(hi), w1 - bfhi(hi));
            const size_t base = ((((size_t)l * 32 + ks) * 2 + nt) * 2) * 256 + ln * 4 + jp;
            WRF[base] = hi; WRF[base + 256] = lo; }
        float* ROPE = (float*)(ws + WS_ROPE);
        for (int i = gt; i < 2048 * 32; i += NGT) { const int t = i >> 5, p = i & 31; const float pos = (float)(p < 16 ? (t >> 6) : (t & 63));
            const float inv = powf(10000.0f, -(float)(p & 15) / 16.0f); float sn, cs; sincosf(pos * inv, &sn, &cs); ROPE[2 * i] = cs; ROPE[2 * i + 1] = sn; }
    }
}

template <int MODE>
__device__ __forceinline__ void phase_n1(CArgs ap, int l, int lane, int gw, int NGW) {
    CA& a = *ap;
    unsigned char* ws = a.ws;
    float* X = (float*)(ws + WS_X); bf16* H = (bf16*)(ws + WS_H);
    const float* MOD = (const float*)(ws + WS_MOD);
    const unsigned char* YS = (const unsigned char*)(ws + WS_YS8); const float* TOPG = (const float*)(ws + WS_TOPG); const int* SLOT = (const int*)(ws + WS_SLOT);
    const float* gn = a.in[I_N1G] + (l < DEPTH ? l : 0) * D;
    constexpr int RPT = 3;
    for (int row0 = gw; row0 < T; row0 += RPT * NGW) {
        int rowv[RPT], bb[RPT], sv[RPT], rv[RPT]; bool on[RPT];
        f32x4 v[RPT][4], tg[RPT]; int4 sl[RPT]; unsigned y8[RPT][4][4];
#pragma unroll
        for (int rr = 0; rr < RPT; ++rr) { const int row = row0 + rr * NGW; rowv[rr] = row; on[rr] = row < T; const int rowc = on[rr] ? row : row0;
            const int b = rowc / TB, s = rowc - b * TB; const bool isctx = s < CTX; bb[rr] = b; sv[rr] = s; rv[rr] = isctx ? 16 : b; if (MODE == 2 && isctx) on[rr] = false;
            const float* src = (MODE == 0) ? (isctx ? a.in[I_CTX] + ((size_t)b * CTX + s) * D : a.in[I_X] + ((size_t)b * SEQ + (s - CTX)) * D) : X + (size_t)rowc * D;
#pragma unroll
            for (int j = 0; j < 4; ++j) v[rr][j] = *(const f32x4*)(src + 4 * lane + 256 * j);
            if (MODE != 0) { tg[rr] = *(const f32x4*)(TOPG + (size_t)rowc * 4); sl[rr] = *(const int4*)(SLOT + (size_t)rowc * 4); } }
        if (MODE != 0) {
#pragma unroll
            for (int rr = 0; rr < RPT; ++rr) { const int sls[4] = {sl[rr].x, sl[rr].y, sl[rr].z, sl[rr].w};
#pragma unroll
                for (int k = 0; k < 4; ++k)
#pragma unroll
                    for (int j = 0; j < 4; ++j) y8[rr][k][j] = *(const unsigned*)((const unsigned char*)YS + (size_t)sls[k] * D + 4 * lane + 256 * j); }
        }
#pragma unroll
        for (int rr = 0; rr < RPT; ++rr) {
            if (!on[rr]) continue;
            const int row = rowv[rr], r = rv[rr];
            if (MODE != 0) {
                const float* g2 = MOD + ((size_t)(l - 1) * 17 + r) * 6144 + 5120;
#pragma unroll
                for (int j = 0; j < 4; ++j) { f32x4 acc = (f32x4){0.f, 0.f, 0.f, 0.f};
#pragma unroll
                    for (int k = 0; k < 4; ++k) { const unsigned w = y8[rr][k][j]; const f32x2 lo = __builtin_amdgcn_cvt_pk_f32_fp8(w, false), hi = __builtin_amdgcn_cvt_pk_f32_fp8(w, true); acc += tg[rr][k] * (f32x4){lo.x, lo.y, hi.x, hi.y}; }
                    v[rr][j] += *(const f32x4*)(g2 + 4 * lane + 256 * j) * acc; }
            }
            if (MODE == 2) {
                float* o = a.out + ((size_t)bb[rr] * SEQ + (sv[rr] - CTX)) * D;
#pragma unroll
                for (int j = 0; j < 4; ++j) *(f32x4*)(o + 4 * lane + 256 * j) = v[rr][j];
                continue;
            }
            float ss = 0.f;
#pragma unroll
            for (int j = 0; j < 4; ++j) { *(f32x4*)(X + (size_t)row * D + 4 * lane + 256 * j) = v[rr][j]; ss += (v[rr][j].x * v[rr][j].x + v[rr][j].y * v[rr][j].y) + (v[rr][j].z * v[rr][j].z + v[rr][j].w * v[rr][j].w); }
            const float rstd = rsqrtf(wave_sum(ss, lane) * (1.0f / D) + EPS);
            const float* md = MOD + ((size_t)l * 17 + r) * 6144;
#pragma unroll
            for (int j = 0; j < 4; ++j) { const int c = 4 * lane + 256 * j;
                const f32x4 g = *(const f32x4*)(gn + c), sh = *(const f32x4*)(md + c), sc = *(const f32x4*)(md + 1024 + c);
                const f32x4 h = (v[rr][j] * rstd * g) * (sc + 1.0f) + sh;
                v2u o; o.x = cvtpk(h.x, h.y); o.y = cvtpk(h.z, h.w); *(v2u*)(H + (size_t)row * D + c) = o;
                unsigned w8 = 0u; w8 = __builtin_amdgcn_cvt_pk_fp8_f32(h.x, h.y, w8, false); w8 = __builtin_amdgcn_cvt_pk_fp8_f32(h.z, h.w, w8, true);
                *(unsigned*)((unsigned char*)(ws + WS_H8) + (size_t)row * D + c) = w8; }
        }
    }
}

__device__ __forceinline__ void build_gc(CArgs ap, int l, int gt, int NGT) {
    CA& a = *ap; const float* MOD = (const float*)(a.ws + WS_MOD); float* GC = (float*)(a.ws + WS_GC) + (size_t)l * 17 * 1024;
    for (int i = gt; i < 17 * 1024; i += NGT) { const int r = i >> 10, k = i & 1023; GC[i] = a.in[I_N2G][l * D + k] * (1.0f + MOD[((size_t)l * 17 + r) * 6144 + 4096 + k]); }
}

__device__ __forceinline__ void phase_prep(CArgs ap, int l, int lane, int gw, int NGW) {
    CA& a = *ap;
    unsigned char* ws = a.ws;
    const bf16* P = (const bf16*)(ws + WS_PROJ); bf16* YB = (bf16*)(ws + WS_YB); bf16* QN = (bf16*)(ws + WS_QN); bf16* KN = (bf16*)(ws + WS_KN);
    const float* ROPE = (const float*)(ws + WS_ROPE);
    const float* cw = a.in[I_CONVW] + l * 3 * 256;
    const int c4 = 4 * lane, d0 = (lane & 7) * 8;
    const f32x4 w0 = *(const f32x4*)(cw + c4), w1 = *(const f32x4*)(cw + 256 + c4), w2 = *(const f32x4*)(cw + 512 + c4);
    const f32x4 gq0 = *(const f32x4*)(a.in[I_QG] + l * 64 + d0), gq1 = *(const f32x4*)(a.in[I_QG] + l * 64 + d0 + 4), gk0 = *(const f32x4*)(a.in[I_KG] + l * 64 + d0), gk1 = *(const f32x4*)(a.in[I_KG] + l * 64 + d0 + 4);
    const bool first = (lane & 4) == 0;
    constexpr int RPT = 4;
    for (int row0 = gw; row0 < T; row0 += RPT * NGW) {
        v2u cc[RPT][3], cx[RPT][3], cb[RPT]; v4u qw[RPT], kw[RPT]; f32x4 rp[RPT][4]; bool isc[RPT], on[RPT]; int rowv[RPT];
#pragma unroll
        for (int rr = 0; rr < RPT; ++rr) { const int rowt = row0 + rr * NGW; on[rr] = rowt < T; const int row = on[rr] ? rowt : row0; rowv[rr] = row;
            const int b = row / TB, s = row - b * TB; const bool isctx = s < CTX; isc[rr] = isctx;
            const int lo = isctx ? 0 : CTX, hi = isctx ? CTX : TB;
#pragma unroll
            for (int d = 0; d < 3; ++d) { const int s2 = s + d - 1; const bool ok = s2 >= lo && s2 < hi; const bf16* pr = P + (size_t)(ok ? row + d - 1 : row) * DIN;
                cc[rr][d] = *(const v2u*)(pr + OFF_CC + c4); cx[rr][d] = *(const v2u*)(pr + OFF_CX + c4); if (!ok) { cc[rr][d] = (v2u){0u, 0u}; } }
            cb[rr] = *(const v2u*)(P + (size_t)row * DIN + OFF_CB + c4);
            qw[rr] = *(const v4u*)(P + (size_t)row * DIN + OFF_Q + lane * 8); kw[rr] = *(const v4u*)(P + (size_t)row * DIN + OFF_K + (lane & 15) * 8);
            const float* rpp = ROPE + ((size_t)(isctx ? 0 : s - CTX) * 32 + (d0 & 31)) * 2;
#pragma unroll
            for (int i = 0; i < 4; ++i) rp[rr][i] = *(const f32x4*)(rpp + 4 * i); }
#pragma unroll
        for (int rr = 0; rr < RPT; ++rr) {
            if (!on[rr]) continue;
            const int row = rowv[rr];
            { f32x4 zz[3];
#pragma unroll
              for (int d = 0; d < 3; ++d) zz[d] = (f32x4){bflo(cc[rr][d].x) * bflo(cx[rr][d].x), bfhi(cc[rr][d].x) * bfhi(cx[rr][d].x), bflo(cc[rr][d].y) * bflo(cx[rr][d].y), bfhi(cc[rr][d].y) * bfhi(cx[rr][d].y)};
              const f32x4 yv = (f32x4){bflo(cb[rr].x), bfhi(cb[rr].x), bflo(cb[rr].y), bfhi(cb[rr].y)} * (w0 * zz[0] + w1 * zz[1] + w2 * zz[2]);
              v2u o; o.x = cvtpk(yv.x, yv.y); o.y = cvtpk(yv.z, yv.w); *(v2u*)(YB + (size_t)row * 256 + c4) = o; }
#pragma unroll
            for (int pass = 0; pass < 2; ++pass) {
                const v4u w = pass ? kw[rr] : qw[rr];
                float x[8] = {bflo(w.x), bfhi(w.x), bflo(w.y), bfhi(w.y), bflo(w.z), bfhi(w.z), bflo(w.w), bfhi(w.w)};
                float ss = 0.f;
#pragma unroll
                for (int i = 0; i < 8; ++i) ss += x[i] * x[i];
                ss = sum8(ss);
                const float rstd = rsqrtf(ss * (1.0f / 64.0f) + EPS) * (pass ? 1.0f : 0.125f * 1.4426950408889634f);
                const f32x4 ga = pass ? gk0 : gq0, gb = pass ? gk1 : gq1;
#pragma unroll
                for (int i = 0; i < 8; ++i) x[i] = x[i] * rstd * (i < 4 ? ga[i] : gb[i - 4]);
                if (!isc[rr]) {
#pragma unroll
                    for (int i = 0; i < 8; ++i) { const float pr = xor4(x[i], lane); const float cs = rp[rr][i >> 1][2 * (i & 1)], sn = rp[rr][i >> 1][2 * (i & 1) + 1];
                        x[i] = first ? (x[i] * cs - pr * sn) : (pr * sn + x[i] * cs); }
                }
                v4u o; o.x = cvtpk(x[0], x[1]); o.y = cvtpk(x[2], x[3]); o.z = cvtpk(x[4], x[5]); o.w = cvtpk(x[6], x[7]);
                if (pass == 0) *(v4u*)(QN + (size_t)row * 512 + lane * 8) = o;
                else if (lane < 16) *(v4u*)(KN + (size_t)row * 128 + lane * 8) = o;
            }
        }
    }
}

typedef short bf16x8v __attribute__((ext_vector_type(8)));
__device__ __forceinline__ f32x4 mfma16(const v4u& a, const v4u& b, const f32x4& c) { return __builtin_amdgcn_mfma_f32_16x16x32_bf16(__builtin_bit_cast(bf16x8v, a), __builtin_bit_cast(bf16x8v, b), c, 0, 0, 0); }

__device__ __forceinline__ void s5_build_mats(CArgs ap, LAS unsigned char* lds, int tid, int l, int g) {
    CA& a = *ap;
    LAS float* LP = (LAS float*)lds;
    LAS float* BB = LP + 2 * 9 * 64 * 2;
    LAS float* CC = BB + 2 * 64 * 16 * 2;
    for (int i = tid; i < 2 * 9 * 64; i += NTHREADS) { const int z = i / 576, d = (i / 64) % 9, p = i & 63; const int pi = (l * 2 + z) * 16 + g;
        const float lre = a.in[I_LRE][pi * 64 + p], lim = a.in[I_LIM][pi * 64 + p], dt = expf(a.in[I_LDT][pi]);
        float sn, cs; sincosf((float)d * lim * dt, &sn, &cs); const float er = expf((float)d * lre * dt);
        LP[2 * i] = er * cs; LP[2 * i + 1] = er * sn; }
    for (int i = tid; i < 2 * 64 * 16; i += NTHREADS) { const int z = i >> 10, p = (i >> 4) & 63, h = i & 15; const int pi = (l * 2 + z) * 16 + g;
        const float lre = a.in[I_LRE][pi * 64 + p], lim = a.in[I_LIM][pi * 64 + p], dt = expf(a.in[I_LDT][pi]);
        float sn, cs; sincosf(lim * dt, &sn, &cs); const float er = expf(lre * dt); const float nr = er * cs - 1.0f, ni = er * sn, d2 = lre * lre + lim * lim;
        const float qr = (nr * lre + ni * lim) / d2, qi = (ni * lre - nr * lim) / d2;
        const float br = a.in[I_BRE][((size_t)pi * 64 + p) * 16 + h], bi = a.in[I_BIM][((size_t)pi * 64 + p) * 16 + h];
        BB[2 * i] = qr * br - qi * bi; BB[2 * i + 1] = qr * bi + qi * br;
        const int hc = (i >> 6) & 15, pc = i & 63;
        CC[2 * i] = a.in[I_CRE][((size_t)pi * 16 + hc) * 64 + pc]; CC[2 * i + 1] = a.in[I_CIM][((size_t)pi * 16 + hc) * 64 + pc]; }
    __syncthreads();
    LAS float* KT = CC + 2 * 16 * 64 * 2;
    { const int e0 = tid * 8; const int z = e0 >> 11, d = (e0 >> 8) & 7, h = (e0 >> 4) & 15, h20 = e0 & 15; float kv[8];
#pragma unroll
      for (int j = 0; j < 8; ++j) kv[j] = 0.f;
      for (int p = 0; p < 64; ++p) { const float cr = CC[2 * ((z * 16 + h) * 64 + p)], ci = CC[2 * ((z * 16 + h) * 64 + p) + 1], lr = LP[2 * ((z * 9 + d) * 64 + p)], li = LP[2 * ((z * 9 + d) * 64 + p) + 1];
          const float tr = cr * lr - ci * li, ti = cr * li + ci * lr;
#pragma unroll
          for (int j = 0; j < 8; ++j) kv[j] += tr * BB[2 * ((z * 64 + p) * 16 + h20 + j)] - ti * BB[2 * ((z * 64 + p) * 16 + h20 + j) + 1]; }
#pragma unroll
      for (int j = 0; j < 8; ++j) KT[e0 + j] = kv[j]; }
    __syncthreads();
    bf16* MS = (bf16*)(a.ws + WS_MS) + (size_t)(l * 16 + g) * 256 * 128; bf16* W = (bf16*)(a.ws + WS_W5) + (size_t)(l * 16 + g) * 128 * 384;
    for (int i = tid; i < 256 * 128; i += NTHREADS) { const int j = i & 7, ln = (i >> 3) & 63, nt = (i >> 9) & 15, ks = i >> 13; const int n = nt * 16 + (ln & 15), k = ks * 32 + (ln >> 4) * 8 + j;
        const int z = n >> 7, part = n & 1, p = (n >> 1) & 63, a2 = k >> 4, h2 = k & 15; const int e = z == 0 ? 7 - a2 : a2;
        const float lr = LP[2 * ((z * 9 + e) * 64 + p)], li = LP[2 * ((z * 9 + e) * 64 + p) + 1], br = BB[2 * ((z * 64 + p) * 16 + h2)], bi = BB[2 * ((z * 64 + p) * 16 + h2) + 1];
        MS[i] = (bf16)f2bf(part == 0 ? lr * br - li * bi : lr * bi + li * br); }
    for (int i = tid; i < 128 * 384; i += NTHREADS) { const int j = i & 7, ln = (i >> 3) & 63, nt = (i >> 9) & 7, ks = i >> 12; const int n = nt * 16 + (ln & 15), k = ks * 32 + (ln >> 4) * 8 + j;
        const int aa = n >> 4, h = n & 15; float v = 0.f;
        if (k < 128) { const int a2 = k >> 4, h2 = k & 15;
            if (a2 <= aa) v += KT[((0 * 8 + (aa - a2)) * 16 + h) * 16 + h2];
            if (a2 >= aa) v += KT[((1 * 8 + (a2 - aa)) * 16 + h) * 16 + h2];
            if (a2 == aa && h2 == h) v += a.in[I_SD][l * 256 + g * 16 + h];
        } else { const int z = (k - 128) >> 7, kk = (k - 128) & 127, part = kk & 1, p = kk >> 1; const int d = z == 0 ? aa + 1 : 8 - aa;
            const float cr = CC[2 * ((z * 16 + h) * 64 + p)], ci = CC[2 * ((z * 16 + h) * 64 + p) + 1], lr = LP[2 * ((z * 9 + d) * 64 + p)], li = LP[2 * ((z * 9 + d) * 64 + p) + 1];
            v = part == 0 ? (cr * lr - ci * li) : -(cr * li + ci * lr); }
        W[i] = (bf16)f2bf(v); }
    __syncthreads();
}

constexpr int S5_ROWS = T / 8, S5_RT = S5_ROWS / 32;
__device__ __forceinline__ void s5a_block(CArgs ap, int l, int blk, LAS unsigned char* lds, int tid, int lane, int wave) {
    CA& a = *ap; unsigned char* ws = a.ws;
    const int g = blk & 15, part = blk >> 4, c = lane & 15, q = lane >> 4;
    { const v4u* src = (const v4u*)((const bf16*)(ws + WS_MS) + (size_t)(l * 16 + g) * 256 * 128); LAS v4u* dst = (LAS v4u*)lds;
#pragma unroll
      for (int i = 0; i < 8; ++i) dst[tid + i * NTHREADS] = src[tid + i * NTHREADS]; }
    __syncthreads();
    const LAS v4u* Bl = (const LAS v4u*)lds + lane;
    for (int mt = wave; mt < 18; mt += NWAVES) {
        const int r0 = part * 288 + mt * 16;
        const bf16* Pu = (const bf16*)(ws + WS_PROJ) + ((size_t)(r0 + c) * 8 + (q >> 1)) * DIN + OFF_U + g * 16 + (q & 1) * 8;
        v4u af[4];
#pragma unroll
        for (int ks = 0; ks < 4; ++ks) af[ks] = *(const v4u*)(Pu + (size_t)2 * ks * DIN);
        f32x4 acc[16];
#pragma unroll
        for (int n = 0; n < 16; ++n) acc[n] = (f32x4){0.f, 0.f, 0.f, 0.f};
#pragma unroll
        for (int ks = 0; ks < 4; ++ks) { v4u bfr[16];
#pragma unroll
            for (int n = 0; n < 16; ++n) bfr[n] = Bl[(ks * 16 + n) * 64];
#pragma unroll
            for (int n = 0; n < 16; ++n) acc[n] = mfma16(bfr[n], af[ks], acc[n]);
            asm volatile("" ::: "memory"); }
        float* Sp = (float*)(ws + WS_S5S) + ((size_t)g * S5_ROWS + r0 + c) * 256 + 4 * q;
#pragma unroll
        for (int n = 0; n < 16; ++n) *(f32x4*)(Sp + n * 16) = acc[n];
    }
    VM_WAIT(); __syncthreads();
}
__device__ __forceinline__ void s5b_unit(CArgs ap, int l, int u, int lane) {
    CA& a = *ap; unsigned char* ws = a.ws;
    const int b = u & 15, z = (u >> 4) & 1, g = u >> 5, p = lane; const int pi = (l * 2 + z) * 16 + g;
    const float lre = a.in[I_LRE][pi * 64 + p], lim = a.in[I_LIM][pi * 64 + p], dt = expf(a.in[I_LDT][pi]);
    float sn, cs; sincosf(8.0f * lim * dt, &sn, &cs); const float er = expf(8.0f * lre * dt); const float l8r = er * cs, l8i = er * sn;
    const f32x2* S = (const f32x2*)((const float*)(ws + WS_S5S) + ((size_t)g * S5_ROWS + b * 288) * 256 + z * 128) + p;
    unsigned* XI = (unsigned*)((bf16*)(ws + WS_XIN) + ((size_t)(z * 16 + g) * S5_ROWS + b * 288) * 128) + p;
    float xr = 0.f, xi = 0.f;
    constexpr int BS = 32;
    f32x2 sv[BS];
#pragma unroll
    for (int j = 0; j < BS; ++j) { const int cc = z == 0 ? j : 31 - j; sv[j] = S[(size_t)cc * 128]; }
    for (int i0 = 0; i0 < 288; i0 += BS) {
        f32x2 nv[BS];
        if (i0 + BS < 288) {
#pragma unroll
            for (int j = 0; j < BS; ++j) { const int i = i0 + BS + j; const int cc = z == 0 ? i : (i < 32 ? 31 - i : 319 - i); nv[j] = S[(size_t)cc * 128]; }
        }
        unsigned ov[BS];
#pragma unroll
        for (int j = 0; j < BS; ++j) { ov[j] = cvtpk(xr, xi);
            const float nr = l8r * xr - l8i * xi + sv[j].x, ni = l8r * xi + l8i * xr + sv[j].y; xr = nr; xi = ni; }
#pragma unroll
        for (int j = 0; j < BS; ++j) { const int i = i0 + j; const int cc = z == 0 ? i : (i < 32 ? 31 - i : 319 - i); XI[(size_t)cc * 64] = ov[j]; }
#pragma unroll
        for (int j = 0; j < BS; ++j) sv[j] = nv[j];
    }
}
__device__ __forceinline__ void s5c_block(CArgs ap, int l, int blk, LAS unsigned char* lds, int tid, int lane, int wave) {
    CA& a = *ap; unsigned char* ws = a.ws;
    const int g = blk & 15, part = blk >> 4, c = lane & 15, q = lane >> 4;
    { const v4u* src = (const v4u*)((const bf16*)(ws + WS_W5) + (size_t)(l * 16 + g) * 128 * 384); LAS v4u* dst = (LAS v4u*)lds;
#pragma unroll
      for (int i = 0; i < 12; ++i) dst[tid + i * NTHREADS] = src[tid + i * NTHREADS]; }
    __syncthreads();
    const LAS v4u* Bl = (const LAS v4u*)lds + lane;
    for (int mt = wave; mt < 18; mt += NWAVES) {
        const int r0 = part * 288 + mt * 16;
        const bf16* Pu = (const bf16*)(ws + WS_PROJ) + ((size_t)(r0 + c) * 8 + (q >> 1)) * DIN + OFF_U + g * 16 + (q & 1) * 8;
        const bf16* X0 = (const bf16*)(ws + WS_XIN) + ((size_t)g * S5_ROWS + r0 + c) * 128 + q * 8; const bf16* X1 = X0 + (size_t)16 * S5_ROWS * 128;
        v4u af[12];
#pragma unroll
        for (int ks = 0; ks < 4; ++ks) { af[ks] = *(const v4u*)(Pu + (size_t)2 * ks * DIN); af[4 + ks] = *(const v4u*)(X0 + ks * 32); af[8 + ks] = *(const v4u*)(X1 + ks * 32); }
        f32x4 acc[8];
#pragma unroll
        for (int n = 0; n < 8; ++n) acc[n] = (f32x4){0.f, 0.f, 0.f, 0.f};
#pragma unroll
        for (int ks = 0; ks < 12; ++ks) { v4u bfr[8];
#pragma unroll
            for (int n = 0; n < 8; ++n) bfr[n] = Bl[(ks * 8 + n) * 64];
#pragma unroll
            for (int n = 0; n < 8; ++n) acc[n] = mfma16(bfr[n], af[ks], acc[n]);
            if (ks & 1) asm volatile("" ::: "memory"); }
        bf16* Zp = (bf16*)(ws + WS_Z) + (size_t)(r0 + c) * 8 * 256 + g * 16 + 4 * q;
#pragma unroll
        for (int n = 0; n < 8; ++n) { const f32x4 y = acc[n]; v2u o; o.x = cvtpk(gelu_tanh(y[0]), gelu_tanh(y[1])); o.y = cvtpk(gelu_tanh(y[2]), gelu_tanh(y[3])); *(v2u*)(Zp + n * 256) = o; }
    }
    __syncthreads();
}

typedef float f32x16 __attribute__((ext_vector_type(16)));
__device__ __forceinline__ f32x16 mfma32(const v4u& a, const v4u& b, const f32x16& c) { return __builtin_amdgcn_mfma_f32_32x32x16_bf16(__builtin_bit_cast(bf16x8v, a), __builtin_bit_cast(bf16x8v, b), c, 0, 0, 0); }
struct AttnFrag { v4u ka[4]; v4u va[2][2]; };
__device__ __forceinline__ void attn_load(AttnFrag& f, const bf16* KN, const bf16* VT, int s0, int r) {
#pragma unroll
    for (int ks = 0; ks < 4; ++ks) f.ka[ks] = *(const v4u*)(KN + (size_t)(s0 + r) * 128 + 16 * ks);
#pragma unroll
    for (int mt = 0; mt < 2; ++mt)
#pragma unroll
        for (int s = 0; s < 2; ++s) f.va[mt][s] = *(const v4u*)(VT + (size_t)mt * 32 * TB + s0 + 16 * s);
}
template <int NH>
__device__ __forceinline__ void attn_tile(const AttnFrag& f, const v4u (&bq)[NH][4], f32x16 (&o)[NH][2], float (&m)[NH], float (&lsum)[NH], int mode, unsigned keep1, unsigned keep2, int lane) {
#pragma unroll
    for (int hh = 0; hh < NH; ++hh) {
        f32x16 st;
#pragma unroll
        for (int i = 0; i < 16; ++i) st[i] = 0.f;
#pragma unroll
        for (int ks = 0; ks < 4; ++ks) st = mfma32(f.ka[ks], bq[hh][ks], st);
        if (mode != 0) {
            unsigned kp = mode == 1 ? keep1 : keep2;
            asm volatile("" : "+v"(kp) :: "memory");
#pragma unroll
            for (int i = 0; i < 16; ++i) if (!((kp >> i) & 1u)) st[i] = -INFINITY;
        }
        float mx = st[0];
#pragma unroll
        for (int i = 1; i < 16; ++i) mx = fmaxf(mx, st[i]);
        mx = fmaxf(mx, shx(mx, 32, lane));
        const float mn = fmaxf(m[hh], mx), al = __builtin_amdgcn_exp2f(m[hh] - mn); m[hh] = mn;
        const f32x2 nm2 = {-mn, -mn}; f32x2 ps2 = {0.f, 0.f};
#pragma unroll
        for (int i = 0; i < 8; ++i) { f32x2 x = {st[2 * i], st[2 * i + 1]}; x = x + nm2; f32x2 e; e.x = __builtin_amdgcn_exp2f(x.x); e.y = __builtin_amdgcn_exp2f(x.y); st[2 * i] = e.x; st[2 * i + 1] = e.y; ps2 = ps2 + e; }
        lsum[hh] = lsum[hh] * al + (ps2.x + ps2.y);
#pragma unroll
        for (int i = 0; i < 16; ++i) { o[hh][0][i] *= al; o[hh][1][i] *= al; }
#pragma unroll
        for (int s = 0; s < 2; ++s) { v4u pb; pb.x = cvtpk(st[8 * s + 0], st[8 * s + 1]); pb.y = cvtpk(st[8 * s + 2], st[8 * s + 3]); pb.z = cvtpk(st[8 * s + 4], st[8 * s + 5]); pb.w = cvtpk(st[8 * s + 6], st[8 * s + 7]);
            o[hh][0] = mfma32(f.va[0][s], pb, o[hh][0]); o[hh][1] = mfma32(f.va[1][s], pb, o[hh][1]); }
    }
}
template <int NH>
__device__ __forceinline__ void attn_item(CArgs ap, int l, bool lat, int idx, int lane) {
    CA& a = *ap; unsigned char* ws = a.ws;
    int b, hd0, qg;
    if (NH == 2) { b = idx >> 8; qg = (idx >> 2) & 63; hd0 = 2 * (idx & 3); } else { b = idx >> 6; qg = (idx >> 3) & 7; hd0 = idx & 7; }
    const int g2 = hd0 >> 2, r = lane & 31, h = lane >> 5, q0 = qg * 32;
    const int qrow = b * TB + (lat ? CTX : 0) + q0 + r;
    const bf16* KN = (const bf16*)(ws + WS_KN) + (size_t)b * TB * 128 + g2 * 64 + 8 * h;
    const bf16* VT = (const bf16*)(ws + WS_VT) + ((size_t)(b * 2 + g2) * 64 + r) * TB + 8 * h;
    v4u bq[NH][4];
#pragma unroll
    for (int hh = 0; hh < NH; ++hh)
#pragma unroll
        for (int ks = 0; ks < 4; ++ks) bq[hh][ks] = *(const v4u*)((const bf16*)(ws + WS_QN) + (size_t)qrow * 512 + (hd0 + hh) * 64 + 16 * ks + 8 * h);
    f32x16 o[NH][2];
#pragma unroll
    for (int hh = 0; hh < NH; ++hh)
#pragma unroll
        for (int i = 0; i < 16; ++i) { o[hh][0][i] = 0.f; o[hh][1][i] = 0.f; }
    constexpr float L2E = 1.4426950408889634f;
    float m[NH], lsum[NH];
#pragma unroll
    for (int hh = 0; hh < NH; ++hh) { m[hh] = a.in[I_SINK][l * 8 + hd0 + hh] * L2E; lsum[hh] = h == 0 ? 1.0f : 0.0f; }
    unsigned keep1 = 0u, keep2 = 0u;
#pragma unroll
    for (int i = 0; i < 16; ++i) { const int jj = (i & 3) + 8 * (i >> 2) + 4 * h; keep1 |= (jj >= r ? 1u : 0u) << i; keep2 |= (jj <= r ? 1u : 0u) << i; }
    const int tlo = lat ? (4 - qg > 0 ? 4 - qg : 0) : 9, thi = lat ? (67 - qg < 8 ? 67 - qg : 8) : -1;
    const int nl = thi - tlo + 1, n = nl + 8;
    AttnFrag fa, fb;
#define ATT_TT(i_) ((i_) < nl ? tlo + (i_) : 9 + (i_) - nl)
#define ATT_S0(t_) ((t_) < 9 ? CTX + q0 - 128 + 32 * (t_) : 32 * ((t_) - 9))
#define ATT_MODE(t_) ((t_) == 0 ? 1 : ((t_) == 8 ? 2 : 0))
    { const int t0 = ATT_TT(0); attn_load(fa, KN, VT, ATT_S0(t0), r); }
    int i = 0;
    for (; i + 1 < n; i += 2) {
        const int ta = ATT_TT(i), tb = ATT_TT(i + 1); const int i2 = i + 2 < n ? i + 2 : n - 1; const int tc = ATT_TT(i2);
        attn_load(fb, KN, VT, ATT_S0(tb), r);
        attn_tile<NH>(fa, bq, o, m, lsum, ATT_MODE(ta), keep1, keep2, lane);
        attn_load(fa, KN, VT, ATT_S0(tc), r);
        attn_tile<NH>(fb, bq, o, m, lsum, ATT_MODE(tb), keep1, keep2, lane);
    }
    if (i < n) { const int ta = ATT_TT(i); attn_tile<NH>(fa, bq, o, m, lsum, ATT_MODE(ta), keep1, keep2, lane); }
#undef ATT_TT
#undef ATT_S0
#undef ATT_MODE
#pragma unroll
    for (int hh = 0; hh < NH; ++hh) {
        const float lt = lsum[hh] + shx(lsum[hh], 32, lane); const float inv = 1.0f / lt;
        bf16* op = (bf16*)(ws + WS_YA) + (size_t)qrow * 512 + (hd0 + hh) * 64 + 4 * h;
#pragma unroll
        for (int gq = 0; gq < 4; ++gq) { v2u w0; w0.x = cvtpk(o[hh][0][4 * gq] * inv, o[hh][0][4 * gq + 1] * inv); w0.y = cvtpk(o[hh][0][4 * gq + 2] * inv, o[hh][0][4 * gq + 3] * inv); *(v2u*)(op + 8 * gq) = w0;
            v2u w1; w1.x = cvtpk(o[hh][1][4 * gq] * inv, o[hh][1][4 * gq + 1] * inv); w1.y = cvtpk(o[hh][1][4 * gq + 2] * inv, o[hh][1][4 * gq + 3] * inv); *(v2u*)(op + 32 + 8 * gq) = w1; }
    }
}
__device__ __forceinline__ void vt_item(CArgs ap, int item, int lane) {
    CA& a = *ap; unsigned char* ws = a.ws;
    const int tile = item >> 1, g2 = item & 1; const int row = tile * 64 + lane; const int b = row / TB, s = row - b * TB;
    const bf16* vp = (const bf16*)(ws + WS_PROJ) + (size_t)row * DIN + OFF_V + g2 * 64;
    const int k16 = s & 15, sp = (s & ~15) | ((((k16 >> 2) & 1) << 3) | (((k16 >> 3) & 1) << 2) | (k16 & 3));
    bf16* vt = (bf16*)(ws + WS_VT) + (size_t)(b * 2 + g2) * 64 * TB + sp;
#pragma unroll
    for (int i = 0; i < 8; ++i) { const v4u w = *(const v4u*)(vp + 8 * i);
        vt[(size_t)(8 * i + 0) * TB] = (bf16)(w.x & 0xffffu); vt[(size_t)(8 * i + 1) * TB] = (bf16)(w.x >> 16); vt[(size_t)(8 * i + 2) * TB] = (bf16)(w.y & 0xffffu); vt[(size_t)(8 * i + 3) * TB] = (bf16)(w.y >> 16);
        vt[(size_t)(8 * i + 4) * TB] = (bf16)(w.z & 0xffffu); vt[(size_t)(8 * i + 5) * TB] = (bf16)(w.z >> 16); vt[(size_t)(8 * i + 6) * TB] = (bf16)(w.w & 0xffffu); vt[(size_t)(8 * i + 7) * TB] = (bf16)(w.w >> 16); }
}

__device__ __forceinline__ void phase_n2(CArgs ap, int l, LAS unsigned char* lds, int tid, int lane, int wave, int bid, int G) {
    CA& a = *ap;
    unsigned char* ws = a.ws;
    const float* X = (const float*)(ws + WS_X); bf16* H = (bf16*)(ws + WS_H); const float* MOD = (const float*)(ws + WS_MOD);
    float* TOPG = (float*)(ws + WS_TOPG); int* SLOT = (int*)(ws + WS_SLOT); unsigned* CNT = (unsigned*)(ws + WS_CTL) + CW_CNT + l * 32;
    LAS unsigned* lcnt = (LAS unsigned*)(lds + LCNT_OFF);
    { const v4u* src = (const v4u*)((const unsigned*)(ws + WS_WRT) + (size_t)l * 32768); LAS v4u* dst = (LAS v4u*)lds;
#pragma unroll
      for (int i = 0; i < 16; ++i) dst[tid + i * NTHREADS] = src[tid + i * NTHREADS]; }
    if (tid < 32) lcnt[tid] = 0u;
    __syncthreads();
    const LAS v4u* Bl = (const LAS v4u*)lds + lane;
    LAS float* scr = (LAS float*)(lds + SCR_OFF) + wave * (16 * 33);
    const int c = lane & 15, q = lane >> 4;
    const bool skipctx = l == DEPTH - 1;
    const int tpb = (T / 16) / G;
    for (int tl = wave; tl < tpb; tl += NWAVES) {
        const int row0 = (bid * tpb + tl) * 16; const int b = row0 / TB, s0 = row0 - b * TB; const bool isctx = s0 < CTX; const int r = isctx ? 16 : b;
        if (skipctx && isctx) continue;
        const float* xr = X + (size_t)(row0 + c) * D + 8 * q;
        float ss = 0.f;
#pragma unroll 16
        for (int ks = 0; ks < 32; ++ks) { const f32x4 x0 = *(const f32x4*)(xr + 32 * ks), x1 = *(const f32x4*)(xr + 32 * ks + 4);
            ss += (x0.x * x0.x + x0.y * x0.y) + (x0.z * x0.z + x0.w * x0.w) + (x1.x * x1.x + x1.y * x1.y) + (x1.z * x1.z + x1.w * x1.w); }
        ss += shx(ss, 16, lane); ss += shx(ss, 32, lane);
        const float rstd = rsqrtf(ss * (1.0f / D) + EPS);
        const float* md = MOD + ((size_t)l * 17 + r) * 6144 + 3072 + 8 * q; const float* gc = (const float*)(ws + WS_GC) + ((size_t)l * 17 + r) * 1024 + 8 * q;
        unsigned char* h8 = (unsigned char*)(ws + WS_H8) + (size_t)(row0 + c) * D + 8 * q;
        f32x4 acc[2] = {(f32x4){0.f, 0.f, 0.f, 0.f}, (f32x4){0.f, 0.f, 0.f, 0.f}};
#pragma unroll 1
        for (int k4 = 0; k4 < 32; k4 += 4) {
          f32x4 xv[4][2], gv[4][2], hv[4][2];
#pragma unroll
          for (int u = 0; u < 4; ++u) { const int ks = k4 + u;
              xv[u][0] = *(const f32x4*)(xr + 32 * ks); xv[u][1] = *(const f32x4*)(xr + 32 * ks + 4); gv[u][0] = *(const f32x4*)(gc + 32 * ks); gv[u][1] = *(const f32x4*)(gc + 32 * ks + 4);
              hv[u][0] = *(const f32x4*)(md + 32 * ks); hv[u][1] = *(const f32x4*)(md + 32 * ks + 4); }
#pragma unroll
          for (int u = 0; u < 4; ++u) { const int ks = k4 + u;
            const f32x4 y0 = (xv[u][0] * rstd) * gv[u][0] + hv[u][0], y1 = (xv[u][1] * rstd) * gv[u][1] + hv[u][1];
            v4u ahi; ahi.x = cvtpk(y0.x, y0.y); ahi.y = cvtpk(y0.z, y0.w); ahi.z = cvtpk(y1.x, y1.y); ahi.w = cvtpk(y1.z, y1.w);
            { unsigned w0 = 0u, w1 = 0u;
              w0 = __builtin_amdgcn_cvt_pk_fp8_f32(y0.x, y0.y, w0, false); w0 = __builtin_amdgcn_cvt_pk_fp8_f32(y0.z, y0.w, w0, true);
              w1 = __builtin_amdgcn_cvt_pk_fp8_f32(y1.x, y1.y, w1, false); w1 = __builtin_amdgcn_cvt_pk_fp8_f32(y1.z, y1.w, w1, true);
              *(v2u*)(h8 + 32 * ks) = (v2u){w0, w1}; }
            v4u alo; alo.x = cvtpk(y0.x - bflo(ahi.x), y0.y - bfhi(ahi.x)); alo.y = cvtpk(y0.z - bflo(ahi.y), y0.w - bfhi(ahi.y)); alo.z = cvtpk(y1.x - bflo(ahi.z), y1.y - bfhi(ahi.z)); alo.w = cvtpk(y1.z - bflo(ahi.w), y1.w - bfhi(ahi.w));
#pragma unroll
            for (int nt = 0; nt < 2; ++nt) { const v4u whi = Bl[((ks * 2 + nt) * 2 + 0) * 64], wlo = Bl[((ks * 2 + nt) * 2 + 1) * 64];
                acc[nt] = mfma16(whi, ahi, acc[nt]); acc[nt] = mfma16(wlo, ahi, acc[nt]); acc[nt] = mfma16(whi, alo, acc[nt]); }
          }
        }
#pragma unroll
        for (int nt = 0; nt < 2; ++nt) { const f32x4 bb = *(const f32x4*)(a.in[I_BR] + l * 32 + nt * 16 + 4 * q);
#pragma unroll
            for (int j = 0; j < 4; ++j) scr[c * 33 + nt * 16 + 4 * q + j] = acc[nt][j] + bb[j]; }
        LDS_WAIT(); asm volatile("" ::: "memory");
        if (lane < 16) {
            float v0 = -INFINITY, v1 = -INFINITY, v2 = -INFINITY, v3 = -INFINITY; int e0 = 0, e1 = 0, e2 = 0, e3 = 0;
#pragma unroll
            for (int e = 0; e < 32; ++e) { const float x = scr[lane * 33 + e];
                const bool b0 = x > v0, b1 = x > v1, b2 = x > v2, b3 = x > v3;
                v3 = b2 ? v2 : (b3 ? x : v3); e3 = b2 ? e2 : (b3 ? e : e3);
                v2 = b1 ? v1 : (b2 ? x : v2); e2 = b1 ? e1 : (b2 ? e : e2);
                v1 = b0 ? v0 : (b1 ? x : v1); e1 = b0 ? e0 : (b1 ? e : e1);
                v0 = b0 ? x : v0; e0 = b0 ? e : e0; }
            const float x1 = __expf(v1 - v0), x2 = __expf(v2 - v0), x3 = __expf(v3 - v0); const float inv = 1.0f / (1.0f + x1 + x2 + x3);
            const unsigned r0 = __hip_atomic_fetch_add(lcnt + e0, 1u, __ATOMIC_RELAXED, __HIP_MEMORY_SCOPE_WORKGROUP), r1 = __hip_atomic_fetch_add(lcnt + e1, 1u, __ATOMIC_RELAXED, __HIP_MEMORY_SCOPE_WORKGROUP),
                           r2 = __hip_atomic_fetch_add(lcnt + e2, 1u, __ATOMIC_RELAXED, __HIP_MEMORY_SCOPE_WORKGROUP), r3 = __hip_atomic_fetch_add(lcnt + e3, 1u, __ATOMIC_RELAXED, __HIP_MEMORY_SCOPE_WORKGROUP);
            *(f32x4*)(TOPG + (size_t)(row0 + lane) * 4) = (f32x4){inv, x1 * inv, x2 * inv, x3 * inv};
            *(int4*)(SLOT + (size_t)(row0 + lane) * 4) = make_int4((int)(((unsigned)e0 << 24) | r0), (int)(((unsigned)e1 << 24) | r1), (int)(((unsigned)e2 << 24) | r2), (int)(((unsigned)e3 << 24) | r3)); }
        LDS_WAIT(); asm volatile("" ::: "memory");
    }
    __syncthreads();
    if (tid < 32) { const unsigned n = lcnt[tid]; const unsigned base = __hip_atomic_fetch_add(CNT + tid, n, RLX_AGENT); ((unsigned*)(ws + WS_BASE))[bid * 32 + tid] = base; }
    __syncthreads();
}

__device__ __forceinline__ void build_expert_tables(CArgs ap, int l, LAS unsigned char* lds, int tid) {
    CA& a = *ap;
    if (tid == 0) { const unsigned* CNT = (const unsigned*)(a.ws + WS_CTL) + CW_CNT + l * 32; LAS int* pads = (LAS int*)(lds + PADS_OFF); LAS unsigned char* te = lds + TILE_E_OFF;
        int t = 0;
#pragma nounroll
        for (int e = 0; e < 32; ++e) { const int c = (int)__hip_atomic_load(CNT + e, RLX_AGENT); const int nt = (c + 255) >> 8; pads[e] = t * 256;
#pragma nounroll
            for (int i = 0; i < nt; ++i) te[t + i] = (unsigned char)e;
            t += nt; }
        pads[32] = t; }
    __syncthreads();
}

__device__ __forceinline__ void phase_moe_prep(CArgs ap, int l, LAS unsigned char* lds, int tid, int lane, int gw, int NGW) {
    CA& a = *ap;
    unsigned char* ws = a.ws;
    build_expert_tables(ap, l, lds, tid);
    const LAS int* pads = (const LAS int*)(lds + PADS_OFF);
    int* SLOT = (int*)(ws + WS_SLOT); const unsigned* BASE = (const unsigned*)(ws + WS_BASE);
    for (int row0 = gw; row0 < T; row0 += 3 * NGW) {
        int rowv[3]; bool on[3]; int4 sl[3]; v4u hv[3];
#pragma unroll
        for (int rr = 0; rr < 3; ++rr) { const int row = row0 + rr * NGW; on[rr] = row < T && !(l == DEPTH - 1 && (row % TB) < CTX); rowv[rr] = on[rr] ? row : row0;
            sl[rr] = *(const int4*)(SLOT + (size_t)rowv[rr] * 4); hv[rr] = *(const v4u*)((const unsigned char*)(ws + WS_H8) + (size_t)rowv[rr] * D + 16 * lane); }
        unsigned bs[3][4];
#pragma unroll
        for (int rr = 0; rr < 3; ++rr) { const unsigned pk[4] = {(unsigned)sl[rr].x, (unsigned)sl[rr].y, (unsigned)sl[rr].z, (unsigned)sl[rr].w};
#pragma unroll
            for (int k = 0; k < 4; ++k) bs[rr][k] = BASE[((unsigned)rowv[rr] / (unsigned)(T / (NGW >> 3))) * 32 + (pk[k] >> 24)]; }
#pragma unroll
        for (int rr = 0; rr < 3; ++rr) { if (!on[rr]) continue;
            const unsigned pk[4] = {(unsigned)sl[rr].x, (unsigned)sl[rr].y, (unsigned)sl[rr].z, (unsigned)sl[rr].w}; int st[4];
#pragma unroll
            for (int k = 0; k < 4; ++k) st[k] = pads[pk[k] >> 24] + (int)bs[rr][k] + (int)(pk[k] & 0xffffffu);
            if (lane == 0) *(int4*)(SLOT + (size_t)rowv[rr] * 4) = make_int4(st[0], st[1], st[2], st[3]);
#pragma unroll
            for (int k = 0; k < 4; ++k) *(v4u*)((unsigned char*)(ws + WS_XG) + (size_t)st[k] * D + 16 * lane) = hv[rr]; }
    }
}


constexpr int PH_PER_LAYER = 11, NPHASES = 1 + DEPTH * PH_PER_LAYER + 1;
__global__ void __launch_bounds__(NTHREADS, 2) fwd(Args args) {
    extern __shared__ __attribute__((aligned(16))) unsigned char lds_raw[];
    volatile LAS unsigned* MISC = (volatile LAS unsigned*)((LAS unsigned char*)lds_raw + MISC_OFF);
    if (threadIdx.x < 64) MISC[threadIdx.x] = 0u;
    __syncthreads();
    const int lo = args.ph_lo, hi = args.ph_hi;
    const int wave_s = __builtin_amdgcn_readfirstlane(threadIdx.x >> 6);
#if MK_ONE_LAUNCH
    (void)xcd_barrier_post((unsigned*)(args.ws + WS_CTL) + CW_BAR, MISC + 8);
#define SEAM(k) do { if ((k) + 1 < hi) { CArgs ap_ = get_args(); XcdBarrier b_; b_.bar = (unsigned*)(ap_->ws + WS_CTL) + CW_BAR; b_.x = xb_xcc_id(); \
        LAS unsigned char* l_ = (LAS unsigned char*)lds_raw; asm volatile("" : "+s"(l_)); b_.st = (volatile LAS unsigned*)(l_ + MISC_OFF) + 8; \
        unsigned z2_ = 0u; asm volatile("" : "+s"(z2_)); const int ln_ = (int)__builtin_amdgcn_mbcnt_hi(~0u, __builtin_amdgcn_mbcnt_lo(~0u, z2_)); \
        xcd_barrier(b_, wave_s == 0 && ln_ == 0); PROBE_STAMP((k) + 1); } } while (0)
#else
#define SEAM(k) do { } while (0)
#endif
#ifndef DBG_MASK
#define DBG_MASK 0xFFFFu
#endif
#ifndef DBGD
#define DBGD DEPTH
#endif
#define EN(j) (((DBG_MASK) >> (j)) & 1u)
#define IN(k) (lo <= (k) && (k) < hi)
#ifndef PROBE_MASK
#define PROBE_MASK 0
#endif
#ifndef PROBE_FACTOR
#define PROBE_FACTOR 4
#endif
#define PROBE_STAMP(idx) do { if (PROBE_MASK) { if (blockIdx.x == 0 && wave_s == 0) { CArgs apz_ = get_args(); unsigned long long* ts_ = (unsigned long long*)(apz_->ws + WS_CTL) + CW_TS / 2; \
        const unsigned long long now_ = __builtin_amdgcn_s_memrealtime(); if (__builtin_amdgcn_mbcnt_lo(~0u, 0u) == 0u && __builtin_amdgcn_mbcnt_hi(~0u, 0u) == 0u) __hip_atomic_store(ts_ + (idx), now_, RLX_AGENT); } } } while (0)
#define PHASE_CTX() CArgs ap = get_args(); unsigned char* ws = ap->ws; (void)ws; \
    LAS unsigned char* lds = (LAS unsigned char*)lds_raw; asm volatile("" : "+s"(lds)); (void)lds; \
    int wave = wave_s; asm volatile("" : "+s"(wave)); unsigned zero_ = 0u; asm volatile("" : "+s"(zero_)); const int lane = (int)__builtin_amdgcn_mbcnt_hi(~0u, __builtin_amdgcn_mbcnt_lo(~0u, zero_)); const int tid = wave * 64 + lane; (void)tid; \
    int bid = blockIdx.x; asm volatile("" : "+s"(bid)); int G = gridDim.x; asm volatile("" : "+s"(G)); \
    const int gw = bid * NWAVES + wave, NGW = G * NWAVES, gws = wave * G + bid; (void)gw; (void)NGW; (void)gws


    PROBE_STAMP(0);
    if (EN(11) && IN(0)) { PHASE_CTX(); phase_prologue(ap, lds, tid, lane, wave, bid, G); SEAM(0); }

    for (int l = 0; l < DBGD; ++l) {
        const int pb = 1 + PH_PER_LAYER * l;
        if (EN(0) && IN(pb + 0)) { PHASE_CTX(); build_gc(ap, l, bid * NTHREADS + tid, G * NTHREADS); if (l == 0) phase_n1<0>(ap, l, lane, gw, NGW); else phase_n1<1>(ap, l, lane, gw, NGW); SEAM(pb + 0); }
        if (EN(1) && IN(pb + 1)) {
            { PHASE_CTX();
              pg8::Gemm g{(const bf16*)(ws + WS_H), (const bf16*)(ws + WS_WIN) + (size_t)l * 1792 * D, T, 1792, D}; pg8::StaticOrder S; S.init(T, 1792, G, bid);
              pg8::EpiPlain E{(bf16*)(ws + WS_PROJ), DIN};
              pg8::gemm_phase<pg8::EpiPlain, pg8::StaticOrder, true, true>(lds, g, S, E, tid); }
            { PHASE_CTX();
              pg8::Gemm g{(const bf16*)(ws + WS_H8), (const bf16*)(ws + WS_WIN8 + (size_t)l * 3072 * D), T, 3072, D / 2}; pg8::StaticOrder S; S.init(T, 3072, G, bid);
              pg8::EpiPlain8 E{(bf16*)(ws + WS_PROJ) + OFF_GT, DIN};
              pg8::gemm_phase<pg8::EpiPlain8, pg8::StaticOrder, true, false>(lds, g, S, E, tid); }
            SEAM(pb + 1);
        }
        if (EN(2) && IN(pb + 2)) { PHASE_CTX();
            PROBE_SUB(ws, tid, 8);
            for (int blk = bid; blk < 256; blk += G) { s5a_block(ap, l, blk, lds, tid, lane, wave); PROBE_SUB(ws, tid, 9); if (wave < 2) s5b_unit(ap, l, (blk >> 4) | (wave << 4) | ((blk & 15) << 5), lane); }
            PROBE_SUB(ws, tid, 10);
            if (wave >= 2) { const int gw6 = bid * 6 + (wave - 2), NGW6 = G * 6;
                PROBE_SUB(ws, tid - 128, 14);
                phase_prep(ap, l, lane, gw6, NGW6);
                PROBE_SUB(ws, tid - 128, 15);
                for (int it = gw6; it < 1152; it += NGW6) vt_item(ap, it, lane);
                PROBE_SUB(ws, tid - 128, 16); }
            SEAM(pb + 2);
        }
        if (EN(3) && IN(pb + 3)) { PHASE_CTX();
            for (int blk = bid; blk < 256; blk += G) s5c_block(ap, l, blk, lds, tid, lane, wave);
            PROBE_SUB(ws, tid, 4);
            for (int it = gw; it < 4096; it += NGW) attn_item<2>(ap, l, true, it, lane);
            PROBE_SUB(ws, tid, 5);
            if (wave < 4 && l < DEPTH - 1) { for (int it = bid * 4 + wave; it < 1024; it += G * 4) attn_item<1>(ap, l, false, it, lane); }
            SEAM(pb + 3);
        }
        if (EN(4) && IN(pb + 4)) { PHASE_CTX();
            pg8::Gemm g{(const bf16*)(ws + WS_Z), (const bf16*)(ws + WS_WGLU) + (size_t)l * 256 * 256, T, 256, 256}; pg8::RowOrder S; S.lat = (l == DEPTH - 1); S.init(S.lat ? NB * SEQ : T, 256, G, bid);
            pg8::EpiGlu E{(const bf16*)(ws + WS_Z), (bf16*)(ws + WS_Z2), 256};
            pg8::gemm_phase<pg8::EpiGlu, pg8::RowOrder, true, true>(lds, g, S, E, tid);
            SEAM(pb + 4);
        }
        if (EN(5) && IN(pb + 5)) {
            { PHASE_CTX(); pg8::RowOrder S; S.lat = (l == DEPTH - 1); S.init(S.lat ? NB * SEQ : T, D, G, bid);
              pg8::Gemm g{(const bf16*)(ws + WS_Z2), (const bf16*)(ws + WS_WSO) + (size_t)l * D * 256, T, D, 256};
              pg8::EpiBranch<true> E{(const bf16*)(ws + WS_PROJ) + OFF_GT, DIN, (bf16*)(ws + WS_MM), D}; pg8::gemm_phase<pg8::EpiBranch<true>, pg8::RowOrder, true, true>(lds, g, S, E, tid); }
            { PHASE_CTX(); pg8::RowOrder S; S.lat = (l == DEPTH - 1); S.init(S.lat ? NB * SEQ : T, D, G, bid);
              pg8::Gemm g{(const bf16*)(ws + WS_YB), (const bf16*)(ws + WS_WCO) + (size_t)l * D * 256, T, D, 256};
              pg8::EpiBranch<false> E{(const bf16*)(ws + WS_PROJ) + OFF_GT + D, DIN, (bf16*)(ws + WS_MM), D}; pg8::gemm_phase<pg8::EpiBranch<false>, pg8::RowOrder, true, true>(lds, g, S, E, tid); }
            { PHASE_CTX(); pg8::RowOrder S; S.lat = (l == DEPTH - 1); S.init(S.lat ? NB * SEQ : T, D, G, bid);
              pg8::Gemm g{(const bf16*)(ws + WS_YA), (const bf16*)(ws + WS_WAO) + (size_t)l * D * 512, T, D, 512};
              pg8::EpiBranch<false> E{(const bf16*)(ws + WS_PROJ) + OFF_GT + 2 * D, DIN, (bf16*)(ws + WS_MM), D}; pg8::gemm_phase<pg8::EpiBranch<false>, pg8::RowOrder, true, true>(lds, g, S, E, tid); }
            SEAM(pb + 5);
        }
        if (EN(6) && IN(pb + 6)) { PHASE_CTX();
            pg8::Gemm g{(const bf16*)(ws + WS_MM), (const bf16*)(ws + WS_WO) + (size_t)l * D * D, T, D, D}; pg8::RowOrder S; S.lat = (l == DEPTH - 1); S.init(S.lat ? NB * SEQ : T, D, G, bid);
            pg8::EpiWo E{(float*)(ws + WS_X), (const float*)(ws + WS_MOD) + (size_t)l * 17 * 6144 + 2048};
            pg8::gemm_phase<pg8::EpiWo, pg8::RowOrder, true, true>(lds, g, S, E, tid);
            SEAM(pb + 6);
        }
        if (EN(7) && IN(pb + 7)) { PHASE_CTX(); phase_n2(ap, l, lds, tid, lane, wave, bid, G); SEAM(pb + 7); }
        if (EN(8) && IN(pb + 8)) { PHASE_CTX(); phase_moe_prep(ap, l, lds, tid, lane, gw, NGW); SEAM(pb + 8); }
        if (EN(9) && IN(pb + 9)) { PHASE_CTX();
            build_expert_tables(ap, l, lds, tid);
            const int nt = ((const LAS int*)(lds + PADS_OFF))[32];
            pg8::Gemm g{(const bf16*)(ws + WS_XG), (const bf16*)(ws + WS_WGU + (size_t)l * 32 * 2048 * 1024), nt * 256, 2048, 512};
            pg8::MoeOrder S{8, nt * 8, G, bid, lds + TILE_E_OFF, (size_t)2048 * 1024};
            pg8::EpiSwiglu E{(unsigned char*)(ws + WS_ACT), ap->in[I_BGU] + (size_t)l * 32 * 2048, lds + TILE_E_OFF};
            pg8::gemm_phase<pg8::EpiSwiglu, pg8::MoeOrder, true, false>(lds, g, S, E, tid);
            SEAM(pb + 9);
        }
        if (EN(10) && IN(pb + 10)) { PHASE_CTX();
            build_expert_tables(ap, l, lds, tid);
            const int nt = ((const LAS int*)(lds + PADS_OFF))[32];
            pg8::Gemm g{(const bf16*)(ws + WS_ACT), (const bf16*)(ws + WS_WD + (size_t)l * 32 * 1024 * 1024), nt * 256, 1024, 512};
            pg8::MoeOrder S{4, nt * 4, G, bid, lds + TILE_E_OFF, (size_t)1024 * 1024};
            pg8::EpiDown E{(unsigned char*)(ws + WS_YS8), ap->in[I_BD] + (size_t)l * 32 * 1024, lds + TILE_E_OFF};
            pg8::gemm_phase<pg8::EpiDown, pg8::MoeOrder, true, false>(lds, g, S, E, tid);
            SEAM(pb + 10);
        }
    }
    if (EN(12) && IN(NPHASES - 1)) { PHASE_CTX(); phase_n1<2>(ap, DEPTH, lane, gw, NGW); }
    if (PROBE_MASK || PROBE_SUB_A >= 0) { if (blockIdx.x == 0 && wave_s == 0) { CArgs apz_ = get_args(); unsigned long long* ts_ = (unsigned long long*)(apz_->ws + WS_CTL) + CW_TS / 2;
        asm volatile("s_waitcnt vmcnt(0)" ::: "memory");
        const unsigned long long t_end = __builtin_amdgcn_s_memrealtime(); unsigned long long sum = 0;
        for (int k2 = 0; k2 < NPHASES; ++k2) { const int cls = k2 == 0 ? 0 : (k2 == NPHASES - 1 ? 13 : 1 + (k2 - 1) % PH_PER_LAYER);
            const unsigned long long t0 = __hip_atomic_load(ts_ + k2, RLX_AGENT), t1 = (k2 == NPHASES - 1) ? t_end : __hip_atomic_load(ts_ + k2 + 1, RLX_AGENT);
            if ((PROBE_MASK >> cls) & 1) sum += t1 - t0; }
        if (PROBE_SUB_A >= 0) sum = (unsigned long long)PROBE_SUBF * (__hip_atomic_load(ts_ + 128 + (PROBE_SUB_B < 0 ? 0 : PROBE_SUB_B), RLX_AGENT) - __hip_atomic_load(ts_ + 128 + (PROBE_SUB_A < 0 ? 0 : PROBE_SUB_A), RLX_AGENT)) / PROBE_FACTOR;
        while (__builtin_amdgcn_s_memrealtime() - t_end < (unsigned long long)PROBE_FACTOR * sum) __builtin_amdgcn_s_sleep(8); } }
#undef IN
#undef SEAM
}

extern "C" void kernel_launch(void* const* d_in, const int* in_sizes, int n_in, void* d_out, int out_size, void* d_ws, size_t ws_size, hipStream_t stream) {
    static int grid = 0;
    if (grid == 0) {
        if (n_in != N_IN || out_size != NB * SEQ * D || ws_size < WS_END) { fprintf(stderr, "kernel_launch: unexpected sizes (n_in %d out %d ws %zu, need %zu)\n", n_in, out_size, ws_size, (size_t)WS_END); grid = -1; return; }
        int dev = 0, cus = 0, per_cu = 0;
        if (hipGetDevice(&dev) != hipSuccess || hipDeviceGetAttribute(&cus, hipDeviceAttributeMultiprocessorCount, dev) != hipSuccess) { grid = -1; return; }
        if (hipFuncSetAttribute((const void*)fwd, hipFuncAttributeMaxDynamicSharedMemorySize, LDS_BYTES) != hipSuccess) { fprintf(stderr, "kernel_launch: hipFuncSetAttribute failed\n"); grid = -1; return; }
        if (hipOccupancyMaxActiveBlocksPerMultiprocessor(&per_cu, (const void*)fwd, NTHREADS, LDS_BYTES) != hipSuccess || per_cu < 1) { fprintf(stderr, "kernel_launch: occupancy query says %d\n", per_cu); }
        (void)hipGetLastError();
        grid = cus;
    }
    if (grid < 0) return;
    if (hipMemsetAsync((char*)d_ws + WS_CTL, 0, CTL_ZERO_BYTES, stream) != hipSuccess) return;
    Args a{};
    for (int i = 0; i < N_IN; ++i) a.in[i] = (const float*)d_in[i];
    a.out = (float*)d_out; a.ws = (unsigned char*)d_ws;
#if MK_ONE_LAUNCH
    a.ph_lo = 0; a.ph_hi = NPHASES;
    hipLaunchKernelGGL(fwd, dim3(grid), dim3(NTHREADS), LDS_BYTES, stream, a);
#else
    for (int p = 0; p < NPHASES; ++p) { a.ph_lo = p; a.ph_hi = p + 1; hipLaunchKernelGGL(fwd, dim3(grid), dim3(NTHREADS), LDS_BYTES, stream, a); }
#endif
}
```

```cpp
#include <hip/hip_runtime.h>
#include <cstdio>
#include <cstdint>
namespace pg8 {
#define PG8_LAS __attribute__((address_space(3)))
#define PG8_GAS __attribute__((address_space(1)))
typedef unsigned short bf16_t;
typedef short bf16x8 __attribute__((ext_vector_type(8)));
typedef float f32x4 __attribute__((ext_vector_type(4)));
typedef unsigned u32x4 __attribute__((ext_vector_type(4)));
typedef int pg8_i4 __attribute__((ext_vector_type(4)));
typedef int pg8_i8 __attribute__((ext_vector_type(8)));
constexpr int BM = 256, BK = 64, HALF = 128, HTB = HALF * BK * 2  , STAGE_BYTES = 8 * HTB, NXCD = 8, WGM = 8;

__host__ __device__ __forceinline__ int lds_byte(int r, int c) { const int st = (r >> 4) * 2 + (c >> 5), rr = r & 15, cc = c & 31, ob = rr * 64 + cc * 2; return st * 1024 + (ob ^ (((ob >> 9) & 1) << 5)); }
__host__ __device__ __forceinline__ void stage_rc(int b, int& R, int& C) { const int st = b / 1024, sb = b % 1024, swz = sb ^ (((sb >> 9) & 1) << 5); R = (st >> 1) * 16 + swz / 64; C = (st & 1) * 32 + (swz % 64) / 2; }
__host__ __device__ __forceinline__ int perm32(int rho) { const int n = rho >> 4, i = rho & 15; return 8 * (i >> 2) + 4 * n + (i & 3); }

struct Unit { int pm, pn; };
struct Gemm { const bf16_t* A; const bf16_t* Bt; int M, N, K; };

struct StaticOrder {
    static constexpr bool GATHER = false;
    int nM, nN, nwg, G, c;
    __host__ __device__ void init(int M, int N, int G_, int c_) { nM = M / BM; nN = N / BM; nwg = nM * nN; G = G_; c = c_; }
    __host__ __device__ bool next(int i, Unit& u) const {
        const long L = (long)i * G + c; if (L >= nwg) return false;
        int wgid = (int)L; { const int q = nwg / NXCD, r = nwg % NXCD, xcd = wgid % NXCD, off = wgid / NXCD; wgid = (xcd < r ? xcd * (q + 1) : r * (q + 1) + (xcd - r) * q) + off; }
        const int nig = WGM * nN, gid = wgid / nig, fm = gid * WGM, gsz = (nM - fm) < WGM ? (nM - fm) : WGM;
        u.pm = fm + ((wgid % nig) % gsz); u.pn = (wgid % nig) / gsz; return true;
    }
    __device__ __forceinline__ void a_ready(const Unit&) const {}
    __device__ __forceinline__ void done(const Unit&) const {}
    __device__ __forceinline__ const char* aptr(const Gemm& g, const Unit& u, size_t tstep) const { return (const char*)g.A + (size_t)u.pm * tstep; }
    __device__ __forceinline__ const char* bptr(const Gemm& g, const Unit& u, size_t tstep) const { return (const char*)g.Bt + (size_t)u.pn * tstep; }
};

__device__ __forceinline__ unsigned cvt_pk_bf16(float lo, float hi) { unsigned r; asm volatile("v_cvt_pk_bf16_f32 %0, %1, %2" : "=v"(r) : "v"(lo), "v"(hi)); return r; }
__device__ __forceinline__ float bf_lo(unsigned w) { return __uint_as_float(w << 16); }
__device__ __forceinline__ float bf_hi(unsigned w) { return __uint_as_float(w & 0xffff0000u); }
__device__ __forceinline__ float sigm(float x) { return __builtin_amdgcn_rcpf(1.0f + __expf(-x)); }
#define PG8_FRESH_LANE() { unsigned z_ = 0u; asm volatile("" : "+s"(z_)); const int l_ = (int)__builtin_amdgcn_mbcnt_hi(~0u, __builtin_amdgcn_mbcnt_lo(~0u, z_)); fr = l_ & 15; fq = l_ >> 4; }

struct EpiPlain {
    static constexpr int PROBE_ID = 1;
    static constexpr bool PERM = true, AFTER_DRAIN = false, FP8 = false; static constexpr int WSCALE = 0x7f;
    bf16_t* O; int ldc;
    __device__ __forceinline__ void operator()(const f32x4 (&acc)[2][2][4][2], const Unit& u, int wr, int wc, int fr, int fq) const {
        PG8_FRESH_LANE();
        const int row0 = u.pm * BM + wr * 64 + fr, col0 = u.pn * BM + wc * 32 + 8 * fq;
#pragma unroll
        for (int ai = 0; ai < 2; ++ai)
#pragma unroll
            for (int m = 0; m < 4; ++m) { bf16_t* rowp = O + (size_t)(row0 + ai * HALF + m * 16) * ldc + col0;
#pragma unroll
                for (int bj = 0; bj < 2; ++bj) { const f32x4 v0 = acc[ai][bj][m][0], v1 = acc[ai][bj][m][1];
                    u32x4 w; w.x = cvt_pk_bf16(v0[0], v0[1]); w.y = cvt_pk_bf16(v0[2], v0[3]); w.z = cvt_pk_bf16(v1[0], v1[1]); w.w = cvt_pk_bf16(v1[2], v1[3]);
                    *(u32x4*)(rowp + bj * HALF) = w; } }
    }
};
struct EpiPlain8 {
    static constexpr int PROBE_ID = 2;
    static constexpr bool PERM = true, AFTER_DRAIN = false, FP8 = true; static constexpr int WSCALE = 0;
    bf16_t* O; int ldc;
    __device__ __forceinline__ void operator()(const f32x4 (&acc)[2][2][4][2], const Unit& u, int wr, int wc, int fr, int fq) const {
        PG8_FRESH_LANE();
        const int row0 = u.pm * BM + wr * 64 + fr, col0 = u.pn * BM + wc * 32 + 8 * fq;
#pragma unroll
        for (int ai = 0; ai < 2; ++ai)
#pragma unroll
            for (int m = 0; m < 4; ++m) { bf16_t* rowp = O + (size_t)(row0 + ai * HALF + m * 16) * ldc + col0;
#pragma unroll
                for (int bj = 0; bj < 2; ++bj) { const f32x4 v0 = acc[ai][bj][m][0] * 0.03125f, v1 = acc[ai][bj][m][1] * 0.03125f;
                    u32x4 w; w.x = cvt_pk_bf16(v0[0], v0[1]); w.y = cvt_pk_bf16(v0[2], v0[3]); w.z = cvt_pk_bf16(v1[0], v1[1]); w.w = cvt_pk_bf16(v1[2], v1[3]);
                    *(u32x4*)(rowp + bj * HALF) = w; } }
    }
};
struct EpiGate8 {
    static constexpr int PROBE_ID = 2;
    static constexpr bool PERM = true, AFTER_DRAIN = false, FP8 = true; static constexpr int WSCALE = 0;
    unsigned char* O; int ldc;
    static __device__ __forceinline__ unsigned pk4(float a, float b, float c, float d) {
        unsigned r = 0u; r = __builtin_amdgcn_cvt_pk_u8_f32(a, 0u, r); r = __builtin_amdgcn_cvt_pk_u8_f32(b, 1u, r); r = __builtin_amdgcn_cvt_pk_u8_f32(c, 2u, r); r = __builtin_amdgcn_cvt_pk_u8_f32(d, 3u, r); return r; }
    static __device__ __forceinline__ float s255(float logit32) { return 255.0f * __builtin_amdgcn_rcpf(1.0f + __expf(-0.03125f * logit32)); }
    __device__ __forceinline__ void operator()(const f32x4 (&acc)[2][2][4][2], const Unit& u, int wr, int wc, int fr, int fq) const {
        PG8_FRESH_LANE();
        const int row0 = u.pm * BM + wr * 64 + fr, col0 = u.pn * BM + wc * 32 + 8 * fq;
#pragma unroll
        for (int ai = 0; ai < 2; ++ai)
#pragma unroll
            for (int m = 0; m < 4; ++m) { unsigned char* rowp = O + (size_t)(row0 + ai * HALF + m * 16) * ldc + col0;
#pragma unroll
                for (int bj = 0; bj < 2; ++bj) { const f32x4 v0 = acc[ai][bj][m][0], v1 = acc[ai][bj][m][1];
                    uint2 w; w.x = pk4(s255(v0[0]), s255(v0[1]), s255(v0[2]), s255(v0[3])); w.y = pk4(s255(v1[0]), s255(v1[1]), s255(v1[2]), s255(v1[3]));
                    *(uint2*)(rowp + bj * HALF) = w; } }
    }
};
struct EpiGlu {
    static constexpr int PROBE_ID = 3;
    static constexpr bool PERM = true, AFTER_DRAIN = false, FP8 = false; static constexpr int WSCALE = 0x7f;
    const bf16_t* Z; bf16_t* O; int ldc;
    __device__ __forceinline__ void operator()(const f32x4 (&acc)[2][2][4][2], const Unit& u, int wr, int wc, int fr, int fq) const {
        PG8_FRESH_LANE();
        const int row0 = u.pm * BM + wr * 64 + fr, col0 = u.pn * BM + wc * 32 + 8 * fq;
#pragma unroll
        for (int ai = 0; ai < 2; ++ai) {
            u32x4 z[4][2];
#pragma unroll
            for (int m = 0; m < 4; ++m)
#pragma unroll
                for (int bj = 0; bj < 2; ++bj) z[m][bj] = *(const u32x4*)(Z + (size_t)(row0 + ai * HALF + m * 16) * ldc + col0 + bj * HALF);
#pragma unroll
            for (int m = 0; m < 4; ++m)
#pragma unroll
                for (int bj = 0; bj < 2; ++bj) { const f32x4 v0 = acc[ai][bj][m][0], v1 = acc[ai][bj][m][1]; const u32x4 zz = z[m][bj];
                    u32x4 w; w.x = cvt_pk_bf16(bf_lo(zz.x) * sigm(v0[0]), bf_hi(zz.x) * sigm(v0[1])); w.y = cvt_pk_bf16(bf_lo(zz.y) * sigm(v0[2]), bf_hi(zz.y) * sigm(v0[3]));
                    w.z = cvt_pk_bf16(bf_lo(zz.z) * sigm(v1[0]), bf_hi(zz.z) * sigm(v1[1])); w.w = cvt_pk_bf16(bf_lo(zz.w) * sigm(v1[2]), bf_hi(zz.w) * sigm(v1[3]));
                    *(u32x4*)(O + (size_t)(row0 + ai * HALF + m * 16) * ldc + col0 + bj * HALF) = w; }
            asm volatile("" ::: "memory"); }
    }
};
template <bool FIRST> struct EpiBranch {
    static constexpr int PROBE_ID = 4;
    static constexpr bool PERM = true, AFTER_DRAIN = false, FP8 = false; static constexpr int WSCALE = 0x7f;
    const unsigned char* GT; bf16_t* MM; static constexpr int ldg = 3072, ldc = 1024;
    __device__ __forceinline__ void operator()(const f32x4 (&acc)[2][2][4][2], const Unit& u, int wr, int wc, int fr, int fq) const {
        PG8_FRESH_LANE();
        const unsigned row0 = u.pm * BM + wr * 64 + fr, col0 = u.pn * BM + wc * 32 + 8 * fq;
#pragma unroll
        for (int ai = 0; ai < 2; ++ai) {
            uint2 g[4][2]; u32x4 pv[4][2];
#pragma unroll
            for (int m = 0; m < 4; ++m)
#pragma unroll
                for (int bj = 0; bj < 2; ++bj) { const unsigned row = row0 + ai * HALF + m * 16;
                    g[m][bj] = *(const uint2*)(GT + row * (unsigned)ldg + col0 + bj * HALF);
                    if (!FIRST) pv[m][bj] = *(const u32x4*)(MM + row * (unsigned)ldc + col0 + bj * HALF); }
#pragma unroll
            for (int m = 0; m < 4; ++m)
#pragma unroll
                for (int bj = 0; bj < 2; ++bj) { const unsigned row = row0 + ai * HALF + m * 16; const f32x4 v0 = acc[ai][bj][m][0], v1 = acc[ai][bj][m][1]; const uint2 gg = g[m][bj]; constexpr float I255 = 1.0f / 255.0f;
                    float o[8];
                    o[0] = (float)((gg.x >> 0) & 0xffu) * I255 * v0[0]; o[1] = (float)((gg.x >> 8) & 0xffu) * I255 * v0[1]; o[2] = (float)((gg.x >> 16) & 0xffu) * I255 * v0[2]; o[3] = (float)((gg.x >> 24) & 0xffu) * I255 * v0[3];
                    o[4] = (float)((gg.y >> 0) & 0xffu) * I255 * v1[0]; o[5] = (float)((gg.y >> 8) & 0xffu) * I255 * v1[1]; o[6] = (float)((gg.y >> 16) & 0xffu) * I255 * v1[2]; o[7] = (float)((gg.y >> 24) & 0xffu) * I255 * v1[3];
                    if (!FIRST) { const u32x4 p = pv[m][bj];
                        o[0] += bf_lo(p.x); o[1] += bf_hi(p.x); o[2] += bf_lo(p.y); o[3] += bf_hi(p.y); o[4] += bf_lo(p.z); o[5] += bf_hi(p.z); o[6] += bf_lo(p.w); o[7] += bf_hi(p.w); }
                    u32x4 w; w.x = cvt_pk_bf16(o[0], o[1]); w.y = cvt_pk_bf16(o[2], o[3]); w.z = cvt_pk_bf16(o[4], o[5]); w.w = cvt_pk_bf16(o[6], o[7]);
                    *(u32x4*)(MM + row * (unsigned)ldc + col0 + bj * HALF) = w; }
            asm volatile("" ::: "memory"); }
    }
};
struct EpiWo {
    static constexpr int PROBE_ID = 5;
    static constexpr bool PERM = false, AFTER_DRAIN = false, FP8 = false; static constexpr int WSCALE = 0x7f;
    bf16_t* X; const float* g1base;
    __device__ __forceinline__ void operator()(const f32x4 (&acc)[2][2][4][2], const Unit& u, int wr, int wc, int fr, int fq) const {
        PG8_FRESH_LANE();
        const int row0 = u.pm * BM + wr * 64 + fr, col0 = u.pn * BM + wc * 32 + 4 * fq;
        const int r = (u.pm % 9 == 0) ? 16 : u.pm / 9; const float* g1 = g1base + (size_t)r * 6144 + col0;
        f32x4 gv[2][2];
#pragma unroll
        for (int bj = 0; bj < 2; ++bj)
#pragma unroll
            for (int n = 0; n < 2; ++n) gv[bj][n] = *(const f32x4*)(g1 + bj * HALF + n * 16);
#pragma unroll
        for (int ai = 0; ai < 2; ++ai)
#pragma unroll
            for (int mh = 0; mh < 2; ++mh) {
                uint2 xv[2][2][2];
#pragma unroll
                for (int mm = 0; mm < 2; ++mm)
#pragma unroll
                    for (int bj = 0; bj < 2; ++bj)
#pragma unroll
                        for (int n = 0; n < 2; ++n) xv[mm][bj][n] = *(const uint2*)(X + (size_t)(row0 + ai * HALF + (2 * mh + mm) * 16) * 1024 + col0 + bj * HALF + n * 16);
#pragma unroll
                for (int mm = 0; mm < 2; ++mm)
#pragma unroll
                    for (int bj = 0; bj < 2; ++bj)
#pragma unroll
                        for (int n = 0; n < 2; ++n) { const uint2 xw = xv[mm][bj][n]; const f32x4 o = (f32x4){bf_lo(xw.x), bf_hi(xw.x), bf_lo(xw.y), bf_hi(xw.y)} + gv[bj][n] * acc[ai][bj][2 * mh + mm][n];
                            uint2 ow; ow.x = cvt_pk_bf16(o[0], o[1]); ow.y = cvt_pk_bf16(o[2], o[3]);
                            *(uint2*)(X + (size_t)(row0 + ai * HALF + (2 * mh + mm) * 16) * 1024 + col0 + bj * HALF + n * 16) = ow; }
                asm volatile("" ::: "memory"); }
    }
};
struct EpiSwiglu {
    static constexpr int PROBE_ID = 6;
    static constexpr bool PERM = true, AFTER_DRAIN = false, FP8 = true; static constexpr int WSCALE = 0;
    unsigned char* O; const float* bias; const PG8_LAS unsigned char* tile_e;
    __device__ __forceinline__ void operator()(const f32x4 (&acc)[2][2][4][2], const Unit& u, int wr, int wc, int fr, int fq) const {
        PG8_FRESH_LANE();
        const int row0 = u.pm * BM + wr * 64 + fr, acol0 = u.pn * HALF + wc * 32 + 8 * fq;
        const int e = tile_e[u.pm]; const float* bb = bias + (size_t)e * 2048 + 2 * acol0;
        const f32x4 b0 = *(const f32x4*)(bb), b1 = *(const f32x4*)(bb + 4), b2 = *(const f32x4*)(bb + 8), b3 = *(const f32x4*)(bb + 12);
        const float bg[8] = {b0[0], b0[2], b1[0], b1[2], b2[0], b2[2], b3[0], b3[2]}, bu[8] = {b0[1], b0[3], b1[1], b1[3], b2[1], b2[3], b3[1], b3[3]};
#pragma unroll
        for (int ai = 0; ai < 2; ++ai)
#pragma unroll
            for (int m = 0; m < 4; ++m) { unsigned char* rowp = O + (size_t)(row0 + ai * HALF + m * 16) * 1024 + acol0;
                float o[8];
#pragma unroll
                for (int j = 0; j < 8; ++j) { const float gt = acc[ai][0][m][j >> 2][j & 3] * 0.03125f + bg[j], up = acc[ai][1][m][j >> 2][j & 3] * 0.03125f + bu[j];
                    const float glu = fminf(gt, 7.0f), upc = fminf(fmaxf(up, -7.0f), 7.0f);
                    o[j] = glu * sigm(1.702f * glu) * (upc + 1.0f); }
                unsigned w0 = 0u, w1 = 0u;
                w0 = __builtin_amdgcn_cvt_pk_fp8_f32(o[0], o[1], w0, false); w0 = __builtin_amdgcn_cvt_pk_fp8_f32(o[2], o[3], w0, true);
                w1 = __builtin_amdgcn_cvt_pk_fp8_f32(o[4], o[5], w1, false); w1 = __builtin_amdgcn_cvt_pk_fp8_f32(o[6], o[7], w1, true);
                typedef unsigned u32x2 __attribute__((ext_vector_type(2)));
                *(u32x2*)rowp = (u32x2){w0, w1}; }
    }
};
struct EpiDown {
    static constexpr int PROBE_ID = 7;
    static constexpr bool PERM = true, AFTER_DRAIN = false, FP8 = true; static constexpr int WSCALE = 0;
    unsigned char* O; const float* bias; const PG8_LAS unsigned char* tile_e;
    __device__ __forceinline__ void operator()(const f32x4 (&acc)[2][2][4][2], const Unit& u, int wr, int wc, int fr, int fq) const {
        PG8_FRESH_LANE();
        const int row0 = u.pm * BM + wr * 64 + fr, col0 = u.pn * BM + wc * 32 + 8 * fq;
        const int e = tile_e[u.pm]; const float* bb = bias + (size_t)e * 1024 + col0;
        f32x4 bv[2][2];
#pragma unroll
        for (int bj = 0; bj < 2; ++bj)
#pragma unroll
            for (int n = 0; n < 2; ++n) bv[bj][n] = *(const f32x4*)(bb + bj * HALF + 4 * n);
        typedef unsigned u32x2 __attribute__((ext_vector_type(2)));
#pragma unroll
        for (int ai = 0; ai < 2; ++ai)
#pragma unroll
            for (int m = 0; m < 4; ++m) { unsigned char* rowp = O + (size_t)(row0 + ai * HALF + m * 16) * 1024 + col0;
#pragma unroll
                for (int bj = 0; bj < 2; ++bj) { const f32x4 v0 = acc[ai][bj][m][0] * 0.03125f + bv[bj][0], v1 = acc[ai][bj][m][1] * 0.03125f + bv[bj][1];
                    unsigned w0 = 0u, w1 = 0u;
                    w0 = __builtin_amdgcn_cvt_pk_fp8_f32(v0[0], v0[1], w0, false); w0 = __builtin_amdgcn_cvt_pk_fp8_f32(v0[2], v0[3], w0, true);
                    w1 = __builtin_amdgcn_cvt_pk_fp8_f32(v1[0], v1[1], w1, false); w1 = __builtin_amdgcn_cvt_pk_fp8_f32(v1[2], v1[3], w1, true);
                    *(u32x2*)(rowp + bj * HALF) = (u32x2){w0, w1}; } }
    }
};
struct RowOrder : StaticOrder {
    int lat; int rev = 0;
    __device__ __forceinline__ bool next(int i, Unit& u) const {
        int ii = i;
        if (rev) { if (c >= nwg) return false; const int nu = (nwg - 1 - c) / G + 1; if (i >= nu) return false; ii = nu - 1 - i; }
        if (!StaticOrder::next(ii, u)) return false; if (lat) u.pm = (u.pm >> 3) * 9 + 1 + (u.pm & 7); return true; }
};
struct PanelOrder {
    static constexpr bool GATHER = false;
    int pm, nN;
    __device__ __forceinline__ bool next(int i, Unit& u) const { if (i >= nN) return false; u.pm = pm; u.pn = i; return true; }
    __device__ __forceinline__ void a_ready(const Unit&) const {}
    __device__ __forceinline__ void done(const Unit&) const {}
    __device__ __forceinline__ const char* aptr(const Gemm& g, const Unit& u, size_t tstep) const { const char* p = (const char*)g.A + (size_t)u.pm * tstep; asm volatile("" : "+s"(p)); return p; }
    __device__ __forceinline__ const char* bptr(const Gemm& g, const Unit& u, size_t tstep) const { return (const char*)g.Bt + (size_t)u.pn * tstep; }
};
struct MoeOrder {
    static constexpr bool GATHER = false;
    int nN, total, G, c; const PG8_LAS unsigned char* tile_e; size_t estride;
    __device__ __forceinline__ bool next(int i, Unit& u) const {
        if ((G & 7) == 0 && ((G >> 3) % nN) == 0) { const int x = c & 7, j = c >> 3, rpx = (G >> 3) / nN; u.pm = i * (G / nN) + x * rpx + j / nN; u.pn = j % nN; return u.pm * nN < total; }
        const int L = i * G + c; if (L >= total) return false; u.pm = L / nN; u.pn = L - u.pm * nN; return true; }
    __device__ __forceinline__ void a_ready(const Unit&) const {}
    __device__ __forceinline__ void done(const Unit&) const {}
    __device__ __forceinline__ const char* aptr(const Gemm& g, const Unit& u, size_t tstep) const { return (const char*)g.A + (size_t)u.pm * tstep; }
    __device__ __forceinline__ const char* bptr(const Gemm& g, const Unit& u, size_t tstep) const { return (const char*)g.Bt + (size_t)tile_e[u.pm] * estride + (size_t)u.pn * tstep; }
};

struct MoeGatherOrder : MoeOrder {
    static constexpr bool GATHER = true;
    const int* rows;
    __device__ __forceinline__ const char* aptr(const Gemm& g, const Unit&, size_t) const { return (const char*)g.A; }
    __device__ __forceinline__ void load_raw(const Unit& u, int (&raw)[2][2], int tid) const {
#pragma unroll
        for (int i = 0; i < 2; ++i) { int R, C; stage_rc(tid * 16 + i * 8192, R, C);
#pragma unroll
            for (int h = 0; h < 2; ++h) raw[h][i] = __hip_atomic_load(rows + u.pm * BM + h * HALF + R, __ATOMIC_RELAXED, __HIP_MEMORY_SCOPE_AGENT); }
    }
    __device__ __forceinline__ void raw_to_off(const int (&raw)[2][2], unsigned (&voff)[2][2], int tid, int K) const {
#pragma unroll
        for (int i = 0; i < 2; ++i) { int R, C; stage_rc(tid * 16 + i * 8192, R, C);
#pragma unroll
            for (int h = 0; h < 2; ++h) voff[h][i] = ((unsigned)raw[h][i] * (unsigned)K + (unsigned)C) * 2u; }
    }
};

template <class Epi, class Sched, bool ALIGN_EPI = false, bool SP2 = false>
__device__ __forceinline__ void gemm_phase(PG8_LAS unsigned char* lds, const Gemm g, const Sched& S, const Epi& E, int tid_in) {
    int tid_ = tid_in; asm volatile("" : "+v"(tid_));
    const int tid = tid_, wid = __builtin_amdgcn_readfirstlane(tid >> 6), lane = tid & 63, wr = wid >> 2, wc = wid & 3, fr = lane & 15, fq = lane >> 4;
    const int K = g.K, nt = K / BK;
    unsigned voffA[2], voffB[2];
#pragma unroll
    for (int i = 0; i < 2; ++i) { int R, C; stage_rc(tid * 16 + i * 8192, R, C); const int Rb = Epi::PERM ? ((R & ~31) + perm32(R & 31)) : R;
        voffA[i] = (unsigned)(R * K + C) * 2u; voffB[i] = (unsigned)(Rb * K + C) * 2u; }
    const size_t kstep = (size_t)(BK * 2);
    const size_t hstep = (size_t)HALF * K * 2;
    const size_t tstep = 2 * hstep;
    const unsigned ldsw = (unsigned)wid * 1024u;
    const int aoff = lds_byte(wr * 64 + fr, fq * 8), boff = lds_byte(wc * 32 + fr, fq * 8);
#define PG8_SA(b, h) (((b) * 2 + (h)) * HTB)
#define PG8_SB(b, h) ((4 + (b) * 2 + (h)) * HTB)
#define PG8_STAGE(bufoff, gbase, voff) do { _Pragma("unroll") for (int _i = 0; _i < 2; ++_i) \
        __builtin_amdgcn_global_load_lds((const PG8_GAS unsigned*)((const PG8_GAS char*)(gbase) + ((voff)[_i] ^ ZK)), (PG8_LAS unsigned*)(lds + (bufoff) + ldsw + _i * 8192), 16, 0, 0); } while (0)
#define PG8_STAGE_A(bufoff, p, h, nx) do { if constexpr (Sched::GATHER) { _Pragma("unroll") for (int _i = 0; _i < 2; ++_i) \
            __builtin_amdgcn_global_load_lds((const PG8_GAS unsigned*)((const PG8_GAS char*)(p) + (((nx) ? voffGN[h][_i] : voffGC[h][_i]) ^ ZK)), (PG8_LAS unsigned*)(lds + (bufoff) + ldsw + _i * 8192), 16, 0, 0); } \
        else PG8_STAGE(bufoff, (p) + (h) * hstep, voffA); } while (0)
#define PG8_LD8(p) __builtin_shufflevector(*(const PG8_LAS pg8_i4*)(p), *(const PG8_LAS pg8_i4*)((p) + 1024), 0, 1, 2, 3, 4, 5, 6, 7)
#define PG8_LDA(dst, b, h) do { if constexpr (Epi::FP8) { _Pragma("unroll") for (int m = 0; m < 4; ++m) { dst##8[m].lo = *(const PG8_LAS pg8_i4*)(lds + PG8_SA(b, h) + aoff + m * 2048); dst##8[m].hi = *(const PG8_LAS pg8_i4*)(lds + PG8_SA(b, h) + aoff + m * 2048 + 1024); } } \
    else { _Pragma("unroll") for (int m = 0; m < 4; ++m) _Pragma("unroll") for (int k = 0; k < 2; ++k) dst[m][k] = *(const PG8_LAS bf16x8*)(lds + PG8_SA(b, h) + aoff + m * 2048 + k * 1024); } } while (0)
#define PG8_LDB(dst, b, h) do { if constexpr (Epi::FP8) { _Pragma("unroll") for (int n = 0; n < 2; ++n) { dst##8[n].lo = *(const PG8_LAS pg8_i4*)(lds + PG8_SB(b, h) + boff + n * 2048); dst##8[n].hi = *(const PG8_LAS pg8_i4*)(lds + PG8_SB(b, h) + boff + n * 2048 + 1024); } } \
    else { _Pragma("unroll") for (int n = 0; n < 2; ++n) _Pragma("unroll") for (int k = 0; k < 2; ++k) dst[n][k] = *(const PG8_LAS bf16x8*)(lds + PG8_SB(b, h) + boff + n * 2048 + k * 1024); } } while (0)
#define PG8_CAT8(lo, hi) __builtin_shufflevector(__builtin_bit_cast(pg8_i4, lo), __builtin_bit_cast(pg8_i4, hi), 0, 1, 2, 3, 4, 5, 6, 7)
#define PG8_MMA(ai, bj, At, Bt) do { __builtin_amdgcn_s_setprio(1); if constexpr (Epi::FP8) { __builtin_amdgcn_sched_barrier(0); _Pragma("unroll") for (int m = 0; m < 4; ++m) _Pragma("unroll") for (int n = 0; n < 2; ++n) \
        { acc[ai][bj][m][n] = __builtin_amdgcn_mfma_scale_f32_16x16x128_f8f6f4(Bt##8[n], At##8[m], acc[ai][bj][m][n], 0, 0, 0, 0, 0, 0); \
          if constexpr (PROBE_MFMA2 != 0 && Epi::PROBE_ID == PROBE_MFMA2) acc[ai][bj][m][n] = __builtin_amdgcn_mfma_scale_f32_16x16x128_f8f6f4(Bt##8[n], Z8, acc[ai][bj][m][n], 0, 0, 0, 0, 0, 0); } \
          \
        asm volatile("" : "+v"(acc[ai][bj][0][0]), "+v"(acc[ai][bj][0][1]), "+v"(acc[ai][bj][1][0]), "+v"(acc[ai][bj][1][1]), "+v"(acc[ai][bj][2][0]), "+v"(acc[ai][bj][2][1]), "+v"(acc[ai][bj][3][0]), "+v"(acc[ai][bj][3][1])); \
        __builtin_amdgcn_sched_barrier(0); } \
    else { _Pragma("unroll") for (int m = 0; m < 4; ++m) _Pragma("unroll") for (int n = 0; n < 2; ++n) _Pragma("unroll") for (int k = 0; k < 2; ++k) \
        acc[ai][bj][m][n] = __builtin_amdgcn_mfma_f32_16x16x32_bf16(Bt[n][k], At[m][k], acc[ai][bj][m][n], 0, 0, 0); } __builtin_amdgcn_s_setprio(0); } while (0)
#define PG8_WAIT_V(n) asm volatile("s_waitcnt vmcnt(" #n ")" ::: "memory")
#define PG8_WAIT_L(n) asm volatile("s_waitcnt lgkmcnt(" #n ")" ::: "memory")
#define PG8_BAR __builtin_amdgcn_s_barrier()
#define PG8_SCHED __builtin_amdgcn_sched_barrier(0)
#ifndef PROBE_GEMM
#define PROBE_GEMM 0
#endif
#ifndef PROBE_MFMA2
#define PROBE_MFMA2 0
#endif
#ifndef PROBE_GBLK
#define PROBE_GBLK 100
#endif
#ifndef PROBE_GUNIT
#define PROBE_GUNIT 3
#endif
#define PG8_LSTAMP(i_) do { if constexpr (PROBE_GEMM != 0 && Epi::PROBE_ID == PROBE_GEMM) { if (blockIdx.x == PROBE_GBLK && tid == 0 && ui == PROBE_GUNIT) { \
        *(volatile PG8_LAS unsigned long long*)(lds + 133120 + 8 * (i_)) = __builtin_amdgcn_s_memrealtime(); } } } while (0)
    unsigned ZK = 0u; asm volatile("" : "+s"(ZK));
    Unit cur, nxt; int ui = 0;
    if (!S.next(0, cur)) return;
    f32x4 acc[2][2][4][2];
#pragma unroll
    for (int a = 0; a < 2; ++a)
#pragma unroll
        for (int b = 0; b < 2; ++b)
#pragma unroll
            for (int m = 0; m < 4; ++m)
#pragma unroll
                for (int n = 0; n < 2; ++n) acc[a][b][m][n] = (f32x4){0.f, 0.f, 0.f, 0.f};
    bf16x8 At[4][2], B0[2][2], B1[2][2];
    pg8_i8 Z8 = {0, 0, 0, 0, 0, 0, 0, 0}; if constexpr (PROBE_MFMA2 != 0) asm volatile("" : "+v"(Z8)); (void)Z8;
    pg8_i8 At8[4], B08[2], B18[2];
    (void)At; (void)B0; (void)B1; (void)At8; (void)B08; (void)B18;
    const char* cA = S.aptr(g, cur, tstep); const char* cB = S.bptr(g, cur, tstep);
    unsigned voffGC[2][2] = {{0u, 0u}, {0u, 0u}}, voffGN[2][2] = {{0u, 0u}, {0u, 0u}}; int rawN[2][2] = {{0, 0}, {0, 0}};
    if constexpr (Sched::GATHER) { S.load_raw(cur, rawN, tid); S.raw_to_off(rawN, voffGC, tid, K); }
    S.a_ready(cur);
    if constexpr (SP2) {
        PG8_STAGE(PG8_SB(0, 0), cB, voffB); PG8_STAGE(PG8_SB(0, 1), cB + hstep, voffB); PG8_STAGE_A(PG8_SA(0, 0), cA, 0, false); PG8_STAGE_A(PG8_SA(0, 1), cA, 1, false);
        if (wr == 1) PG8_BAR;
        PG8_WAIT_V(2); PG8_BAR;
        PG8_STAGE(PG8_SB(1, 0), cB + kstep, voffB); PG8_STAGE_A(PG8_SA(1, 0), cA + kstep, 0, false); PG8_STAGE(PG8_SB(1, 1), cB + hstep + kstep, voffB);
        PG8_WAIT_V(6); PG8_BAR;
    } else {
        PG8_STAGE(PG8_SB(0, 0), cB, voffB); PG8_STAGE_A(PG8_SA(0, 0), cA, 0, false); PG8_STAGE(PG8_SB(0, 1), cB + hstep, voffB); PG8_STAGE_A(PG8_SA(0, 1), cA, 1, false);
        if (wr == 1) PG8_BAR;
        PG8_WAIT_V(4); PG8_BAR;
        PG8_STAGE(PG8_SB(1, 0), cB + kstep, voffB); PG8_STAGE_A(PG8_SA(1, 0), cA + kstep, 0, false); PG8_STAGE(PG8_SB(1, 1), cB + hstep + kstep, voffB);
        PG8_WAIT_V(6); PG8_BAR;
    }
    for (;;) {
        const bool has_next = S.next(ui + 1, nxt);
        const char* nA = has_next ? S.aptr(g, nxt, tstep) : cA; const char* nB = has_next ? S.bptr(g, nxt, tstep) : cB;
        PG8_LSTAMP(0);
        for (int t = 0; t < nt; t += 2) {
            asm volatile("" : "+s"(ZK));
            const bool last = (t == nt - 2);
            const char* a1 = cA + (size_t)(t + 1) * kstep;
            const char* a2 = last ? nA : cA + (size_t)(t + 2) * kstep; const char* b2 = last ? nB : cB + (size_t)(t + 2) * kstep;
            const char* a3 = a2 + kstep; const char* b3 = b2 + kstep;
            if (last && has_next) S.a_ready(nxt);
            if constexpr (Sched::GATHER) {
                if (t == nt - 4 && has_next) S.load_raw(nxt, rawN, tid);
                if (last) { if (has_next) S.raw_to_off(rawN, voffGN, tid, K); else { voffGN[0][0] = voffGC[0][0]; voffGN[0][1] = voffGC[0][1]; voffGN[1][0] = voffGC[1][0]; voffGN[1][1] = voffGC[1][1]; } } }
            if constexpr (SP2) {
            PG8_LDB(B0, 0, 0); PG8_LDB(B1, 0, 1); PG8_SCHED; PG8_LDA(At, 0, 0); PG8_STAGE_A(PG8_SA(1, 1), a1, 1, false);
            PG8_WAIT_V(8); PG8_WAIT_L(0); PG8_BAR; PG8_MMA(0, 0, At, B0); PG8_MMA(0, 1, At, B1); PG8_BAR; PG8_SCHED;
            PG8_LDA(At, 0, 1); PG8_STAGE(PG8_SB(0, 0), b2, voffB); PG8_STAGE(PG8_SB(0, 1), b2 + hstep, voffB); PG8_STAGE_A(PG8_SA(0, 0), a2, 0, last);
            PG8_WAIT_V(8); PG8_WAIT_L(0); PG8_BAR; PG8_MMA(1, 0, At, B0); PG8_MMA(1, 1, At, B1); PG8_BAR; PG8_SCHED;
            PG8_LDB(B0, 1, 0); PG8_LDB(B1, 1, 1); PG8_SCHED; PG8_LDA(At, 1, 0); PG8_STAGE_A(PG8_SA(0, 1), a2, 1, last);
            PG8_WAIT_V(8); PG8_WAIT_L(0); PG8_BAR; PG8_MMA(0, 0, At, B0); PG8_MMA(0, 1, At, B1); PG8_BAR; PG8_SCHED;
            PG8_LDA(At, 1, 1); PG8_STAGE(PG8_SB(1, 0), b3, voffB); PG8_STAGE(PG8_SB(1, 1), b3 + hstep, voffB); PG8_STAGE_A(PG8_SA(1, 0), a3, 0, last);
            PG8_WAIT_V(8); PG8_WAIT_L(0); PG8_BAR; PG8_MMA(1, 0, At, B0); PG8_MMA(1, 1, At, B1); PG8_BAR; PG8_SCHED;
            } else {
            PG8_LDB(B0, 0, 0); PG8_SCHED; PG8_LDA(At, 0, 0); PG8_STAGE_A(PG8_SA(1, 1), a1, 1, false);
            PG8_WAIT_L(8); PG8_BAR; PG8_WAIT_L(0); PG8_MMA(0, 0, At, B0); PG8_BAR; PG8_SCHED;
            PG8_LDB(B1, 0, 1); PG8_STAGE(PG8_SB(0, 0), b2, voffB);
            PG8_BAR; PG8_WAIT_L(0); PG8_MMA(0, 1, At, B1); PG8_BAR;
            PG8_LDA(At, 0, 1); PG8_STAGE_A(PG8_SA(0, 0), a2, 0, last);
            PG8_BAR; PG8_WAIT_L(0); PG8_MMA(1, 0, At, B0); PG8_BAR; PG8_SCHED;
            PG8_STAGE(PG8_SB(0, 1), b2 + hstep, voffB);
            PG8_WAIT_V(6); PG8_BAR; PG8_MMA(1, 1, At, B1); PG8_BAR;
            PG8_LDB(B0, 1, 0); PG8_SCHED; PG8_LDA(At, 1, 0); PG8_STAGE_A(PG8_SA(0, 1), a2, 1, last);
            PG8_WAIT_L(8); PG8_BAR; PG8_WAIT_L(0); PG8_MMA(0, 0, At, B0); PG8_BAR; PG8_SCHED;
            PG8_LDB(B1, 1, 1); PG8_STAGE(PG8_SB(1, 0), b3, voffB);
            PG8_BAR; PG8_WAIT_L(0); PG8_MMA(0, 1, At, B1); PG8_BAR;
            PG8_LDA(At, 1, 1); PG8_STAGE_A(PG8_SA(1, 0), a3, 0, last);
            PG8_BAR; PG8_WAIT_L(0); PG8_MMA(1, 0, At, B0); PG8_BAR; PG8_SCHED;
            PG8_STAGE(PG8_SB(1, 1), b3 + hstep, voffB);
            PG8_WAIT_V(6); PG8_BAR; PG8_MMA(1, 1, At, B1); PG8_BAR;
            }
        }
        PG8_LSTAMP(1);
        if constexpr (ALIGN_EPI) { if (wr == 0) PG8_BAR; }
        if constexpr (!Epi::AFTER_DRAIN) { E(acc, cur, wr, wc, fr, fq); S.done(cur); }
        PG8_LSTAMP(2);
        if (!has_next) break;
#pragma unroll
        for (int a = 0; a < 2; ++a)
#pragma unroll
            for (int b = 0; b < 2; ++b)
#pragma unroll
                for (int m = 0; m < 4; ++m)
#pragma unroll
                    for (int n = 0; n < 2; ++n) acc[a][b][m][n] = (f32x4){0.f, 0.f, 0.f, 0.f};
        cur = nxt; cA = nA; cB = nB; ++ui;
        if constexpr (Sched::GATHER) { voffGC[0][0] = voffGN[0][0]; voffGC[0][1] = voffGN[0][1]; voffGC[1][0] = voffGN[1][0]; voffGC[1][1] = voffGN[1][1]; }
        if constexpr (ALIGN_EPI) { if (wr == 1) PG8_BAR; }
    }
    PG8_WAIT_V(0);
    if constexpr (!ALIGN_EPI) { if (wr == 0) PG8_BAR; }
    PG8_BAR;
    if constexpr (Epi::AFTER_DRAIN) { E.fused(acc, cur, wr, wc, fr, fq, lds, wid, lane); S.done(cur); }
#undef PG8_SA
#undef PG8_SB
#undef PG8_STAGE
#undef PG8_CAT8
#undef PG8_LD8
#undef PG8_STAGE_A
#undef PG8_LDA
#undef PG8_LDB
#undef PG8_MMA
#undef PG8_WAIT_V
#undef PG8_WAIT_L
#undef PG8_BAR
#undef PG8_SCHED
#undef PG8_LSTAMP
}
}

#ifndef MK_ONE_LAUNCH
#define MK_ONE_LAUNCH 1
#endif
constexpr int NWAVES = 8, NTHREADS = 512;
constexpr int NB = 16, SEQ = 2048, CTX = 256, TB = SEQ + CTX, T = NB * TB, D = 1024, DIN = 4864, DEPTH = 4;
constexpr int OFF_U = 0, OFF_CB = 256, OFF_CC = 512, OFF_CX = 768, OFF_Q = 1024, OFF_K = 1536, OFF_V = 1664, OFF_GT = 1792;
constexpr int NE = 32, MAX_TILES = (T * 4 + NE * 255) / 256, MAX_SLOTS = MAX_TILES * 256;
constexpr float EPS = 1e-6f;
enum { I_X = 0, I_C, I_CTX, I_CCTX, I_WMOD, I_BMOD, I_N1G, I_N2G, I_WIN, I_LRE, I_LIM, I_LDT, I_BRE, I_BIM, I_CRE, I_CIM, I_SD, I_WGLU, I_WSO, I_CONVW, I_WCO, I_QG, I_KG, I_SINK, I_WAO, I_WO,
       I_WR, I_BR, I_WGU, I_BGU, I_WD, I_BD, N_IN };
constexpr size_t MiB = 1u << 20;
constexpr size_t WS_CTL = 0, CTL_ZERO_BYTES = 1 * MiB;
constexpr size_t WS_MOD = 1 * MiB;
constexpr size_t WS_WRT = 3 * MiB;
constexpr size_t WS_ROPE = 4 * MiB;
constexpr size_t WS_WGLU = 5 * MiB;
constexpr size_t WS_WSO = 6 * MiB;
constexpr size_t WS_WCO = 8 * MiB;
constexpr size_t WS_WAO = 10 * MiB;
constexpr size_t WS_WO = 14 * MiB;
constexpr size_t WS_WIN = 22 * MiB;
constexpr size_t WS_WGU = 60 * MiB;
constexpr size_t WS_WD = 572 * MiB;
constexpr size_t WS_X = 828 * MiB;
constexpr size_t WS_H = 972 * MiB;
constexpr size_t WS_PROJ = 1044 * MiB;
constexpr size_t WS_QN = 1386 * MiB;
constexpr size_t WS_KN = 1422 * MiB;
constexpr size_t WS_Z = 1431 * MiB;
constexpr size_t WS_Z2 = 1449 * MiB;
constexpr size_t WS_YB = 1467 * MiB;
constexpr size_t WS_YA = 1485 * MiB;
constexpr size_t WS_MM = 1521 * MiB;
constexpr size_t WS_XG = 1593 * MiB;
constexpr size_t WS_G8 = 1753 * MiB;
constexpr size_t WS_ACT = 1897 * MiB;
constexpr size_t WS_TOPG = 2201 * MiB;
constexpr size_t WS_SLOT = 2202 * MiB;
constexpr size_t WS_S5S = 2203 * MiB;
constexpr size_t WS_XIN = 2275 * MiB;
constexpr size_t WS_VT = 2311 * MiB;
constexpr size_t WS_MS = 2320 * MiB;
constexpr size_t WS_W5 = 2324 * MiB;
constexpr size_t WS_BASE = 2330 * MiB;
constexpr size_t WS_STOK = 2331 * MiB;
constexpr size_t WS_GC = 2334 * MiB;
constexpr size_t WS_H8 = 2335 * MiB;
constexpr size_t WS_WIN8 = 2371 * MiB;
constexpr size_t WS_YS8 = 2383 * MiB;
constexpr size_t WS_END = 2535 * MiB;
static_assert(WS_XG + (size_t)MAX_SLOTS * D <= WS_G8 && WS_G8 + (size_t)T * 3072 <= WS_ACT, "d_ws map 3");
static_assert(WS_WIN + (size_t)4 * DIN * D * 2 <= WS_WGU && WS_PROJ + (size_t)T * DIN * 2 <= WS_QN && WS_XG + (size_t)MAX_SLOTS * D * 2 <= WS_ACT && WS_ACT + (size_t)MAX_SLOTS * D * 2 <= WS_TOPG, "d_ws map");
static_assert(WS_X + (size_t)T * D * 4 <= WS_H && WS_H + (size_t)T * D * 2 <= WS_PROJ && WS_S5S + (size_t)16 * 4608 * 256 * 4 <= WS_XIN && WS_XIN + (size_t)32 * 4608 * 128 * 2 <= WS_VT && WS_VT + (size_t)32 * 64 * TB * 2 <= WS_MS && WS_W5 + (size_t)64 * 128 * 384 * 2 <= WS_END, "d_ws map 2");
constexpr int CW_CNT = 64;
constexpr int CW_BAR = 4096;
constexpr int CW_TS = 16384;
constexpr int RING_BYTES = 131072, MISC_OFF = RING_BYTES, LCNT_OFF = MISC_OFF + 128, TILE_E_OFF = MISC_OFF + 256, PADS_OFF = MISC_OFF + 1024, SCR_OFF = MISC_OFF + 2048, LDS_BYTES = 155648;

#define GAS __attribute__((address_space(1)))
#define LAS __attribute__((address_space(3)))
typedef unsigned short bf16;
typedef unsigned v4u __attribute__((ext_vector_type(4)));
typedef unsigned v2u __attribute__((ext_vector_type(2)));
typedef float f32x4 __attribute__((ext_vector_type(4)));
typedef float f32x2 __attribute__((ext_vector_type(2)));
typedef GAS unsigned gu32;
#define RLX_AGENT __ATOMIC_RELAXED, __HIP_MEMORY_SCOPE_AGENT
#define LDS_WAIT() asm volatile("s_waitcnt lgkmcnt(0)" ::: "memory")
#define VM_WAIT() asm volatile("s_waitcnt vmcnt(0)" ::: "memory")
__device__ __forceinline__ unsigned f2bf(float f) { unsigned u = __builtin_bit_cast(unsigned, f); return (u + 0x7fffu + ((u >> 16) & 1u)) >> 16; }
__device__ __forceinline__ unsigned pk2(float lo, float hi) { return f2bf(lo) | (f2bf(hi) << 16); }
__device__ __forceinline__ float bflo(unsigned w) { return __uint_as_float(w << 16); }
__device__ __forceinline__ float bfhi(unsigned w) { return __uint_as_float(w & 0xffff0000u); }

#define XB_TMO      128
#define XB_XCNT(j)  (256  + 64 * (j))
#define XB_XSUB(j)  (1280 + 64 * (j))
#define XB_XGEN(j)  (2304 + 64 * (j))
#define XB_TOP      3328
#define XB_TOPGEN   3392
#define XCD_BAR_WORDS 3456
#define XB_SPIN_CAP (1u << 18)

__device__ __forceinline__ unsigned xb_ld(unsigned* p)              { return __hip_atomic_load(p, __ATOMIC_RELAXED, __HIP_MEMORY_SCOPE_AGENT); }
__device__ __forceinline__ unsigned xb_add(unsigned* p, unsigned v) { return __hip_atomic_fetch_add(p, v, __ATOMIC_RELAXED, __HIP_MEMORY_SCOPE_AGENT); }
__device__ __forceinline__ unsigned xb_xcc_id() { return (unsigned)__builtin_amdgcn_s_getreg((3 << 11) | 20) & 0xFu; }
#define XB_SPIN(cond, bar) do { unsigned _sp = 0; while (cond) { __builtin_amdgcn_s_sleep(1); \
    if ((++_sp & 255u) == 0u) { if (xb_ld(&(bar)[XB_TMO])) break; if (_sp > XB_SPIN_CAP) { atomicAdd(&(bar)[XB_TMO], 1u); break; } } } } while (0)

struct XcdBarrier {
    unsigned* bar; unsigned x;
    volatile LAS unsigned* st;
};

__device__ __forceinline__ XcdBarrier xcd_barrier_post(unsigned* bar, volatile LAS unsigned* st) {
    XcdBarrier b; b.bar = bar; b.x = xb_xcc_id(); b.st = st;
    if (threadIdx.x == 0) (void)xb_add(&bar[XB_XCNT(b.x)], 1u);
    return b;
}
__device__ __forceinline__ void xcd_barrier_complete(unsigned* bar, unsigned x, unsigned& nloc, unsigned& nx) {
    const unsigned G = gridDim.x * gridDim.y * gridDim.z;
    unsigned sum, cnt, mine, sp = 0u;
    for (;;) {
        sum = 0u; cnt = 0u; mine = 0u;
#pragma unroll
        for (unsigned j = 0; j < 16; ++j) { const unsigned c = xb_ld(&bar[XB_XCNT(j)]); sum += c; cnt += (c > 0u) ? 1u : 0u; mine = (j == x) ? c : mine; }
        if (sum == G) break;
        __builtin_amdgcn_s_sleep(1);
        if ((++sp & 255u) == 0u) { if (xb_ld(&bar[XB_TMO])) break; if (sp > XB_SPIN_CAP) { atomicAdd(&bar[XB_TMO], 1u); break; } }
    }
    nloc = mine > 0u ? mine : 1u; nx = cnt > 0u ? cnt : 1u;
}

__device__ __forceinline__ void xcd_barrier(const XcdBarrier& b, const bool leader) {
    asm volatile("s_waitcnt vmcnt(0)" ::: "memory");
    __syncthreads();
    if (leader) {
        unsigned* bar = b.bar;
        __builtin_amdgcn_s_waitcnt(0);
        unsigned nloc = b.st[0], nx = b.st[1];
        if (nloc == 0u) { xcd_barrier_complete(bar, b.x, nloc, nx); b.st[0] = nloc; b.st[1] = nx; }
        const unsigned old = xb_add(&bar[XB_XSUB(b.x)], 1u);
        const unsigned gen = old / nloc;
        if (old + 1u == (gen + 1u) * nloc) {
            __builtin_amdgcn_fence(__ATOMIC_RELEASE, "agent");
            asm volatile("s_waitcnt vmcnt(0)" ::: "memory");
            const unsigned og = xb_add(&bar[XB_TOP], 1u);
            const unsigned tg = og / nx;
            if (og + 1u == (tg + 1u) * nx) xb_add(&bar[XB_TOPGEN], 1u);
            else XB_SPIN(xb_ld(&bar[XB_TOPGEN]) == tg, bar);
            __builtin_amdgcn_fence(__ATOMIC_ACQUIRE, "agent");
            xb_add(&bar[XB_XGEN(b.x)], 1u);
            asm volatile("s_waitcnt vmcnt(0)" ::: "memory");
        } else {
            XB_SPIN(xb_ld(&bar[XB_XGEN(b.x)]) == gen, bar);
            __builtin_amdgcn_fence(__ATOMIC_ACQUIRE, "agent");
            asm volatile("s_waitcnt vmcnt(0)" ::: "memory");
        }
    }
    __syncthreads();
}

struct Args { const float* in[N_IN]; float* out; unsigned char* ws; int ph_lo, ph_hi; };
typedef const __attribute__((address_space(4))) Args CA;
typedef CA* CArgs;
__device__ __forceinline__ CArgs get_args() { CArgs p = (CArgs)__builtin_amdgcn_kernarg_segment_ptr(); asm volatile("" : "+s"(p)); return p; }

__device__ __forceinline__ float shx(float v, int m, int lane) { return __builtin_bit_cast(float, __builtin_amdgcn_ds_bpermute((lane ^ m) << 2, __builtin_bit_cast(int, v))); }
#define DPPF(v, ctrl) __builtin_bit_cast(float, __builtin_amdgcn_update_dpp(0, __builtin_bit_cast(int, (v)), (ctrl), 0xF, 0xF, true))
__device__ __forceinline__ float sum8(float v) { v += DPPF(v, 0xB1); v += DPPF(v, 0x4E); v += DPPF(v, 0x141); return v; }
__device__ __forceinline__ float xor4(float v, int lane) { const float up = DPPF(v, 0x104), dn = DPPF(v, 0x114); return (lane & 4) ? dn : up; }
__device__ __forceinline__ float wave_sum(float v, int lane) {
    v += DPPF(v, 0xB1); v += DPPF(v, 0x4E); v += DPPF(v, 0x141); v += DPPF(v, 0x140);
    v += shx(v, 16, lane); v += shx(v, 32, lane); return v;
}
__device__ __forceinline__ float wave_sum_bp(float v, int lane) {
#pragma unroll
    for (int o = 1; o < 64; o <<= 1) v += shx(v, o, lane);
    return v;
}
__device__ __forceinline__ float wave_max(float v, int lane) {
#pragma unroll
    for (int o = 1; o < 64; o <<= 1) v = fmaxf(v, shx(v, o, lane));
    return v;
}
typedef float f32x2_t __attribute__((ext_vector_type(2))); typedef __bf16 bf16x2_t __attribute__((ext_vector_type(2)));
__device__ __forceinline__ unsigned cvtpk(float lo, float hi) { f32x2_t v = {lo, hi}; bf16x2_t b = __builtin_convertvector(v, bf16x2_t); return __builtin_bit_cast(unsigned, b); }
#ifndef PROBE_MASK
#define PROBE_MASK 0
#endif
#ifndef PROBE_SUB_A
#define PROBE_SUB_A -1
#endif
#ifndef PROBE_SUB_B
#define PROBE_SUB_B -1
#endif
#ifndef PROBE_SUBF
#define PROBE_SUBF 16
#endif
#ifndef PROBE_BLK
#define PROBE_BLK 0
#endif
#define PROBE_SUB(ws_, tid_, i_) do { if (PROBE_MASK || PROBE_SUB_A >= 0) { if (blockIdx.x == PROBE_BLK && (tid_) == 0) { asm volatile("s_waitcnt vmcnt(0) lgkmcnt(0)" ::: "memory"); \
        __hip_atomic_store((unsigned long long*)((ws_) + WS_CTL) + CW_TS / 2 + 128 + (i_), (unsigned long long)__builtin_amdgcn_s_memrealtime(), RLX_AGENT); } } } while (0)
__device__ __forceinline__ float gelu_tanh(float x) {
    const float y = 0.7978845608028654f * (x + 0.044715f * x * x * x);
    const float t = 1.0f - 2.0f * __builtin_amdgcn_rcpf(1.0f + __expf(2.0f * y));
    return 0.5f * x * (1.0f + t);
}

__device__ __forceinline__ void s5_build_mats(CArgs ap, LAS unsigned char* lds, int tid, int l, int g);
template <int MODE>
__device__ __forceinline__ void transpose_item(const float* W, int K, int N, bf16* WT, LAS float* scr, int item, int lane) {
    const int nblk = N / 32, kb = item / nblk, nb = item - kb * nblk, k0 = 64 * kb, n0 = 32 * nb;
#pragma unroll 8
    for (int i = 0; i < 32; ++i) { const int kk = 2 * i + (lane >> 5); scr[kk * 33 + (lane & 31)] = W[(size_t)(k0 + kk) * N + n0 + (lane & 31)]; }
    LDS_WAIT(); asm volatile("" ::: "memory");
    const int c = lane & 7;
#pragma unroll
    for (int j = 0; j < 4; ++j) { const int n = (lane >> 3) + 8 * j; const LAS float* s = scr + (8 * c) * 33 + n;
        const int nn = n0 + n; const int jj = nn >> 1;
        const int drow = (MODE == 0 || MODE == 2) ? nn : ((jj >> 7) * 256 + (nn & 1) * 128 + (jj & 127));
        if (MODE >= 1) {
            unsigned w0 = 0u, w1 = 0u;
            w0 = __builtin_amdgcn_cvt_pk_fp8_f32(32.0f * s[0 * 33], 32.0f * s[1 * 33], w0, false); w0 = __builtin_amdgcn_cvt_pk_fp8_f32(32.0f * s[2 * 33], 32.0f * s[3 * 33], w0, true);
            w1 = __builtin_amdgcn_cvt_pk_fp8_f32(32.0f * s[4 * 33], 32.0f * s[5 * 33], w1, false); w1 = __builtin_amdgcn_cvt_pk_fp8_f32(32.0f * s[6 * 33], 32.0f * s[7 * 33], w1, true);
            *(GAS v2u*)((unsigned char*)WT + (size_t)drow * K + k0 + 8 * c) = (v2u){w0, w1};
        } else {
            v4u o; o.x = pk2(s[0 * 33], s[1 * 33]); o.y = pk2(s[2 * 33], s[3 * 33]); o.z = pk2(s[4 * 33], s[5 * 33]); o.w = pk2(s[6 * 33], s[7 * 33]);
            *(GAS v4u*)(WT + (size_t)drow * K + k0 + 8 * c) = o; } }
    LDS_WAIT(); asm volatile("" ::: "memory");
}

__device__ __forceinline__ void phase_prologue(CArgs ap, LAS unsigned char* lds, int tid, int lane, int wave, int bid, int G) {
    CA& a = *ap;
    unsigned char* ws = a.ws;
    PROBE_SUB(ws, tid, 11);
    { int* z = (int*)(ws + WS_STOK); for (int i = bid * NTHREADS + tid; i < DEPTH * MAX_SLOTS; i += G * NTHREADS) __hip_atomic_store(z + i, 0, RLX_AGENT); }
    if (bid < 192) {
        LAS float* S = (LAS float*)lds;
        LAS float* R = (LAS float*)(lds + 17 * 1024 * 4);
        for (int idx = tid; idx < 17 * 1024; idx += NTHREADS) { const int r = idx >> 10, k = idx & 1023; const float v = r < 16 ? a.in[I_C][r * 1024 + k] : a.in[I_CCTX][k]; S[idx] = v / (1.0f + __expf(-v)); }
        __syncthreads();
        const int l = bid / 48, c0 = (bid % 48) * 128, col = tid & 127, kq = tid >> 7;
        float acc[17];
#pragma unroll
        for (int r = 0; r < 17; ++r) acc[r] = 0.f;
        const float* wp = a.in[I_WMOD] + ((size_t)l * 1024 + kq * 256) * 6144 + c0 + col;
#pragma unroll 2
        for (int k = 0; k < 256; k += 4) { const float w0 = wp[(size_t)k * 6144], w1 = wp[(size_t)(k + 1) * 6144], w2 = wp[(size_t)(k + 2) * 6144], w3 = wp[(size_t)(k + 3) * 6144];
#pragma unroll
            for (int r = 0; r < 17; ++r) { const f32x4 s4 = *(const LAS f32x4*)(S + r * 1024 + kq * 256 + k); acc[r] += (s4.x * w0 + s4.y * w1) + (s4.z * w2 + s4.w * w3); } }
#pragma unroll
        for (int r = 0; r < 17; ++r) R[(kq * 17 + r) * 128 + col] = acc[r];
        __syncthreads();
        float* MOD = (float*)(ws + WS_MOD);
        for (int idx = tid; idx < 17 * 128; idx += NTHREADS) { const int r = idx >> 7, cc = idx & 127;
            const float v = R[(0 * 17 + r) * 128 + cc] + R[(1 * 17 + r) * 128 + cc] + R[(2 * 17 + r) * 128 + cc] + R[(3 * 17 + r) * 128 + cc] + a.in[I_BMOD][l * 6144 + c0 + cc];
            MOD[((size_t)l * 17 + r) * 6144 + c0 + cc] = v; }
    }
    else s5_build_mats(ap, lds, tid, (bid - 192) >> 4, (bid - 192) & 15);
    PROBE_SUB(ws, tid, 12);
    __syncthreads();
    {
        LAS float* scr = (LAS float*)(lds + wave * 16384);
        const int gw = bid * NWAVES + wave, NGW = G * NWAVES;
        constexpr int N_WGU = 128 * 1024, N_WD = 128 * 512, N_WIN = 4 * 2432, N_WO = 4 * 512, N_WAO = 4 * 256, N_WSO = 4 * 128, N_WCO = 4 * 128, N_WGLU = 4 * 32;
        constexpr int NITEMS = N_WGU + N_WD + N_WIN + N_WO + N_WAO + N_WSO + N_WCO + N_WGLU;
        for (int it = gw; it < NITEMS; it += NGW) {
            int r = it;
            if (r < N_WGU) { const int m = r >> 10; transpose_item<1>(a.in[I_WGU] + (size_t)m * 1024 * 2048, 1024, 2048, (bf16*)(ws + WS_WGU + (size_t)m * 2048 * 1024), scr, r & 1023, lane); continue; } r -= N_WGU;
            if (r < N_WD) { const int m = r >> 9; transpose_item<2>(a.in[I_WD] + (size_t)m * 1024 * 1024, 1024, 1024, (bf16*)(ws + WS_WD + (size_t)m * 1024 * 1024), scr, r & 511, lane); continue; } r -= N_WD;
            if (r < N_WIN) { const int m = r / 2432, it2 = r - m * 2432;
                if ((it2 % 152) < 56) transpose_item<0>(a.in[I_WIN] + (size_t)m * 1024 * DIN, 1024, DIN, (bf16*)(ws + WS_WIN) + (size_t)m * 1792 * 1024, scr, it2, lane);
                else transpose_item<2>(a.in[I_WIN] + (size_t)m * 1024 * DIN, 1024, DIN, (bf16*)(ws + WS_WIN8 + (size_t)m * 3072 * 1024 - (size_t)1792 * 1024), scr, it2, lane);
                continue; } r -= N_WIN;
            if (r < N_WO) { const int m = r >> 9; transpose_item<0>(a.in[I_WO] + (size_t)m * 1024 * 1024, 1024, 1024, (bf16*)(ws + WS_WO) + (size_t)m * 1024 * 1024, scr, r & 511, lane); continue; } r -= N_WO;
            if (r < N_WAO) { const int m = r >> 8; transpose_item<0>(a.in[I_WAO] + (size_t)m * 512 * 1024, 512, 1024, (bf16*)(ws + WS_WAO) + (size_t)m * 1024 * 512, scr, r & 255, lane); continue; } r -= N_WAO;
            if (r < N_WSO) { const int m = r >> 7; transpose_item<0>(a.in[I_WSO] + (size_t)m * 256 * 1024, 256, 1024, (bf16*)(ws + WS_WSO) + (size_t)m * 1024 * 256, scr, r & 127, lane); continue; } r -= N_WSO;
            if (r < N_WCO) { const int m = r >> 7; transpose_item<0>(a.in[I_WCO] + (size_t)m * 256 * 1024, 256, 1024, (bf16*)(ws + WS_WCO) + (size_t)m * 1024 * 256, scr, r & 127, lane); continue; } r -= N_WCO;
            { const int m = r >> 5; transpose_item<0>(a.in[I_WGLU] + (size_t)m * 256 * 256, 256, 256, (bf16*)(ws + WS_WGLU) + (size_t)m * 256 * 256, scr, r & 31, lane); }
        }
    }
    PROBE_SUB(ws, tid, 13);
    {
        const int gt = bid * NTHREADS + tid, NGT = G * NTHREADS;
        unsigned* WRF = (unsigned*)(ws + WS_WRT);
        for (int i = gt; i < 4 * 32 * 2 * 64 * 4; i += NGT) { const int jp = i & 3, ln = (i >> 2) & 63, nt = (i >> 8) & 1, ks = (i >> 9) & 31, l = i >> 14;
            const int e = nt * 16 + (ln & 15), k = 32 * ks + 8 * (ln >> 4) + 2 * jp;
            const float w0 = a.in[I_WR][((size_t)l * 1024 + k) * 32 + e], w1 = a.in[I_WR][((size_t)l * 1024 + k + 1) * 32 + e];
            const unsigned hi = cvtpk(w0, w1); const unsigned lo = cvtpk(w0 - bflo(hi), w1 - bfhi(hi));
            const size_t base = ((((size_t)l * 32 + ks) * 2 + nt) * 2) * 256 + ln * 4 + jp;
            WRF[base] = hi; WRF[base + 256] = lo; }
        float* ROPE = (float*)(ws + WS_ROPE);
        for (int i = gt; i < 2048 * 32; i += NGT) { const int t = i >> 5, p = i & 31; const float pos = (float)(p < 16 ? (t >> 6) : (t & 63));
            const float inv = powf(10000.0f, -(float)(p & 15) / 16.0f); float sn, cs; sincosf(pos * inv, &sn, &cs); ROPE[2 * i] = cs; ROPE[2 * i + 1] = sn; }
    }
}

template <int MODE>
__device__ __forceinline__ void phase_n1(CArgs ap, int l, int lane, int gw, int NGW) {
    CA& a = *ap;
    unsigned char* ws = a.ws;
    bf16* X = (bf16*)(ws + WS_X); bf16* H = (bf16*)(ws + WS_H);
    const float* MOD = (const float*)(ws + WS_MOD);
    const unsigned char* YS = (const unsigned char*)(ws + WS_YS8); const float* TOPG = (const float*)(ws + WS_TOPG); const int* SLOT = (const int*)(ws + WS_SLOT);
    const float* gn = a.in[I_N1G] + (l < DEPTH ? l : 0) * D;
    constexpr int RPT = 3;
    for (int row0 = gw; row0 < T; row0 += RPT * NGW) {
        int rowv[RPT], bb[RPT], sv[RPT], rv[RPT]; bool on[RPT];
        f32x4 v[RPT][2][2], tg[RPT]; int4 sl[RPT]; v2u y8[RPT][4][2];
#pragma unroll
        for (int rr = 0; rr < RPT; ++rr) { const int row = row0 + rr * NGW; rowv[rr] = row; on[rr] = row < T; const int rowc = on[rr] ? row : row0;
            const int b = rowc / TB, s = rowc - b * TB; const bool isctx = s < CTX; bb[rr] = b; sv[rr] = s; rv[rr] = isctx ? 16 : b; if (MODE == 2 && isctx) on[rr] = false;
            const float* src = isctx ? a.in[I_CTX] + ((size_t)b * CTX + s) * D : a.in[I_X] + ((size_t)b * SEQ + (s - CTX)) * D;
#pragma unroll
            for (int g = 0; g < 2; ++g) { const int c0 = 8 * lane + 512 * g;
                if (MODE == 0) { v[rr][g][0] = *(const f32x4*)(src + c0); v[rr][g][1] = *(const f32x4*)(src + c0 + 4); }
                else { const v4u w = __builtin_nontemporal_load((const v4u*)(X + (size_t)rowc * D + c0)); v[rr][g][0] = (f32x4){bflo(w.x), bfhi(w.x), bflo(w.y), bfhi(w.y)}; v[rr][g][1] = (f32x4){bflo(w.z), bfhi(w.z), bflo(w.w), bfhi(w.w)}; } }
            if (MODE != 0) { tg[rr] = *(const f32x4*)(TOPG + (size_t)rowc * 4); sl[rr] = *(const int4*)(SLOT + (size_t)rowc * 4); } }
        if (MODE != 0) {
#pragma unroll
            for (int rr = 0; rr < RPT; ++rr) { const int sls[4] = {sl[rr].x, sl[rr].y, sl[rr].z, sl[rr].w};
#pragma unroll
                for (int k = 0; k < 4; ++k)
#pragma unroll
                    for (int g = 0; g < 2; ++g) y8[rr][k][g] = __builtin_nontemporal_load((const v2u*)((const unsigned char*)YS + (size_t)sls[k] * D + 8 * lane + 512 * g)); }
        }
#pragma unroll
        for (int rr = 0; rr < RPT; ++rr) {
            if (!on[rr]) continue;
            const int row = rowv[rr], r = rv[rr];
            if (MODE != 0) {
                const float* g2 = MOD + ((size_t)(l - 1) * 17 + r) * 6144 + 5120;
#pragma unroll
                for (int g = 0; g < 2; ++g) { f32x4 acc0 = (f32x4){0.f, 0.f, 0.f, 0.f}, acc1 = acc0;
#pragma unroll
                    for (int k = 0; k < 4; ++k) { const v2u w = y8[rr][k][g];
                        const f32x2 a0 = __builtin_amdgcn_cvt_pk_f32_fp8(w.x, false), a1 = __builtin_amdgcn_cvt_pk_f32_fp8(w.x, true), a2 = __builtin_amdgcn_cvt_pk_f32_fp8(w.y, false), a3 = __builtin_amdgcn_cvt_pk_f32_fp8(w.y, true);
                        acc0 += tg[rr][k] * (f32x4){a0.x, a0.y, a1.x, a1.y}; acc1 += tg[rr][k] * (f32x4){a2.x, a2.y, a3.x, a3.y}; }
                    const int c0 = 8 * lane + 512 * g;
                    v[rr][g][0] += *(const f32x4*)(g2 + c0) * acc0; v[rr][g][1] += *(const f32x4*)(g2 + c0 + 4) * acc1; }
            }
            if (MODE == 2) {
                float* o = a.out + ((size_t)bb[rr] * SEQ + (sv[rr] - CTX)) * D;
#pragma unroll
                for (int g = 0; g < 2; ++g) { const int c0 = 8 * lane + 512 * g; *(f32x4*)(o + c0) = v[rr][g][0]; *(f32x4*)(o + c0 + 4) = v[rr][g][1]; }
                continue;
            }
            float ss = 0.f;
#pragma unroll
            for (int g = 0; g < 2; ++g) { const f32x4 p = v[rr][g][0], q = v[rr][g][1];
                v4u xo; xo.x = cvtpk(p.x, p.y); xo.y = cvtpk(p.z, p.w); xo.z = cvtpk(q.x, q.y); xo.w = cvtpk(q.z, q.w); *(v4u*)(X + (size_t)row * D + 8 * lane + 512 * g) = xo;
                ss += ((p.x * p.x + p.y * p.y) + (p.z * p.z + p.w * p.w)) + ((q.x * q.x + q.y * q.y) + (q.z * q.z + q.w * q.w)); }
            const float rstd = rsqrtf(wave_sum(ss, lane) * (1.0f / D) + EPS);
            const float* md = MOD + ((size_t)l * 17 + r) * 6144;
#pragma unroll
            for (int g = 0; g < 2; ++g) { const int c = 8 * lane + 512 * g;
                const f32x4 g0 = *(const f32x4*)(gn + c), g1 = *(const f32x4*)(gn + c + 4), sh0 = *(const f32x4*)(md + c), sh1 = *(const f32x4*)(md + c + 4), sc0 = *(const f32x4*)(md + 1024 + c), sc1 = *(const f32x4*)(md + 1024 + c + 4);
                const f32x4 h0 = (v[rr][g][0] * rstd * g0) * (sc0 + 1.0f) + sh0, h1 = (v[rr][g][1] * rstd * g1) * (sc1 + 1.0f) + sh1;
                v4u o; o.x = cvtpk(h0.x, h0.y); o.y = cvtpk(h0.z, h0.w); o.z = cvtpk(h1.x, h1.y); o.w = cvtpk(h1.z, h1.w); *(v4u*)(H + (size_t)row * D + c) = o;
                unsigned w0 = 0u, w1 = 0u; w0 = __builtin_amdgcn_cvt_pk_fp8_f32(h0.x, h0.y, w0, false); w0 = __builtin_amdgcn_cvt_pk_fp8_f32(h0.z, h0.w, w0, true);
                w1 = __builtin_amdgcn_cvt_pk_fp8_f32(h1.x, h1.y, w1, false); w1 = __builtin_amdgcn_cvt_pk_fp8_f32(h1.z, h1.w, w1, true);
                *(v2u*)((unsigned char*)(ws + WS_H8) + (size_t)row * D + c) = (v2u){w0, w1}; }
        }
    }
}

__device__ __forceinline__ void build_gc(CArgs ap, int l, int gt, int NGT) {
    CA& a = *ap; const float* MOD = (const float*)(a.ws + WS_MOD); float* GC = (float*)(a.ws + WS_GC) + (size_t)l * 17 * 1024;
    for (int i = gt; i < 17 * 1024; i += NGT) { const int r = i >> 10, k = i & 1023; GC[i] = a.in[I_N2G][l * D + k] * (1.0f + MOD[((size_t)l * 17 + r) * 6144 + 4096 + k]); }
}

__device__ __forceinline__ void phase_prep(CArgs ap, int l, int lane, int gw, int NGW) {
    CA& a = *ap;
    unsigned char* ws = a.ws;
    const bf16* P = (const bf16*)(ws + WS_PROJ); bf16* YB = (bf16*)(ws + WS_YB); bf16* QN = (bf16*)(ws + WS_QN); bf16* KN = (bf16*)(ws + WS_KN);
    const float* ROPE = (const float*)(ws + WS_ROPE);
    const float* cw = a.in[I_CONVW] + l * 3 * 256;
    const int c4 = 4 * lane, d0 = (lane & 7) * 8;
    const f32x4 w0 = *(const f32x4*)(cw + c4), w1 = *(const f32x4*)(cw + 256 + c4), w2 = *(const f32x4*)(cw + 512 + c4);
    const f32x4 gq0 = *(const f32x4*)(a.in[I_QG] + l * 64 + d0), gq1 = *(const f32x4*)(a.in[I_QG] + l * 64 + d0 + 4), gk0 = *(const f32x4*)(a.in[I_KG] + l * 64 + d0), gk1 = *(const f32x4*)(a.in[I_KG] + l * 64 + d0 + 4);
    const bool first = (lane & 4) == 0;
    constexpr int RPT = 4;
    for (int row0 = gw; row0 < T; row0 += RPT * NGW) {
        v2u cc[RPT][3], cx[RPT][3], cb[RPT]; v4u qw[RPT], kw[RPT]; f32x4 rp[RPT][4]; bool isc[RPT], on[RPT]; int rowv[RPT];
#pragma unroll
        for (int rr = 0; rr < RPT; ++rr) { const int rowt = row0 + rr * NGW; on[rr] = rowt < T; const int row = on[rr] ? rowt : row0; rowv[rr] = row;
            const int b = row / TB, s = row - b * TB; const bool isctx = s < CTX; isc[rr] = isctx;
            const int lo = isctx ? 0 : CTX, hi = isctx ? CTX : TB;
#pragma unroll
            for (int d = 0; d < 3; ++d) { const int s2 = s + d - 1; const bool ok = s2 >= lo && s2 < hi; const bf16* pr = P + (size_t)(ok ? row + d - 1 : row) * DIN;
                cc[rr][d] = *(const v2u*)(pr + OFF_CC + c4); cx[rr][d] = *(const v2u*)(pr + OFF_CX + c4); if (!ok) { cc[rr][d] = (v2u){0u, 0u}; } }
            cb[rr] = *(const v2u*)(P + (size_t)row * DIN + OFF_CB + c4);
            qw[rr] = *(const v4u*)(P + (size_t)row * DIN + OFF_Q + lane * 8); kw[rr] = *(const v4u*)(P + (size_t)row * DIN + OFF_K + (lane & 15) * 8);
            const float* rpp = ROPE + ((size_t)(isctx ? 0 : s - CTX) * 32 + (d0 & 31)) * 2;
#pragma unroll
            for (int i = 0; i < 4; ++i) rp[rr][i] = *(const f32x4*)(rpp + 4 * i); }
#pragma unroll
        for (int rr = 0; rr < RPT; ++rr) {
            if (!on[rr]) continue;
            const int row = rowv[rr];
            { f32x4 zz[3];
#pragma unroll
              for (int d = 0; d < 3; ++d) zz[d] = (f32x4){bflo(cc[rr][d].x) * bflo(cx[rr][d].x), bfhi(cc[rr][d].x) * bfhi(cx[rr][d].x), bflo(cc[rr][d].y) * bflo(cx[rr][d].y), bfhi(cc[rr][d].y) * bfhi(cx[rr][d].y)};
              const f32x4 yv = (f32x4){bflo(cb[rr].x), bfhi(cb[rr].x), bflo(cb[rr].y), bfhi(cb[rr].y)} * (w0 * zz[0] + w1 * zz[1] + w2 * zz[2]);
              v2u o; o.x = cvtpk(yv.x, yv.y); o.y = cvtpk(yv.z, yv.w); *(v2u*)(YB + (size_t)row * 256 + c4) = o; }
#pragma unroll
            for (int pass = 0; pass < 2; ++pass) {
                const v4u w = pass ? kw[rr] : qw[rr];
                float x[8] = {bflo(w.x), bfhi(w.x), bflo(w.y), bfhi(w.y), bflo(w.z), bfhi(w.z), bflo(w.w), bfhi(w.w)};
                float ss = 0.f;
#pragma unroll
                for (int i = 0; i < 8; ++i) ss += x[i] * x[i];
                ss = sum8(ss);
                const float rstd = rsqrtf(ss * (1.0f / 64.0f) + EPS) * (pass ? 1.0f : 0.125f * 1.4426950408889634f);
                const f32x4 ga = pass ? gk0 : gq0, gb = pass ? gk1 : gq1;
#pragma unroll
                for (int i = 0; i < 8; ++i) x[i] = x[i] * rstd * (i < 4 ? ga[i] : gb[i - 4]);
                if (!isc[rr]) {
#pragma unroll
                    for (int i = 0; i < 8; ++i) { const float pr = xor4(x[i], lane); const float cs = rp[rr][i >> 1][2 * (i & 1)], sn = rp[rr][i >> 1][2 * (i & 1) + 1];
                        x[i] = first ? (x[i] * cs - pr * sn) : (pr * sn + x[i] * cs); }
                }
                v4u o; o.x = cvtpk(x[0], x[1]); o.y = cvtpk(x[2], x[3]); o.z = cvtpk(x[4], x[5]); o.w = cvtpk(x[6], x[7]);
                if (pass == 0) *(v4u*)(QN + (size_t)row * 512 + lane * 8) = o;
                else if (lane < 16) *(v4u*)(KN + (size_t)row * 128 + lane * 8) = o;
            }
        }
    }
}

typedef short bf16x8v __attribute__((ext_vector_type(8)));
__device__ __forceinline__ f32x4 mfma16(const v4u& a, const v4u& b, const f32x4& c) { return __builtin_amdgcn_mfma_f32_16x16x32_bf16(__builtin_bit_cast(bf16x8v, a), __builtin_bit_cast(bf16x8v, b), c, 0, 0, 0); }

__device__ __forceinline__ void s5_build_mats(CArgs ap, LAS unsigned char* lds, int tid, int l, int g) {
    CA& a = *ap;
    LAS float* LP = (LAS float*)lds;
    LAS float* BB = LP + 2 * 9 * 64 * 2;
    LAS float* CC = BB + 2 * 64 * 16 * 2;
    for (int i = tid; i < 2 * 9 * 64; i += NTHREADS) { const int z = i / 576, d = (i / 64) % 9, p = i & 63; const int pi = (l * 2 + z) * 16 + g;
        const float lre = a.in[I_LRE][pi * 64 + p], lim = a.in[I_LIM][pi * 64 + p], dt = expf(a.in[I_LDT][pi]);
        float sn, cs; sincosf((float)d * lim * dt, &sn, &cs); const float er = expf((float)d * lre * dt);
        LP[2 * i] = er * cs; LP[2 * i + 1] = er * sn; }
    for (int i = tid; i < 2 * 64 * 16; i += NTHREADS) { const int z = i >> 10, p = (i >> 4) & 63, h = i & 15; const int pi = (l * 2 + z) * 16 + g;
        const float lre = a.in[I_LRE][pi * 64 + p], lim = a.in[I_LIM][pi * 64 + p], dt = expf(a.in[I_LDT][pi]);
        float sn, cs; sincosf(lim * dt, &sn, &cs); const float er = expf(lre * dt); const float nr = er * cs - 1.0f, ni = er * sn, d2 = lre * lre + lim * lim;
        const float qr = (nr * lre + ni * lim) / d2, qi = (ni * lre - nr * lim) / d2;
        const float br = a.in[I_BRE][((size_t)pi * 64 + p) * 16 + h], bi = a.in[I_BIM][((size_t)pi * 64 + p) * 16 + h];
        BB[2 * i] = qr * br - qi * bi; BB[2 * i + 1] = qr * bi + qi * br;
        const int hc = (i >> 6) & 15, pc = i & 63;
        CC[2 * i] = a.in[I_CRE][((size_t)pi * 16 + hc) * 64 + pc]; CC[2 * i + 1] = a.in[I_CIM][((size_t)pi * 16 + hc) * 64 + pc]; }
    __syncthreads();
    LAS float* KT = CC + 2 * 16 * 64 * 2;
    { const int e0 = tid * 8; const int z = e0 >> 11, d = (e0 >> 8) & 7, h = (e0 >> 4) & 15, h20 = e0 & 15; float kv[8];
#pragma unroll
      for (int j = 0; j < 8; ++j) kv[j] = 0.f;
      for (int p = 0; p < 64; ++p) { const float cr = CC[2 * ((z * 16 + h) * 64 + p)], ci = CC[2 * ((z * 16 + h) * 64 + p) + 1], lr = LP[2 * ((z * 9 + d) * 64 + p)], li = LP[2 * ((z * 9 + d) * 64 + p) + 1];
          const float tr = cr * lr - ci * li, ti = cr * li + ci * lr;
#pragma unroll
          for (int j = 0; j < 8; ++j) kv[j] += tr * BB[2 * ((z * 64 + p) * 16 + h20 + j)] - ti * BB[2 * ((z * 64 + p) * 16 + h20 + j) + 1]; }
#pragma unroll
      for (int j = 0; j < 8; ++j) KT[e0 + j] = kv[j]; }
    __syncthreads();
    bf16* MS = (bf16*)(a.ws + WS_MS) + (size_t)(l * 16 + g) * 256 * 128; bf16* W = (bf16*)(a.ws + WS_W5) + (size_t)(l * 16 + g) * 128 * 384;
    for (int i = tid; i < 256 * 128; i += NTHREADS) { const int j = i & 7, ln = (i >> 3) & 63, nt = (i >> 9) & 15, ks = i >> 13; const int n = nt * 16 + (ln & 15), k = ks * 32 + (ln >> 4) * 8 + j;
        const int z = n >> 7, part = n & 1, p = (n >> 1) & 63, a2 = k >> 4, h2 = k & 15; const int e = z == 0 ? 7 - a2 : a2;
        const float lr = LP[2 * ((z * 9 + e) * 64 + p)], li = LP[2 * ((z * 9 + e) * 64 + p) + 1], br = BB[2 * ((z * 64 + p) * 16 + h2)], bi = BB[2 * ((z * 64 + p) * 16 + h2) + 1];
        MS[i] = (bf16)f2bf(part == 0 ? lr * br - li * bi : lr * bi + li * br); }
    for (int i = tid; i < 128 * 384; i += NTHREADS) { const int j = i & 7, ln = (i >> 3) & 63, nt = (i >> 9) & 7, ks = i >> 12; const int n = nt * 16 + (ln & 15), k = ks * 32 + (ln >> 4) * 8 + j;
        const int aa = n >> 4, h = n & 15; float v = 0.f;
        if (k < 128) { const int a2 = k >> 4, h2 = k & 15;
            if (a2 <= aa) v += KT[((0 * 8 + (aa - a2)) * 16 + h) * 16 + h2];
            if (a2 >= aa) v += KT[((1 * 8 + (a2 - aa)) * 16 + h) * 16 + h2];
            if (a2 == aa && h2 == h) v += a.in[I_SD][l * 256 + g * 16 + h];
        } else { const int z = (k - 128) >> 7, kk = (k - 128) & 127, part = kk & 1, p = kk >> 1; const int d = z == 0 ? aa + 1 : 8 - aa;
            const float cr = CC[2 * ((z * 16 + h) * 64 + p)], ci = CC[2 * ((z * 16 + h) * 64 + p) + 1], lr = LP[2 * ((z * 9 + d) * 64 + p)], li = LP[2 * ((z * 9 + d) * 64 + p) + 1];
            v = part == 0 ? (cr * lr - ci * li) : -(cr * li + ci * lr); }
        W[i] = (bf16)f2bf(v); }
    __syncthreads();
}

constexpr int S5_ROWS = T / 8, S5_RT = S5_ROWS / 32;
__device__ __forceinline__ void s5a_block(CArgs ap, int l, int blk, LAS unsigned char* lds, int tid, int lane, int wave) {
    CA& a = *ap; unsigned char* ws = a.ws;
    const int g = blk & 15, part = blk >> 4, c = lane & 15, q = lane >> 4;
    { const v4u* src = (const v4u*)((const bf16*)(ws + WS_MS) + (size_t)(l * 16 + g) * 256 * 128); LAS v4u* dst = (LAS v4u*)lds;
#pragma unroll
      for (int i = 0; i < 8; ++i) dst[tid + i * NTHREADS] = src[tid + i * NTHREADS]; }
    __syncthreads();
    const LAS v4u* Bl = (const LAS v4u*)lds + lane;
    for (int mt = wave; mt < 18; mt += NWAVES) {
        const int r0 = part * 288 + mt * 16;
        const bf16* Pu = (const bf16*)(ws + WS_PROJ) + ((size_t)(r0 + c) * 8 + (q >> 1)) * DIN + OFF_U + g * 16 + (q & 1) * 8;
        v4u af[4];
#pragma unroll
        for (int ks = 0; ks < 4; ++ks) af[ks] = *(const v4u*)(Pu + (size_t)2 * ks * DIN);
        f32x4 acc[16];
#pragma unroll
        for (int n = 0; n < 16; ++n) acc[n] = (f32x4){0.f, 0.f, 0.f, 0.f};
#pragma unroll
        for (int ks = 0; ks < 4; ++ks) { v4u bfr[16];
#pragma unroll
            for (int n = 0; n < 16; ++n) bfr[n] = Bl[(ks * 16 + n) * 64];
#pragma unroll
            for (int n = 0; n < 16; ++n) acc[n] = mfma16(bfr[n], af[ks], acc[n]);
            asm volatile("" ::: "memory"); }
        bf16* Sp = (bf16*)(ws + WS_S5S) + ((size_t)g * S5_ROWS + r0 + c) * 256 + 4 * q;
#pragma unroll
        for (int n = 0; n < 16; ++n) { v2u o; o.x = cvtpk(acc[n][0], acc[n][1]); o.y = cvtpk(acc[n][2], acc[n][3]); *(v2u*)(Sp + n * 16) = o; }
    }
    VM_WAIT(); __syncthreads();
}
__device__ __forceinline__ void s5b_unit(CArgs ap, int l, int u, int lane) {
    CA& a = *ap; unsigned char* ws = a.ws;
    const int b = u & 15, z = (u >> 4) & 1, g = u >> 5, p = lane; const int pi = (l * 2 + z) * 16 + g;
    const float lre = a.in[I_LRE][pi * 64 + p], lim = a.in[I_LIM][pi * 64 + p], dt = expf(a.in[I_LDT][pi]);
    float sn, cs; sincosf(8.0f * lim * dt, &sn, &cs); const float er = expf(8.0f * lre * dt); const float l8r = er * cs, l8i = er * sn;
    unsigned* S = (unsigned*)((bf16*)(ws + WS_S5S) + ((size_t)g * S5_ROWS + b * 288) * 256 + z * 128) + p;
    unsigned* XI = (unsigned*)((bf16*)(ws + WS_XIN) + ((size_t)(z * 16 + g) * S5_ROWS + b * 288) * 128) + p;
    float xr = 0.f, xi = 0.f;
    constexpr int BS = 32;
    unsigned sv[BS];
#pragma unroll
    for (int j = 0; j < BS; ++j) { const int cc = z == 0 ? j : 31 - j; sv[j] = __hip_atomic_load(S + (size_t)cc * 128, __ATOMIC_RELAXED, __HIP_MEMORY_SCOPE_AGENT); }
    for (int i0 = 0; i0 < 288; i0 += BS) {
        unsigned nv[BS];
        if (i0 + BS < 288) {
#pragma unroll
            for (int j = 0; j < BS; ++j) { const int i = i0 + BS + j; const int cc = z == 0 ? i : (i < 32 ? 31 - i : 319 - i); nv[j] = __hip_atomic_load(S + (size_t)cc * 128, __ATOMIC_RELAXED, __HIP_MEMORY_SCOPE_AGENT); }
        }
        unsigned ov[BS];
#pragma unroll
        for (int j = 0; j < BS; ++j) { ov[j] = cvtpk(xr, xi);
            const float nr = l8r * xr - l8i * xi + bflo(sv[j]), ni = l8r * xi + l8i * xr + bfhi(sv[j]); xr = nr; xi = ni; }
#pragma unroll
        for (int j = 0; j < BS; ++j) { const int i = i0 + j; const int cc = z == 0 ? i : (i < 32 ? 31 - i : 319 - i); XI[(size_t)cc * 64] = ov[j]; }
#pragma unroll
        for (int j = 0; j < BS; ++j) sv[j] = nv[j];
    }
}
__device__ __forceinline__ void s5c_block(CArgs ap, int l, int blk, LAS unsigned char* lds, int tid, int lane, int wave) {
    CA& a = *ap; unsigned char* ws = a.ws;
    const int g = blk & 15, part = blk >> 4, c = lane & 15, q = lane >> 4;
    { const v4u* src = (const v4u*)((const bf16*)(ws + WS_W5) + (size_t)(l * 16 + g) * 128 * 384); LAS v4u* dst = (LAS v4u*)lds;
#pragma unroll
      for (int i = 0; i < 12; ++i) dst[tid + i * NTHREADS] = src[tid + i * NTHREADS]; }
    __syncthreads();
    const LAS v4u* Bl = (const LAS v4u*)lds + lane;
    for (int mt = wave; mt < 18; mt += NWAVES) {
        const int r0 = part * 288 + mt * 16;
        const bf16* Pu = (const bf16*)(ws + WS_PROJ) + ((size_t)(r0 + c) * 8 + (q >> 1)) * DIN + OFF_U + g * 16 + (q & 1) * 8;
        const bf16* X0 = (const bf16*)(ws + WS_XIN) + ((size_t)g * S5_ROWS + r0 + c) * 128 + q * 8; const bf16* X1 = X0 + (size_t)16 * S5_ROWS * 128;
        v4u af[12];
#pragma unroll
        for (int ks = 0; ks < 4; ++ks) { af[ks] = *(const v4u*)(Pu + (size_t)2 * ks * DIN); af[4 + ks] = *(const v4u*)(X0 + ks * 32); af[8 + ks] = *(const v4u*)(X1 + ks * 32); }
        f32x4 acc[8];
#pragma unroll
        for (int n = 0; n < 8; ++n) acc[n] = (f32x4){0.f, 0.f, 0.f, 0.f};
#pragma unroll
        for (int ks = 0; ks < 12; ++ks) { v4u bfr[8];
#pragma unroll
            for (int n = 0; n < 8; ++n) bfr[n] = Bl[(ks * 8 + n) * 64];
#pragma unroll
            for (int n = 0; n < 8; ++n) acc[n] = mfma16(bfr[n], af[ks], acc[n]);
            if (ks & 1) asm volatile("" ::: "memory"); }
        bf16* Zp = (bf16*)(ws + WS_Z) + (size_t)(r0 + c) * 8 * 256 + g * 16 + 4 * q;
#pragma unroll
        for (int n = 0; n < 8; ++n) { const f32x4 y = acc[n]; v2u o; o.x = cvtpk(gelu_tanh(y[0]), gelu_tanh(y[1])); o.y = cvtpk(gelu_tanh(y[2]), gelu_tanh(y[3])); *(v2u*)(Zp + n * 256) = o; }
    }
    __syncthreads();
}

typedef float f32x16 __attribute__((ext_vector_type(16)));
__device__ __forceinline__ f32x16 mfma32(const v4u& a, const v4u& b, const f32x16& c) { return __builtin_amdgcn_mfma_f32_32x32x16_bf16(__builtin_bit_cast(bf16x8v, a), __builtin_bit_cast(bf16x8v, b), c, 0, 0, 0); }
#ifdef ATT_PROBE_LD
struct AttnFrag { v4u ka[4]; v4u va[2][2]; v4u dk[2]; };
#else
struct AttnFrag { v4u ka[4]; v4u va[2][2]; };
#endif
__device__ __forceinline__ void attn_load(AttnFrag& f, const bf16* KN, const bf16* VT, int s0, int r) {
#pragma unroll
    for (int ks = 0; ks < 4; ++ks) f.ka[ks] = *(const v4u*)(KN + (size_t)(s0 + r) * 128 + 16 * ks);
#ifdef ATT_PROBE_LD
#pragma unroll
    for (int ks = 0; ks < 2; ++ks) f.dk[ks] = *(const v4u*)((unsigned long long)(KN + (size_t)(s0 + r) * 128 + 32 * ks) ^ (unsigned long long)ATT_PROBE_LD);
#endif
#pragma unroll
    for (int mt = 0; mt < 2; ++mt)
#pragma unroll
        for (int s = 0; s < 2; ++s) f.va[mt][s] = *(const v4u*)(VT + (size_t)mt * 32 * TB + s0 + 16 * s);
}
__device__ __forceinline__ float vsub1(float a, float b) { float r; asm("v_sub_f32 %0, %1, %2" : "=v"(r) : "v"(a), "v"(b)); return r; }
__device__ __forceinline__ float vadd1(float a, float b) { float r; asm("v_add_f32 %0, %1, %2" : "=v"(r) : "v"(a), "v"(b)); return r; }
__device__ __forceinline__ float vmul1(float a, float b) { float r; asm("v_mul_f32 %0, %1, %2" : "=v"(r) : "v"(a), "v"(b)); return r; }
template <int NH>
__device__ __forceinline__ void attn_tile(const AttnFrag& f, const v4u (&bq)[NH][4], f32x16 (&o)[NH][2], float (&m)[NH], float (&lsum)[NH], int mode, unsigned keep1, unsigned keep2, int lane) {
#pragma unroll
    for (int hh = 0; hh < NH; ++hh) {
        f32x16 st;
#pragma unroll
        for (int i = 0; i < 16; ++i) st[i] = 0.f;
#pragma unroll
        for (int ks = 0; ks < 4; ++ks) st = mfma32(f.ka[ks], bq[hh][ks], st);
        if (mode != 0) {
            unsigned kp = mode == 1 ? keep1 : keep2;
            asm volatile("" : "+v"(kp) :: "memory");
#pragma unroll
            for (int i = 0; i < 16; ++i) if (!((kp >> i) & 1u)) st[i] = -INFINITY;
        }
        float mx = st[0];
#pragma unroll
        for (int i = 1; i < 16; ++i) mx = fmaxf(mx, st[i]);
        mx = fmaxf(mx, shx(mx, 32, lane));
        const float mn = fmaxf(m[hh], mx), al = __builtin_amdgcn_exp2f(m[hh] - mn); m[hh] = mn;
        float ps0 = 0.f, ps1 = 0.f;
#pragma unroll
        for (int i = 0; i < 8; ++i) { const float e0 = __builtin_amdgcn_exp2f(vsub1(st[2 * i], mn)), e1 = __builtin_amdgcn_exp2f(vsub1(st[2 * i + 1], mn)); st[2 * i] = e0; st[2 * i + 1] = e1; ps0 = vadd1(ps0, e0); ps1 = vadd1(ps1, e1); }
#ifdef ATT_PROBE_EXP
#pragma unroll
        for (int i = 0; i < 16; ++i) { float d = __builtin_amdgcn_exp2f(st[i] - 1.0f); asm volatile("" :: "v"(d)); }
#endif
#ifdef ATT_PROBE_MFMA
        { f32x16 d; for (int i = 0; i < 16; ++i) d[i] = 0.f;
#pragma unroll
          for (int ks = 0; ks < 4; ++ks) d = mfma32(f.ka[ks], bq[hh][ks], d);
          asm volatile("" :: "v"(d)); }
#endif
        lsum[hh] = lsum[hh] * al + vadd1(ps0, ps1);
#pragma unroll
        for (int i = 0; i < 16; ++i) { o[hh][0][i] = vmul1(o[hh][0][i], al); o[hh][1][i] = vmul1(o[hh][1][i], al); }
#pragma unroll
        for (int s = 0; s < 2; ++s) { v4u pb; pb.x = cvtpk(st[8 * s + 0], st[8 * s + 1]); pb.y = cvtpk(st[8 * s + 2], st[8 * s + 3]); pb.z = cvtpk(st[8 * s + 4], st[8 * s + 5]); pb.w = cvtpk(st[8 * s + 6], st[8 * s + 7]);
            o[hh][0] = mfma32(f.va[0][s], pb, o[hh][0]); o[hh][1] = mfma32(f.va[1][s], pb, o[hh][1]); }
    }
#ifdef ATT_PROBE_LD
    asm volatile("" :: "v"(f.dk[0]), "v"(f.dk[1]));
#endif
}
template <int NH>
__device__ __forceinline__ void attn_item(CArgs ap, int l, bool lat, int idx, int lane) {
    CA& a = *ap; unsigned char* ws = a.ws;
    int b, hd0, qg;
    if (NH == 2) { b = idx >> 8; qg = (idx >> 2) & 63; hd0 = 2 * (idx & 3); } else { b = idx >> 6; qg = (idx >> 3) & 7; hd0 = idx & 7; }
    const int g2 = hd0 >> 2, r = lane & 31, h = lane >> 5, q0 = qg * 32;
    const int qrow = b * TB + (lat ? CTX : 0) + q0 + r;
    const bf16* KN = (const bf16*)(ws + WS_KN) + (size_t)b * TB * 128 + g2 * 64 + 8 * h;
    const bf16* VT = (const bf16*)(ws + WS_VT) + ((size_t)(b * 2 + g2) * 64 + r) * TB + 8 * h;
    v4u bq[NH][4];
#pragma unroll
    for (int hh = 0; hh < NH; ++hh)
#pragma unroll
        for (int ks = 0; ks < 4; ++ks) bq[hh][ks] = *(const v4u*)((const bf16*)(ws + WS_QN) + (size_t)qrow * 512 + (hd0 + hh) * 64 + 16 * ks + 8 * h);
    f32x16 o[NH][2];
#pragma unroll
    for (int hh = 0; hh < NH; ++hh)
#pragma unroll
        for (int i = 0; i < 16; ++i) { o[hh][0][i] = 0.f; o[hh][1][i] = 0.f; }
    constexpr float L2E = 1.4426950408889634f;
    float m[NH], lsum[NH];
#pragma unroll
    for (int hh = 0; hh < NH; ++hh) { m[hh] = a.in[I_SINK][l * 8 + hd0 + hh] * L2E; lsum[hh] = h == 0 ? 1.0f : 0.0f; }
    unsigned keep1 = 0u, keep2 = 0u;
#pragma unroll
    for (int i = 0; i < 16; ++i) { const int jj = (i & 3) + 8 * (i >> 2) + 4 * h; keep1 |= (jj >= r ? 1u : 0u) << i; keep2 |= (jj <= r ? 1u : 0u) << i; }
    const int tlo = lat ? (4 - qg > 0 ? 4 - qg : 0) : 9, thi = lat ? (67 - qg < 8 ? 67 - qg : 8) : -1;
    const int nl = lat ? thi - tlo + 1 : 0, n = nl + 8;
    AttnFrag fa, fb;
#define ATT_TT(i_) ((i_) < nl ? tlo + (i_) : 9 + (i_) - nl)
#define ATT_S0(t_) ((t_) < 9 ? CTX + q0 - 128 + 32 * (t_) : 32 * ((t_) - 9))
#define ATT_MODE(t_) ((t_) == 0 ? 1 : ((t_) == 8 ? 2 : 0))
    { const int t0 = ATT_TT(0); attn_load(fa, KN, VT, ATT_S0(t0), r); }
    int i = 0;
    for (; i + 1 < n; i += 2) {
        const int ta = ATT_TT(i), tb = ATT_TT(i + 1); const int i2 = i + 2 < n ? i + 2 : n - 1; const int tc = ATT_TT(i2);
        attn_load(fb, KN, VT, ATT_S0(tb), r);
        attn_tile<NH>(fa, bq, o, m, lsum, ATT_MODE(ta), keep1, keep2, lane);
        attn_load(fa, KN, VT, ATT_S0(tc), r);
        attn_tile<NH>(fb, bq, o, m, lsum, ATT_MODE(tb), keep1, keep2, lane);
    }
    if (i < n) { const int ta = ATT_TT(i); attn_tile<NH>(fa, bq, o, m, lsum, ATT_MODE(ta), keep1, keep2, lane); }
#undef ATT_TT
#undef ATT_S0
#undef ATT_MODE
#pragma unroll
    for (int hh = 0; hh < NH; ++hh) {
        const float lt = lsum[hh] + shx(lsum[hh], 32, lane); const float inv = 1.0f / lt;
        bf16* op = (bf16*)(ws + WS_YA) + (size_t)qrow * 512 + (hd0 + hh) * 64 + 4 * h;
#pragma unroll
        for (int gq = 0; gq < 4; ++gq) { v2u w0; w0.x = cvtpk(o[hh][0][4 * gq] * inv, o[hh][0][4 * gq + 1] * inv); w0.y = cvtpk(o[hh][0][4 * gq + 2] * inv, o[hh][0][4 * gq + 3] * inv); *(v2u*)(op + 8 * gq) = w0;
            v2u w1; w1.x = cvtpk(o[hh][1][4 * gq] * inv, o[hh][1][4 * gq + 1] * inv); w1.y = cvtpk(o[hh][1][4 * gq + 2] * inv, o[hh][1][4 * gq + 3] * inv); *(v2u*)(op + 32 + 8 * gq) = w1; }
    }
}
__device__ __forceinline__ void vt_item(CArgs ap, int item, int lane) {
    CA& a = *ap; unsigned char* ws = a.ws;
    const int tile = item >> 1, g2 = item & 1; const int row = tile * 64 + lane; const int b = row / TB, s = row - b * TB;
    const bf16* vp = (const bf16*)(ws + WS_PROJ) + (size_t)row * DIN + OFF_V + g2 * 64;
    const int k16 = s & 15, sp = (s & ~15) | ((((k16 >> 2) & 1) << 3) | (((k16 >> 3) & 1) << 2) | (k16 & 3));
    bf16* vt = (bf16*)(ws + WS_VT) + (size_t)(b * 2 + g2) * 64 * TB + sp;
#pragma unroll
    for (int i = 0; i < 8; ++i) { const v4u w = *(const v4u*)(vp + 8 * i);
        vt[(size_t)(8 * i + 0) * TB] = (bf16)(w.x & 0xffffu); vt[(size_t)(8 * i + 1) * TB] = (bf16)(w.x >> 16); vt[(size_t)(8 * i + 2) * TB] = (bf16)(w.y & 0xffffu); vt[(size_t)(8 * i + 3) * TB] = (bf16)(w.y >> 16);
        vt[(size_t)(8 * i + 4) * TB] = (bf16)(w.z & 0xffffu); vt[(size_t)(8 * i + 5) * TB] = (bf16)(w.z >> 16); vt[(size_t)(8 * i + 6) * TB] = (bf16)(w.w & 0xffffu); vt[(size_t)(8 * i + 7) * TB] = (bf16)(w.w >> 16); }
}

template <int NT>
__device__ __forceinline__ void n2_tiles(CA& a, int l, const int (&row0v)[NT], int r, LAS unsigned char* lds, int lane, int wave) {
    unsigned char* ws = a.ws;
    const bf16* X = (const bf16*)(ws + WS_X); const float* MOD = (const float*)(ws + WS_MOD);
    float* TOPG = (float*)(ws + WS_TOPG); int* SLOT = (int*)(ws + WS_SLOT);
    LAS unsigned* lcnt = (LAS unsigned*)(lds + LCNT_OFF);
    const LAS v4u* Bl = (const LAS v4u*)lds + lane;
    LAS float* scr = (LAS float*)(lds + SCR_OFF) + wave * (16 * 33);
    const int c = lane & 15, q = lane >> 4;
    const bf16* xr[NT]; float rstd[NT];
#pragma unroll
    for (int t = 0; t < NT; ++t) xr[t] = X + (size_t)(row0v[t] + c) * D + 8 * q;
    { float ss[NT];
#pragma unroll
      for (int t = 0; t < NT; ++t) ss[t] = 0.f;
#pragma unroll 16
      for (int ks = 0; ks < 32; ++ks)
#pragma unroll
        for (int t = 0; t < NT; ++t) { const v4u xw = *(const v4u*)(xr[t] + 32 * ks); const f32x4 x0 = (f32x4){bflo(xw.x), bfhi(xw.x), bflo(xw.y), bfhi(xw.y)}, x1 = (f32x4){bflo(xw.z), bfhi(xw.z), bflo(xw.w), bfhi(xw.w)};
            ss[t] += (x0.x * x0.x + x0.y * x0.y) + (x0.z * x0.z + x0.w * x0.w) + (x1.x * x1.x + x1.y * x1.y) + (x1.z * x1.z + x1.w * x1.w); }
#pragma unroll
      for (int t = 0; t < NT; ++t) { float s2 = ss[t]; s2 += shx(s2, 16, lane); s2 += shx(s2, 32, lane); rstd[t] = rsqrtf(s2 * (1.0f / D) + EPS); } }
    const float* md = MOD + ((size_t)l * 17 + r) * 6144 + 3072 + 8 * q; const float* gc = (const float*)(ws + WS_GC) + ((size_t)l * 17 + r) * 1024 + 8 * q;
    f32x4 acc[NT][2];
#pragma unroll
    for (int t = 0; t < NT; ++t) { acc[t][0] = (f32x4){0.f, 0.f, 0.f, 0.f}; acc[t][1] = (f32x4){0.f, 0.f, 0.f, 0.f}; }
#pragma unroll 1
    for (int k4 = 0; k4 < 32; k4 += 4) {
        v4u xw[NT][4]; f32x4 gv[4][2], hv[4][2];
#pragma unroll
        for (int u = 0; u < 4; ++u) { const int ks = k4 + u;
#pragma unroll
            for (int t = 0; t < NT; ++t) xw[t][u] = *(const v4u*)(xr[t] + 32 * ks);
            gv[u][0] = *(const f32x4*)(gc + 32 * ks); gv[u][1] = *(const f32x4*)(gc + 32 * ks + 4); hv[u][0] = *(const f32x4*)(md + 32 * ks); hv[u][1] = *(const f32x4*)(md + 32 * ks + 4); }
#pragma unroll
        for (int u = 0; u < 4; ++u) { const int ks = k4 + u;
            v4u whi[2], wlo[2];
#pragma unroll
            for (int nt = 0; nt < 2; ++nt) { whi[nt] = Bl[((ks * 2 + nt) * 2 + 0) * 64]; wlo[nt] = Bl[((ks * 2 + nt) * 2 + 1) * 64]; }
#pragma unroll
            for (int t = 0; t < NT; ++t) { const v4u w = xw[t][u];
                const f32x4 xa = (f32x4){bflo(w.x), bfhi(w.x), bflo(w.y), bfhi(w.y)}, xb = (f32x4){bflo(w.z), bfhi(w.z), bflo(w.w), bfhi(w.w)};
                const f32x4 y0 = (xa * rstd[t]) * gv[u][0] + hv[u][0], y1 = (xb * rstd[t]) * gv[u][1] + hv[u][1];
                v4u ahi; ahi.x = cvtpk(y0.x, y0.y); ahi.y = cvtpk(y0.z, y0.w); ahi.z = cvtpk(y1.x, y1.y); ahi.w = cvtpk(y1.z, y1.w);
                { unsigned w0 = 0u, w1 = 0u;
                  w0 = __builtin_amdgcn_cvt_pk_fp8_f32(y0.x, y0.y, w0, false); w0 = __builtin_amdgcn_cvt_pk_fp8_f32(y0.z, y0.w, w0, true);
                  w1 = __builtin_amdgcn_cvt_pk_fp8_f32(y1.x, y1.y, w1, false); w1 = __builtin_amdgcn_cvt_pk_fp8_f32(y1.z, y1.w, w1, true);
                  *(v2u*)((unsigned char*)(ws + WS_H8) + (size_t)(row0v[t] + c) * D + 8 * q + 32 * ks) = (v2u){w0, w1}; }
                v4u alo; alo.x = cvtpk(y0.x - bflo(ahi.x), y0.y - bfhi(ahi.x)); alo.y = cvtpk(y0.z - bflo(ahi.y), y0.w - bfhi(ahi.y)); alo.z = cvtpk(y1.x - bflo(ahi.z), y1.y - bfhi(ahi.z)); alo.w = cvtpk(y1.z - bflo(ahi.w), y1.w - bfhi(ahi.w));
#pragma unroll
                for (int nt = 0; nt < 2; ++nt) { acc[t][nt] = mfma16(whi[nt], ahi, acc[t][nt]); acc[t][nt] = mfma16(wlo[nt], ahi, acc[t][nt]); acc[t][nt] = mfma16(whi[nt], alo, acc[t][nt]); } }
        }
    }
#pragma unroll
    for (int t = 0; t < NT; ++t) {
#pragma unroll
        for (int nt = 0; nt < 2; ++nt) { const f32x4 bb = *(const f32x4*)(a.in[I_BR] + l * 32 + nt * 16 + 4 * q);
#pragma unroll
            for (int j = 0; j < 4; ++j) scr[c * 33 + nt * 16 + 4 * q + j] = acc[t][nt][j] + bb[j]; }
        LDS_WAIT(); asm volatile("" ::: "memory");
        if (lane < 16) {
            float v0 = -INFINITY, v1 = -INFINITY, v2 = -INFINITY, v3 = -INFINITY; int e0 = 0, e1 = 0, e2 = 0, e3 = 0;
#pragma unroll
            for (int e = 0; e < 32; ++e) { const float x = scr[lane * 33 + e];
                const bool b0 = x > v0, b1 = x > v1, b2 = x > v2, b3 = x > v3;
                v3 = b2 ? v2 : (b3 ? x : v3); e3 = b2 ? e2 : (b3 ? e : e3);
                v2 = b1 ? v1 : (b2 ? x : v2); e2 = b1 ? e1 : (b2 ? e : e2);
                v1 = b0 ? v0 : (b1 ? x : v1); e1 = b0 ? e0 : (b1 ? e : e1);
                v0 = b0 ? x : v0; e0 = b0 ? e : e0; }
            const float x1 = __expf(v1 - v0), x2 = __expf(v2 - v0), x3 = __expf(v3 - v0); const float inv = 1.0f / (1.0f + x1 + x2 + x3);
            const unsigned r0 = __hip_atomic_fetch_add(lcnt + e0, 1u, __ATOMIC_RELAXED, __HIP_MEMORY_SCOPE_WORKGROUP), r1 = __hip_atomic_fetch_add(lcnt + e1, 1u, __ATOMIC_RELAXED, __HIP_MEMORY_SCOPE_WORKGROUP),
                           r2 = __hip_atomic_fetch_add(lcnt + e2, 1u, __ATOMIC_RELAXED, __HIP_MEMORY_SCOPE_WORKGROUP), r3 = __hip_atomic_fetch_add(lcnt + e3, 1u, __ATOMIC_RELAXED, __HIP_MEMORY_SCOPE_WORKGROUP);
            *(f32x4*)(TOPG + (size_t)(row0v[t] + lane) * 4) = (f32x4){inv, x1 * inv, x2 * inv, x3 * inv};
            *(int4*)(SLOT + (size_t)(row0v[t] + lane) * 4) = make_int4((int)(((unsigned)e0 << 24) | r0), (int)(((unsigned)e1 << 24) | r1), (int)(((unsigned)e2 << 24) | r2), (int)(((unsigned)e3 << 24) | r3)); }
        LDS_WAIT(); asm volatile("" ::: "memory");
    }
}
__device__ __forceinline__ void phase_n2(CArgs ap, int l, LAS unsigned char* lds, int tid, int lane, int wave, int bid, int G) {
    CA& a = *ap;
    unsigned char* ws = a.ws;
    unsigned* CNT = (unsigned*)(ws + WS_CTL) + CW_CNT + l * 32;
    LAS unsigned* lcnt = (LAS unsigned*)(lds + LCNT_OFF);
    { const v4u* src = (const v4u*)((const unsigned*)(ws + WS_WRT) + (size_t)l * 32768); LAS v4u* dst = (LAS v4u*)lds;
#pragma unroll
      for (int i = 0; i < 16; ++i) dst[tid + i * NTHREADS] = src[tid + i * NTHREADS]; }
    if (tid < 32) lcnt[tid] = 0u;
    __syncthreads();
    const bool skipctx = l == DEPTH - 1;
    const int tpb = (T / 16) / G;
    int tl = wave; bool paired = false; int partner = 0, r8 = 0;
    if (tpb == NWAVES + 1) {
        const int ra = (bid * tpb) * 16, rc = (bid * tpb + NWAVES - 1) * 16, rb = (bid * tpb + NWAVES) * 16;
        const int r_a = (ra % TB) < CTX ? 16 : ra / TB, r_c = (rc % TB) < CTX ? 16 : rc / TB; r8 = (rb % TB) < CTX ? 16 : rb / TB;
        partner = (r_a == r8) ? 0 : NWAVES - 1; paired = ((partner == 0 ? r_a : r_c) == r8) && !(skipctx && r8 == 16);
        if (paired && wave == partner) { const int rows2[2] = {(bid * tpb + partner) * 16, rb}; n2_tiles<2>(a, l, rows2, r8, lds, lane, wave); tl = tpb; }
    }
#pragma nounroll
    for (; tl < tpb; tl += NWAVES) {
        if (paired && tl == NWAVES) continue;
        const int row0 = (bid * tpb + tl) * 16; const int b = row0 / TB, s0 = row0 - b * TB; const bool isctx = s0 < CTX;
        if (skipctx && isctx) continue;
        const int rows1[1] = {row0}; n2_tiles<1>(a, l, rows1, isctx ? 16 : b, lds, lane, wave);
    }
    __syncthreads();
    if (tid < 32) { const unsigned n = lcnt[tid]; const unsigned base = __hip_atomic_fetch_add(CNT + tid, n, RLX_AGENT); ((unsigned*)(ws + WS_BASE))[bid * 32 + tid] = base; }
    __syncthreads();
}

__device__ __forceinline__ void build_expert_tables(CArgs ap, int l, LAS unsigned char* lds, int tid) {
    CA& a = *ap;
    if (tid == 0) { const unsigned* CNT = (const unsigned*)(a.ws + WS_CTL) + CW_CNT + l * 32; LAS int* pads = (LAS int*)(lds + PADS_OFF); LAS unsigned char* te = lds + TILE_E_OFF;
        int t = 0;
#pragma nounroll
        for (int e = 0; e < 32; ++e) { const int c = (int)__hip_atomic_load(CNT + e, RLX_AGENT); const int nt = (c + 255) >> 8; pads[e] = t * 256;
#pragma nounroll
            for (int i = 0; i < nt; ++i) te[t + i] = (unsigned char)e;
            t += nt; }
        pads[32] = t; }
    __syncthreads();
}

__device__ __forceinline__ void phase_moe_prep(CArgs ap, int l, LAS unsigned char* lds, int tid, int lane, int gw, int NGW) {
    CA& a = *ap;
    unsigned char* ws = a.ws;
    build_expert_tables(ap, l, lds, tid);
    const LAS int* pads = (const LAS int*)(lds + PADS_OFF);
    int* SLOT = (int*)(ws + WS_SLOT); const unsigned* BASE = (const unsigned*)(ws + WS_BASE); int* STOK = (int*)(ws + WS_STOK) + (size_t)l * MAX_SLOTS;
    const unsigned rpw = (unsigned)(T / (NGW >> 3));
    for (int row = gw * 64 + lane; row < T; row += NGW * 64) {
        if (l == DEPTH - 1 && (row % TB) < CTX) continue;
        const int4 sl = *(const int4*)(SLOT + (size_t)row * 4);
        const unsigned pk[4] = {(unsigned)sl.x, (unsigned)sl.y, (unsigned)sl.z, (unsigned)sl.w}; int st[4];
#pragma unroll
        for (int k = 0; k < 4; ++k) st[k] = pads[pk[k] >> 24] + (int)BASE[((unsigned)row / rpw) * 32 + (pk[k] >> 24)] + (int)(pk[k] & 0xffffffu);
        *(int4*)(SLOT + (size_t)row * 4) = make_int4(st[0], st[1], st[2], st[3]);
#pragma unroll
        for (int k = 0; k < 4; ++k) __hip_atomic_store(STOK + st[k], row, RLX_AGENT);
    }
}


constexpr int PH_PER_LAYER = 11, NPHASES = 1 + DEPTH * PH_PER_LAYER + 1;
__global__ void __launch_bounds__(NTHREADS, 2) fwd(Args args) {
    extern __shared__ __attribute__((aligned(16))) unsigned char lds_raw[];
    volatile LAS unsigned* MISC = (volatile LAS unsigned*)((LAS unsigned char*)lds_raw + MISC_OFF);
    if (threadIdx.x < 64) MISC[threadIdx.x] = 0u;
    __syncthreads();
    const int lo = args.ph_lo, hi = args.ph_hi;
    const int wave_s = __builtin_amdgcn_readfirstlane(threadIdx.x >> 6);
#if MK_ONE_LAUNCH
    (void)xcd_barrier_post((unsigned*)(args.ws + WS_CTL) + CW_BAR, MISC + 8);
#ifndef PROBE_GEMM
#define PROBE_GEMM 0
#endif
#define PROBE_GCOPY(id_) do { if (PROBE_GEMM != 0 && (PROBE_GEMM == (id_) || (PROBE_GEMM == 2 && (id_) == 1))) { if (blockIdx.x == PROBE_GBLK && threadIdx.x == 0) { for (int i_ = 0; i_ < 3; ++i_) __hip_atomic_store((unsigned long long*)(get_args()->ws + WS_CTL) + CW_TS / 2 + 128 + 20 + i_, *(volatile LAS unsigned long long*)((LAS unsigned char*)lds_raw + SCR_OFF + 8 * i_), RLX_AGENT); } } } while (0)
#define SEAM(k) do { if ((k) + 1 < hi) { CArgs ap_ = get_args(); XcdBarrier b_; b_.bar = (unsigned*)(ap_->ws + WS_CTL) + CW_BAR; b_.x = xb_xcc_id(); \
        LAS unsigned char* l_ = (LAS unsigned char*)lds_raw; asm volatile("" : "+s"(l_)); b_.st = (volatile LAS unsigned*)(l_ + MISC_OFF) + 8; \
        unsigned z2_ = 0u; asm volatile("" : "+s"(z2_)); const int ln_ = (int)__builtin_amdgcn_mbcnt_hi(~0u, __builtin_amdgcn_mbcnt_lo(~0u, z2_)); \
        xcd_barrier(b_, wave_s == 0 && ln_ == 0); PROBE_STAMP((k) + 1); } } while (0)
#else
#define SEAM(k) do { } while (0)
#endif
#ifndef DBG_MASK
#define DBG_MASK 0xFFFFu
#endif
#ifndef DBGD
#define DBGD DEPTH
#endif
#define EN(j) (((DBG_MASK) >> (j)) & 1u)
#define IN(k) (lo <= (k) && (k) < hi)
#ifndef PROBE_MASK
#define PROBE_MASK 0
#endif
#ifndef PROBE_FACTOR
#define PROBE_FACTOR 4
#endif
#define PROBE_STAMP(idx) do { if (PROBE_MASK) { if (blockIdx.x == 0 && wave_s == 0) { CArgs apz_ = get_args(); unsigned long long* ts_ = (unsigned long long*)(apz_->ws + WS_CTL) + CW_TS / 2; \
        const unsigned long long now_ = __builtin_amdgcn_s_memrealtime(); if (__builtin_amdgcn_mbcnt_lo(~0u, 0u) == 0u && __builtin_amdgcn_mbcnt_hi(~0u, 0u) == 0u) __hip_atomic_store(ts_ + (idx), now_, RLX_AGENT); } } } while (0)
#define PHASE_CTX() CArgs ap = get_args(); unsigned char* ws = ap->ws; (void)ws; \
    LAS unsigned char* lds = (LAS unsigned char*)lds_raw; asm volatile("" : "+s"(lds)); (void)lds; \
    int wave = wave_s; asm volatile("" : "+s"(wave)); unsigned zero_ = 0u; asm volatile("" : "+s"(zero_)); const int lane = (int)__builtin_amdgcn_mbcnt_hi(~0u, __builtin_amdgcn_mbcnt_lo(~0u, zero_)); const int tid = wave * 64 + lane; (void)tid; \
    int bid = blockIdx.x; asm volatile("" : "+s"(bid)); int G = gridDim.x; asm volatile("" : "+s"(G)); \
    const int gw = bid * NWAVES + wave, NGW = G * NWAVES, gws = wave * G + bid; (void)gw; (void)NGW; (void)gws


    PROBE_STAMP(0);
    if (EN(11) && IN(0)) { PHASE_CTX(); phase_prologue(ap, lds, tid, lane, wave, bid, G); SEAM(0); }

    for (int l = 0; l < DBGD; ++l) {
        const int pb = 1 + PH_PER_LAYER * l;
        if (EN(0) && IN(pb + 0)) { PHASE_CTX(); build_gc(ap, l, bid * NTHREADS + tid, G * NTHREADS); if (l == 0) phase_n1<0>(ap, l, lane, gw, NGW); else phase_n1<1>(ap, l, lane, gw, NGW); SEAM(pb + 0); }
        if (EN(1) && IN(pb + 1)) {
            { PHASE_CTX();
              pg8::Gemm g{(const bf16*)(ws + WS_H), (const bf16*)(ws + WS_WIN) + (size_t)l * 1792 * D, T, 1792, D}; pg8::StaticOrder S; S.init(T, 1792, G, bid);
              pg8::EpiPlain E{(bf16*)(ws + WS_PROJ), DIN};
              pg8::gemm_phase<pg8::EpiPlain, pg8::StaticOrder, true, true>(lds, g, S, E, tid); }
            { PHASE_CTX();
              pg8::Gemm g{(const bf16*)(ws + WS_H8), (const bf16*)(ws + WS_WIN8 + (size_t)l * 3072 * D), T, 3072, D / 2}; pg8::StaticOrder S; S.init(T, 3072, G, bid);
              pg8::EpiGate8 E{(unsigned char*)(ws + WS_G8), 3072};
              pg8::gemm_phase<pg8::EpiGate8, pg8::StaticOrder, true, true>((LAS unsigned char*)lds_raw, g, S, E, tid); }
            PROBE_GCOPY(1);
            SEAM(pb + 1);
        }
        if (EN(2) && IN(pb + 2)) { PHASE_CTX();
            PROBE_SUB(ws, tid, 8);
            for (int blk = bid; blk < 256; blk += G) { s5a_block(ap, l, blk, lds, tid, lane, wave); PROBE_SUB(ws, tid, 9); if (wave < 2) s5b_unit(ap, l, (blk >> 4) | (wave << 4) | ((blk & 15) << 5), lane); }
            PROBE_SUB(ws, tid, 10);
            if (wave >= 2) { const int gw6 = bid * 6 + (wave - 2), NGW6 = G * 6;
                PROBE_SUB(ws, tid - 128, 14);
                phase_prep(ap, l, lane, gw6, NGW6);
                PROBE_SUB(ws, tid - 128, 15);
                for (int it = gw6; it < 1152; it += NGW6) vt_item(ap, it, lane);
                PROBE_SUB(ws, tid - 128, 16); }
            SEAM(pb + 2);
        }
        if (EN(3) && IN(pb + 3)) { PHASE_CTX();
            PROBE_SUB(ws, tid, 3);
            for (int blk = bid; blk < 256; blk += G) s5c_block(ap, l, blk, lds, tid, lane, wave);
            PROBE_SUB(ws, tid, 4);
            const bool xsw = (G == 256); const int xcd = bid & 7, jx = bid >> 3;
            const int nit = xsw ? 2 : (4096 - gw + NGW - 1) / NGW;
            if (wave < 4 && l < DEPTH - 1) __builtin_amdgcn_s_setprio(1);
#pragma nounroll
            for (int k = 0; k < nit; ++k) attn_item<2>(ap, l, true, xsw ? (((2 * xcd + k) << 8) | (jx * 8 + wave)) : gw + k * NGW, lane);
            PROBE_SUB(ws, tid, 5);
            if (wave < 4 && l < DEPTH - 1) {
                const int lc = jx * 4 + wave, nic = xsw ? 1 : (1024 - (bid * 4 + wave) + G * 4 - 1) / (G * 4);
#pragma nounroll
                for (int k = 0; k < nic; ++k) attn_item<1>(ap, l, false, xsw ? (((2 * xcd + (lc >> 6)) << 6) | (lc & 63)) : bid * 4 + wave + k * G * 4, lane); }
            __builtin_amdgcn_s_setprio(0);
            PROBE_SUB(ws, tid, 6);
            SEAM(pb + 3);
        }
        if (EN(4) && IN(pb + 4)) {
            { PHASE_CTX(); pg8::RowOrder S; S.lat = (l == DEPTH - 1); S.init(S.lat ? NB * SEQ : T, D, G, bid);
              pg8::Gemm g{(const bf16*)(ws + WS_YB), (const bf16*)(ws + WS_WCO) + (size_t)l * D * 256, T, D, 256};
              pg8::EpiBranch<true> E{(const unsigned char*)(ws + WS_G8) + D, (bf16*)(ws + WS_MM)}; pg8::gemm_phase<pg8::EpiBranch<true>, pg8::RowOrder, true, false>(lds, g, S, E, tid); }
            { PHASE_CTX(); pg8::RowOrder S; S.lat = (l == DEPTH - 1); S.rev = 1; S.init(S.lat ? NB * SEQ : T, D, G, bid);
              pg8::Gemm g{(const bf16*)(ws + WS_YA), (const bf16*)(ws + WS_WAO) + (size_t)l * D * 512, T, D, 512};
              pg8::EpiBranch<false> E{(const unsigned char*)(ws + WS_G8) + 2 * D, (bf16*)(ws + WS_MM)}; pg8::gemm_phase<pg8::EpiBranch<false>, pg8::RowOrder, true, true>(lds, g, S, E, tid); }
            { PHASE_CTX();
              const int cg = (bid + G - (G >> 2)) % G;
              pg8::Gemm g{(const bf16*)(ws + WS_Z), (const bf16*)(ws + WS_WGLU) + (size_t)l * 256 * 256, T, 256, 256}; pg8::RowOrder S; S.lat = (l == DEPTH - 1); S.init(S.lat ? NB * SEQ : T, 256, G, cg);
              pg8::EpiGlu E{(const bf16*)(ws + WS_Z), (bf16*)(ws + WS_Z2), 256};
              pg8::gemm_phase<pg8::EpiGlu, pg8::RowOrder, true, true>(lds, g, S, E, tid); }
            PROBE_GCOPY(3);
            SEAM(pb + 4);
        }
        if (EN(5) && IN(pb + 5)) {
            { PHASE_CTX(); pg8::RowOrder S; S.lat = (l == DEPTH - 1); S.init(S.lat ? NB * SEQ : T, D, G, bid);
              pg8::Gemm g{(const bf16*)(ws + WS_Z2), (const bf16*)(ws + WS_WSO) + (size_t)l * D * 256, T, D, 256};
              pg8::EpiBranch<false> E{(const unsigned char*)(ws + WS_G8), (bf16*)(ws + WS_MM)}; pg8::gemm_phase<pg8::EpiBranch<false>, pg8::RowOrder, true, true>(lds, g, S, E, tid); }
            PROBE_GCOPY(4);
            SEAM(pb + 5);
        }
        if (EN(6) && IN(pb + 6)) { PHASE_CTX();
            pg8::Gemm g{(const bf16*)(ws + WS_MM), (const bf16*)(ws + WS_WO) + (size_t)l * D * D, T, D, D}; pg8::RowOrder S; S.lat = (l == DEPTH - 1); S.init(S.lat ? NB * SEQ : T, D, G, bid);
            pg8::EpiWo E{(bf16*)(ws + WS_X), (const float*)(ws + WS_MOD) + (size_t)l * 17 * 6144 + 2048};
            pg8::gemm_phase<pg8::EpiWo, pg8::RowOrder, true, true>(lds, g, S, E, tid);
            PROBE_GCOPY(5);
            SEAM(pb + 6);
        }
        if (EN(7) && IN(pb + 7)) { PHASE_CTX(); phase_n2(ap, l, lds, tid, lane, wave, bid, G); SEAM(pb + 7); }
        if (EN(8) && IN(pb + 8)) { PHASE_CTX(); phase_moe_prep(ap, l, lds, tid, lane, gw, NGW); SEAM(pb + 8); }
        if (EN(9) && IN(pb + 9)) { PHASE_CTX();
            build_expert_tables(ap, l, lds, tid);
            const int nt = ((const LAS int*)(lds + PADS_OFF))[32];
            pg8::Gemm g{(const bf16*)(ws + WS_H8), (const bf16*)(ws + WS_WGU + (size_t)l * 32 * 2048 * 1024), nt * 256, 2048, 512};
            pg8::MoeGatherOrder S{{8, nt * 8, G, bid, lds + TILE_E_OFF, (size_t)2048 * 1024}, (const int*)(ws + WS_STOK) + (size_t)l * MAX_SLOTS};
            pg8::EpiSwiglu E{(unsigned char*)(ws + WS_ACT), ap->in[I_BGU] + (size_t)l * 32 * 2048, lds + TILE_E_OFF};
            pg8::gemm_phase<pg8::EpiSwiglu, pg8::MoeGatherOrder, true, false>((LAS unsigned char*)lds_raw, g, S, E, tid);
            PROBE_GCOPY(6);
            SEAM(pb + 9);
        }
        if (EN(10) && IN(pb + 10)) { PHASE_CTX();
            build_expert_tables(ap, l, lds, tid);
            const int nt = ((const LAS int*)(lds + PADS_OFF))[32];
            pg8::Gemm g{(const bf16*)(ws + WS_ACT), (const bf16*)(ws + WS_WD + (size_t)l * 32 * 1024 * 1024), nt * 256, 1024, 512};
            pg8::MoeOrder S{4, nt * 4, G, bid, lds + TILE_E_OFF, (size_t)1024 * 1024};
            pg8::EpiDown E{(unsigned char*)(ws + WS_YS8), ap->in[I_BD] + (size_t)l * 32 * 1024, lds + TILE_E_OFF};
            pg8::gemm_phase<pg8::EpiDown, pg8::MoeOrder, true, true>((LAS unsigned char*)lds_raw, g, S, E, tid);
            PROBE_GCOPY(7);
            SEAM(pb + 10);
        }
    }
    if (EN(12) && IN(NPHASES - 1)) { PHASE_CTX(); phase_n1<2>(ap, DEPTH, lane, gw, NGW); }
    if (PROBE_MASK || PROBE_SUB_A >= 0) { if (blockIdx.x == 0 && wave_s == 0) { CArgs apz_ = get_args(); unsigned long long* ts_ = (unsigned long long*)(apz_->ws + WS_CTL) + CW_TS / 2;
        asm volatile("s_waitcnt vmcnt(0)" ::: "memory");
        const unsigned long long t_end = __builtin_amdgcn_s_memrealtime(); unsigned long long sum = 0;
        for (int k2 = 0; k2 < NPHASES; ++k2) { const int cls = k2 == 0 ? 0 : (k2 == NPHASES - 1 ? 13 : 1 + (k2 - 1) % PH_PER_LAYER);
            const unsigned long long t0 = __hip_atomic_load(ts_ + k2, RLX_AGENT), t1 = (k2 == NPHASES - 1) ? t_end : __hip_atomic_load(ts_ + k2 + 1, RLX_AGENT);
            if ((PROBE_MASK >> cls) & 1) sum += t1 - t0; }
        if (PROBE_SUB_A >= 0) sum = (unsigned long long)PROBE_SUBF * (__hip_atomic_load(ts_ + 128 + (PROBE_SUB_B < 0 ? 0 : PROBE_SUB_B), RLX_AGENT) - __hip_atomic_load(ts_ + 128 + (PROBE_SUB_A < 0 ? 0 : PROBE_SUB_A), RLX_AGENT)) / PROBE_FACTOR;
        while (__builtin_amdgcn_s_memrealtime() - t_end < (unsigned long long)PROBE_FACTOR * sum) __builtin_amdgcn_s_sleep(8); } }
#undef IN
#undef SEAM
}

extern "C" void kernel_launch(void* const* d_in, const int* in_sizes, int n_in, void* d_out, int out_size, void* d_ws, size_t ws_size, hipStream_t stream) {
    static int grid = 0;
    if (grid == 0) {
        if (n_in != N_IN || out_size != NB * SEQ * D || ws_size < WS_END) { fprintf(stderr, "kernel_launch: unexpected sizes (n_in %d out %d ws %zu, need %zu)\n", n_in, out_size, ws_size, (size_t)WS_END); grid = -1; return; }
        int dev = 0, cus = 0, per_cu = 0;
        if (hipGetDevice(&dev) != hipSuccess || hipDeviceGetAttribute(&cus, hipDeviceAttributeMultiprocessorCount, dev) != hipSuccess) { grid = -1; return; }
        if (hipFuncSetAttribute((const void*)fwd, hipFuncAttributeMaxDynamicSharedMemorySize, LDS_BYTES) != hipSuccess) { fprintf(stderr, "kernel_launch: hipFuncSetAttribute failed\n"); grid = -1; return; }
        if (hipOccupancyMaxActiveBlocksPerMultiprocessor(&per_cu, (const void*)fwd, NTHREADS, LDS_BYTES) != hipSuccess || per_cu < 1) { fprintf(stderr, "kernel_launch: occupancy query says %d\n", per_cu); }
        (void)hipGetLastError();
        grid = cus;
    }
    if (grid < 0) return;
    if (hipMemsetAsync((char*)d_ws + WS_CTL, 0, CTL_ZERO_BYTES, stream) != hipSuccess) return;
    Args a{};
    for (int i = 0; i < N_IN; ++i) a.in[i] = (const float*)d_in[i];
    a.out = (float*)d_out; a.ws = (unsigned char*)d_ws;
#if MK_ONE_LAUNCH
    a.ph_lo = 0; a.ph_hi = NPHASES;
    hipLaunchKernelGGL(fwd, dim3(grid), dim3(NTHREADS), LDS_BYTES, stream, a);
#else
    for (int p = 0; p < NPHASES; ++p) { a.ph_lo = p; a.ph_hi = p + 1; hipLaunchKernelGGL(fwd, dim3(grid), dim3(NTHREADS), LDS_BYTES, stream, a); }
#endif
}
```
